# Optimizing an MI355X kernel written in HIP

```python
import math
import jax, jax.numpy as jnp
from jax import lax
import numpy as np

D_MODEL = 2048
BATCH = 2
SEQ = 4096
DEPTH = 1

HG_HEADS = 8
HG_DK = 128
HG_DV = 128
HG_CHUNK = 64
ATT_HEADS = 8
ATT_KV_HEADS = 2
HEAD_DIM = 128
WINDOW = 128
ATT_BLOCK = 128
ROPE_THETA = 10000.0
N_EXPERTS = 16
EXPERT_FF = 1024
CAPACITY_FACTOR = 2
NORM_EPS = 1e-6

HG_QK = HG_HEADS * HG_DK
HG_V = HG_HEADS * HG_DV
ATT_Q = ATT_HEADS * HEAD_DIM
ATT_KV = ATT_KV_HEADS * HEAD_DIM
IN_SPLITS = (HG_QK, HG_QK, HG_QK, HG_V, HG_V, ATT_Q, ATT_KV, ATT_KV, D_MODEL, D_MODEL)
IN_WIDTH = 5 * 1024 + 1024 + 256 + 256 + 2 * D_MODEL

kernel_name = "hybrid_hgrn2_swa_ecmoe_block"


def rmsnorm(x, g):
    xf = x.astype(jnp.float32)
    y = xf * lax.rsqrt(jnp.mean(xf * xf, axis=-1, keepdims=True) + NORM_EPS)
    return y.astype(x.dtype) * g


def to_heads(t, n):
    b, s, _ = t.shape
    return t.reshape(b, s, n, -1).transpose(0, 2, 1, 3)


def hgrn2_scan(q, k, v, log_f):
    B, H, S, DK = q.shape
    DV = v.shape[-1]
    L = HG_CHUNK
    N = S // L
    rs = lambda t: t.astype(jnp.float32).reshape(B, H, N, L, t.shape[-1])
    q, k, v, log_f = rs(q), rs(k), rs(v), rs(log_f)
    b = jnp.cumsum(log_f, axis=3)
    b_ref = b[..., L // 2:L // 2 + 1, :]
    q_in = q * jnp.exp(b - b_ref)
    k_in = k * jnp.exp(b_ref - b)
    causal_in_chunk = jnp.tril(jnp.ones((L, L), dtype=bool))
    a = jnp.einsum('bhnld,bhnmd->bhnlm', q_in, k_in)
    a = jnp.where(causal_in_chunk, a, 0.0)
    o_intra = jnp.einsum('bhnlm,bhnmv->bhnlv', a, v)
    b_last = b[..., -1:, :]
    chunk_state = jnp.einsum('bhnld,bhnlv->bhndv', k * jnp.exp(b_last - b), v)
    chunk_decay = jnp.exp(b_last[..., 0, :])

    def step(s_prev, inp):
        dec, cs = inp
        return dec[..., None] * s_prev + cs, s_prev

    _, s_prevs = lax.scan(step, jnp.zeros((B, H, DK, DV), jnp.float32),
                          (jnp.moveaxis(chunk_decay, 2, 0), jnp.moveaxis(chunk_state, 2, 0)))
    s_prevs = jnp.moveaxis(s_prevs, 0, 2)
    o_inter = jnp.einsum('bhnld,bhndv->bhnlv', q * jnp.exp(b), s_prevs)
    return (o_intra + o_inter).reshape(B, H, S, DV)


def rope(x, pos):
    half = x.shape[-1] // 2
    inv = ROPE_THETA ** (-jnp.arange(half, dtype=jnp.float32) / half)
    ang = pos[:, None, :, None].astype(jnp.float32) * inv
    cos, sin = jnp.cos(ang), jnp.sin(ang)
    xf = x.astype(jnp.float32)
    x1, x2 = xf[..., :half], xf[..., half:]
    return jnp.concatenate([x1 * cos - x2 * sin, x1 * sin + x2 * cos], axis=-1).astype(x.dtype)


def window_attention(q, k, v, sink):
    B, HQ, S, Dh = q.shape
    HKV = k.shape[1]
    G = HQ // HKV
    Bk = ATT_BLOCK
    NB = S // Bk
    qb = q.reshape(B, HKV, G, NB, Bk, Dh).astype(jnp.float32)
    pad = ((0, 0), (0, 0), (Bk, Bk), (0, 0))
    kp = jnp.pad(k, pad).reshape(B, HKV, NB + 2, Bk, Dh)
    vp = jnp.pad(v, pad).reshape(B, HKV, NB + 2, Bk, Dh)
    kb = jnp.concatenate([kp[:, :, :-2], kp[:, :, 1:-1], kp[:, :, 2:]], axis=3)
    vb = jnp.concatenate([vp[:, :, :-2], vp[:, :, 1:-1], vp[:, :, 2:]], axis=3)
    s = jnp.einsum('bhgnqd,bhnkd->bhgnqk', qb, kb.astype(jnp.float32)) * (Dh ** -0.5)
    qi = jnp.arange(Bk)[:, None]
    kj = jnp.arange(3 * Bk)[None, :]
    band = jnp.abs(kj - Bk - qi) <= WINDOW
    key_pos = jnp.arange(NB)[:, None] * Bk - Bk + jnp.arange(3 * Bk)[None, :]
    in_range = (key_pos >= 0) & (key_pos < S)
    mask = band[None] & in_range[:, None, :]
    s = jnp.where(mask, s, -jnp.inf)
    sk = sink.astype(jnp.float32).reshape(1, HKV, G, 1, 1, 1)
    m = jnp.maximum(jnp.max(s, axis=-1, keepdims=True), sk)
    p = jnp.exp(s - m)
    denom = jnp.sum(p, axis=-1, keepdims=True) + jnp.exp(sk - m)
    o = jnp.einsum('bhgnqk,bhnkd->bhgnqd', p, vb.astype(jnp.float32)) / denom
    o = o.reshape(B, HQ, S, Dh).astype(q.dtype)
    return o.transpose(0, 2, 1, 3).reshape(B, S, HQ * Dh)


def hybrid_mixer(h, positions, w_in, lb, hg_out_norm, attn_sink, w_branch_a, w_branch_b, w_out):
    B, S, _ = h.shape
    proj = h @ w_in
    offsets = [int(o) for o in np.cumsum(IN_SPLITS)[:-1]]
    hq, hf_f, hf_b, hi, hg, aq, ak, av, gate_a, gate_b = jnp.split(proj, offsets, axis=-1)

    q = jax.nn.silu(to_heads(hq, HG_HEADS))
    v = to_heads(hi, HG_HEADS)

    def forget(z, lb_d):
        lb_h = lb_d.reshape(HG_HEADS, 1, HG_DK)
        return lb_h + (1.0 - lb_h) * jax.nn.sigmoid(to_heads(z, HG_HEADS).astype(jnp.float32))

    f_fwd = forget(hf_f, lb[0])
    f_bwd = forget(hf_b, lb[1])
    o_f = hgrn2_scan(q, 1.0 - f_fwd, v, jnp.log(f_fwd))
    flip = lambda t: jnp.flip(t, axis=2)
    o_b = flip(hgrn2_scan(flip(q), flip(1.0 - f_bwd), flip(v), flip(jnp.log(f_bwd))))
    o = (o_f + o_b).astype(h.dtype)
    o = rmsnorm(o, hg_out_norm[:, None, :]) * jax.nn.silu(to_heads(hg, HG_HEADS))
    y_a = o.transpose(0, 2, 1, 3).reshape(B, S, HG_V) @ w_branch_a

    qa = rope(to_heads(aq, ATT_HEADS), positions)
    ka = rope(to_heads(ak, ATT_KV_HEADS), positions)
    va = to_heads(av, ATT_KV_HEADS)
    y_b = window_attention(qa, ka, va, attn_sink) @ w_branch_b

    merged = jax.nn.sigmoid(gate_a) * y_a + jax.nn.sigmoid(gate_b) * y_b
    return merged @ w_out


def expert_choice_ffn(h, w_router, w_gate, w_up, w_down):
    B, T, D = h.shape
    C = CAPACITY_FACTOR * T // N_EXPERTS
    logits = jnp.einsum('btd,de->bte', h.astype(jnp.float32), w_router.astype(jnp.float32))
    aff = jax.nn.softmax(logits, axis=-1)
    top_aff, top_idx = lax.top_k(jnp.swapaxes(aff, 1, 2), C)
    xe = jax.vmap(lambda hb, ib: hb[ib])(h, top_idx)
    g = jnp.einsum('becd,edf->becf', xe, w_gate)
    u = jnp.einsum('becd,edf->becf', xe, w_up)
    y = jnp.einsum('becf,efd->becd', jax.nn.silu(g) * u, w_down)
    y = y * top_aff[..., None].astype(y.dtype)
    return jax.vmap(lambda ib, yb: jnp.zeros((T, D), yb.dtype).at[ib.reshape(-1)].add(yb.reshape(-1, D)))(top_idx, y)


def setup_inputs(seed: int = 0) -> dict:
    key = jax.random.key(seed)
    ks = jax.random.split(key, 24)
    f32 = jnp.float32
    nrm = lambda k, shape, scale: jax.random.normal(k, shape, f32) * scale
    gain = lambda k, shape: 1.0 + 0.02 * jax.random.normal(k, shape, f32)
    D = D_MODEL
    return {
        "x": nrm(ks[0], (BATCH, SEQ, D), 1.0),
        "c": nrm(ks[1], (BATCH, D), 1.0),
        "positions": jnp.broadcast_to(jnp.arange(SEQ, dtype=jnp.int32), (BATCH, SEQ)),
        "w_ada": nrm(ks[2], (DEPTH, D, 6 * D), 0.5 * D ** -0.5),
        "b_ada": nrm(ks[3], (DEPTH, 6 * D), 0.02),
        "g_pre_mix": gain(ks[4], (DEPTH, D)),
        "g_post_mix": gain(ks[5], (DEPTH, D)),
        "g_pre_ffn": gain(ks[6], (DEPTH, D)),
        "g_post_ffn": gain(ks[7], (DEPTH, D)),
        "w_in": nrm(ks[8], (DEPTH, D, IN_WIDTH), D ** -0.5),
        "hg_lb_logits": nrm(ks[9], (2, DEPTH + 1, HG_QK), 0.1),
        "hg_out_norm": gain(ks[10], (DEPTH, HG_HEADS, HG_DV)),
        "attn_sink": nrm(ks[11], (DEPTH, ATT_HEADS), 0.5),
        "w_branch_a": nrm(ks[12], (DEPTH, HG_V, D), HG_V ** -0.5),
        "w_branch_b": nrm(ks[13], (DEPTH, ATT_Q, D), ATT_Q ** -0.5),
        "w_out": nrm(ks[14], (DEPTH, D, D), D ** -0.5),
        "w_router": nrm(ks[15], (DEPTH, D, N_EXPERTS), D ** -0.5),
        "w_exp_gate": nrm(ks[16], (DEPTH, N_EXPERTS, D, EXPERT_FF), D ** -0.5),
        "w_exp_up": nrm(ks[17], (DEPTH, N_EXPERTS, D, EXPERT_FF), D ** -0.5),
        "w_exp_down": nrm(ks[18], (DEPTH, N_EXPERTS, EXPERT_FF, D), EXPERT_FF ** -0.5),
    }


def reference(x, c, positions, w_ada, b_ada, g_pre_mix, g_post_mix, g_pre_ffn, g_post_ffn,
              w_in, hg_lb_logits, hg_out_norm, attn_sink, w_branch_a, w_branch_b, w_out,
              w_router, w_exp_gate, w_exp_up, w_exp_down):
    lb_all = jnp.cumsum(jax.nn.softmax(hg_lb_logits.astype(jnp.float32), axis=1), axis=1)
    for layer in range(DEPTH):
        mod = jax.nn.silu(c) @ w_ada[layer] + b_ada[layer]
        sh1, sc1, gt1, sh2, sc2, gt2 = jnp.split(mod[:, None, :], 6, axis=-1)
        h = rmsnorm(x, g_pre_mix[layer]) * (1.0 + sc1) + sh1
        y = hybrid_mixer(h, positions, w_in[layer], lb_all[:, layer], hg_out_norm[layer],
                         attn_sink[layer], w_branch_a[layer], w_branch_b[layer], w_out[layer])
        x = x + gt1 * rmsnorm(y, g_post_mix[layer])
        h = rmsnorm(x, g_pre_ffn[layer]) * (1.0 + sc2) + sh2
        y = expert_choice_ffn(h, w_router[layer], w_exp_gate[layer], w_exp_up[layer], w_exp_down[layer])
        x = x + gt2 * rmsnorm(y, g_post_ffn[layer])
    return x
```

```cpp
#include <hip/hip_runtime.h>
#include <cstdint>
#include <cstdio>

constexpr int D = 2048, BATCH = 2, SEQ = 4096, T = BATCH * SEQ;
constexpr int INW = 10752;
constexpr int C_HQ = 0, C_FF = 1024, C_FB = 2048, C_HI = 3072, C_HG = 4096, C_AQ = 5120, C_AK = 6144, C_AV = 6400, C_GA = 6656, C_GB = 8704;
constexpr int NE = 16, EFF = 1024, CAP = 512;
constexpr float EPS = 1e-6f;

typedef unsigned short bf16;
__device__ __forceinline__ float bf2f(bf16 v) { return __uint_as_float(((unsigned)v) << 16); }
typedef float f32x2h_t __attribute__((ext_vector_type(2))); typedef __bf16 bf16x2h_t __attribute__((ext_vector_type(2)));
__device__ __forceinline__ unsigned cvtpk2(float lo, float hi) { const f32x2h_t v = {lo, hi}; const bf16x2h_t b = __builtin_convertvector(v, bf16x2h_t); return __builtin_bit_cast(unsigned, b); }
__device__ __forceinline__ bf16 f2bf(float f) { return (bf16)(cvtpk2(f, 0.f) & 0xffffu); }
__device__ __forceinline__ float sigmoidf_(float x) { return __builtin_amdgcn_rcpf(1.f + __expf(-x)); }
__device__ __forceinline__ float siluf_(float x) { return x * __builtin_amdgcn_rcpf(1.f + __expf(-x)); }

constexpr size_t MiB = 1u << 20;
constexpr size_t WS_CTL = 0, CTL_ZERO_BYTES = 64 * 1024;
constexpr size_t WS_MOD = 1 * MiB;
constexpr size_t WS_LB = WS_MOD + 128 * 1024;
constexpr size_t WS_AFF = 2 * MiB;
constexpr size_t WS_GIDX = 3 * MiB;
constexpr size_t WS_SELAFF = WS_GIDX + 128 * 1024;
constexpr size_t WS_TOKSLOT = 4 * MiB;
constexpr size_t WS_DEC = 5 * MiB;
constexpr size_t WS_ROPE = 8 * MiB;
constexpr size_t WS_WIN = 16 * MiB;
constexpr size_t WS_WA = 60 * MiB, WS_WB = 64 * MiB, WS_WO = 68 * MiB;
constexpr size_t WS_WGU = 76 * MiB;
constexpr size_t WS_WD = 204 * MiB;
constexpr size_t WS_H = 268 * MiB;
constexpr size_t WS_PROJ = 300 * MiB;
constexpr size_t WS_Y = 520 * MiB;
constexpr size_t WS_XE = 300 * MiB;
constexpr size_t WS_ACT = 364 * MiB;
constexpr size_t WS_SLAB = 396 * MiB;
constexpr size_t WS_QR = 468 * MiB, WS_KR = 484 * MiB;
constexpr size_t WS_YAIN = 488 * MiB, WS_ATT = 504 * MiB;
constexpr size_t WS_CS = 520 * MiB;
constexpr size_t WS_STATE = 584 * MiB;
constexpr size_t WS_H2 = 584 * MiB;
constexpr size_t WS_MERGED = 268 * MiB;
constexpr size_t WS_END = 648 * MiB;
constexpr int CW_BAR = 4096;

namespace pg8 {
#define PG8_LAS __attribute__((address_space(3)))
typedef unsigned short bf16_t;
typedef short bf16x8 __attribute__((ext_vector_type(8)));
typedef float f32x4 __attribute__((ext_vector_type(4)));
typedef unsigned u32x4 __attribute__((ext_vector_type(4)));
constexpr int BM = 256, BK = 64, HALF = 128, HTB = HALF * BK * 2  , STAGE_BYTES = 8 * HTB, NXCD = 8, WGM = 8;

__host__ __device__ __forceinline__ int lds_byte(int r, int c) { const int st = (r >> 4) * 2 + (c >> 5), rr = r & 15, cc = c & 31, ob = rr * 64 + cc * 2; return st * 1024 + (ob ^ (((ob >> 9) & 1) << 5)); }
__host__ __device__ __forceinline__ void stage_rc(int b, int& R, int& C) { const int st = b / 1024, sb = b % 1024, swz = sb ^ (((sb >> 9) & 1) << 5); R = (st >> 1) * 16 + swz / 64; C = (st & 1) * 32 + (swz % 64) / 2; }
__host__ __device__ __forceinline__ int perm32(int rho) { const int n = rho >> 4, i = rho & 15; return 8 * (i >> 2) + 4 * n + (i & 3); }

struct Unit { int pm, pn; };
struct Gemm { const bf16_t* A; const bf16_t* Bt; int M, N, K; const int* gidx = nullptr; };

struct StaticOrder {
    int nM, nN, nwg, G, c;
    __host__ __device__ void init(int M, int N, int G_, int c_) { nM = M / BM; nN = N / BM; nwg = nM * nN; G = G_; c = c_; }
    __host__ __device__ bool next(int i, Unit& u) const {
        const long L = (long)i * G + c; if (L >= nwg) return false;
        int wgid = (int)L; { const int q = nwg / NXCD, r = nwg % NXCD, xcd = wgid % NXCD, off = wgid / NXCD; wgid = (xcd < r ? xcd * (q + 1) : r * (q + 1) + (xcd - r) * q) + off; }
        const int nig = WGM * nN, gid = wgid / nig, fm = gid * WGM, gsz = (nM - fm) < WGM ? (nM - fm) : WGM;
        u.pm = fm + ((wgid % nig) % gsz); u.pn = (wgid % nig) / gsz; return true;
    }
    __device__ __forceinline__ void a_ready(const Unit&) const {}
    __device__ __forceinline__ void done(const Unit&) const {}
};

typedef float f32x2c_t __attribute__((ext_vector_type(2))); typedef __bf16 bf16x2c_t __attribute__((ext_vector_type(2)));
__device__ __forceinline__ unsigned cvt_pk_bf16(float lo, float hi) { const f32x2c_t v = {lo, hi}; const bf16x2c_t b = __builtin_convertvector(v, bf16x2c_t); return __builtin_bit_cast(unsigned, b); }
typedef float f32x2 __attribute__((ext_vector_type(2)));

typedef unsigned u32x2 __attribute__((ext_vector_type(2)));
struct EpiStore {
    static constexpr bool PERM = true, AFTER_DRAIN = false;
    bf16_t* O; int ldc; int cmask; const float* rowscale;
    __device__ __forceinline__ void operator()(const f32x4 (&acc)[2][2][4][2], const Unit& u, int wr, int wc, int fr, int fq) const {
        const int row0 = u.pm * BM + wr * 64 + fr, col0 = (u.pn & cmask) * BM + wc * 32 + 8 * fq;
#pragma unroll
        for (int ai = 0; ai < 2; ++ai)
#pragma unroll
            for (int m = 0; m < 4; ++m) { const int row = row0 + ai * HALF + m * 16; const float sc = rowscale ? rowscale[row] : 1.f; bf16_t* rowp = O + (size_t)row * ldc + col0;
#pragma unroll
                for (int bj = 0; bj < 2; ++bj) { const f32x4 v0 = acc[ai][bj][m][0] * sc, v1 = acc[ai][bj][m][1] * sc;
                    u32x4 w; w.x = cvt_pk_bf16(v0[0], v0[1]); w.y = cvt_pk_bf16(v0[2], v0[3]); w.z = cvt_pk_bf16(v1[0], v1[1]); w.w = cvt_pk_bf16(v1[2], v1[3]);
                    *(u32x4*)(rowp + bj * HALF) = w; } }
    }
};
__device__ __forceinline__ float sigm(float x) { return __builtin_amdgcn_rcpf(1.f + __expf(-x)); }
struct EpiGate2 {
    static constexpr bool PERM = true, AFTER_DRAIN = false;
    bf16_t* O; int ldc; const bf16_t* Ga; const bf16_t* Gb; int ldg;
    __device__ __forceinline__ void operator()(const f32x4 (&acc)[2][2][4][2], const Unit& u, int wr, int wc, int fr, int fq) const {
        const bool second = u.pm >= 32; const bf16_t* G = second ? Gb : Ga;
        const int row0 = (u.pm & 31) * BM + wr * 64 + fr, col0 = (u.pn & 7) * BM + wc * 32 + 8 * fq;
#pragma unroll
        for (int ai = 0; ai < 2; ++ai)
#pragma unroll
            for (int m = 0; m < 4; ++m) { const int row = row0 + ai * HALF + m * 16;
#pragma unroll
                for (int bj = 0; bj < 2; ++bj) { const int col = col0 + bj * HALF;
                    const u32x4 g = *(const u32x4*)(G + (size_t)row * ldg + col);
                    float gg[8] = {__uint_as_float(g.x << 16), __uint_as_float(g.x & 0xffff0000u), __uint_as_float(g.y << 16), __uint_as_float(g.y & 0xffff0000u),
                                   __uint_as_float(g.z << 16), __uint_as_float(g.z & 0xffff0000u), __uint_as_float(g.w << 16), __uint_as_float(g.w & 0xffff0000u)};
                    float t[8] = {0.f, 0.f, 0.f, 0.f, 0.f, 0.f, 0.f, 0.f};
                    if (second) { const u32x4 q = *(const u32x4*)(O + (size_t)row * ldc + col);
                        t[0] = __uint_as_float(q.x << 16); t[1] = __uint_as_float(q.x & 0xffff0000u); t[2] = __uint_as_float(q.y << 16); t[3] = __uint_as_float(q.y & 0xffff0000u);
                        t[4] = __uint_as_float(q.z << 16); t[5] = __uint_as_float(q.z & 0xffff0000u); t[6] = __uint_as_float(q.w << 16); t[7] = __uint_as_float(q.w & 0xffff0000u); }
                    const f32x4 a0 = acc[ai][bj][m][0], a1 = acc[ai][bj][m][1];
                    float o[8];
#pragma unroll
                    for (int i = 0; i < 4; ++i) { o[i] = t[i] + sigm(gg[i]) * a0[i]; o[4 + i] = t[4 + i] + sigm(gg[4 + i]) * a1[i]; }
                    u32x4 w; w.x = cvt_pk_bf16(o[0], o[1]); w.y = cvt_pk_bf16(o[2], o[3]); w.z = cvt_pk_bf16(o[4], o[5]); w.w = cvt_pk_bf16(o[6], o[7]);
                    *(u32x4*)(O + (size_t)row * ldc + col) = w; } }
    }
};
struct BranchOrder {
    StaticOrder S;
    __device__ __forceinline__ bool next(int i, Unit& u) const { Unit t; if (!S.next(i >> 1, t)) return false; u.pm = t.pm + 32 * (i & 1); u.pn = t.pn + 8 * (i & 1); return true; }
    __device__ __forceinline__ void a_ready(const Unit&) const {}
    __device__ __forceinline__ void done(const Unit&) const {}
};
struct EpiF32 {
    static constexpr bool PERM = true, AFTER_DRAIN = false;
    float* O; int ldc;
    __device__ __forceinline__ void operator()(const f32x4 (&acc)[2][2][4][2], const Unit& u, int wr, int wc, int fr, int fq) const {
        const int row0 = u.pm * BM + wr * 64 + fr, col0 = u.pn * BM + wc * 32 + 8 * fq;
#pragma unroll
        for (int ai = 0; ai < 2; ++ai)
#pragma unroll
            for (int m = 0; m < 4; ++m) { float* rowp = O + (size_t)(row0 + ai * HALF + m * 16) * ldc + col0;
#pragma unroll
                for (int bj = 0; bj < 2; ++bj) { *(f32x4*)(rowp + bj * HALF) = acc[ai][bj][m][0]; *(f32x4*)(rowp + bj * HALF + 4) = acc[ai][bj][m][1]; } }
    }
};
struct EpiSwiglu {
    static constexpr bool PERM = true, AFTER_DRAIN = false;
    bf16_t* O;
    __device__ __forceinline__ void operator()(const f32x4 (&acc)[2][2][4][2], const Unit& u, int wr, int wc, int fr, int fq) const {
        const int row0 = u.pm * BM + wr * 64 + fr, col0 = (u.pn & 7) * HALF + wc * 32 + 8 * fq;
#pragma unroll
        for (int ai = 0; ai < 2; ++ai)
#pragma unroll
            for (int m = 0; m < 4; ++m) { bf16_t* rowp = O + (size_t)(row0 + ai * HALF + m * 16) * 1024 + col0;
                float o[8];
#pragma unroll
                for (int n = 0; n < 2; ++n)
#pragma unroll
                    for (int i = 0; i < 4; ++i) { const float g = acc[ai][0][m][n][i], up = acc[ai][1][m][n][i]; o[4 * n + i] = g * sigm(g) * up; }
                u32x4 w; w.x = cvt_pk_bf16(o[0], o[1]); w.y = cvt_pk_bf16(o[2], o[3]); w.z = cvt_pk_bf16(o[4], o[5]); w.w = cvt_pk_bf16(o[6], o[7]);
                *(u32x4*)rowp = w; }
    }
};
struct GroupedOrder {
    int G, c;
    __device__ __forceinline__ bool next(int i, Unit& u) const { const int L = i * G + c; if (L >= 512) return false; const int e = L >> 5, r = L & 31; u.pm = e * 4 + (r & 3); u.pn = e * 8 + (r >> 2); return true; }
    __device__ __forceinline__ void a_ready(const Unit&) const {}
    __device__ __forceinline__ void done(const Unit&) const {}
};

template <class Epi, class Sched, bool ALIGN_EPI = false, bool SP2 = false, bool GATHER = false>
__device__ __forceinline__ void gemm_phase(PG8_LAS unsigned char* lds, const Gemm g, const Sched& S, const Epi& E) {
    const int tid = threadIdx.x, wid = __builtin_amdgcn_readfirstlane(tid >> 6), lane = tid & 63, wr = wid >> 2, wc = wid & 3, fr = lane & 15, fq = lane >> 4;
    const int K = g.K, nt = K / BK;
    unsigned voffA[2], voffB[2]; int Rr[2], Cc[2];
#pragma unroll
    for (int i = 0; i < 2; ++i) { int R, C; stage_rc(tid * 16 + i * 8192, R, C); const int Rb = Epi::PERM ? ((R & ~31) + perm32(R & 31)) : R; Rr[i] = R; Cc[i] = C;
        voffA[i] = (unsigned)(R * K + C) * 2u; voffB[i] = (unsigned)(Rb * K + C) * 2u; }
    unsigned cv0[2], cv1[2], nv0[2], nv1[2], sv0[2], sv1[2];
#define PG8_GOFF(o0, o1, pm_) do { _Pragma("unroll") for (int _i = 0; _i < 2; ++_i) { \
        o0[_i] = (unsigned)(g.gidx[(pm_) * BM + Rr[_i]] * K + Cc[_i]) * 2u; o1[_i] = (unsigned)(g.gidx[(pm_) * BM + HALF + Rr[_i]] * K + Cc[_i]) * 2u; } } while (0)
    const size_t kstep = (size_t)(BK * 2);
    const size_t hstep = (size_t)HALF * K * 2;
    const size_t tstep = 2 * hstep;
    const unsigned ldsw = (unsigned)wid * 1024u;
    const int aoff = lds_byte(wr * 64 + fr, fq * 8), boff = lds_byte(wc * 32 + fr, fq * 8);
#define PG8_SA(b, h) (((b) * 2 + (h)) * HTB)
#define PG8_SB(b, h) ((4 + (b) * 2 + (h)) * HTB)
#define PG8_STAGE(bufoff, gbase, voff) do { _Pragma("unroll") for (int _i = 0; _i < 2; ++_i) \
        __builtin_amdgcn_global_load_lds((const unsigned*)((const char*)(gbase) + (voff)[_i]), (PG8_LAS unsigned*)(lds + (bufoff) + ldsw + _i * 8192), 16, 0, 0); } while (0)
#define PG8_LDA(dst, b, h) do { _Pragma("unroll") for (int m = 0; m < 4; ++m) _Pragma("unroll") for (int k = 0; k < 2; ++k) dst[m][k] = *(const PG8_LAS bf16x8*)(lds + PG8_SA(b, h) + aoff + m * 2048 + k * 1024); } while (0)
#define PG8_LDB(dst, b, h) do { _Pragma("unroll") for (int n = 0; n < 2; ++n) _Pragma("unroll") for (int k = 0; k < 2; ++k) dst[n][k] = *(const PG8_LAS bf16x8*)(lds + PG8_SB(b, h) + boff + n * 2048 + k * 1024); } while (0)
#define PG8_MMA(ai, bj, At, Bt) do { __builtin_amdgcn_s_setprio(1); _Pragma("unroll") for (int m = 0; m < 4; ++m) _Pragma("unroll") for (int n = 0; n < 2; ++n) _Pragma("unroll") for (int k = 0; k < 2; ++k) \
        acc[ai][bj][m][n] = __builtin_amdgcn_mfma_f32_16x16x32_bf16(Bt[n][k], At[m][k], acc[ai][bj][m][n], 0, 0, 0); __builtin_amdgcn_s_setprio(0); } while (0)
#define PG8_WAIT_V(n) asm volatile("s_waitcnt vmcnt(" #n ")" ::: "memory")
#define PG8_WAIT_L(n) asm volatile("s_waitcnt lgkmcnt(" #n ")" ::: "memory")
#define PG8_BAR __builtin_amdgcn_s_barrier()
#define PG8_SCHED __builtin_amdgcn_sched_barrier(0)
    Unit cur, nxt; int ui = 0;
    if (!S.next(0, cur)) return;
    if constexpr (GATHER) { PG8_GOFF(cv0, cv1, cur.pm); }
    else {
#pragma unroll
        for (int i = 0; i < 2; ++i) { cv0[i] = voffA[i]; cv1[i] = voffA[i] + (unsigned)(HALF * K * 2); } }
    f32x4 acc[2][2][4][2];
#pragma unroll
    for (int a = 0; a < 2; ++a)
#pragma unroll
        for (int b = 0; b < 2; ++b)
#pragma unroll
            for (int m = 0; m < 4; ++m)
#pragma unroll
                for (int n = 0; n < 2; ++n) acc[a][b][m][n] = (f32x4){0.f, 0.f, 0.f, 0.f};
    bf16x8 At[4][2], B0[2][2], B1[2][2];
    const char* cA = (const char*)g.A + (GATHER ? (size_t)0 : (size_t)cur.pm * tstep); const char* cB = (const char*)g.Bt + (size_t)cur.pn * tstep;
    S.a_ready(cur);
    if constexpr (SP2) {
        PG8_STAGE(PG8_SB(0, 0), cB, voffB); PG8_STAGE(PG8_SB(0, 1), cB + hstep, voffB); PG8_STAGE(PG8_SA(0, 0), cA, cv0); PG8_STAGE(PG8_SA(0, 1), cA, cv1);
        if (wr == 1) PG8_BAR;
        PG8_WAIT_V(2); PG8_BAR;
        PG8_STAGE(PG8_SB(1, 0), cB + kstep, voffB); PG8_STAGE(PG8_SA(1, 0), cA + kstep, cv0); PG8_STAGE(PG8_SB(1, 1), cB + hstep + kstep, voffB);
        PG8_WAIT_V(6); PG8_BAR;
    } else {
        PG8_STAGE(PG8_SB(0, 0), cB, voffB); PG8_STAGE(PG8_SA(0, 0), cA, cv0); PG8_STAGE(PG8_SB(0, 1), cB + hstep, voffB); PG8_STAGE(PG8_SA(0, 1), cA, cv1);
        if (wr == 1) PG8_BAR;
        PG8_WAIT_V(4); PG8_BAR;
        PG8_STAGE(PG8_SB(1, 0), cB + kstep, voffB); PG8_STAGE(PG8_SA(1, 0), cA + kstep, cv0); PG8_STAGE(PG8_SB(1, 1), cB + hstep + kstep, voffB);
        PG8_WAIT_V(6); PG8_BAR;
    }
    for (;;) {
        const bool has_next = S.next(ui + 1, nxt);
        if (GATHER && has_next) { PG8_GOFF(nv0, nv1, nxt.pm); }
        else {
#pragma unroll
            for (int i = 0; i < 2; ++i) { nv0[i] = cv0[i]; nv1[i] = cv1[i]; } }
        const char* nA = (has_next && !GATHER) ? (const char*)g.A + (size_t)nxt.pm * tstep : cA; const char* nB = has_next ? (const char*)g.Bt + (size_t)nxt.pn * tstep : cB;
        for (int t = 0; t < nt; t += 2) {
            const bool last = (t == nt - 2);
            const char* a1 = cA + (size_t)(t + 1) * kstep;
            const char* a2 = last ? nA : cA + (size_t)(t + 2) * kstep; const char* b2 = last ? nB : cB + (size_t)(t + 2) * kstep;
            const char* a3 = a2 + kstep; const char* b3 = b2 + kstep;
#pragma unroll
            for (int i = 0; i < 2; ++i) { sv0[i] = last ? nv0[i] : cv0[i]; sv1[i] = last ? nv1[i] : cv1[i]; }
            if (last && has_next) S.a_ready(nxt);
            if constexpr (SP2) {
            PG8_LDB(B0, 0, 0); PG8_LDB(B1, 0, 1); PG8_SCHED; PG8_LDA(At, 0, 0); PG8_STAGE(PG8_SA(1, 1), a1, cv1);
            PG8_WAIT_V(8); PG8_WAIT_L(0); PG8_BAR; PG8_MMA(0, 0, At, B0); PG8_MMA(0, 1, At, B1); PG8_BAR; PG8_SCHED;
            PG8_LDA(At, 0, 1); PG8_STAGE(PG8_SB(0, 0), b2, voffB); PG8_STAGE(PG8_SB(0, 1), b2 + hstep, voffB); PG8_STAGE(PG8_SA(0, 0), a2, sv0);
            PG8_WAIT_V(8); PG8_WAIT_L(0); PG8_BAR; PG8_MMA(1, 0, At, B0); PG8_MMA(1, 1, At, B1); PG8_BAR; PG8_SCHED;
            PG8_LDB(B0, 1, 0); PG8_LDB(B1, 1, 1); PG8_SCHED; PG8_LDA(At, 1, 0); PG8_STAGE(PG8_SA(0, 1), a2, sv1);
            PG8_WAIT_V(8); PG8_WAIT_L(0); PG8_BAR; PG8_MMA(0, 0, At, B0); PG8_MMA(0, 1, At, B1); PG8_BAR; PG8_SCHED;
            PG8_LDA(At, 1, 1); PG8_STAGE(PG8_SB(1, 0), b3, voffB); PG8_STAGE(PG8_SB(1, 1), b3 + hstep, voffB); PG8_STAGE(PG8_SA(1, 0), a3, sv0);
            PG8_WAIT_V(8); PG8_WAIT_L(0); PG8_BAR; PG8_MMA(1, 0, At, B0); PG8_MMA(1, 1, At, B1); PG8_BAR; PG8_SCHED;
            } else {
            PG8_LDB(B0, 0, 0); PG8_SCHED; PG8_LDA(At, 0, 0); PG8_STAGE(PG8_SA(1, 1), a1, cv1);
            PG8_WAIT_L(8); PG8_BAR; PG8_WAIT_L(0); PG8_MMA(0, 0, At, B0); PG8_BAR; PG8_SCHED;
            PG8_LDB(B1, 0, 1); PG8_STAGE(PG8_SB(0, 0), b2, voffB);
            PG8_BAR; PG8_WAIT_L(0); PG8_MMA(0, 1, At, B1); PG8_BAR;
            PG8_LDA(At, 0, 1); PG8_STAGE(PG8_SA(0, 0), a2, sv0);
            PG8_BAR; PG8_WAIT_L(0); PG8_MMA(1, 0, At, B0); PG8_BAR; PG8_SCHED;
            PG8_STAGE(PG8_SB(0, 1), b2 + hstep, voffB);
            PG8_WAIT_V(6); PG8_BAR; PG8_MMA(1, 1, At, B1); PG8_BAR;
            PG8_LDB(B0, 1, 0); PG8_SCHED; PG8_LDA(At, 1, 0); PG8_STAGE(PG8_SA(0, 1), a2, sv1);
            PG8_WAIT_L(8); PG8_BAR; PG8_WAIT_L(0); PG8_MMA(0, 0, At, B0); PG8_BAR; PG8_SCHED;
            PG8_LDB(B1, 1, 1); PG8_STAGE(PG8_SB(1, 0), b3, voffB);
            PG8_BAR; PG8_WAIT_L(0); PG8_MMA(0, 1, At, B1); PG8_BAR;
            PG8_LDA(At, 1, 1); PG8_STAGE(PG8_SA(1, 0), a3, sv0);
            PG8_BAR; PG8_WAIT_L(0); PG8_MMA(1, 0, At, B0); PG8_BAR; PG8_SCHED;
            PG8_STAGE(PG8_SB(1, 1), b3 + hstep, voffB);
            PG8_WAIT_V(6); PG8_BAR; PG8_MMA(1, 1, At, B1); PG8_BAR;
            }
        }
        if constexpr (ALIGN_EPI) { if (wr == 0) PG8_BAR; }
        if constexpr (!Epi::AFTER_DRAIN) { E(acc, cur, wr, wc, fr, fq); S.done(cur); }
        if (!has_next) break;
#pragma unroll
        for (int a = 0; a < 2; ++a)
#pragma unroll
            for (int b = 0; b < 2; ++b)
#pragma unroll
                for (int m = 0; m < 4; ++m)
#pragma unroll
                    for (int n = 0; n < 2; ++n) acc[a][b][m][n] = (f32x4){0.f, 0.f, 0.f, 0.f};
        cur = nxt; cA = nA; cB = nB; ++ui;
#pragma unroll
        for (int i = 0; i < 2; ++i) { cv0[i] = nv0[i]; cv1[i] = nv1[i]; }
        if constexpr (ALIGN_EPI) { if (wr == 1) PG8_BAR; }
    }
    PG8_WAIT_V(0);
    if constexpr (!ALIGN_EPI) { if (wr == 0) PG8_BAR; }
    PG8_BAR;
    if constexpr (Epi::AFTER_DRAIN) { E.fused(acc, cur, wr, wc, fr, fq, lds, wid, lane); S.done(cur); }
#undef PG8_GOFF
#undef PG8_SA
#undef PG8_SB
#undef PG8_STAGE
#undef PG8_LDA
#undef PG8_LDB
#undef PG8_MMA
#undef PG8_WAIT_V
#undef PG8_WAIT_L
#undef PG8_BAR
#undef PG8_SCHED
}
}

#ifndef PG8_SP2
#define PG8_SP2 true
#endif
#ifndef PG8_ALIGN
#define PG8_ALIGN true
#endif
constexpr int RING_OFF = 0, RING_BYTES = 131072;
constexpr int LDSCTL_OFF = RING_BYTES, MISC_OFF = LDSCTL_OFF + 320;
constexpr int LDS_BYTES = 163840;
constexpr int PARAM_OFF = 135168;
constexpr int NWAVES = 8;
#define GAS __attribute__((address_space(1)))
#define LAS __attribute__((address_space(3)))
typedef unsigned v4u __attribute__((ext_vector_type(4)));
typedef float f32x4 __attribute__((ext_vector_type(4)));
typedef GAS unsigned gu32;
#define RLX_AGENT __ATOMIC_RELAXED, __HIP_MEMORY_SCOPE_AGENT
#define LDS_WAIT() asm volatile("s_waitcnt lgkmcnt(0)" ::: "memory")
__device__ __forceinline__ unsigned pk2(float lo, float hi) { return cvtpk2(lo, hi); }

#define XB_TMO      128
#define XB_XCNT(j)  (256  + 64 * (j))
#define XB_XSUB(j)  (1280 + 64 * (j))
#define XB_XGEN(j)  (2304 + 64 * (j))
#define XB_TOP      3328
#define XB_TOPGEN   3392
#define XCD_BAR_WORDS 3456
#define XB_SPIN_CAP (1u << 18)

__device__ __forceinline__ unsigned xb_ld(unsigned* p)              { return __hip_atomic_load(p, __ATOMIC_RELAXED, __HIP_MEMORY_SCOPE_AGENT); }
__device__ __forceinline__ unsigned xb_add(unsigned* p, unsigned v) { return __hip_atomic_fetch_add(p, v, __ATOMIC_RELAXED, __HIP_MEMORY_SCOPE_AGENT); }
__device__ __forceinline__ unsigned xb_xcc_id() { return (unsigned)__builtin_amdgcn_s_getreg((3 << 11) | 20) & 0xFu; }
#define XB_SPIN(cond, bar) do { unsigned _sp = 0; while (cond) { __builtin_amdgcn_s_sleep(1); \
    if ((++_sp & 255u) == 0u) { if (xb_ld(&(bar)[XB_TMO])) break; if (_sp > XB_SPIN_CAP) { atomicAdd(&(bar)[XB_TMO], 1u); break; } } } } while (0)

struct XcdBarrier {
    unsigned* bar; unsigned x;
    volatile LAS unsigned* st;
};

__device__ __forceinline__ XcdBarrier xcd_barrier_post(unsigned* bar, volatile LAS unsigned* st) {
    XcdBarrier b; b.bar = bar; b.x = xb_xcc_id(); b.st = st;
    if (threadIdx.x == 0) (void)xb_add(&bar[XB_XCNT(b.x)], 1u);
    return b;
}
__device__ __forceinline__ void xcd_barrier_complete(unsigned* bar, unsigned x, unsigned& nloc, unsigned& nx) {
    const unsigned G = gridDim.x * gridDim.y * gridDim.z;
    unsigned sum, cnt, mine, sp = 0u;
    for (;;) {
        sum = 0u; cnt = 0u; mine = 0u;
#pragma unroll
        for (unsigned j = 0; j < 16; ++j) { const unsigned c = xb_ld(&bar[XB_XCNT(j)]); sum += c; cnt += (c > 0u) ? 1u : 0u; mine = (j == x) ? c : mine; }
        if (sum == G) break;
        __builtin_amdgcn_s_sleep(1);
        if ((++sp & 255u) == 0u) { if (xb_ld(&bar[XB_TMO])) break; if (sp > XB_SPIN_CAP) { atomicAdd(&bar[XB_TMO], 1u); break; } }
    }
    nloc = mine > 0u ? mine : 1u; nx = cnt > 0u ? cnt : 1u;
}

__device__ __forceinline__ void xcd_barrier(const XcdBarrier& b) {
    asm volatile("s_waitcnt vmcnt(0)" ::: "memory");
    __syncthreads();
    if (threadIdx.x == 0) {
        unsigned* bar = b.bar;
        __builtin_amdgcn_s_waitcnt(0);
        unsigned nloc = b.st[0], nx = b.st[1];
        if (nloc == 0u) { xcd_barrier_complete(bar, b.x, nloc, nx); b.st[0] = nloc; b.st[1] = nx; }
        const unsigned old = xb_add(&bar[XB_XSUB(b.x)], 1u);
        const unsigned gen = old / nloc;
        if (old + 1u == (gen + 1u) * nloc) {
            __builtin_amdgcn_fence(__ATOMIC_RELEASE, "agent");
            asm volatile("s_waitcnt vmcnt(0)" ::: "memory");
            const unsigned og = xb_add(&bar[XB_TOP], 1u);
            const unsigned tg = og / nx;
            if (og + 1u == (tg + 1u) * nx) xb_add(&bar[XB_TOPGEN], 1u);
            else XB_SPIN(xb_ld(&bar[XB_TOPGEN]) == tg, bar);
            __builtin_amdgcn_fence(__ATOMIC_ACQUIRE, "agent");
            xb_add(&bar[XB_XGEN(b.x)], 1u);
            asm volatile("s_waitcnt vmcnt(0)" ::: "memory");
        } else {
            XB_SPIN(xb_ld(&bar[XB_XGEN(b.x)]) == gen, bar);
            __builtin_amdgcn_fence(__ATOMIC_ACQUIRE, "agent");
            asm volatile("s_waitcnt vmcnt(0)" ::: "memory");
        }
    }
    __syncthreads();
}

struct Args { const void* in[20]; float* out; unsigned char* ws; int ph_lo, ph_hi, li, mask, rep, pad; };
struct Ctx {
    unsigned char* lds; int tid, lane, wave, G, gw, NGW;
    const float *x, *c, *w_ada, *b_ada, *g_pre_mix, *g_post_mix, *g_pre_ffn, *g_post_ffn, *w_in, *lbl, *onorm, *sink, *w_a, *w_b, *w_o, *w_router, *w_eg, *w_eu, *w_ed;
    const int* pos; float* out; unsigned char* ws;
};
__device__ __forceinline__ float wave_sum(float v) {
#pragma unroll
    for (int o = 1; o < 64; o <<= 1) v += __shfl_xor(v, o);
    return v;
}
struct TDesc { const float* src; bf16* dst; int N, K; };
__device__ __forceinline__ void t_load(const TDesc& d, f32x4 (&r)[8], int lane) {
    const float* p = d.src + (size_t)(lane >> 3) * d.N + 4 * (lane & 7);
#pragma unroll
    for (int i = 0; i < 8; ++i) r[i] = *(const f32x4*)(p + (size_t)(8 * i) * d.N);
}
__device__ __forceinline__ void t_process(const TDesc& d, const f32x4 (&r)[8], float* scr, int lane) {
    { float* w = scr + (lane >> 3) * 33 + 4 * (lane & 7);
#pragma unroll
      for (int i = 0; i < 8; ++i) { float* q = w + (8 * i) * 33; q[0] = r[i].x; q[1] = r[i].y; q[2] = r[i].z; q[3] = r[i].w; } }
    LDS_WAIT(); asm volatile("" ::: "memory");
    const int c = lane & 7;
#pragma unroll
    for (int j = 0; j < 4; ++j) { const int n = (lane >> 3) + 8 * j; const float* s = scr + (8 * c) * 33 + n;
        v4u o; o.x = pk2(s[0 * 33], s[1 * 33]); o.y = pk2(s[2 * 33], s[3 * 33]); o.z = pk2(s[4 * 33], s[5 * 33]); o.w = pk2(s[6 * 33], s[7 * 33]);
        *(v4u*)(d.dst + (size_t)n * d.K + 8 * c) = o; }
    LDS_WAIT(); asm volatile("" ::: "memory");
}
__device__ __forceinline__ void rope_entry(const int* pos, float* rope, int gid) {
    const int t = gid >> 6, i = gid & 63;
    double inv = 1.0, rr = 0.8659643233600653523531691834202299819398;
    for (int bit = 0; bit < 6; ++bit) { if ((i >> bit) & 1) inv *= rr; rr *= rr; }
    const double ang = (double)pos[t] * inv;
    const double kq = rint(ang * 0.3183098861837906715377675267450287);
    const double r = ang - kq * 3.141592653589793238462643383279502884;
    const double u = -(r * r);
    double s = 1.0 / 121645100408832000.0;
    s = s * u + 1.0 / 355687428096000.0; s = s * u + 1.0 / 1307674368000.0; s = s * u + 1.0 / 6227020800.0; s = s * u + 1.0 / 39916800.0; s = s * u + 1.0 / 362880.0;
    s = s * u + 1.0 / 5040.0; s = s * u + 1.0 / 120.0; s = s * u + 1.0 / 6.0; s = s * u + 1.0; s = s * r;
    double cz = 1.0 / 6402373705728000.0;
    cz = cz * u + 1.0 / 20922789888000.0; cz = cz * u + 1.0 / 87178291200.0; cz = cz * u + 1.0 / 479001600.0; cz = cz * u + 1.0 / 3628800.0; cz = cz * u + 1.0 / 40320.0;
    cz = cz * u + 1.0 / 720.0; cz = cz * u + 1.0 / 24.0; cz = cz * u + 0.5; cz = cz * u + 1.0;
    const double sg = (((long long)kq) & 1) ? -1.0 : 1.0;
    rope[(size_t)gid * 2] = (float)(sg * cz); rope[(size_t)gid * 2 + 1] = (float)(sg * s);
}
constexpr int I_IN = 32 * 336, I_A = 16 * 64, I_O = 32 * 64, I_E = 1024, I_MIX = I_IN + 2 * I_A + I_O, I_EXP = 48 * I_E;
constexpr int CONV_BLOCKS = 32;
constexpr int CONV_ITEMS_PER_WAVE = 100;
constexpr int P0_EXPERT_ITEMS = I_EXP - CONV_BLOCKS * NWAVES * CONV_ITEMS_PER_WAVE;
constexpr int P0_GEMV_ROUNDS = 8;
constexpr int GEMV_BLOCKS = 96;
__device__ __forceinline__ TDesc transpose_desc(Ctx& F, int it) {
    bf16* WIN = (bf16*)(F.ws + WS_WIN); bf16* WA = (bf16*)(F.ws + WS_WA); bf16* WB = (bf16*)(F.ws + WS_WB); bf16* WO = (bf16*)(F.ws + WS_WO); bf16* WGU = (bf16*)(F.ws + WS_WGU); bf16* WD = (bf16*)(F.ws + WS_WD);
    int r = it; const float* W; bf16* WT; int K, N, kb, nb; size_t drow;
    if (r < I_IN) { W = F.w_in; WT = WIN; K = 2048; N = INW; kb = r / 336; nb = r % 336; drow = (size_t)32 * nb; }
    else if ((r -= I_IN) < I_A) { W = F.w_a; WT = WA; K = 1024; N = 2048; kb = r / 64; nb = r % 64; drow = (size_t)32 * nb; }
    else if ((r -= I_A) < I_A) { W = F.w_b; WT = WB; K = 1024; N = 2048; kb = r / 64; nb = r % 64; drow = (size_t)32 * nb; }
    else if ((r -= I_A) < I_O) { W = F.w_o; WT = WO; K = 2048; N = 2048; kb = r / 64; nb = r % 64; drow = (size_t)32 * nb; }
    else { r -= I_O; const int e = r / (3 * I_E), q = r % (3 * I_E), which = q / I_E, ii = q % I_E;
        if (which < 2) { kb = ii / 32; nb = ii % 32; const int n0 = 32 * nb; W = (which ? F.w_eu : F.w_eg) + (size_t)e * 2048 * 1024; WT = WGU; K = 2048; N = 1024; drow = (size_t)e * 2048 + (n0 >> 7) * 256 + which * 128 + (n0 & 127); }
        else { kb = ii / 64; nb = ii % 64; W = F.w_ed + (size_t)e * 1024 * 2048; WT = WD; K = 1024; N = 2048; drow = (size_t)e * 2048 + 32 * nb; } }
    TDesc d; d.src = W + (size_t)(64 * kb) * N + 32 * nb; d.dst = WT + drow * K + 64 * kb; d.N = N; d.K = K; return d;
}
template <class Seq> __device__ __forceinline__ void transpose_stream(Ctx& F, const Seq& seq, float* scr) {
    f32x4 ra[8], rb[8]; TDesc da, db; int j = 0; int it = seq(j);
    if (it < 0) return;
    da = transpose_desc(F, it); t_load(da, ra, F.lane);
    for (;;) {
        const int itn = seq(++j);
        if (itn >= 0) { db = transpose_desc(F, itn); t_load(db, rb, F.lane); }
        t_process(da, ra, scr, F.lane);
        if (itn < 0) break;
        const int itnn = seq(++j);
        if (itnn >= 0) { da = transpose_desc(F, itnn); t_load(da, ra, F.lane); }
        t_process(db, rb, scr, F.lane);
        if (itnn < 0) break;
    }
}
struct P0Seq { int gw, NGW, ngv; bool gemv;
    __device__ __forceinline__ int operator()(int r) const { int it; if (r < P0_GEMV_ROUNDS) it = r * NGW + gw; else { if (gemv) return -1; it = P0_GEMV_ROUNDS * NGW + (r - P0_GEMV_ROUNDS) * (NGW - ngv) + (gw - ngv); }
        return it < I_MIX + P0_EXPERT_ITEMS ? it : -1; } };
struct TailSeq { int first, stride;
    __device__ __forceinline__ int operator()(int j) const { const int it = first + j * stride; return it < I_MIX + I_EXP ? it : -1; } };
__device__ __forceinline__ void p1_modnorm(Ctx& F, int first, int stride) {
    const float* MOD = (const float*)(F.ws + WS_MOD); bf16* H = (bf16*)(F.ws + WS_H);
    for (int row0 = first; row0 < T; row0 += 2 * stride) {
        f32x4 v[2][8];
#pragma unroll
        for (int k = 0; k < 2; ++k) { const int row = row0 + k * stride; if (row < T) { const f32x4* xr = (const f32x4*)(F.x + (size_t)row * D) + F.lane;
#pragma unroll
            for (int j = 0; j < 8; ++j) v[k][j] = xr[64 * j]; } }
#pragma unroll
        for (int k = 0; k < 2; ++k) { const int row = row0 + k * stride; if (row < T) {
            const int b = row / SEQ; float ss = 0.f;
#pragma unroll
            for (int j = 0; j < 8; ++j) ss += (v[k][j].x * v[k][j].x + v[k][j].y * v[k][j].y) + (v[k][j].z * v[k][j].z + v[k][j].w * v[k][j].w);
            const float r = rsqrtf(wave_sum(ss) * (1.f / D) + EPS);
            const f32x4* gp = (const f32x4*)F.g_pre_mix + F.lane; const f32x4* shp = (const f32x4*)(MOD + b * 12288) + F.lane; const f32x4* scp = (const f32x4*)(MOD + b * 12288 + 2048) + F.lane;
            uint2* o8 = (uint2*)(H + (size_t)row * D) + F.lane;
            f32x4 g[8], sh[8], sc[8];
#pragma unroll
            for (int j = 0; j < 8; ++j) { g[j] = gp[64 * j]; sh[j] = shp[64 * j]; sc[j] = scp[64 * j]; }
#pragma unroll
            for (int j = 0; j < 8; ++j) { const f32x4 h = v[k][j] * r * g[j] * (sc[j] + 1.f) + sh[j];
                uint2 w; w.x = pk2(h.x, h.y); w.y = pk2(h.z, h.w); o8[64 * j] = w; } } }
    }
}
__device__ __forceinline__ void p0_prep(Ctx& F) {
    float* MOD = (float*)(F.ws + WS_MOD); float* LB = (float*)(F.ws + WS_LB); float* ROPE = (float*)(F.ws + WS_ROPE);
    if (blockIdx.x < GEMV_BLOCKS) {
        float* sc = (float*)F.lds; float* red = (float*)(F.lds + 16384);
        for (int i = F.tid; i < 4096; i += 512) sc[i] = siluf_(F.c[i]);
        __syncthreads();
        const int j0 = blockIdx.x * 128, k0 = F.wave * 256, half = F.lane >> 5, l32 = F.lane & 31;
        f32x4 a0 = {0.f, 0.f, 0.f, 0.f}, a1 = {0.f, 0.f, 0.f, 0.f};
        const float* wp = F.w_ada + (size_t)(k0 + half) * 12288 + j0 + 4 * l32;
#pragma unroll 16
        for (int k = 0; k < 128; ++k) { const f32x4 w = *(const f32x4*)(wp + (size_t)(2 * k) * 12288); const float s0 = sc[k0 + 2 * k + half], s1 = sc[2048 + k0 + 2 * k + half]; a0 += w * s0; a1 += w * s1; }
        *(f32x4*)(red + ((F.wave * 2 + half) * 2 + 0) * 128 + 4 * l32) = a0; *(f32x4*)(red + ((F.wave * 2 + half) * 2 + 1) * 128 + 4 * l32) = a1;
        __syncthreads();
        if (F.tid < 256) { const int b = F.tid >> 7, jj = F.tid & 127; float s = 0.f;
#pragma unroll
          for (int p = 0; p < 16; ++p) s += red[(p * 2 + b) * 128 + jj];
          MOD[b * 12288 + j0 + jj] = s + F.b_ada[j0 + jj]; }
        __syncthreads();
    }
    { const int gt = blockIdx.x * 512 + F.tid, NT = F.G * 512;
      if (gt < 2048) { const int dir = gt >> 10, ch = gt & 1023; const float l0 = F.lbl[dir * 2048 + ch], l1 = F.lbl[dir * 2048 + 1024 + ch]; LB[gt] = 1.f / (1.f + expf(l1 - l0)); }
      for (int g = gt; g < T * 64; g += NT) rope_entry(F.pos, ROPE, g); }
    unsigned* cnt = (unsigned*)(F.ws + WS_CTL) + 1024;
    if (blockIdx.x < GEMV_BLOCKS) {
        asm volatile("s_waitcnt vmcnt(0)" ::: "memory"); __syncthreads();
        if (F.tid == 0) { __builtin_amdgcn_fence(__ATOMIC_RELEASE, "agent"); asm volatile("s_waitcnt vmcnt(0)" ::: "memory"); __hip_atomic_fetch_add(cnt, 1u, __ATOMIC_RELAXED, __HIP_MEMORY_SCOPE_AGENT); }
    }
    float* scr = (float*)(F.lds + F.wave * 16384);
    P0Seq seq{F.gw, F.NGW, GEMV_BLOCKS * NWAVES, blockIdx.x < GEMV_BLOCKS};
    transpose_stream(F, seq, scr);
    __syncthreads();
    if (F.tid == 0) { unsigned sp = 0; while (__hip_atomic_load(cnt, __ATOMIC_RELAXED, __HIP_MEMORY_SCOPE_AGENT) < (unsigned)GEMV_BLOCKS && ++sp < (1u << 22)) __builtin_amdgcn_s_sleep(2);
        __builtin_amdgcn_fence(__ATOMIC_ACQUIRE, "agent"); asm volatile("s_waitcnt vmcnt(0)" ::: "memory"); }
    __syncthreads();
    p1_modnorm(F, F.gw, F.NGW);
}
__device__ __forceinline__ void p6_post1(Ctx& F) {
    const float* MOD = (const float*)(F.ws + WS_MOD); const float* Y = (const float*)(F.ws + WS_Y); bf16* H2 = (bf16*)(F.ws + WS_H2); float* AFF = (float*)(F.ws + WS_AFF);
    float* wT = (float*)F.lds;
    float* PA = (float*)(F.lds + PARAM_OFF); float* PB = PA + 2048; float* PC = PB + 2048;
    for (int f = F.tid; f < 8192; f += 512) { const int d = f >> 2, q = f & 3; const f32x4 wv = *((const f32x4*)F.w_router + f);
        wT[(4 * q + 0) * 2048 + d] = wv.x; wT[(4 * q + 1) * 2048 + d] = wv.y; wT[(4 * q + 2) * 2048 + d] = wv.z; wT[(4 * q + 3) * 2048 + d] = wv.w; }
    uint2 ywn[8]; f32x4 xvn[8];
#define P6_LOAD(rr) do { const uint2* yr_ = (const uint2*)((const bf16*)Y + (size_t)(rr) * D) + F.lane; const f32x4* xr_ = (const f32x4*)(F.x + (size_t)(rr) * D) + F.lane; \
        _Pragma("unroll") for (int j = 0; j < 8; ++j) { ywn[j] = yr_[64 * j]; xvn[j] = xr_[64 * j]; } } while (0)
    for (int b = 0; b < BATCH; ++b) {
        const float* mb = MOD + b * 12288;
        __syncthreads();
        if (F.tid < 512) { const int d4 = F.tid;
            const f32x4 gt = *((const f32x4*)(mb + 4096) + d4), gp = *((const f32x4*)F.g_post_mix + d4), g2 = *((const f32x4*)F.g_pre_ffn + d4), sc = *((const f32x4*)(mb + 8192) + d4), sh = *((const f32x4*)(mb + 6144) + d4);
            *((f32x4*)PA + d4) = gt * gp; *((f32x4*)PB + d4) = g2 * (sc + 1.f); *((f32x4*)PC + d4) = sh; }
        const int rfirst = b * SEQ + F.gw;
        if (F.gw < SEQ) P6_LOAD(rfirst);
        __syncthreads();
        for (int rl = F.gw; rl < SEQ; rl += F.NGW) {
            const int row = b * SEQ + rl, s = rl;
            f32x4 xv[8]; float ss = 0.f;
            {   uint2 yc[8];
#pragma unroll
                for (int j = 0; j < 8; ++j) { yc[j] = ywn[j]; const float y0 = __uint_as_float(yc[j].x << 16), y1 = __uint_as_float(yc[j].x & 0xffff0000u), y2 = __uint_as_float(yc[j].y << 16), y3 = __uint_as_float(yc[j].y & 0xffff0000u);
                    xv[j] = xvn[j]; ss += (y0 * y0 + y1 * y1) + (y2 * y2 + y3 * y3); }
                if (rl + F.NGW < SEQ) P6_LOAD(row + F.NGW);
                const float r = rsqrtf(wave_sum(ss) * (1.f / D) + EPS);
                f32x4* op = (f32x4*)(F.out + (size_t)row * D) + F.lane;
                ss = 0.f;
#pragma unroll
                for (int j = 0; j < 8; ++j) { const f32x4 y = {__uint_as_float(yc[j].x << 16), __uint_as_float(yc[j].x & 0xffff0000u), __uint_as_float(yc[j].y << 16), __uint_as_float(yc[j].y & 0xffff0000u)};
                    const f32x4 pa = *((const f32x4*)PA + F.lane + 64 * j);
                    xv[j] = xv[j] + pa * (y * r); ss += (xv[j].x * xv[j].x + xv[j].y * xv[j].y) + (xv[j].z * xv[j].z + xv[j].w * xv[j].w); }
#pragma unroll
                for (int j = 0; j < 8; ++j) op[64 * j] = xv[j];
            }
            const float r2 = rsqrtf(wave_sum(ss) * (1.f / D) + EPS);
            uint2* o8 = (uint2*)(H2 + (size_t)row * D) + F.lane;
            float lg[16];
#pragma unroll
            for (int j = 0; j < 8; ++j) { const f32x4 pb = *((const f32x4*)PB + F.lane + 64 * j), pc = *((const f32x4*)PC + F.lane + 64 * j); xv[j] = xv[j] * r2 * pb + pc; }
#pragma unroll
            for (int j = 0; j < 8; ++j) { uint2 w; w.x = pk2(xv[j].x, xv[j].y); w.y = pk2(xv[j].z, xv[j].w); o8[64 * j] = w; }
#pragma unroll
            for (int e = 0; e < 16; ++e) { float a = 0.f;
#pragma unroll
                for (int j = 0; j < 8; ++j) { const f32x4 wv = *((const f32x4*)(wT + e * 2048) + F.lane + 64 * j); a += (xv[j].x * wv.x + xv[j].y * wv.y) + (xv[j].z * wv.z + xv[j].w * wv.w); }
                lg[e] = a; asm volatile("" ::: "memory"); }
            float mx = -1e30f;
#pragma unroll
            for (int e = 0; e < 16; ++e) { lg[e] = wave_sum(lg[e]); mx = fmaxf(mx, lg[e]); }
            float sm = 0.f;
#pragma unroll
            for (int e = 0; e < 16; ++e) { lg[e] = expf(lg[e] - mx); sm += lg[e]; }
            float mine = 0.f;
#pragma unroll
            for (int e = 0; e < 16; ++e) mine = (F.lane == e) ? lg[e] : mine;
            if (F.lane < 16) AFF[((size_t)b * 16 + F.lane) * SEQ + s] = mine / sm;
        }
    }
#undef P6_LOAD
    __syncthreads();
}
__device__ __forceinline__ void p7_topk_gather(Ctx& F) {
    const float* AFF = (const float*)(F.ws + WS_AFF); int* GIDX = (int*)(F.ws + WS_GIDX); float* SELAFF = (float*)(F.ws + WS_SELAFF); int* TOKSLOT = (int*)(F.ws + WS_TOKSLOT);
        int* sh = (int*)F.lds; int* wsum = (int*)(F.lds + 64);
    for (int unit = blockIdx.x; unit < 256; unit += F.G) {
        const int be = unit >> 3, part = unit & 7, b = be >> 4, e = be & 15, tid = F.tid, lane = F.lane;
        if (F.wave == 0) {
            unsigned v[64];
#pragma unroll
            for (int i = 0; i < 64; ++i) v[i] = __float_as_uint(AFF[(size_t)be * SEQ + i * 64 + lane]);
            unsigned tau = 0u;
            for (int bit = 30; bit >= 0; --bit) { const unsigned cand = tau | (1u << bit); int cl = 0;
#pragma unroll
                for (int i = 0; i < 64; ++i) cl += (v[i] >= cand) ? 1 : 0;
                int c = 0;
#pragma unroll
                for (int q = 0; q < 7; ++q) c += __popcll(__ballot((cl >> q) & 1)) << q;
                if (c >= CAP) tau = cand; }
            int cgt = 0;
            { int cl = 0;
#pragma unroll
              for (int i = 0; i < 64; ++i) cl += (v[i] > tau) ? 1 : 0;
#pragma unroll
              for (int q = 0; q < 7; ++q) cgt += __popcll(__ballot((cl >> q) & 1)) << q; }
            if (lane == 0) { sh[0] = (int)tau; sh[1] = cgt; }
        }
        __syncthreads();
        const unsigned tau = (unsigned)sh[0]; const int need = CAP - sh[1];
        const f32x4* a = (const f32x4*)(AFF + (size_t)be * SEQ + tid * 8);
        const f32x4 a0 = a[0], a1 = a[1];
        const unsigned v[8] = {__float_as_uint(a0.x), __float_as_uint(a0.y), __float_as_uint(a0.z), __float_as_uint(a0.w), __float_as_uint(a1.x), __float_as_uint(a1.y), __float_as_uint(a1.z), __float_as_uint(a1.w)};
        int cg = 0, ce = 0;
#pragma unroll
        for (int i = 0; i < 8; ++i) { cg += (v[i] > tau) ? 1 : 0; ce += (v[i] == tau) ? 1 : 0; }
        const int pk = cg | (ce << 16); int inc = pk;
#pragma unroll
        for (int o = 1; o < 64; o <<= 1) { const int t = __shfl_up(inc, o); if (lane >= o) inc += t; }
        if (lane == 63) wsum[F.wave] = inc;
        __syncthreads();
        int base = 0;
#pragma unroll
        for (int w = 0; w < 8; ++w) base += (w < F.wave) ? wsum[w] : 0;
        const int excl = base + inc - pk, pg = excl & 0xffff, pe = excl >> 16;
        int tie_before = pe, sel_before = pg + (pe < need ? pe : need);
#pragma unroll
        for (int i = 0; i < 8; ++i) {
            const int tok = tid * 8 + i; bool sel = false;
            if (v[i] > tau) sel = true; else if (v[i] == tau) { sel = tie_before < need; ++tie_before; }
            int slot = -1;
            if (sel) { const int sl = sel_before; ++sel_before; slot = b * CAP + sl;
                if ((sl >> 6) == part) { GIDX[e * 1024 + slot] = b * SEQ + tok; SELAFF[e * 1024 + slot] = __uint_as_float(v[i]); } }
            if (F.wave == part) TOKSLOT[((size_t)b * 16 + e) * SEQ + tok] = slot;
        }
        __syncthreads();
    }
}
__device__ __forceinline__ void p10_final(Ctx& F) {
    const float* MOD = (const float*)(F.ws + WS_MOD); const bf16* SLAB = (const bf16*)(F.ws + WS_SLAB); const int* TOKSLOT = (const int*)(F.ws + WS_TOKSLOT);
    for (int row0 = F.gw; row0 < T; row0 += 4 * F.NGW) {
        int slotw[4];
#pragma unroll
        for (int k = 0; k < 4; ++k) { const int row = row0 + k * F.NGW; slotw[k] = (row < T && F.lane < 16) ? TOKSLOT[((size_t)(row / SEQ) * 16 + F.lane) * SEQ + (row % SEQ)] : -1; }
#pragma unroll
        for (int k = 0; k < 4; ++k) { const int row = row0 + k * F.NGW; if (row < T) {
            const int b = row / SEQ; const float* mb = MOD + b * 12288;
            f32x4 x1v[8], gtv[8], gpv[8];
#pragma unroll
            for (int j = 0; j < 4; ++j) { const int col = 8 * F.lane + 512 * j; const float* op = F.out + (size_t)row * D + col;
#pragma unroll
                for (int hh = 0; hh < 2; ++hh) { x1v[2 * j + hh] = *(const f32x4*)(op + 4 * hh); gtv[2 * j + hh] = *(const f32x4*)(mb + 10240 + col + 4 * hh); gpv[2 * j + hh] = *(const f32x4*)(F.g_post_ffn + col + 4 * hh); } }
            float y[32];
#pragma unroll
            for (int i = 0; i < 32; ++i) y[i] = 0.f;
            for (int e = 0; e < 16; ++e) { const int sl = __shfl(slotw[k], e); if (sl >= 0) { const v4u* r = (const v4u*)(SLAB + ((size_t)e * 1024 + sl) * D) + F.lane;
#pragma unroll
                    for (int j = 0; j < 4; ++j) { const v4u q = r[64 * j];
                        y[8 * j + 0] += __uint_as_float(q.x << 16); y[8 * j + 1] += __uint_as_float(q.x & 0xffff0000u); y[8 * j + 2] += __uint_as_float(q.y << 16); y[8 * j + 3] += __uint_as_float(q.y & 0xffff0000u);
                        y[8 * j + 4] += __uint_as_float(q.z << 16); y[8 * j + 5] += __uint_as_float(q.z & 0xffff0000u); y[8 * j + 6] += __uint_as_float(q.w << 16); y[8 * j + 7] += __uint_as_float(q.w & 0xffff0000u); } } }
            float ss = 0.f;
#pragma unroll
            for (int i = 0; i < 32; ++i) ss += y[i] * y[i];
            const float r = rsqrtf(wave_sum(ss) * (1.f / D) + EPS);
#pragma unroll
            for (int j = 0; j < 4; ++j) { const int col = 8 * F.lane + 512 * j; float* op = F.out + (size_t)row * D + col;
#pragma unroll
                for (int hh = 0; hh < 2; ++hh) { f32x4 yy = {y[8 * j + 4 * hh], y[8 * j + 4 * hh + 1], y[8 * j + 4 * hh + 2], y[8 * j + 4 * hh + 3]};
                    *(f32x4*)(op + 4 * hh) = x1v[2 * j + hh] + gtv[2 * j + hh] * (yy * r * gpv[2 * j + hh]); } } } }
    }
}
typedef short bf16x8 __attribute__((ext_vector_type(8)));
typedef short s16x4 __attribute__((ext_vector_type(4)));
typedef short v4i16_t __attribute__((ext_vector_type(4)));
typedef float f32x16 __attribute__((ext_vector_type(16)));
typedef float f32x2m __attribute__((ext_vector_type(2)));
constexpr int RS = 272;
constexpr int RSA = 144;
constexpr float LOG2E = 1.4426950408889634f;
__device__ __forceinline__ s16x4 tr4(const LAS unsigned char* p) { return __builtin_bit_cast(s16x4, __builtin_amdgcn_ds_read_tr16_b64_v4i16((LAS v4i16_t*)p)); }
__device__ __forceinline__ bf16x8 tr8(const LAS unsigned char* p, int second) { const s16x4 a = tr4(p), b = tr4(p + second); return (bf16x8){a[0], a[1], a[2], a[3], b[0], b[1], b[2], b[3]}; }
__device__ __forceinline__ bf16x8 ld8(const LAS unsigned char* p) { return *(const LAS bf16x8*)p; }
__device__ __forceinline__ unsigned cvtpk(float lo, float hi) { return pg8::cvt_pk_bf16(lo, hi); }
__device__ __forceinline__ int crow(int r, int hi) { return (r & 3) + 8 * (r >> 2) + 4 * hi; }
#define MFMA16(a, b, c) __builtin_amdgcn_mfma_f32_16x16x32_bf16((a), (b), (c), 0, 0, 0)
#define MFMA32(a, b, c) __builtin_amdgcn_mfma_f32_32x32x16_bf16((a), (b), (c), 0, 0, 0)

__device__ __forceinline__ void rope_pass(Ctx& F) {
    const bf16* PROJ = (const bf16*)(F.ws + WS_PROJ); const float* ROPE = (const float*)(F.ws + WS_ROPE); bf16* QR = (bf16*)(F.ws + WS_QR); bf16* KR = (bf16*)(F.ws + WS_KR);
    const int NT = F.G * 512;
    for (int it0 = blockIdx.x * 512 + F.tid; it0 < T * 80; it0 += 2 * NT) {
        v4u a[2], bq[2]; f32x4 cs[2][4]; bool ok[2];
#pragma unroll
        for (int u = 0; u < 2; ++u) { const int it = it0 + u * NT; ok[u] = it < T * 80; if (ok[u]) { const int i8 = it & 7, hh = (it >> 3) % 10, t = it / 80;
            const bf16* src = PROJ + (size_t)t * INW + (hh < 8 ? C_AQ + hh * 128 : C_AK + (hh - 8) * 128) + i8 * 8;
            a[u] = *(const v4u*)src; bq[u] = *(const v4u*)(src + 64);
            const f32x4* rp = (const f32x4*)(ROPE + ((size_t)t * 64 + i8 * 8) * 2);
#pragma unroll
            for (int k = 0; k < 4; ++k) cs[u][k] = rp[k]; } }
#pragma unroll
        for (int u = 0; u < 2; ++u) { if (ok[u]) { const int it = it0 + u * NT; const int i8 = it & 7, hh = (it >> 3) % 10, t = it / 80;
            const unsigned aw[4] = {a[u].x, a[u].y, a[u].z, a[u].w}, bw[4] = {bq[u].x, bq[u].y, bq[u].z, bq[u].w};
            unsigned o1[4], o2[4];
#pragma unroll
            for (int k = 0; k < 4; ++k) { const f32x4 c4 = cs[u][k];
                const float x1a = __uint_as_float(aw[k] << 16), x1b = __uint_as_float(aw[k] & 0xffff0000u), x2a = __uint_as_float(bw[k] << 16), x2b = __uint_as_float(bw[k] & 0xffff0000u);
                o1[k] = pk2(x1a * c4.x - x2a * c4.y, x1b * c4.z - x2b * c4.w); o2[k] = pk2(x1a * c4.y + x2a * c4.x, x1b * c4.w + x2b * c4.z); }
            bf16* dst = (hh < 8 ? QR + (size_t)t * 1024 + hh * 128 : KR + (size_t)t * 256 + (hh - 8) * 128) + i8 * 8;
            *(v4u*)dst = (v4u){o1[0], o1[1], o1[2], o1[3]}; *(v4u*)(dst + 64) = (v4u){o2[0], o2[1], o2[2], o2[3]}; } }
    }
}
__device__ __forceinline__ void hgrn_a_phase(Ctx& F, LAS unsigned char* L) {
    const bf16* PROJ = (const bf16*)(F.ws + WS_PROJ); const float* LB = (const float*)(F.ws + WS_LB); bf16* CS = (bf16*)(F.ws + WS_CS); float* DEC = (float*)(F.ws + WS_DEC);
    LAS unsigned char* KD = L; LAS unsigned char* VV = L + 17408; LAS float* TOT = (LAS float*)(L + 34816);
    const int tid = F.tid, lane = F.lane, w = F.wave, dk0 = 2 * lane;
    const int tro16 = (8 * (lane >> 4) + ((lane & 15) >> 2)) * RS + (lane & 3) * 8;
    unsigned zraw[8]; v4u vr[2]; float lbA = 0.f, lbB = 0.f;
#define HA_LOAD(un) do { const int c_ = (un) & 63, dir_ = ((un) >> 6) & 1, h_ = ((un) >> 7) & 7, b_ = (un) >> 10; const size_t rb_ = (size_t)b_ * SEQ + c_ * 64; \
        { const float2 l2_ = *(const float2*)(LB + dir_ * 1024 + h_ * 128 + dk0); lbA = l2_.x; lbB = l2_.y; } \
        const bf16* zp_ = PROJ + (rb_ + 8 * w) * INW + (dir_ ? C_FB : C_FF) + h_ * 128; \
        _Pragma("unroll") for (int i = 0; i < 8; ++i) zraw[i] = *(const unsigned*)(zp_ + (size_t)i * INW + dk0); \
        _Pragma("unroll") for (int i = 0; i < 2; ++i) { const int idx = tid + 512 * i, row = idx >> 4, ch = idx & 15; vr[i] = *(const v4u*)(PROJ + (rb_ + row) * INW + C_HI + h_ * 128 + ch * 8); } } while (0)
    if ((int)blockIdx.x < 2048) HA_LOAD((int)blockIdx.x);
    for (int unit = blockIdx.x; unit < 2048; unit += F.G) {
        const int dir = (unit >> 6) & 1;
        float lfa[8], lfb[8], ka[8], kb[8];
#pragma unroll
        for (int i = 0; i < 8; ++i) { const float za = __uint_as_float(zraw[i] << 16), zb = __uint_as_float(zraw[i] & 0xffff0000u);
            const float fa = lbA + (1.f - lbA) * sigmoidf_(za), fb = lbB + (1.f - lbB) * sigmoidf_(zb); lfa[i] = __logf(fa); lfb[i] = __logf(fb); ka[i] = 1.f - fa; kb[i] = 1.f - fb; }
#pragma unroll
        for (int i = 0; i < 2; ++i) { const int idx = tid + 512 * i, row = idx >> 4, ch = idx & 15; *(LAS v4u*)(VV + row * RS + ch * 16) = vr[i]; }
        if (unit + F.G < 2048) HA_LOAD(unit + F.G);
        float runa = 0.f, runb = 0.f;
        if (dir == 0) {
#pragma unroll
            for (int i = 0; i < 8; ++i) { runa += lfa[i]; lfa[i] = runa; runb += lfb[i]; lfb[i] = runb; } }
        else {
#pragma unroll
            for (int i = 7; i >= 0; --i) { runa += lfa[i]; lfa[i] = runa; runb += lfb[i]; lfb[i] = runb; } }
        *(LAS f32x2m*)(TOT + w * 128 + dk0) = (f32x2m){runa, runb};
        __syncthreads();
        float totA = 0.f, totB = 0.f, offA = 0.f, offB = 0.f;
#pragma unroll
        for (int p = 0; p < 8; ++p) { const f32x2m t = *(const LAS f32x2m*)(TOT + p * 128 + dk0); totA += t.x; totB += t.y;
            const bool inoff = dir == 0 ? (p < w) : (p > w); offA += inoff ? t.x : 0.f; offB += inoff ? t.y : 0.f; }
#pragma unroll
        for (int i = 0; i < 8; ++i) { const float va = ka[i] * __expf(totA - (lfa[i] + offA)), vb = kb[i] * __expf(totB - (lfb[i] + offB));
            *(LAS unsigned*)(KD + (8 * w + i) * RS + dk0 * 2) = pk2(va, vb); }
        if (w == 0) *(float2*)(DEC + (size_t)unit * 128 + dk0) = make_float2(__expf(totA), __expf(totB));
        __syncthreads();
        f32x4 acc[2][4];
#pragma unroll
        for (int a = 0; a < 2; ++a)
#pragma unroll
            for (int t = 0; t < 4; ++t) acc[a][t] = (f32x4){0.f, 0.f, 0.f, 0.f};
        const int dvb = 32 * (w & 3), dkb = 64 * (w >> 2);
#pragma unroll
        for (int s = 0; s < 2; ++s) {
            bf16x8 af[2], bfr[4];
#pragma unroll
            for (int a = 0; a < 2; ++a) af[a] = tr8(VV + (32 * s) * RS + (dvb + 16 * a) * 2 + tro16, 4 * RS);
#pragma unroll
            for (int t = 0; t < 4; ++t) bfr[t] = tr8(KD + (32 * s) * RS + (dkb + 16 * t) * 2 + tro16, 4 * RS);
#pragma unroll
            for (int a = 0; a < 2; ++a)
#pragma unroll
                for (int t = 0; t < 4; ++t) acc[a][t] = MFMA16(af[a], bfr[t], acc[a][t]);
        }
        bf16* cso = CS + (size_t)unit * 16384;
        const int cc = lane & 15, rg = lane >> 4;
#pragma unroll
        for (int a = 0; a < 2; ++a)
#pragma unroll
            for (int t = 0; t < 4; ++t) { const int dkk = dkb + 16 * t + cc, dv0 = dvb + 16 * a + 4 * rg;
                uint2 o; o.x = cvtpk(acc[a][t][0], acc[a][t][1]); o.y = cvtpk(acc[a][t][2], acc[a][t][3]); *(uint2*)(cso + dkk * 128 + dv0) = o; }
        __syncthreads();
    }
#undef HA_LOAD
}
__device__ __forceinline__ void hgrn_scan_phase(Ctx& F) {
    const bf16* CS = (const bf16*)(F.ws + WS_CS); bf16* ST = (bf16*)(F.ws + WS_STATE); const float* DEC = (const float*)(F.ws + WS_DEC);
    const int NT = F.G * 512;
    for (int gt = blockIdx.x * 512 + F.tid; gt < 32 * 4096; gt += NT) {
        const int g = gt >> 12, e4 = (gt & 4095) * 4, dk = e4 >> 7, dir = g & 1;
        float s0 = 0.f, s1 = 0.f, s2 = 0.f, s3 = 0.f;
        for (int st = 0; st < 64; st += 8) {
            uint2 tmp[8]; float dc[8];
#pragma unroll
            for (int k = 0; k < 8; ++k) { const int c = dir ? 63 - (st + k) : st + k; const size_t unit = (size_t)g * 64 + c; tmp[k] = *(const uint2*)(CS + unit * 16384 + e4); dc[k] = DEC[unit * 128 + dk]; }
#pragma unroll
            for (int k = 0; k < 8; ++k) { const int c = dir ? 63 - (st + k) : st + k; const size_t unit = (size_t)g * 64 + c;
                uint2 o; o.x = pk2(s0, s1); o.y = pk2(s2, s3); *(uint2*)(ST + unit * 16384 + e4) = o;
                s0 = dc[k] * s0 + __uint_as_float(tmp[k].x << 16); s1 = dc[k] * s1 + __uint_as_float(tmp[k].x & 0xffff0000u);
                s2 = dc[k] * s2 + __uint_as_float(tmp[k].y << 16); s3 = dc[k] * s3 + __uint_as_float(tmp[k].y & 0xffff0000u); }
        }
    }
}
__device__ __forceinline__ void hgrn_c_phase(Ctx& F, LAS unsigned char* L) {
    const bf16* PROJ = (const bf16*)(F.ws + WS_PROJ); const float* LB = (const float*)(F.ws + WS_LB); const bf16* ST = (const bf16*)(F.ws + WS_STATE); bf16* YAIN = (bf16*)(F.ws + WS_YAIN);
    LAS unsigned char* QI = L; LAS unsigned char* KI = L + 17408; LAS unsigned char* QE = L + 34816; LAS unsigned char* VV = L + 52224; LAS unsigned char* SP = L + 69632; LAS unsigned char* AM = L + 104448;
    LAS float* TOT = (LAS float*)(L + 113664); LAS float* SSQ = (LAS float*)(L + 117760);
    const int tid = F.tid, lane = F.lane, w = F.wave, dk0 = 2 * lane, cc = lane & 15, rg = lane >> 4;
    const int tro16 = (8 * (lane >> 4) + ((lane & 15) >> 2)) * RS + (lane & 3) * 8;
    unsigned zraw[8], qraw[8]; v4u vr[2], sr[4]; float lbA = 0.f, lbB = 0.f;
#define HC_LOAD(un, dr) do { const int c_ = (un) & 63, h_ = ((un) >> 6) & 7, b_ = (un) >> 9; const size_t rb_ = (size_t)b_ * SEQ + c_ * 64; \
        { const float2 l2_ = *(const float2*)(LB + (dr) * 1024 + h_ * 128 + dk0); lbA = l2_.x; lbB = l2_.y; } \
        const bf16* zp_ = PROJ + (rb_ + 8 * w) * INW + h_ * 128; \
        _Pragma("unroll") for (int i = 0; i < 8; ++i) { const bf16* rp_ = zp_ + (size_t)i * INW; zraw[i] = *(const unsigned*)(rp_ + ((dr) ? C_FB : C_FF) + dk0); qraw[i] = *(const unsigned*)(rp_ + C_HQ + dk0); } \
        if ((dr) == 0) { _Pragma("unroll") for (int i = 0; i < 2; ++i) { const int idx = tid + 512 * i, row = idx >> 4, ch = idx & 15; vr[i] = *(const v4u*)(PROJ + (rb_ + row) * INW + C_HI + h_ * 128 + ch * 8); } } \
        { const bf16* sp_ = ST + ((size_t)((b_ * 8 + h_) * 2 + (dr)) * 64 + c_) * 16384; \
          _Pragma("unroll") for (int i = 0; i < 4; ++i) { const int idx = tid + 512 * i; sr[i] = *(const v4u*)(sp_ + idx * 8); } } } while (0)
    if ((int)blockIdx.x < 1024) HC_LOAD((int)blockIdx.x, 0);
    for (int unit = blockIdx.x; unit < 1024; unit += F.G) {
        const int c = unit & 63, h = (unit >> 6) & 7, b = unit >> 9;
        const size_t rb = (size_t)b * SEQ + c * 64;
        f32x4 o[4];
#pragma unroll
        for (int t = 0; t < 4; ++t) o[t] = (f32x4){0.f, 0.f, 0.f, 0.f};
        for (int dir = 0; dir < 2; ++dir) {
            float lfa[8], lfb[8], ka[8], kb[8], qa[8], qb[8];
#pragma unroll
            for (int i = 0; i < 8; ++i) { const float za = __uint_as_float(zraw[i] << 16), zb = __uint_as_float(zraw[i] & 0xffff0000u);
                const float fa = lbA + (1.f - lbA) * sigmoidf_(za), fb = lbB + (1.f - lbB) * sigmoidf_(zb); lfa[i] = __logf(fa); lfb[i] = __logf(fb); ka[i] = 1.f - fa; kb[i] = 1.f - fb;
                qa[i] = siluf_(__uint_as_float(qraw[i] << 16)); qb[i] = siluf_(__uint_as_float(qraw[i] & 0xffff0000u)); }
            if (dir == 0) {
#pragma unroll
                for (int i = 0; i < 2; ++i) { const int idx = tid + 512 * i, row = idx >> 4, ch = idx & 15; *(LAS v4u*)(VV + row * RS + ch * 16) = vr[i]; } }
#pragma unroll
            for (int i = 0; i < 4; ++i) { const int idx = tid + 512 * i, row = idx >> 4, ch = idx & 15; *(LAS v4u*)(SP + row * RS + ch * 16) = sr[i]; }
            if (dir == 0) HC_LOAD(unit, 1); else if (unit + F.G < 1024) HC_LOAD(unit + F.G, 0);
            float runa = 0.f, runb = 0.f;
            if (dir == 0) {
#pragma unroll
                for (int i = 0; i < 8; ++i) { runa += lfa[i]; lfa[i] = runa; runb += lfb[i]; lfb[i] = runb; } }
            else {
#pragma unroll
                for (int i = 7; i >= 0; --i) { runa += lfa[i]; lfa[i] = runa; runb += lfb[i]; lfb[i] = runb; } }
            *(LAS f32x2m*)(TOT + w * 128 + dk0) = (f32x2m){runa, runb};
            __syncthreads();
            {   float offA = 0.f, offB = 0.f, brA = 0.f, brB = 0.f;
#pragma unroll
                for (int p = 0; p < 8; ++p) { const f32x2m t = *(const LAS f32x2m*)(TOT + p * 128 + dk0);
                    const bool inoff = dir == 0 ? (p < w) : (p > w), inref = dir == 0 ? (p < 4) : (p >= 4);
                    offA += inoff ? t.x : 0.f; offB += inoff ? t.y : 0.f; brA += inref ? t.x : 0.f; brB += inref ? t.y : 0.f; }
#pragma unroll
                for (int i = 0; i < 8; ++i) { const float ba = lfa[i] + offA, bb = lfb[i] + offB; const int ro = (8 * w + i) * RS + dk0 * 2;
                    *(LAS unsigned*)(QI + ro) = pk2(qa[i] * __expf(ba - brA), qb[i] * __expf(bb - brB));
                    *(LAS unsigned*)(KI + ro) = pk2(ka[i] * __expf(brA - ba), kb[i] * __expf(brB - bb));
                    *(LAS unsigned*)(QE + ro) = pk2(qa[i] * __expf(ba), qb[i] * __expf(bb)); }
            }
            __syncthreads();
            {
                const int rt = w >> 1, ct0 = 2 * (w & 1);
                f32x4 am[2] = {(f32x4){0.f, 0.f, 0.f, 0.f}, (f32x4){0.f, 0.f, 0.f, 0.f}};
#pragma unroll
                for (int s = 0; s < 4; ++s) { const bf16x8 af = ld8(QI + (16 * rt + cc) * RS + (32 * s + 8 * rg) * 2);
#pragma unroll
                    for (int t = 0; t < 2; ++t) { const bf16x8 bfr = ld8(KI + (16 * (ct0 + t) + cc) * RS + (32 * s + 8 * rg) * 2); am[t] = MFMA16(af, bfr, am[t]); } }
#pragma unroll
                for (int t = 0; t < 2; ++t)
#pragma unroll
                    for (int i = 0; i < 4; ++i) { const int l = 16 * rt + 4 * rg + i, m = 16 * (ct0 + t) + cc; const bool keep = dir == 0 ? (m <= l) : (m >= l);
                        *(LAS bf16*)(AM + l * RSA + m * 2) = f2bf(keep ? am[t][i] : 0.f); }
            }
            __syncthreads();
            {
                const int rt = w & 3, cb = 64 * (w >> 2);
#pragma unroll
                for (int s = 0; s < 2; ++s) { const bf16x8 af = ld8(AM + (16 * rt + cc) * RSA + (32 * s + 8 * rg) * 2);
#pragma unroll
                    for (int t = 0; t < 4; ++t) { const bf16x8 bfr = tr8(VV + (32 * s) * RS + (cb + 16 * t) * 2 + tro16, 4 * RS); o[t] = MFMA16(af, bfr, o[t]); } }
#pragma unroll
                for (int s = 0; s < 4; ++s) { const bf16x8 af = ld8(QE + (16 * rt + cc) * RS + (32 * s + 8 * rg) * 2);
#pragma unroll
                    for (int t = 0; t < 4; ++t) { const bf16x8 bfr = tr8(SP + (32 * s) * RS + (cb + 16 * t) * 2 + tro16, 4 * RS); o[t] = MFMA16(af, bfr, o[t]); } }
            }
            __syncthreads();
        }
        const int rt = w & 3, chh = w >> 2, cb = 64 * chh;
        float ssv[4];
#pragma unroll
        for (int i = 0; i < 4; ++i) { float sq = 0.f;
#pragma unroll
            for (int t = 0; t < 4; ++t) sq += o[t][i] * o[t][i];
            sq += __shfl_xor(sq, 1); sq += __shfl_xor(sq, 2); sq += __shfl_xor(sq, 4); sq += __shfl_xor(sq, 8); ssv[i] = sq; }
        if (cc == 0) {
#pragma unroll
            for (int i = 0; i < 4; ++i) SSQ[chh * 64 + 16 * rt + 4 * rg + i] = ssv[i]; }
        __syncthreads();
#pragma unroll
        for (int i = 0; i < 4; ++i) { const int l = 16 * rt + 4 * rg + i; const float r = rsqrtf((SSQ[l] + SSQ[64 + l]) * (1.f / 128.f) + EPS);
#pragma unroll
            for (int t = 0; t < 4; ++t) { const int dv = cb + 16 * t + cc; const float g = bf2f(PROJ[(rb + l) * INW + C_HG + h * 128 + dv]);
                YAIN[(rb + l) * 1024 + h * 128 + dv] = f2bf(o[t][i] * r * F.onorm[h * 128 + dv] * siluf_(g)); } }
        __syncthreads();
    }
#undef HC_LOAD
}
__device__ __forceinline__ void rope8(v4u& a, v4u& bq, const f32x4 (&cs)[4]) {
    const unsigned aw[4] = {a.x, a.y, a.z, a.w}, bw[4] = {bq.x, bq.y, bq.z, bq.w}; unsigned o1[4], o2[4];
#pragma unroll
    for (int k = 0; k < 4; ++k) { const f32x4 c4 = cs[k];
        const float x1a = __uint_as_float(aw[k] << 16), x1b = __uint_as_float(aw[k] & 0xffff0000u), x2a = __uint_as_float(bw[k] << 16), x2b = __uint_as_float(bw[k] & 0xffff0000u);
        o1[k] = pk2(x1a * c4.x - x2a * c4.y, x1b * c4.z - x2b * c4.w); o2[k] = pk2(x1a * c4.y + x2a * c4.x, x1b * c4.w + x2b * c4.z); }
    a = (v4u){o1[0], o1[1], o1[2], o1[3]}; bq = (v4u){o2[0], o2[1], o2[2], o2[3]};
}
__device__ __forceinline__ void attn_phase(Ctx& F, LAS unsigned char* L) {
    const bf16* PROJ = (const bf16*)(F.ws + WS_PROJ); const float* ROPE = (const float*)(F.ws + WS_ROPE); bf16* ATT = (bf16*)(F.ws + WS_ATT);
    LAS unsigned char* KT = L; LAS unsigned char* VT = L + 17408; LAS float* AL = (LAS float*)(L + 34816) + F.wave * 32;
    const int tid = F.tid, lane = F.lane, w = F.wave, q32 = lane & 31, hh = lane >> 5;
    const int tro32 = (4 * hh + ((lane & 15) >> 2)) * RS + (16 * ((lane >> 4) & 1) + 4 * (lane & 3)) * 2;
    const int krow = tid >> 3, kc8 = tid & 7;
    constexpr float C2 = 0.08838834764831845f * LOG2E;
    for (int unit = blockIdx.x; unit < 256; unit += F.G) {
        const int qb = unit & 63, kvh = (unit >> 6) & 1, b = unit >> 7, q0 = qb * 64, h = kvh * 4 + (w >> 1);
        const int qp = q0 + 32 * (w & 1) + q32;
        bf16x8 qf[8];
        {
            const bf16* qptr = PROJ + ((size_t)b * SEQ + qp) * INW + C_AQ + h * 128 + 8 * hh;
            const f32x4* rp = (const f32x4*)(ROPE + (((size_t)b * SEQ + qp) * 64 + 8 * hh) * 2);
#pragma unroll
            for (int s = 0; s < 4; ++s) { v4u x1 = *(const v4u*)(qptr + 16 * s), x2 = *(const v4u*)(qptr + 16 * s + 64);
                f32x4 cs[4];
#pragma unroll
                for (int k = 0; k < 4; ++k) cs[k] = rp[8 * s + k];
                rope8(x1, x2, cs); qf[s] = __builtin_bit_cast(bf16x8, x1); qf[s + 4] = __builtin_bit_cast(bf16x8, x2); }
        }
        float m = F.sink[h] * LOG2E, l = 1.f;
        f32x16 o[4];
#pragma unroll
        for (int d = 0; d < 4; ++d)
#pragma unroll
            for (int r = 0; r < 16; ++r) o[d][r] = 0.f;
        int j = 0; while (j < 5 && (q0 - 128 + 64 * j < 0 || q0 - 128 + 64 * j >= SEQ)) ++j;
        v4u kr[2], vr[2]; f32x4 kcs[4];
#define ATT_LOAD(jj) do { const int kb_ = q0 - 128 + 64 * (jj); \
            { const size_t t_ = (size_t)b * SEQ + kb_ + krow; const bf16* kp_ = PROJ + t_ * INW + C_AK + kvh * 128 + kc8 * 8; kr[0] = *(const v4u*)kp_; kr[1] = *(const v4u*)(kp_ + 64); \
              const f32x4* rp_ = (const f32x4*)(ROPE + (t_ * 64 + kc8 * 8) * 2); _Pragma("unroll") for (int k = 0; k < 4; ++k) kcs[k] = rp_[k]; } \
            _Pragma("unroll") for (int i = 0; i < 2; ++i) { const int idx = tid + 512 * i, row = idx >> 4, ch = idx & 15; \
                vr[i] = *(const v4u*)(PROJ + ((size_t)b * SEQ + kb_ + row) * INW + C_AV + kvh * 128 + ch * 8); } } while (0)
        if (j < 5) ATT_LOAD(j);
        while (j < 5) {
            const int kb = q0 - 128 + 64 * j;
            __syncthreads();
            rope8(kr[0], kr[1], kcs);
            *(LAS v4u*)(KT + krow * RS + kc8 * 16) = kr[0]; *(LAS v4u*)(KT + krow * RS + (kc8 + 8) * 16) = kr[1];
#pragma unroll
            for (int i = 0; i < 2; ++i) { const int idx = tid + 512 * i, row = idx >> 4, ch = idx & 15; *(LAS v4u*)(VT + row * RS + ch * 16) = vr[i]; }
            __syncthreads();
            int jn = j + 1; while (jn < 5 && (q0 - 128 + 64 * jn < 0 || q0 - 128 + 64 * jn >= SEQ)) ++jn;
            if (jn < 5) ATT_LOAD(jn);
            f32x16 p0, p1;
#pragma unroll
            for (int r = 0; r < 16; ++r) { p0[r] = 0.f; p1[r] = 0.f; }
#pragma unroll
            for (int s = 0; s < 8; ++s) { const bf16x8 k0 = ld8(KT + q32 * RS + (16 * s + 8 * hh) * 2), k1 = ld8(KT + (32 + q32) * RS + (16 * s + 8 * hh) * 2);
                p0 = MFMA32(k0, qf[s], p0); p1 = MFMA32(k1, qf[s], p1); }
            float tmax = -INFINITY;
#pragma unroll
            for (int r = 0; r < 16; ++r) { const int d0 = kb + crow(r, hh) - qp;
                p0[r] = ((unsigned)(d0 + 128) <= 256u) ? p0[r] * C2 : -INFINITY; p1[r] = ((unsigned)(d0 + 32 + 128) <= 256u) ? p1[r] * C2 : -INFINITY;
                tmax = fmaxf(tmax, fmaxf(p0[r], p1[r])); }
            tmax = fmaxf(tmax, __shfl_xor(tmax, 32));
            const float mn = fmaxf(m, tmax), alpha = __builtin_amdgcn_exp2f(m - mn); m = mn;
            float rs = 0.f;
#pragma unroll
            for (int r = 0; r < 16; ++r) { p0[r] = __builtin_amdgcn_exp2f(p0[r] - mn); p1[r] = __builtin_amdgcn_exp2f(p1[r] - mn); rs += p0[r] + p1[r]; }
            rs += __shfl_xor(rs, 32);
            l = l * alpha + rs;
            if (hh == 0) AL[q32] = alpha;
            LDS_WAIT();
#pragma unroll
            for (int g4 = 0; g4 < 4; ++g4) { const f32x4 a4 = *(const LAS f32x4*)(AL + 8 * g4 + 4 * hh);
#pragma unroll
                for (int d = 0; d < 4; ++d) { o[d][4 * g4 + 0] *= a4.x; o[d][4 * g4 + 1] *= a4.y; o[d][4 * g4 + 2] *= a4.z; o[d][4 * g4 + 3] *= a4.w; } }
#pragma unroll
            for (int kb2 = 0; kb2 < 2; ++kb2)
#pragma unroll
                for (int s = 0; s < 2; ++s) {
                    unsigned pw[4];
#pragma unroll
                    for (int k = 0; k < 4; ++k) pw[k] = kb2 ? cvtpk(p1[8 * s + 2 * k], p1[8 * s + 2 * k + 1]) : cvtpk(p0[8 * s + 2 * k], p0[8 * s + 2 * k + 1]);
                    const bf16x8 pa = __builtin_bit_cast(bf16x8, (v4u){pw[0], pw[1], pw[2], pw[3]});
#pragma unroll
                    for (int d = 0; d < 4; ++d) { const bf16x8 vf = tr8(VT + (32 * kb2 + 16 * s) * RS + 64 * d + tro32, 8 * RS); o[d] = MFMA32(pa, vf, o[d]); }
                }
            j = jn;
        }
#undef ATT_LOAD
        if (hh == 0) AL[q32] = 1.f / l;
        LDS_WAIT();
#pragma unroll
        for (int g4 = 0; g4 < 4; ++g4) { const f32x4 a4 = *(const LAS f32x4*)(AL + 8 * g4 + 4 * hh); const float av[4] = {a4.x, a4.y, a4.z, a4.w};
#pragma unroll
            for (int i = 0; i < 4; ++i) { const int r = 4 * g4 + i; const int qrow = q0 + 32 * (w & 1) + crow(r, hh);
                bf16* op = ATT + ((size_t)b * SEQ + qrow) * 1024 + h * 128 + q32;
#pragma unroll
                for (int d = 0; d < 4; ++d) op[32 * d] = f2bf(o[d][r] * av[i]); } }
        __syncthreads();
    }
}

#ifdef TESTMODE
__global__ void __launch_bounds__(256) k_rope(const bf16* __restrict__ PROJ, const float* __restrict__ rope, bf16* __restrict__ QR, bf16* __restrict__ KR) {
    const int gid = blockIdx.x * 256 + threadIdx.x;
    const int i = gid & 63, hh = (gid >> 6) % 10, t = gid / 640;
    const float cs = rope[((size_t)t * 64 + i) * 2], sn = rope[((size_t)t * 64 + i) * 2 + 1];
    const bf16* src = PROJ + (size_t)t * INW + (hh < 8 ? C_AQ + hh * 128 : C_AK + (hh - 8) * 128);
    const float x1 = bf2f(src[i]), x2 = bf2f(src[i + 64]);
    bf16* dst = hh < 8 ? QR + (size_t)t * 1024 + hh * 128 : KR + (size_t)t * 256 + (hh - 8) * 128;
    dst[i] = f2bf(x1 * cs - x2 * sn); dst[i + 64] = f2bf(x1 * sn + x2 * cs);
}
__global__ void __launch_bounds__(256) k_hgrn_naive(const bf16* __restrict__ PROJ, const float* __restrict__ lb, float* __restrict__ OF, float* __restrict__ OB) {
    __shared__ float qs[128], fs[128], ks[128], part[128];
    const int dir = blockIdx.x & 1, h = (blockIdx.x >> 1) & 7, b = blockIdx.x >> 4, tid = threadIdx.x, dv = tid & 127, half = tid >> 7;
    float S[64];
#pragma unroll
    for (int i = 0; i < 64; ++i) S[i] = 0.f;
    float* O = dir ? OB : OF;
    const float lbv = tid < 128 ? lb[dir * 1024 + h * 128 + tid] : 0.f;
    bf16 nzq = 0, nzf = 0, nv = 0;
    { const int t = dir ? SEQ - 1 : 0; const bf16* pr = PROJ + ((size_t)b * SEQ + t) * INW;
      if (tid < 128) { nzq = pr[C_HQ + h * 128 + tid]; nzf = pr[(dir ? C_FB : C_FF) + h * 128 + tid]; } nv = pr[C_HI + h * 128 + dv]; }
    for (int tp = 0; tp < SEQ; ++tp) {
        const int t = dir ? SEQ - 1 - tp : tp; const size_t row = (size_t)b * SEQ + t;
        const bf16 czq = nzq, czf = nzf, cv = nv;
        if (tp + 1 < SEQ) { const int t2 = dir ? SEQ - 2 - tp : tp + 1; const bf16* pr = PROJ + ((size_t)b * SEQ + t2) * INW;
            if (tid < 128) { nzq = pr[C_HQ + h * 128 + tid]; nzf = pr[(dir ? C_FB : C_FF) + h * 128 + tid]; } nv = pr[C_HI + h * 128 + dv]; }
        if (tid < 128) { const float zq = bf2f(czq), zf = bf2f(czf);
            const float f = lbv + (1.f - lbv) * sigmoidf_(zf); qs[tid] = siluf_(zq); fs[tid] = f; ks[tid] = 1.f - f; }
        const float v = bf2f(cv);
        __syncthreads();
        float acc = 0.f;
#pragma unroll
        for (int i = 0; i < 64; ++i) { const int dk = half * 64 + i; S[i] = fs[dk] * S[i] + ks[dk] * v; acc += S[i] * qs[dk]; }
        if (half == 1) part[dv] = acc;
        __syncthreads();
        if (half == 0) O[row * 1024 + h * 128 + dv] = acc + part[dv];
    }
}
__global__ void __launch_bounds__(256) k_hgrn_post(const float* __restrict__ OF, const float* __restrict__ OB, const bf16* __restrict__ PROJ, const float* __restrict__ onorm, bf16* __restrict__ YAIN) {
    const int w = blockIdx.x * 4 + (threadIdx.x >> 6), lane = threadIdx.x & 63, row = w >> 3, h = w & 7;
    const size_t o = (size_t)row * 1024 + h * 128;
    const float a0 = OF[o + lane] + OB[o + lane], a1 = OF[o + 64 + lane] + OB[o + 64 + lane];
    float ss = a0 * a0 + a1 * a1;
    for (int s = 32; s > 0; s >>= 1) ss += __shfl_xor(ss, s);
    const float r = rsqrtf(ss * (1.f / 128.f) + EPS);
    const bf16* pg = PROJ + (size_t)row * INW + C_HG + h * 128;
    YAIN[o + lane] = f2bf(a0 * r * onorm[h * 128 + lane] * siluf_(bf2f(pg[lane])));
    YAIN[o + 64 + lane] = f2bf(a1 * r * onorm[h * 128 + 64 + lane] * siluf_(bf2f(pg[64 + lane])));
}
__global__ void __launch_bounds__(256) k_attn_naive(const bf16* __restrict__ QR, const bf16* __restrict__ KR, const bf16* __restrict__ PROJ, const float* __restrict__ sink, bf16* __restrict__ ATT) {
    __shared__ float sl[4][264];
    const int wv = threadIdx.x >> 6, lane = threadIdx.x & 63;
    const int w = blockIdx.x * 4 + wv;
    const int i = w & 4095, h = (w >> 12) & 7, b = w >> 15, kvh = h >> 2;
    const size_t qrow = (size_t)b * SEQ + i;
    const float q0 = bf2f(QR[qrow * 1024 + h * 128 + 2 * lane]), q1 = bf2f(QR[qrow * 1024 + h * 128 + 2 * lane + 1]);
    const int jlo = i - 128 < 0 ? 0 : i - 128, jhi = i + 128 > SEQ - 1 ? SEQ - 1 : i + 128;
    const float sk = sink[h];
    float m = sk;
    for (int j = jlo; j <= jhi; ++j) {
        const bf16* kr = KR + ((size_t)b * SEQ + j) * 256 + kvh * 128;
        float p = q0 * bf2f(kr[2 * lane]) + q1 * bf2f(kr[2 * lane + 1]);
        for (int s = 32; s > 0; s >>= 1) p += __shfl_xor(p, s);
        p *= 0.08838834764831845f;
        if (lane == 0) sl[wv][j - jlo] = p;
        m = fmaxf(m, p);
    }
    __syncthreads();
    float den = expf(sk - m), o0 = 0.f, o1 = 0.f;
    for (int j = jlo; j <= jhi; ++j) {
        const float p = expf(sl[wv][j - jlo] - m); den += p;
        const bf16* vr = PROJ + ((size_t)b * SEQ + j) * INW + C_AV + kvh * 128;
        o0 += p * bf2f(vr[2 * lane]); o1 += p * bf2f(vr[2 * lane + 1]);
    }
    ATT[qrow * 1024 + h * 128 + 2 * lane] = f2bf(o0 / den); ATT[qrow * 1024 + h * 128 + 2 * lane + 1] = f2bf(o1 / den);
}
#endif
__global__ void __launch_bounds__(NWAVES * 64, 2) mega(Args args) {
    extern __shared__ __attribute__((aligned(16))) unsigned char lds[];
    Ctx F;
    F.lds = lds; F.tid = threadIdx.x; F.lane = F.tid & 63; F.wave = __builtin_amdgcn_readfirstlane(F.tid >> 6); F.G = gridDim.x;
    F.gw = blockIdx.x * NWAVES + F.wave; F.NGW = F.G * NWAVES;
    F.x = (const float*)args.in[0]; F.c = (const float*)args.in[1]; F.pos = (const int*)args.in[2]; F.w_ada = (const float*)args.in[3]; F.b_ada = (const float*)args.in[4];
    F.g_pre_mix = (const float*)args.in[5]; F.g_post_mix = (const float*)args.in[6]; F.g_pre_ffn = (const float*)args.in[7]; F.g_post_ffn = (const float*)args.in[8];
    F.w_in = (const float*)args.in[9]; F.lbl = (const float*)args.in[10]; F.onorm = (const float*)args.in[11]; F.sink = (const float*)args.in[12];
    F.w_a = (const float*)args.in[13]; F.w_b = (const float*)args.in[14]; F.w_o = (const float*)args.in[15]; F.w_router = (const float*)args.in[16];
    F.w_eg = (const float*)args.in[17]; F.w_eu = (const float*)args.in[18]; F.w_ed = (const float*)args.in[19];
    F.out = args.out; F.ws = args.ws;
    LAS unsigned char* ldsl = (LAS unsigned char*)lds;
    for (int u = F.tid; u < (LDS_BYTES - LDSCTL_OFF) / 4; u += NWAVES * 64) ((LAS unsigned*)(ldsl + LDSCTL_OFF))[u] = 0u;
    __syncthreads();
    volatile LAS unsigned* MISC = (volatile LAS unsigned*)(ldsl + MISC_OFF);
    XcdBarrier bar = xcd_barrier_post((unsigned*)(args.ws + WS_CTL) + CW_BAR + args.li * XCD_BAR_WORDS, MISC + 8);
    const int lo = args.ph_lo, hi = args.ph_hi;
#ifdef PROBE_REP
#define REP(k) ((((PROBE_REP) >> (k)) & 1) ? 2 : 1)
#else
#define REP(k) 1
#endif
#define IN(k) (lo <= (k) && (k) < hi)
#define SEAM(k) do { if (IN(k) && IN((k) + 1)) xcd_barrier(bar); } while (0)
    unsigned char* ws = args.ws;
    bf16* H = (bf16*)(ws + WS_H); bf16* PROJ = (bf16*)(ws + WS_PROJ); bf16* WIN = (bf16*)(ws + WS_WIN); bf16* WA = (bf16*)(ws + WS_WA); bf16* WB = (bf16*)(ws + WS_WB); bf16* WO = (bf16*)(ws + WS_WO);
    bf16* WGU = (bf16*)(ws + WS_WGU); bf16* WD = (bf16*)(ws + WS_WD); bf16* YAIN = (bf16*)(ws + WS_YAIN); bf16* ATT = (bf16*)(ws + WS_ATT); bf16* MERGED = (bf16*)(ws + WS_MERGED);
    float* Y = (float*)(ws + WS_Y); bf16* XE = (bf16*)(ws + WS_XE); bf16* ACT = (bf16*)(ws + WS_ACT); bf16* SLAB = (bf16*)(ws + WS_SLAB); const float* SELAFF = (const float*)(ws + WS_SELAFF);
    const int vcu = (F.G % 8 == 0) ? ((int)blockIdx.x % 8) * (F.G / 8) + (int)blockIdx.x / 8 : (int)blockIdx.x;

    {
    if (IN(0)) { p0_prep(F); __syncthreads(); } SEAM(0);
#if defined(PROBE_DUP) && PROBE_DUP == 0
    if (IN(0)) { p0_prep(F); __syncthreads(); } SEAM(0);
#endif
    }
    {
    if (IN(2)) {
        if (F.G == 256 && blockIdx.x >= 256 - CONV_BLOCKS) { float* scr = (float*)(F.lds + F.wave * 16384); TailSeq seq{I_MIX + P0_EXPERT_ITEMS + ((int)blockIdx.x - (256 - CONV_BLOCKS)) * NWAVES + F.wave, CONV_BLOCKS * NWAVES}; transpose_stream(F, seq, scr); }
        else {
            const int gg = F.G == 256 ? 256 - CONV_BLOCKS : F.G;
            pg8::Gemm g{H, WIN, T, INW, D}; pg8::StaticOrder S; S.init(T, INW, gg, (int)blockIdx.x);
            pg8::EpiStore E{PROJ, INW, 0xffff, nullptr};
            pg8::gemm_phase<pg8::EpiStore, pg8::StaticOrder, PG8_ALIGN, PG8_SP2>(ldsl + RING_OFF, g, S, E);
            if (F.G != 256 && blockIdx.x == 0) { float* scr = (float*)(F.lds + F.wave * 16384); TailSeq seq{I_MIX + P0_EXPERT_ITEMS + F.wave, NWAVES}; transpose_stream(F, seq, scr); }
        }
    } SEAM(2);
    }
    {
    if (IN(3)) { if (args.mask & 2) hgrn_a_phase(F, ldsl); } SEAM(3);
#if defined(PROBE_DUP) && PROBE_DUP == 3
    if (IN(3)) { if (args.mask & 2) hgrn_a_phase(F, ldsl); } SEAM(3);
#endif
    }
    {
    if (IN(4)) { if (args.mask & 2) hgrn_scan_phase(F); if (args.mask & 1) attn_phase(F, ldsl); } SEAM(4);
#if defined(PROBE_DUP) && PROBE_DUP == 4
    if (IN(4)) { if (args.mask & 2) hgrn_scan_phase(F); if (args.mask & 1) attn_phase(F, ldsl); } SEAM(4);
#endif
    }
    {
    if (IN(5)) { if (args.mask & 2) hgrn_c_phase(F, ldsl); } SEAM(5);
#if defined(PROBE_DUP) && PROBE_DUP == 5
    if (IN(5)) { if (args.mask & 2) hgrn_c_phase(F, ldsl); } SEAM(5);
#endif
    }
    {
    if (IN(6)) {
        static_assert(WS_ATT == WS_YAIN + 16 * MiB && WS_WB == WS_WA + 4 * MiB, "branch operands must be contiguous");
        pg8::Gemm g{YAIN, WA, 2 * T, 2 * D, 1024}; pg8::BranchOrder S; S.S.init(T, D, F.G, (int)blockIdx.x);
        pg8::EpiGate2 E{MERGED, D, PROJ + C_GA, PROJ + C_GB, INW};
        pg8::gemm_phase<pg8::EpiGate2, pg8::BranchOrder, PG8_ALIGN, PG8_SP2>(ldsl + RING_OFF, g, S, E);
    } SEAM(6);
    }
    {
    if (IN(7)) {
        pg8::Gemm g{MERGED, WO, T, D, D}; pg8::StaticOrder S; S.init(T, D, F.G, (int)blockIdx.x);
        pg8::EpiStore E{(bf16*)Y, D, 0xffff, nullptr};
        pg8::gemm_phase<pg8::EpiStore, pg8::StaticOrder, PG8_ALIGN, PG8_SP2>(ldsl + RING_OFF, g, S, E);
    } SEAM(7);
#if defined(PROBE_DUP) && PROBE_DUP == 7
    if (IN(7)) {
        pg8::Gemm g{MERGED, WO, T, D, D}; pg8::StaticOrder S; S.init(T, D, F.G, (int)blockIdx.x);
        pg8::EpiStore E{(bf16*)Y, D, 0xffff, nullptr};
        pg8::gemm_phase<pg8::EpiStore, pg8::StaticOrder, PG8_ALIGN, PG8_SP2>(ldsl + RING_OFF, g, S, E);
    } SEAM(7);
#endif
    }
    {
    if (IN(8)) { p6_post1(F); } SEAM(8);
#if defined(PROBE_DUP) && PROBE_DUP == 8
    if (IN(8)) { p6_post1(F); } SEAM(8);
#endif
    }
    {
    if (IN(9)) { p7_topk_gather(F); } SEAM(9);
#if defined(PROBE_DUP) && PROBE_DUP == 9
    if (IN(9)) { p7_topk_gather(F); } SEAM(9);
#endif
    }
    {
    if (IN(10)) {
        pg8::Gemm g{(const bf16*)(ws + WS_H2), WGU, 16 * 1024, 16 * 2048, D, (const int*)(ws + WS_GIDX)}; pg8::GroupedOrder S{F.G, vcu};
        pg8::EpiSwiglu E{ACT};
        pg8::gemm_phase<pg8::EpiSwiglu, pg8::GroupedOrder, PG8_ALIGN, PG8_SP2, true>(ldsl + RING_OFF, g, S, E);
    } SEAM(10);
    }
    {
    if (IN(11)) {
        pg8::Gemm g{ACT, WD, 16 * 1024, 16 * 2048, 1024}; pg8::GroupedOrder S{F.G, vcu};
        pg8::EpiStore E{SLAB, D, 7, SELAFF};
        pg8::gemm_phase<pg8::EpiStore, pg8::GroupedOrder, PG8_ALIGN, PG8_SP2>(ldsl + RING_OFF, g, S, E);
    } SEAM(11);
    }
    {
    if (IN(12)) { p10_final(F); }
    }
#undef IN
#undef SEAM
}

extern "C" void kernel_launch(void* const* d_in, const int* in_sizes, int n_in, void* d_out, int out_size, void* d_ws, size_t ws_size, hipStream_t stream) {
    static int grid = 0;
    if (grid == 0) {
        if (n_in != 20 || ws_size < WS_END) { fprintf(stderr, "kernel_launch: unexpected n_in %d or ws_size %zu\n", n_in, ws_size); grid = -1; return; }
        int dev = 0, cus = 0;
        if (hipGetDevice(&dev) != hipSuccess || hipDeviceGetAttribute(&cus, hipDeviceAttributeMultiprocessorCount, dev) != hipSuccess) { grid = -1; return; }
        if (hipFuncSetAttribute((const void*)mega, hipFuncAttributeMaxDynamicSharedMemorySize, LDS_BYTES) != hipSuccess) { fprintf(stderr, "kernel_launch: hipFuncSetAttribute failed\n"); grid = -1; return; }
        grid = cus;
    }
    if (grid < 0) return;
    char* ws = (char*)d_ws;
    (void)hipMemsetAsync(ws + WS_CTL, 0, CTL_ZERO_BYTES, stream);
    Args a{};
    for (int i = 0; i < 20; ++i) a.in[i] = d_in[i];
    a.out = (float*)d_out; a.ws = (unsigned char*)d_ws;
#ifndef TESTMODE
    a.ph_lo = 0; a.ph_hi = 13; a.li = 0; a.mask = 3;
#ifdef PROBE_REPEAT
    a.rep = PROBE_REPEAT;
#else
    a.rep = -1;
#endif
    hipLaunchKernelGGL(mega, dim3(grid), dim3(NWAVES * 64), LDS_BYTES, stream, a);
#ifdef PROBE_LO
    a.ph_lo = PROBE_LO; a.ph_hi = PROBE_HI; a.li = 1; a.mask = PROBE_MASK;
    hipLaunchKernelGGL(mega, dim3(grid), dim3(NWAVES * 64), LDS_BYTES, stream, a);
#endif
#else
    const float* LB = (const float*)(ws + WS_LB); const float* ROPE = (const float*)(ws + WS_ROPE);
    bf16* PROJ = (bf16*)(ws + WS_PROJ); bf16* QR = (bf16*)(ws + WS_QR); bf16* KR = (bf16*)(ws + WS_KR); bf16* YAIN = (bf16*)(ws + WS_YAIN); bf16* ATT = (bf16*)(ws + WS_ATT);
    float* OF = (float*)(ws + WS_CS); float* OB = (float*)(ws + WS_CS + 32 * MiB);
    a.ph_lo = 0; a.ph_hi = 3; a.li = 0; a.mask = 3;
    hipLaunchKernelGGL(mega, dim3(grid), dim3(NWAVES * 64), LDS_BYTES, stream, a);
#if TESTMODE == 1
    k_hgrn_naive<<<32, 256, 0, stream>>>(PROJ, LB, OF, OB);
    k_hgrn_post<<<T * 8 / 4, 256, 0, stream>>>(OF, OB, PROJ, (const float*)d_in[11], YAIN);
    a.ph_lo = 3; a.ph_hi = 6; a.li = 1; a.mask = 1;
    hipLaunchKernelGGL(mega, dim3(grid), dim3(NWAVES * 64), LDS_BYTES, stream, a);
#else
    k_rope<<<T * 640 / 256, 256, 0, stream>>>(PROJ, ROPE, QR, KR);
    k_attn_naive<<<BATCH * 8 * SEQ / 4, 256, 0, stream>>>(QR, KR, PROJ, (const float*)d_in[12], ATT);
    a.ph_lo = 3; a.ph_hi = 6; a.li = 1; a.mask = 2;
    hipLaunchKernelGGL(mega, dim3(grid), dim3(NWAVES * 64), LDS_BYTES, stream, a);
#endif
    a.ph_lo = 6; a.ph_hi = 13; a.li = 2; a.mask = 3;
    hipLaunchKernelGGL(mega, dim3(grid), dim3(NWAVES * 64), LDS_BYTES, stream, a);
#endif
}
```

```cpp
#include <hip/hip_runtime.h>
#include <cstdint>
#include <cstdio>

constexpr int D = 2048, BATCH = 2, SEQ = 4096, T = BATCH * SEQ;
constexpr int INW = 10752;
constexpr int C_HQ = 0, C_FF = 1024, C_FB = 2048, C_HI = 3072, C_HG = 4096, C_AQ = 5120, C_AK = 6144, C_AV = 6400, C_GA = 6656, C_GB = 8704;
constexpr int NE = 16, EFF = 1024, CAP = 512;
constexpr float EPS = 1e-6f;

typedef unsigned short bf16;
__device__ __forceinline__ float bf2f(bf16 v) { return __uint_as_float(((unsigned)v) << 16); }
typedef float f32x2h_t __attribute__((ext_vector_type(2))); typedef __bf16 bf16x2h_t __attribute__((ext_vector_type(2)));
__device__ __forceinline__ unsigned cvtpk2(float lo, float hi) { const f32x2h_t v = {lo, hi}; const bf16x2h_t b = __builtin_convertvector(v, bf16x2h_t); return __builtin_bit_cast(unsigned, b); }
__device__ __forceinline__ bf16 f2bf(float f) { return (bf16)(cvtpk2(f, 0.f) & 0xffffu); }
__device__ __forceinline__ float sigmoidf_(float x) { return __builtin_amdgcn_rcpf(1.f + __expf(-x)); }
__device__ __forceinline__ float siluf_(float x) { return x * __builtin_amdgcn_rcpf(1.f + __expf(-x)); }

constexpr size_t MiB = 1u << 20;
constexpr size_t WS_CTL = 0, CTL_ZERO_BYTES = 64 * 1024;
constexpr size_t WS_MOD = 1 * MiB;
constexpr size_t WS_LB = WS_MOD + 128 * 1024;
constexpr size_t WS_AFF = 2 * MiB;
constexpr size_t WS_GIDX = 3 * MiB;
constexpr size_t WS_SELAFF = WS_GIDX + 128 * 1024;
constexpr size_t WS_TOKSLOT = 4 * MiB;
constexpr size_t WS_DEC = 5 * MiB;
constexpr size_t WS_ROPE = 8 * MiB;
constexpr size_t WS_WIN = 16 * MiB;
constexpr size_t WS_WA = 60 * MiB, WS_WB = 64 * MiB, WS_WO = 68 * MiB;
constexpr size_t WS_WGU = 76 * MiB;
constexpr size_t WS_WD = 204 * MiB;
constexpr size_t WS_H = 268 * MiB;
constexpr size_t WS_PROJ = 300 * MiB;
constexpr size_t WS_Y = 520 * MiB;
constexpr size_t WS_XE = 300 * MiB;
constexpr size_t WS_ACT = 364 * MiB;
constexpr size_t WS_SLAB = 396 * MiB;
constexpr size_t WS_QR = 468 * MiB, WS_KR = 484 * MiB;
constexpr size_t WS_YAIN = 488 * MiB, WS_ATT = 504 * MiB;
constexpr size_t WS_CS = 520 * MiB;
constexpr size_t WS_STATE = 584 * MiB;
constexpr size_t WS_H2 = 584 * MiB;
constexpr size_t WS_MERGED = 268 * MiB;
constexpr size_t WS_END = 648 * MiB;
constexpr int CW_BAR = 4096;

namespace pg8 {
#define PG8_LAS __attribute__((address_space(3)))
typedef unsigned short bf16_t;
typedef short bf16x8 __attribute__((ext_vector_type(8)));
typedef float f32x4 __attribute__((ext_vector_type(4)));
typedef unsigned u32x4 __attribute__((ext_vector_type(4)));
constexpr int BM = 256, BK = 64, HALF = 128, HTB = HALF * BK * 2  , STAGE_BYTES = 8 * HTB, NXCD = 8, WGM = 8;

__host__ __device__ __forceinline__ int lds_byte(int r, int c) { const int st = (r >> 4) * 2 + (c >> 5), rr = r & 15, cc = c & 31, ob = rr * 64 + cc * 2; return st * 1024 + (ob ^ (((ob >> 9) & 1) << 5)); }
__host__ __device__ __forceinline__ void stage_rc(int b, int& R, int& C) { const int st = b / 1024, sb = b % 1024, swz = sb ^ (((sb >> 9) & 1) << 5); R = (st >> 1) * 16 + swz / 64; C = (st & 1) * 32 + (swz % 64) / 2; }
__host__ __device__ __forceinline__ int perm32(int rho) { const int n = rho >> 4, i = rho & 15; return 8 * (i >> 2) + 4 * n + (i & 3); }

struct Unit { int pm, pn; };
struct Gemm { const bf16_t* A; const bf16_t* Bt; int M, N, K; const int* gidx = nullptr; };

struct StaticOrder {
    int nM, nN, nwg, G, c;
    __host__ __device__ void init(int M, int N, int G_, int c_) { nM = M / BM; nN = N / BM; nwg = nM * nN; G = G_; c = c_; }
    __host__ __device__ bool next(int i, Unit& u) const {
        const long L = (long)i * G + c; if (L >= nwg) return false;
        int wgid = (int)L; { const int q = nwg / NXCD, r = nwg % NXCD, xcd = wgid % NXCD, off = wgid / NXCD; wgid = (xcd < r ? xcd * (q + 1) : r * (q + 1) + (xcd - r) * q) + off; }
        const int nig = WGM * nN, gid = wgid / nig, fm = gid * WGM, gsz = (nM - fm) < WGM ? (nM - fm) : WGM;
        u.pm = fm + ((wgid % nig) % gsz); u.pn = (wgid % nig) / gsz; return true;
    }
    __device__ __forceinline__ void a_ready(const Unit&) const {}
    __device__ __forceinline__ void done(const Unit&) const {}
};

typedef float f32x2c_t __attribute__((ext_vector_type(2))); typedef __bf16 bf16x2c_t __attribute__((ext_vector_type(2)));
__device__ __forceinline__ unsigned cvt_pk_bf16(float lo, float hi) { const f32x2c_t v = {lo, hi}; const bf16x2c_t b = __builtin_convertvector(v, bf16x2c_t); return __builtin_bit_cast(unsigned, b); }
typedef float f32x2 __attribute__((ext_vector_type(2)));

typedef unsigned u32x2 __attribute__((ext_vector_type(2)));
struct EpiStore {
    static constexpr bool PERM = true, AFTER_DRAIN = false;
    bf16_t* O; int ldc; int cmask; const float* rowscale; float osc = 1.f;
    __device__ __forceinline__ void operator()(const f32x4 (&acc)[2][2][4][2], const Unit& u, int wr, int wc, int fr, int fq) const {
        const int row0 = u.pm * BM + wr * 64 + fr, col0 = (u.pn & cmask) * BM + wc * 32 + 8 * fq;
#pragma unroll
        for (int ai = 0; ai < 2; ++ai)
#pragma unroll
            for (int m = 0; m < 4; ++m) { const int row = row0 + ai * HALF + m * 16; const float sc = (rowscale ? rowscale[row] : 1.f) * osc; bf16_t* rowp = O + (size_t)row * ldc + col0;
#pragma unroll
                for (int bj = 0; bj < 2; ++bj) { const f32x4 v0 = acc[ai][bj][m][0] * sc, v1 = acc[ai][bj][m][1] * sc;
                    u32x4 w; w.x = cvt_pk_bf16(v0[0], v0[1]); w.y = cvt_pk_bf16(v0[2], v0[3]); w.z = cvt_pk_bf16(v1[0], v1[1]); w.w = cvt_pk_bf16(v1[2], v1[3]);
                    *(u32x4*)(rowp + bj * HALF) = w; } }
    }
};
__device__ __forceinline__ float sigm(float x) { return __builtin_amdgcn_rcpf(1.f + __expf(-x)); }
struct EpiGate2 {
    static constexpr bool PERM = true, AFTER_DRAIN = false;
    bf16_t* O; int ldc; const bf16_t* Ga; const bf16_t* Gb; int ldg;
    __device__ __forceinline__ void operator()(const f32x4 (&acc)[2][2][4][2], const Unit& u, int wr, int wc, int fr, int fq) const {
        const bool second = u.pm >= 32; const bf16_t* G = second ? Gb : Ga;
        const int row0 = (u.pm & 31) * BM + wr * 64 + fr, col0 = (u.pn & 7) * BM + wc * 32 + 8 * fq;
#pragma unroll
        for (int ai = 0; ai < 2; ++ai)
#pragma unroll
            for (int m = 0; m < 4; ++m) { const int row = row0 + ai * HALF + m * 16;
#pragma unroll
                for (int bj = 0; bj < 2; ++bj) { const int col = col0 + bj * HALF;
                    const u32x4 g = *(const u32x4*)(G + (size_t)row * ldg + col);
                    float gg[8] = {__uint_as_float(g.x << 16), __uint_as_float(g.x & 0xffff0000u), __uint_as_float(g.y << 16), __uint_as_float(g.y & 0xffff0000u),
                                   __uint_as_float(g.z << 16), __uint_as_float(g.z & 0xffff0000u), __uint_as_float(g.w << 16), __uint_as_float(g.w & 0xffff0000u)};
                    float t[8] = {0.f, 0.f, 0.f, 0.f, 0.f, 0.f, 0.f, 0.f};
                    if (second) { const u32x4 q = *(const u32x4*)(O + (size_t)row * ldc + col);
                        t[0] = __uint_as_float(q.x << 16); t[1] = __uint_as_float(q.x & 0xffff0000u); t[2] = __uint_as_float(q.y << 16); t[3] = __uint_as_float(q.y & 0xffff0000u);
                        t[4] = __uint_as_float(q.z << 16); t[5] = __uint_as_float(q.z & 0xffff0000u); t[6] = __uint_as_float(q.w << 16); t[7] = __uint_as_float(q.w & 0xffff0000u); }
                    const f32x4 a0 = acc[ai][bj][m][0], a1 = acc[ai][bj][m][1];
                    float o[8];
#pragma unroll
                    for (int i = 0; i < 4; ++i) { o[i] = t[i] + sigm(gg[i]) * a0[i]; o[4 + i] = t[4 + i] + sigm(gg[4 + i]) * a1[i]; }
                    u32x4 w; w.x = cvt_pk_bf16(o[0], o[1]); w.y = cvt_pk_bf16(o[2], o[3]); w.z = cvt_pk_bf16(o[4], o[5]); w.w = cvt_pk_bf16(o[6], o[7]);
                    *(u32x4*)(O + (size_t)row * ldc + col) = w; } }
    }
};
struct BranchOrder {
    StaticOrder S;
    __device__ __forceinline__ bool next(int i, Unit& u) const { Unit t; if (!S.next(i >> 1, t)) return false; u.pm = t.pm + 32 * (i & 1); u.pn = t.pn + 8 * (i & 1); return true; }
    __device__ __forceinline__ void a_ready(const Unit&) const {}
    __device__ __forceinline__ void done(const Unit&) const {}
};
struct EpiF32 {
    static constexpr bool PERM = true, AFTER_DRAIN = false;
    float* O; int ldc;
    __device__ __forceinline__ void operator()(const f32x4 (&acc)[2][2][4][2], const Unit& u, int wr, int wc, int fr, int fq) const {
        const int row0 = u.pm * BM + wr * 64 + fr, col0 = u.pn * BM + wc * 32 + 8 * fq;
#pragma unroll
        for (int ai = 0; ai < 2; ++ai)
#pragma unroll
            for (int m = 0; m < 4; ++m) { float* rowp = O + (size_t)(row0 + ai * HALF + m * 16) * ldc + col0;
#pragma unroll
                for (int bj = 0; bj < 2; ++bj) { *(f32x4*)(rowp + bj * HALF) = acc[ai][bj][m][0]; *(f32x4*)(rowp + bj * HALF + 4) = acc[ai][bj][m][1]; } }
    }
};
__device__ __forceinline__ unsigned pk4_fp8(float a, float b, float c, float d) { int w = __builtin_amdgcn_cvt_pk_fp8_f32(a, b, 0, false); w = __builtin_amdgcn_cvt_pk_fp8_f32(c, d, w, true); return (unsigned)w; }
struct EpiSwiglu8 {
    static constexpr bool PERM = true, AFTER_DRAIN = false;
    unsigned char* O; float isc;
    __device__ __forceinline__ void operator()(const f32x4 (&acc)[2][2][4][2], const Unit& u, int wr, int wc, int fr, int fq) const {
        const int row0 = u.pm * BM + wr * 64 + fr, col0 = (u.pn & 7) * HALF + wc * 32 + 8 * fq;
#pragma unroll
        for (int ai = 0; ai < 2; ++ai)
#pragma unroll
            for (int m = 0; m < 4; ++m) { unsigned char* rowp = O + (size_t)(row0 + ai * HALF + m * 16) * 1024 + col0;
                float o[8];
#pragma unroll
                for (int n = 0; n < 2; ++n)
#pragma unroll
                    for (int i = 0; i < 4; ++i) { const float g = acc[ai][0][m][n][i] * isc, up = acc[ai][1][m][n][i] * isc; o[4 * n + i] = g * sigm(g) * up; }
                u32x2 w; w.x = pk4_fp8(o[0], o[1], o[2], o[3]); w.y = pk4_fp8(o[4], o[5], o[6], o[7]);
                *(u32x2*)rowp = w; }
    }
};
struct EpiSwiglu {
    static constexpr bool PERM = true, AFTER_DRAIN = false;
    bf16_t* O;
    __device__ __forceinline__ void operator()(const f32x4 (&acc)[2][2][4][2], const Unit& u, int wr, int wc, int fr, int fq) const {
        const int row0 = u.pm * BM + wr * 64 + fr, col0 = (u.pn & 7) * HALF + wc * 32 + 8 * fq;
#pragma unroll
        for (int ai = 0; ai < 2; ++ai)
#pragma unroll
            for (int m = 0; m < 4; ++m) { bf16_t* rowp = O + (size_t)(row0 + ai * HALF + m * 16) * 1024 + col0;
                float o[8];
#pragma unroll
                for (int n = 0; n < 2; ++n)
#pragma unroll
                    for (int i = 0; i < 4; ++i) { const float g = acc[ai][0][m][n][i], up = acc[ai][1][m][n][i]; o[4 * n + i] = g * sigm(g) * up; }
                u32x4 w; w.x = cvt_pk_bf16(o[0], o[1]); w.y = cvt_pk_bf16(o[2], o[3]); w.z = cvt_pk_bf16(o[4], o[5]); w.w = cvt_pk_bf16(o[6], o[7]);
                *(u32x4*)rowp = w; }
    }
};
struct GroupedOrder {
    int G, c;
    __device__ __forceinline__ bool next(int i, Unit& u) const { const int L = i * G + c; if (L >= 512) return false; const int e = L >> 5, r = L & 31; u.pm = e * 4 + (r & 3); u.pn = e * 8 + (r >> 2); return true; }
    __device__ __forceinline__ void a_ready(const Unit&) const {}
    __device__ __forceinline__ void done(const Unit&) const {}
};

typedef int v8i32 __attribute__((ext_vector_type(8)));
typedef int v4i32 __attribute__((ext_vector_type(4)));
__device__ __forceinline__ void mfma_f8(f32x4& acc, const v8i32& a, const v8i32& b, int sc) {
    asm volatile("v_mfma_scale_f32_16x16x128_f8f6f4 %0, %1, %2, %0, %3, %3 op_sel_hi:[0,0,0]" : "+v"(acc) : "v"(a), "v"(b), "v"(sc));
}
template <class Epi, class Sched, bool ALIGN_EPI = false, bool SP2 = false, bool GATHER = false, bool FP8 = false>
__device__ __forceinline__ void gemm_phase(PG8_LAS unsigned char* lds, const Gemm g, const Sched& S, const Epi& E) {
    const int tid = threadIdx.x, wid = __builtin_amdgcn_readfirstlane(tid >> 6), lane = tid & 63, wr = wid >> 2, wc = wid & 3, fr = lane & 15, fq = lane >> 4;
    const int K = g.K, nt = K / BK;
    unsigned voffA[2], voffB[2]; int Rr[2], Cc[2];
#pragma unroll
    for (int i = 0; i < 2; ++i) { int R, C; stage_rc(tid * 16 + i * 8192, R, C); const int Rb = Epi::PERM ? ((R & ~31) + perm32(R & 31)) : R; Rr[i] = R; Cc[i] = C;
        voffA[i] = (unsigned)(R * K + C) * 2u; voffB[i] = (unsigned)(Rb * K + C) * 2u; }
    unsigned cv0[2], cv1[2], nv0[2], nv1[2], sv0[2], sv1[2];
#define PG8_GOFF(o0, o1, pm_) do { _Pragma("unroll") for (int _i = 0; _i < 2; ++_i) { \
        o0[_i] = (unsigned)(g.gidx[(pm_) * BM + Rr[_i]] * K + Cc[_i]) * 2u; o1[_i] = (unsigned)(g.gidx[(pm_) * BM + HALF + Rr[_i]] * K + Cc[_i]) * 2u; } } while (0)
    const size_t kstep = (size_t)(BK * 2);
    const size_t hstep = (size_t)HALF * K * 2;
    const size_t tstep = 2 * hstep;
    const unsigned ldsw = (unsigned)wid * 1024u;
    const int aoff = FP8 ? lds_byte(wr * 64 + fr, fq * 16) : lds_byte(wr * 64 + fr, fq * 8), boff = FP8 ? lds_byte(wc * 32 + fr, fq * 16) : lds_byte(wc * 32 + fr, fq * 8);
#define PG8_SA(b, h) (((b) * 2 + (h)) * HTB)
#define PG8_SB(b, h) ((4 + (b) * 2 + (h)) * HTB)
#define PG8_STAGE(bufoff, gbase, voff) do { _Pragma("unroll") for (int _i = 0; _i < 2; ++_i) \
        __builtin_amdgcn_global_load_lds((const unsigned*)((const char*)(gbase) + (voff)[_i]), (PG8_LAS unsigned*)(lds + (bufoff) + ldsw + _i * 8192), 16, 0, 0); } while (0)
#define PG8_LDA(dst, b, h) do { if constexpr (FP8) { _Pragma("unroll") for (int m = 0; m < 4; ++m) { const PG8_LAS unsigned char* p_ = lds + PG8_SA(b, h) + aoff + m * 2048; \
            const v4i32 lo_ = *(const PG8_LAS v4i32*)p_, hi_ = *(const PG8_LAS v4i32*)(p_ + 16); dst##8[m] = __builtin_shufflevector(lo_, hi_, 0, 1, 2, 3, 4, 5, 6, 7); } } \
        else { _Pragma("unroll") for (int m = 0; m < 4; ++m) _Pragma("unroll") for (int k = 0; k < 2; ++k) dst[m][k] = *(const PG8_LAS bf16x8*)(lds + PG8_SA(b, h) + aoff + m * 2048 + k * 1024); } } while (0)
#define PG8_LDB(dst, b, h) do { if constexpr (FP8) { _Pragma("unroll") for (int n = 0; n < 2; ++n) { const PG8_LAS unsigned char* p_ = lds + PG8_SB(b, h) + boff + n * 2048; \
            const v4i32 lo_ = *(const PG8_LAS v4i32*)p_, hi_ = *(const PG8_LAS v4i32*)(p_ + 16); dst##8[n] = __builtin_shufflevector(lo_, hi_, 0, 1, 2, 3, 4, 5, 6, 7); } } \
        else { _Pragma("unroll") for (int n = 0; n < 2; ++n) _Pragma("unroll") for (int k = 0; k < 2; ++k) dst[n][k] = *(const PG8_LAS bf16x8*)(lds + PG8_SB(b, h) + boff + n * 2048 + k * 1024); } } while (0)
#define PG8_MMA(ai, bj, At, Bt) do { __builtin_amdgcn_s_setprio(1); \
        if constexpr (FP8) { _Pragma("unroll") for (int m = 0; m < 4; ++m) _Pragma("unroll") for (int n = 0; n < 2; ++n) \
            mfma_f8(acc[ai][bj][m][n], Bt##8[n], At##8[m], f8one); } \
        else { _Pragma("unroll") for (int m = 0; m < 4; ++m) _Pragma("unroll") for (int n = 0; n < 2; ++n) _Pragma("unroll") for (int k = 0; k < 2; ++k) \
            acc[ai][bj][m][n] = __builtin_amdgcn_mfma_f32_16x16x32_bf16(Bt[n][k], At[m][k], acc[ai][bj][m][n], 0, 0, 0); } \
        __builtin_amdgcn_s_setprio(0); } while (0)
#define PG8_WAIT_V(n) asm volatile("s_waitcnt vmcnt(" #n ")" ::: "memory")
#define PG8_WAIT_L(n) asm volatile("s_waitcnt lgkmcnt(" #n ")" ::: "memory")
#define PG8_BAR __builtin_amdgcn_s_barrier()
#define PG8_SCHED __builtin_amdgcn_sched_barrier(0)
    Unit cur, nxt; int ui = 0;
    if (!S.next(0, cur)) return;
    if constexpr (GATHER) { PG8_GOFF(cv0, cv1, cur.pm); }
    else {
#pragma unroll
        for (int i = 0; i < 2; ++i) { cv0[i] = voffA[i]; cv1[i] = voffA[i] + (unsigned)(HALF * K * 2); } }
    f32x4 acc[2][2][4][2];
#pragma unroll
    for (int a = 0; a < 2; ++a)
#pragma unroll
        for (int b = 0; b < 2; ++b)
#pragma unroll
            for (int m = 0; m < 4; ++m)
#pragma unroll
                for (int n = 0; n < 2; ++n) acc[a][b][m][n] = (f32x4){0.f, 0.f, 0.f, 0.f};
    bf16x8 At[4][2], B0[2][2], B1[2][2]; v8i32 At8[4], B08[2], B18[2]; int f8one = 0x7f7f7f7f; asm volatile("" : "+v"(f8one));
    const char* cA = (const char*)g.A + (GATHER ? (size_t)0 : (size_t)cur.pm * tstep); const char* cB = (const char*)g.Bt + (size_t)cur.pn * tstep;
    S.a_ready(cur);
    if constexpr (SP2) {
        PG8_STAGE(PG8_SB(0, 0), cB, voffB); PG8_STAGE(PG8_SB(0, 1), cB + hstep, voffB); PG8_STAGE(PG8_SA(0, 0), cA, cv0); PG8_STAGE(PG8_SA(0, 1), cA, cv1);
        if (wr == 1) PG8_BAR;
        PG8_WAIT_V(2); PG8_BAR;
        PG8_STAGE(PG8_SB(1, 0), cB + kstep, voffB); PG8_STAGE(PG8_SA(1, 0), cA + kstep, cv0); PG8_STAGE(PG8_SB(1, 1), cB + hstep + kstep, voffB);
        PG8_WAIT_V(6); PG8_BAR;
    } else {
        PG8_STAGE(PG8_SB(0, 0), cB, voffB); PG8_STAGE(PG8_SA(0, 0), cA, cv0); PG8_STAGE(PG8_SB(0, 1), cB + hstep, voffB); PG8_STAGE(PG8_SA(0, 1), cA, cv1);
        if (wr == 1) PG8_BAR;
        PG8_WAIT_V(4); PG8_BAR;
        PG8_STAGE(PG8_SB(1, 0), cB + kstep, voffB); PG8_STAGE(PG8_SA(1, 0), cA + kstep, cv0); PG8_STAGE(PG8_SB(1, 1), cB + hstep + kstep, voffB);
        PG8_WAIT_V(6); PG8_BAR;
    }
    for (;;) {
        const bool has_next = S.next(ui + 1, nxt);
        if (GATHER && has_next) { PG8_GOFF(nv0, nv1, nxt.pm); }
        else {
#pragma unroll
            for (int i = 0; i < 2; ++i) { nv0[i] = cv0[i]; nv1[i] = cv1[i]; } }
        const char* nA = (has_next && !GATHER) ? (const char*)g.A + (size_t)nxt.pm * tstep : cA; const char* nB = has_next ? (const char*)g.Bt + (size_t)nxt.pn * tstep : cB;
#pragma unroll 1
        for (int t = 0; t < nt; t += 2) {
            const bool last = (t == nt - 2);
            const char* a1 = cA + (size_t)(t + 1) * kstep;
            const char* a2 = last ? nA : cA + (size_t)(t + 2) * kstep; const char* b2 = last ? nB : cB + (size_t)(t + 2) * kstep;
            const char* a3 = a2 + kstep; const char* b3 = b2 + kstep;
#pragma unroll
            for (int i = 0; i < 2; ++i) { sv0[i] = last ? nv0[i] : cv0[i]; sv1[i] = last ? nv1[i] : cv1[i]; }
            if (last && has_next) S.a_ready(nxt);
            if constexpr (SP2) {
            PG8_LDB(B0, 0, 0); PG8_LDB(B1, 0, 1); PG8_SCHED; PG8_LDA(At, 0, 0); PG8_STAGE(PG8_SA(1, 1), a1, cv1);
            PG8_WAIT_V(8); PG8_WAIT_L(0); PG8_BAR; PG8_MMA(0, 0, At, B0); PG8_MMA(0, 1, At, B1); PG8_BAR; PG8_SCHED;
            PG8_LDA(At, 0, 1); PG8_STAGE(PG8_SB(0, 0), b2, voffB); PG8_STAGE(PG8_SB(0, 1), b2 + hstep, voffB); PG8_STAGE(PG8_SA(0, 0), a2, sv0);
            PG8_WAIT_V(8); PG8_WAIT_L(0); PG8_BAR; PG8_MMA(1, 0, At, B0); PG8_MMA(1, 1, At, B1); PG8_BAR; PG8_SCHED;
            PG8_LDB(B0, 1, 0); PG8_LDB(B1, 1, 1); PG8_SCHED; PG8_LDA(At, 1, 0); PG8_STAGE(PG8_SA(0, 1), a2, sv1);
            PG8_WAIT_V(8); PG8_WAIT_L(0); PG8_BAR; PG8_MMA(0, 0, At, B0); PG8_MMA(0, 1, At, B1); PG8_BAR; PG8_SCHED;
            PG8_LDA(At, 1, 1); PG8_STAGE(PG8_SB(1, 0), b3, voffB); PG8_STAGE(PG8_SB(1, 1), b3 + hstep, voffB); PG8_STAGE(PG8_SA(1, 0), a3, sv0);
            PG8_WAIT_V(8); PG8_WAIT_L(0); PG8_BAR; PG8_MMA(1, 0, At, B0); PG8_MMA(1, 1, At, B1); PG8_BAR; PG8_SCHED;
            } else {
            PG8_LDB(B0, 0, 0); PG8_SCHED; PG8_LDA(At, 0, 0); PG8_STAGE(PG8_SA(1, 1), a1, cv1);
            PG8_WAIT_L(8); PG8_BAR; PG8_WAIT_L(0); PG8_MMA(0, 0, At, B0); PG8_BAR; PG8_SCHED;
            PG8_LDB(B1, 0, 1); PG8_STAGE(PG8_SB(0, 0), b2, voffB);
            PG8_BAR; PG8_WAIT_L(0); PG8_MMA(0, 1, At, B1); PG8_BAR;
            PG8_LDA(At, 0, 1); PG8_STAGE(PG8_SA(0, 0), a2, sv0);
            PG8_BAR; PG8_WAIT_L(0); PG8_MMA(1, 0, At, B0); PG8_BAR; PG8_SCHED;
            PG8_STAGE(PG8_SB(0, 1), b2 + hstep, voffB);
            PG8_WAIT_V(6); PG8_BAR; PG8_MMA(1, 1, At, B1); PG8_BAR;
            PG8_LDB(B0, 1, 0); PG8_SCHED; PG8_LDA(At, 1, 0); PG8_STAGE(PG8_SA(0, 1), a2, sv1);
            PG8_WAIT_L(8); PG8_BAR; PG8_WAIT_L(0); PG8_MMA(0, 0, At, B0); PG8_BAR; PG8_SCHED;
            PG8_LDB(B1, 1, 1); PG8_STAGE(PG8_SB(1, 0), b3, voffB);
            PG8_BAR; PG8_WAIT_L(0); PG8_MMA(0, 1, At, B1); PG8_BAR;
            PG8_LDA(At, 1, 1); PG8_STAGE(PG8_SA(1, 0), a3, sv0);
            PG8_BAR; PG8_WAIT_L(0); PG8_MMA(1, 0, At, B0); PG8_BAR; PG8_SCHED;
            PG8_STAGE(PG8_SB(1, 1), b3 + hstep, voffB);
            PG8_WAIT_V(6); PG8_BAR; PG8_MMA(1, 1, At, B1); PG8_BAR;
            }
        }
        if constexpr (FP8) { asm volatile("s_nop 15\n\ts_nop 15\n\ts_nop 7" ::: "memory"); }
        if constexpr (ALIGN_EPI) { if (wr == 0) PG8_BAR; }
        if constexpr (!Epi::AFTER_DRAIN) { E(acc, cur, wr, wc, fr, fq); S.done(cur); }
        if (!has_next) break;
#pragma unroll
        for (int a = 0; a < 2; ++a)
#pragma unroll
            for (int b = 0; b < 2; ++b)
#pragma unroll
                for (int m = 0; m < 4; ++m)
#pragma unroll
                    for (int n = 0; n < 2; ++n) acc[a][b][m][n] = (f32x4){0.f, 0.f, 0.f, 0.f};
        cur = nxt; cA = nA; cB = nB; ++ui;
#pragma unroll
        for (int i = 0; i < 2; ++i) { cv0[i] = nv0[i]; cv1[i] = nv1[i]; }
        if constexpr (ALIGN_EPI) { if (wr == 1) PG8_BAR; }
    }
    PG8_WAIT_V(0);
    if constexpr (!ALIGN_EPI) { if (wr == 0) PG8_BAR; }
    PG8_BAR;
    if constexpr (Epi::AFTER_DRAIN) { E.fused(acc, cur, wr, wc, fr, fq, lds, wid, lane); S.done(cur); }
#undef PG8_GOFF
#undef PG8_SA
#undef PG8_SB
#undef PG8_STAGE
#undef PG8_LDA
#undef PG8_LDB
#undef PG8_MMA
#undef PG8_WAIT_V
#undef PG8_WAIT_L
#undef PG8_BAR
#undef PG8_SCHED
}
}

#ifndef PG8_SP2
#define PG8_SP2 true
#endif
#ifndef PG8_ALIGN
#define PG8_ALIGN true
#endif
constexpr int RING_OFF = 0, RING_BYTES = 131072;
constexpr int LDSCTL_OFF = RING_BYTES, MISC_OFF = LDSCTL_OFF + 320;
constexpr int LDS_BYTES = 163840;
constexpr int PARAM_OFF = 135168;
constexpr int NWAVES = 8;
#define GAS __attribute__((address_space(1)))
#define LAS __attribute__((address_space(3)))
typedef unsigned v4u __attribute__((ext_vector_type(4)));
typedef float f32x4 __attribute__((ext_vector_type(4)));
typedef GAS unsigned gu32;
#define RLX_AGENT __ATOMIC_RELAXED, __HIP_MEMORY_SCOPE_AGENT
#define LDS_WAIT() asm volatile("s_waitcnt lgkmcnt(0)" ::: "memory")
__device__ __forceinline__ unsigned pk2(float lo, float hi) { return cvtpk2(lo, hi); }

#define XB_TMO      128
#define XB_XCNT(j)  (256  + 64 * (j))
#define XB_XSUB(j)  (1280 + 64 * (j))
#define XB_XGEN(j)  (2304 + 64 * (j))
#define XB_TOP      3328
#define XB_TOPGEN   3392
#define XCD_BAR_WORDS 3456
#define XB_SPIN_CAP (1u << 18)

__device__ __forceinline__ unsigned xb_ld(unsigned* p)              { return __hip_atomic_load(p, __ATOMIC_RELAXED, __HIP_MEMORY_SCOPE_AGENT); }
__device__ __forceinline__ unsigned xb_add(unsigned* p, unsigned v) { return __hip_atomic_fetch_add(p, v, __ATOMIC_RELAXED, __HIP_MEMORY_SCOPE_AGENT); }
__device__ __forceinline__ unsigned xb_xcc_id() { return (unsigned)__builtin_amdgcn_s_getreg((3 << 11) | 20) & 0xFu; }
#define XB_SPIN(cond, bar) do { unsigned _sp = 0; while (cond) { __builtin_amdgcn_s_sleep(1); \
    if ((++_sp & 255u) == 0u) { if (xb_ld(&(bar)[XB_TMO])) break; if (_sp > XB_SPIN_CAP) { atomicAdd(&(bar)[XB_TMO], 1u); break; } } } } while (0)

struct XcdBarrier {
    unsigned* bar; unsigned x;
    volatile LAS unsigned* st;
};

__device__ __forceinline__ XcdBarrier xcd_barrier_post(unsigned* bar, volatile LAS unsigned* st) {
    XcdBarrier b; b.bar = bar; b.x = xb_xcc_id(); b.st = st;
    if (threadIdx.x == 0) (void)xb_add(&bar[XB_XCNT(b.x)], 1u);
    return b;
}
__device__ __forceinline__ void xcd_barrier_complete(unsigned* bar, unsigned x, unsigned& nloc, unsigned& nx) {
    const unsigned G = gridDim.x * gridDim.y * gridDim.z;
    unsigned sum, cnt, mine, sp = 0u;
    for (;;) {
        sum = 0u; cnt = 0u; mine = 0u;
#pragma unroll
        for (unsigned j = 0; j < 16; ++j) { const unsigned c = xb_ld(&bar[XB_XCNT(j)]); sum += c; cnt += (c > 0u) ? 1u : 0u; mine = (j == x) ? c : mine; }
        if (sum == G) break;
        __builtin_amdgcn_s_sleep(1);
        if ((++sp & 255u) == 0u) { if (xb_ld(&bar[XB_TMO])) break; if (sp > XB_SPIN_CAP) { atomicAdd(&bar[XB_TMO], 1u); break; } }
    }
    nloc = mine > 0u ? mine : 1u; nx = cnt > 0u ? cnt : 1u;
}

__device__ __forceinline__ void xcd_barrier(const XcdBarrier& b) {
    asm volatile("s_waitcnt vmcnt(0)" ::: "memory");
    __syncthreads();
    if (threadIdx.x == 0) {
        unsigned* bar = b.bar;
        __builtin_amdgcn_s_waitcnt(0);
        unsigned nloc = b.st[0], nx = b.st[1];
        if (nloc == 0u) { xcd_barrier_complete(bar, b.x, nloc, nx); b.st[0] = nloc; b.st[1] = nx; }
        const unsigned old = xb_add(&bar[XB_XSUB(b.x)], 1u);
        const unsigned gen = old / nloc;
        if (old + 1u == (gen + 1u) * nloc) {
            __builtin_amdgcn_fence(__ATOMIC_RELEASE, "agent");
            asm volatile("s_waitcnt vmcnt(0)" ::: "memory");
            const unsigned og = xb_add(&bar[XB_TOP], 1u);
            const unsigned tg = og / nx;
            if (og + 1u == (tg + 1u) * nx) xb_add(&bar[XB_TOPGEN], 1u);
            else XB_SPIN(xb_ld(&bar[XB_TOPGEN]) == tg, bar);
            __builtin_amdgcn_fence(__ATOMIC_ACQUIRE, "agent");
            xb_add(&bar[XB_XGEN(b.x)], 1u);
            asm volatile("s_waitcnt vmcnt(0)" ::: "memory");
        } else {
            XB_SPIN(xb_ld(&bar[XB_XGEN(b.x)]) == gen, bar);
            __builtin_amdgcn_fence(__ATOMIC_ACQUIRE, "agent");
            asm volatile("s_waitcnt vmcnt(0)" ::: "memory");
        }
    }
    __syncthreads();
}

struct Args { const void* in[20]; float* out; unsigned char* ws; int ph_lo, ph_hi, li, mask, rep, pad; };
struct Ctx {
    unsigned char* lds; int tid, lane, wave, G, gw, NGW;
    const float *x, *c, *w_ada, *b_ada, *g_pre_mix, *g_post_mix, *g_pre_ffn, *g_post_ffn, *w_in, *lbl, *onorm, *sink, *w_a, *w_b, *w_o, *w_router, *w_eg, *w_eu, *w_ed;
    const int* pos; float* out; unsigned char* ws;
};
__device__ __forceinline__ float wave_sum(float v) {
#pragma unroll
    for (int o = 1; o < 64; o <<= 1) v += __shfl_xor(v, o);
    return v;
}
struct TDesc { const float* src; bf16* dst; int N, K; float f8s; };
__device__ __forceinline__ void t_load(const TDesc& d, f32x4 (&r)[8], int lane) {
    const float* p = d.src + (size_t)(lane >> 3) * d.N + 4 * (lane & 7);
#pragma unroll
    for (int i = 0; i < 8; ++i) r[i] = *(const f32x4*)(p + (size_t)(8 * i) * d.N);
}
__device__ __forceinline__ void t_process(const TDesc& d, const f32x4 (&r)[8], float* scr, int lane) {
    { float* w = scr + (lane >> 3) * 33 + 4 * (lane & 7);
#pragma unroll
      for (int i = 0; i < 8; ++i) { float* q = w + (8 * i) * 33; q[0] = r[i].x; q[1] = r[i].y; q[2] = r[i].z; q[3] = r[i].w; } }
    LDS_WAIT(); asm volatile("" ::: "memory");
    if (d.f8s != 0.f) {
        const int c = lane & 3; const float f = d.f8s; unsigned char* dst8 = (unsigned char*)d.dst;
#pragma unroll
        for (int j = 0; j < 2; ++j) { const int n = (lane >> 2) + 16 * j; const float* s = scr + (16 * c) * 33 + n;
            v4u o; o.x = pg8::pk4_fp8(s[0 * 33] * f, s[1 * 33] * f, s[2 * 33] * f, s[3 * 33] * f); o.y = pg8::pk4_fp8(s[4 * 33] * f, s[5 * 33] * f, s[6 * 33] * f, s[7 * 33] * f);
            o.z = pg8::pk4_fp8(s[8 * 33] * f, s[9 * 33] * f, s[10 * 33] * f, s[11 * 33] * f); o.w = pg8::pk4_fp8(s[12 * 33] * f, s[13 * 33] * f, s[14 * 33] * f, s[15 * 33] * f);
            *(v4u*)(dst8 + (size_t)n * d.K + 16 * c) = o; }
    } else {
    const int c = lane & 7;
#pragma unroll
    for (int j = 0; j < 4; ++j) { const int n = (lane >> 3) + 8 * j; const float* s = scr + (8 * c) * 33 + n;
        v4u o; o.x = pk2(s[0 * 33], s[1 * 33]); o.y = pk2(s[2 * 33], s[3 * 33]); o.z = pk2(s[4 * 33], s[5 * 33]); o.w = pk2(s[6 * 33], s[7 * 33]);
        *(v4u*)(d.dst + (size_t)n * d.K + 8 * c) = o; }
    }
    LDS_WAIT(); asm volatile("" ::: "memory");
}
__device__ __forceinline__ void rope_entry(const int* pos, float* rope, int gid) {
    const int t = gid >> 6, i = gid & 63;
    double inv = 1.0, rr = 0.8659643233600653523531691834202299819398;
    for (int bit = 0; bit < 6; ++bit) { if ((i >> bit) & 1) inv *= rr; rr *= rr; }
    const double ang = (double)pos[t] * inv;
    const double kq = rint(ang * 0.3183098861837906715377675267450287);
    const double r = ang - kq * 3.141592653589793238462643383279502884;
    const double u = -(r * r);
    double s = 1.0 / 121645100408832000.0;
    s = s * u + 1.0 / 355687428096000.0; s = s * u + 1.0 / 1307674368000.0; s = s * u + 1.0 / 6227020800.0; s = s * u + 1.0 / 39916800.0; s = s * u + 1.0 / 362880.0;
    s = s * u + 1.0 / 5040.0; s = s * u + 1.0 / 120.0; s = s * u + 1.0 / 6.0; s = s * u + 1.0; s = s * r;
    double cz = 1.0 / 6402373705728000.0;
    cz = cz * u + 1.0 / 20922789888000.0; cz = cz * u + 1.0 / 87178291200.0; cz = cz * u + 1.0 / 479001600.0; cz = cz * u + 1.0 / 3628800.0; cz = cz * u + 1.0 / 40320.0;
    cz = cz * u + 1.0 / 720.0; cz = cz * u + 1.0 / 24.0; cz = cz * u + 0.5; cz = cz * u + 1.0;
    const double sg = (((long long)kq) & 1) ? -1.0 : 1.0;
    rope[(size_t)gid * 2] = (float)(sg * cz); rope[(size_t)gid * 2 + 1] = (float)(sg * s);
}
constexpr float W8S_GU = 64.f, W8S_D = 32.f;
constexpr int I_IN = 32 * 336, I_A = 16 * 64, I_O = 32 * 64, I_E = 1024, I_MIX = I_IN + 2 * I_A + I_O, I_EXP = 48 * I_E;
constexpr int CONV_BLOCKS = 32;
constexpr int CONV_ITEMS_PER_WAVE = 100;
constexpr int P0_EXPERT_ITEMS = I_EXP - CONV_BLOCKS * NWAVES * CONV_ITEMS_PER_WAVE;
constexpr int P0_GEMV_ROUNDS = 8;
constexpr int GEMV_BLOCKS = 96;
__device__ __forceinline__ TDesc transpose_desc(Ctx& F, int it) {
    bf16* WIN = (bf16*)(F.ws + WS_WIN); bf16* WA = (bf16*)(F.ws + WS_WA); bf16* WB = (bf16*)(F.ws + WS_WB); bf16* WO = (bf16*)(F.ws + WS_WO); bf16* WGU = (bf16*)(F.ws + WS_WGU); bf16* WD = (bf16*)(F.ws + WS_WD);
    int r = it; const float* W; bf16* WT; int K, N, kb, nb; size_t drow; float f8s = 0.f;
    if (r < I_IN) { W = F.w_in; WT = WIN; K = 2048; N = INW; kb = r / 336; nb = r % 336; drow = (size_t)32 * nb; }
    else if ((r -= I_IN) < I_A) { W = F.w_a; WT = WA; K = 1024; N = 2048; kb = r / 64; nb = r % 64; drow = (size_t)32 * nb; }
    else if ((r -= I_A) < I_A) { W = F.w_b; WT = WB; K = 1024; N = 2048; kb = r / 64; nb = r % 64; drow = (size_t)32 * nb; }
    else if ((r -= I_A) < I_O) { W = F.w_o; WT = WO; K = 2048; N = 2048; kb = r / 64; nb = r % 64; drow = (size_t)32 * nb; }
    else { r -= I_O; const int e = r / (3 * I_E), q = r % (3 * I_E), which = q / I_E, ii = q % I_E;
        if (which < 2) { kb = ii / 32; nb = ii % 32; const int n0 = 32 * nb; W = (which ? F.w_eu : F.w_eg) + (size_t)e * 2048 * 1024; WT = WGU; K = 2048; N = 1024; f8s = W8S_GU; drow = (size_t)e * 2048 + (n0 >> 7) * 256 + which * 128 + (n0 & 127); }
        else { kb = ii / 64; nb = ii % 64; W = F.w_ed + (size_t)e * 1024 * 2048; WT = WD; K = 1024; N = 2048; f8s = W8S_D; drow = (size_t)e * 2048 + 32 * nb; } }
    TDesc d; d.src = W + (size_t)(64 * kb) * N + 32 * nb; d.N = N; d.K = K; d.f8s = f8s;
    if (f8s != 0.f) d.dst = (bf16*)((unsigned char*)WT + drow * K + 64 * kb); else d.dst = WT + drow * K + 64 * kb;
    return d;
}
template <class Seq> __device__ __forceinline__ void transpose_stream(Ctx& F, const Seq& seq, float* scr) {
    f32x4 ra[8], rb[8]; TDesc da, db; int j = 0; int it = seq(j);
    if (it < 0) return;
    da = transpose_desc(F, it); t_load(da, ra, F.lane);
    for (;;) {
        const int itn = seq(++j);
        if (itn >= 0) { db = transpose_desc(F, itn); t_load(db, rb, F.lane); }
        t_process(da, ra, scr, F.lane);
        if (itn < 0) break;
        const int itnn = seq(++j);
        if (itnn >= 0) { da = transpose_desc(F, itnn); t_load(da, ra, F.lane); }
        t_process(db, rb, scr, F.lane);
        if (itnn < 0) break;
    }
}
struct P0Seq { int gw, NGW, ngv; bool gemv;
    __device__ __forceinline__ int operator()(int r) const { int it; if (r < P0_GEMV_ROUNDS) it = r * NGW + gw; else { if (gemv) return -1; it = P0_GEMV_ROUNDS * NGW + (r - P0_GEMV_ROUNDS) * (NGW - ngv) + (gw - ngv); }
        return it < I_MIX + P0_EXPERT_ITEMS ? it : -1; } };
struct TailSeq { int first, stride;
    __device__ __forceinline__ int operator()(int j) const { const int it = first + j * stride; return it < I_MIX + I_EXP ? it : -1; } };
__device__ __forceinline__ void p1_modnorm(Ctx& F, int first, int stride) {
    const float* MOD = (const float*)(F.ws + WS_MOD); bf16* H = (bf16*)(F.ws + WS_H);
    for (int row0 = first; row0 < T; row0 += 2 * stride) {
        f32x4 v[2][8];
#pragma unroll
        for (int k = 0; k < 2; ++k) { const int row = row0 + k * stride; if (row < T) { const f32x4* xr = (const f32x4*)(F.x + (size_t)row * D) + F.lane;
#pragma unroll
            for (int j = 0; j < 8; ++j) v[k][j] = xr[64 * j]; } }
#pragma unroll
        for (int k = 0; k < 2; ++k) { const int row = row0 + k * stride; if (row < T) {
            const int b = row / SEQ; float ss = 0.f;
#pragma unroll
            for (int j = 0; j < 8; ++j) ss += (v[k][j].x * v[k][j].x + v[k][j].y * v[k][j].y) + (v[k][j].z * v[k][j].z + v[k][j].w * v[k][j].w);
            const float r = rsqrtf(wave_sum(ss) * (1.f / D) + EPS);
            const f32x4* gp = (const f32x4*)F.g_pre_mix + F.lane; const f32x4* shp = (const f32x4*)(MOD + b * 12288) + F.lane; const f32x4* scp = (const f32x4*)(MOD + b * 12288 + 2048) + F.lane;
            uint2* o8 = (uint2*)(H + (size_t)row * D) + F.lane;
            f32x4 g[8], sh[8], sc[8];
#pragma unroll
            for (int j = 0; j < 8; ++j) { g[j] = gp[64 * j]; sh[j] = shp[64 * j]; sc[j] = scp[64 * j]; }
#pragma unroll
            for (int j = 0; j < 8; ++j) { const f32x4 h = v[k][j] * r * g[j] * (sc[j] + 1.f) + sh[j];
                uint2 w; w.x = pk2(h.x, h.y); w.y = pk2(h.z, h.w); o8[64 * j] = w; } } }
    }
}
__device__ __forceinline__ void p0_prep(Ctx& F) {
    float* MOD = (float*)(F.ws + WS_MOD); float* LB = (float*)(F.ws + WS_LB); float* ROPE = (float*)(F.ws + WS_ROPE);
    if (blockIdx.x < GEMV_BLOCKS) {
        float* sc = (float*)F.lds; float* red = (float*)(F.lds + 16384);
        for (int i = F.tid; i < 4096; i += 512) sc[i] = siluf_(F.c[i]);
        __syncthreads();
        const int j0 = blockIdx.x * 128, k0 = F.wave * 256, half = F.lane >> 5, l32 = F.lane & 31;
        f32x4 a0 = {0.f, 0.f, 0.f, 0.f}, a1 = {0.f, 0.f, 0.f, 0.f};
        const float* wp = F.w_ada + (size_t)(k0 + half) * 12288 + j0 + 4 * l32;
#pragma unroll 16
        for (int k = 0; k < 128; ++k) { const f32x4 w = *(const f32x4*)(wp + (size_t)(2 * k) * 12288); const float s0 = sc[k0 + 2 * k + half], s1 = sc[2048 + k0 + 2 * k + half]; a0 += w * s0; a1 += w * s1; }
        *(f32x4*)(red + ((F.wave * 2 + half) * 2 + 0) * 128 + 4 * l32) = a0; *(f32x4*)(red + ((F.wave * 2 + half) * 2 + 1) * 128 + 4 * l32) = a1;
        __syncthreads();
        if (F.tid < 256) { const int b = F.tid >> 7, jj = F.tid & 127; float s = 0.f;
#pragma unroll
          for (int p = 0; p < 16; ++p) s += red[(p * 2 + b) * 128 + jj];
          MOD[b * 12288 + j0 + jj] = s + F.b_ada[j0 + jj]; }
        __syncthreads();
    }
    { const int gt = blockIdx.x * 512 + F.tid, NT = F.G * 512;
      if (gt < 2048) { const int dir = gt >> 10, ch = gt & 1023; const float l0 = F.lbl[dir * 2048 + ch], l1 = F.lbl[dir * 2048 + 1024 + ch]; LB[gt] = 1.f / (1.f + expf(l1 - l0)); }
      for (int g = gt; g < T * 64; g += NT) rope_entry(F.pos, ROPE, g); }
    unsigned* cnt = (unsigned*)(F.ws + WS_CTL) + 1024;
    if (blockIdx.x < GEMV_BLOCKS) {
        asm volatile("s_waitcnt vmcnt(0)" ::: "memory"); __syncthreads();
        if (F.tid == 0) { __builtin_amdgcn_fence(__ATOMIC_RELEASE, "agent"); asm volatile("s_waitcnt vmcnt(0)" ::: "memory"); __hip_atomic_fetch_add(cnt, 1u, __ATOMIC_RELAXED, __HIP_MEMORY_SCOPE_AGENT); }
    }
    float* scr = (float*)(F.lds + F.wave * 16384);
    P0Seq seq{F.gw, F.NGW, GEMV_BLOCKS * NWAVES, blockIdx.x < GEMV_BLOCKS};
    transpose_stream(F, seq, scr);
    __syncthreads();
    if (F.tid == 0) { unsigned sp = 0; while (__hip_atomic_load(cnt, __ATOMIC_RELAXED, __HIP_MEMORY_SCOPE_AGENT) < (unsigned)GEMV_BLOCKS && ++sp < (1u << 22)) __builtin_amdgcn_s_sleep(2);
        __builtin_amdgcn_fence(__ATOMIC_ACQUIRE, "agent"); asm volatile("s_waitcnt vmcnt(0)" ::: "memory"); }
    __syncthreads();
    p1_modnorm(F, F.gw, F.NGW);
}
__device__ __forceinline__ void p6_post1(Ctx& F) {
    const float* MOD = (const float*)(F.ws + WS_MOD); const float* Y = (const float*)(F.ws + WS_Y); bf16* H2 = (bf16*)(F.ws + WS_H2); float* AFF = (float*)(F.ws + WS_AFF);
    float* wT = (float*)F.lds;
    float* PA = (float*)(F.lds + PARAM_OFF); float* PB = PA + 2048; float* PC = PB + 2048;
    for (int f = F.tid; f < 8192; f += 512) { const int d = f >> 2, q = f & 3; const f32x4 wv = *((const f32x4*)F.w_router + f);
        wT[(4 * q + 0) * 2048 + d] = wv.x; wT[(4 * q + 1) * 2048 + d] = wv.y; wT[(4 * q + 2) * 2048 + d] = wv.z; wT[(4 * q + 3) * 2048 + d] = wv.w; }
    uint2 ywn[8]; f32x4 xvn[8];
#define P6_LOAD(rr) do { const uint2* yr_ = (const uint2*)((const bf16*)Y + (size_t)(rr) * D) + F.lane; const f32x4* xr_ = (const f32x4*)(F.x + (size_t)(rr) * D) + F.lane; \
        _Pragma("unroll") for (int j = 0; j < 8; ++j) { ywn[j] = yr_[64 * j]; xvn[j] = xr_[64 * j]; } } while (0)
    for (int b = 0; b < BATCH; ++b) {
        const float* mb = MOD + b * 12288;
        __syncthreads();
        if (F.tid < 512) { const int d4 = F.tid;
            const f32x4 gt = *((const f32x4*)(mb + 4096) + d4), gp = *((const f32x4*)F.g_post_mix + d4), g2 = *((const f32x4*)F.g_pre_ffn + d4), sc = *((const f32x4*)(mb + 8192) + d4), sh = *((const f32x4*)(mb + 6144) + d4);
            *((f32x4*)PA + d4) = gt * gp; *((f32x4*)PB + d4) = g2 * (sc + 1.f); *((f32x4*)PC + d4) = sh; }
        const int rfirst = b * SEQ + F.gw;
        if (F.gw < SEQ) P6_LOAD(rfirst);
        __syncthreads();
        for (int rl = F.gw; rl < SEQ; rl += F.NGW) {
            const int row = b * SEQ + rl, s = rl;
            f32x4 xv[8]; float ss = 0.f;
            {   uint2 yc[8];
#pragma unroll
                for (int j = 0; j < 8; ++j) { yc[j] = ywn[j]; const float y0 = __uint_as_float(yc[j].x << 16), y1 = __uint_as_float(yc[j].x & 0xffff0000u), y2 = __uint_as_float(yc[j].y << 16), y3 = __uint_as_float(yc[j].y & 0xffff0000u);
                    xv[j] = xvn[j]; ss += (y0 * y0 + y1 * y1) + (y2 * y2 + y3 * y3); }
                if (rl + F.NGW < SEQ) P6_LOAD(row + F.NGW);
                const float r = rsqrtf(wave_sum(ss) * (1.f / D) + EPS);
                f32x4* op = (f32x4*)(F.out + (size_t)row * D) + F.lane;
                ss = 0.f;
#pragma unroll
                for (int j = 0; j < 8; ++j) { const f32x4 y = {__uint_as_float(yc[j].x << 16), __uint_as_float(yc[j].x & 0xffff0000u), __uint_as_float(yc[j].y << 16), __uint_as_float(yc[j].y & 0xffff0000u)};
                    const f32x4 pa = *((const f32x4*)PA + F.lane + 64 * j);
                    xv[j] = xv[j] + pa * (y * r); ss += (xv[j].x * xv[j].x + xv[j].y * xv[j].y) + (xv[j].z * xv[j].z + xv[j].w * xv[j].w); }
#pragma unroll
                for (int j = 0; j < 8; ++j) op[64 * j] = xv[j];
            }
            const float r2 = rsqrtf(wave_sum(ss) * (1.f / D) + EPS);
            unsigned* o4 = (unsigned*)((unsigned char*)H2 + (size_t)row * D) + F.lane;
            float lg[16];
#pragma unroll
            for (int j = 0; j < 8; ++j) { const f32x4 pb = *((const f32x4*)PB + F.lane + 64 * j), pc = *((const f32x4*)PC + F.lane + 64 * j); xv[j] = xv[j] * r2 * pb + pc; }
#pragma unroll
            for (int j = 0; j < 8; ++j) o4[64 * j] = pg8::pk4_fp8(xv[j].x, xv[j].y, xv[j].z, xv[j].w);
#pragma unroll
            for (int e = 0; e < 16; ++e) { float a = 0.f;
#pragma unroll
                for (int j = 0; j < 8; ++j) { const f32x4 wv = *((const f32x4*)(wT + e * 2048) + F.lane + 64 * j); a += (xv[j].x * wv.x + xv[j].y * wv.y) + (xv[j].z * wv.z + xv[j].w * wv.w); }
                lg[e] = a; asm volatile("" ::: "memory"); }
            float mx = -1e30f;
#pragma unroll
            for (int e = 0; e < 16; ++e) { lg[e] = wave_sum(lg[e]); mx = fmaxf(mx, lg[e]); }
            float sm = 0.f;
#pragma unroll
            for (int e = 0; e < 16; ++e) { lg[e] = expf(lg[e] - mx); sm += lg[e]; }
            float mine = 0.f;
#pragma unroll
            for (int e = 0; e < 16; ++e) mine = (F.lane == e) ? lg[e] : mine;
            if (F.lane < 16) AFF[((size_t)b * 16 + F.lane) * SEQ + s] = mine / sm;
        }
    }
#undef P6_LOAD
    __syncthreads();
}
__device__ __forceinline__ void p7_topk_gather(Ctx& F) {
    const float* AFF = (const float*)(F.ws + WS_AFF); int* GIDX = (int*)(F.ws + WS_GIDX); float* SELAFF = (float*)(F.ws + WS_SELAFF); int* TOKSLOT = (int*)(F.ws + WS_TOKSLOT);
        int* sh = (int*)F.lds; int* wsum = (int*)(F.lds + 64);
    for (int unit = blockIdx.x; unit < 256; unit += F.G) {
        const int be = unit >> 3, part = unit & 7, b = be >> 4, e = be & 15, tid = F.tid, lane = F.lane;
        if (F.wave == 0) {
            unsigned v[64];
#pragma unroll
            for (int i = 0; i < 64; ++i) v[i] = __float_as_uint(AFF[(size_t)be * SEQ + i * 64 + lane]);
            unsigned tau = 0u;
            for (int bit = 30; bit >= 0; --bit) { const unsigned cand = tau | (1u << bit); int cl = 0;
#pragma unroll
                for (int i = 0; i < 64; ++i) cl += (v[i] >= cand) ? 1 : 0;
                int c = 0;
#pragma unroll
                for (int q = 0; q < 7; ++q) c += __popcll(__ballot((cl >> q) & 1)) << q;
                if (c >= CAP) tau = cand; }
            int cgt = 0;
            { int cl = 0;
#pragma unroll
              for (int i = 0; i < 64; ++i) cl += (v[i] > tau) ? 1 : 0;
#pragma unroll
              for (int q = 0; q < 7; ++q) cgt += __popcll(__ballot((cl >> q) & 1)) << q; }
            if (lane == 0) { sh[0] = (int)tau; sh[1] = cgt; }
        }
        __syncthreads();
        const unsigned tau = (unsigned)sh[0]; const int need = CAP - sh[1];
        const f32x4* a = (const f32x4*)(AFF + (size_t)be * SEQ + tid * 8);
        const f32x4 a0 = a[0], a1 = a[1];
        const unsigned v[8] = {__float_as_uint(a0.x), __float_as_uint(a0.y), __float_as_uint(a0.z), __float_as_uint(a0.w), __float_as_uint(a1.x), __float_as_uint(a1.y), __float_as_uint(a1.z), __float_as_uint(a1.w)};
        int cg = 0, ce = 0;
#pragma unroll
        for (int i = 0; i < 8; ++i) { cg += (v[i] > tau) ? 1 : 0; ce += (v[i] == tau) ? 1 : 0; }
        const int pk = cg | (ce << 16); int inc = pk;
#pragma unroll
        for (int o = 1; o < 64; o <<= 1) { const int t = __shfl_up(inc, o); if (lane >= o) inc += t; }
        if (lane == 63) wsum[F.wave] = inc;
        __syncthreads();
        int base = 0;
#pragma unroll
        for (int w = 0; w < 8; ++w) base += (w < F.wave) ? wsum[w] : 0;
        const int excl = base + inc - pk, pg = excl & 0xffff, pe = excl >> 16;
        int tie_before = pe, sel_before = pg + (pe < need ? pe : need);
#pragma unroll
        for (int i = 0; i < 8; ++i) {
            const int tok = tid * 8 + i; bool sel = false;
            if (v[i] > tau) sel = true; else if (v[i] == tau) { sel = tie_before < need; ++tie_before; }
            int slot = -1;
            if (sel) { const int sl = sel_before; ++sel_before; slot = b * CAP + sl;
                if ((sl >> 6) == part) { GIDX[e * 1024 + slot] = b * SEQ + tok; SELAFF[e * 1024 + slot] = __uint_as_float(v[i]); } }
            if (F.wave == part) TOKSLOT[((size_t)b * 16 + e) * SEQ + tok] = slot;
        }
        __syncthreads();
    }
}
__device__ __forceinline__ void p10_final(Ctx& F) {
    const float* MOD = (const float*)(F.ws + WS_MOD); const bf16* SLAB = (const bf16*)(F.ws + WS_SLAB); const int* TOKSLOT = (const int*)(F.ws + WS_TOKSLOT);
    for (int row0 = F.gw; row0 < T; row0 += 4 * F.NGW) {
        int slotw[4];
#pragma unroll
        for (int k = 0; k < 4; ++k) { const int row = row0 + k * F.NGW; slotw[k] = (row < T && F.lane < 16) ? TOKSLOT[((size_t)(row / SEQ) * 16 + F.lane) * SEQ + (row % SEQ)] : -1; }
#pragma unroll
        for (int k = 0; k < 4; ++k) { const int row = row0 + k * F.NGW; if (row < T) {
            const int b = row / SEQ; const float* mb = MOD + b * 12288;
            f32x4 x1v[8], gtv[8], gpv[8];
#pragma unroll
            for (int j = 0; j < 4; ++j) { const int col = 8 * F.lane + 512 * j; const float* op = F.out + (size_t)row * D + col;
#pragma unroll
                for (int hh = 0; hh < 2; ++hh) { x1v[2 * j + hh] = *(const f32x4*)(op + 4 * hh); gtv[2 * j + hh] = *(const f32x4*)(mb + 10240 + col + 4 * hh); gpv[2 * j + hh] = *(const f32x4*)(F.g_post_ffn + col + 4 * hh); } }
            float y[32];
#pragma unroll
            for (int i = 0; i < 32; ++i) y[i] = 0.f;
            for (int e = 0; e < 16; ++e) { const int sl = __shfl(slotw[k], e); if (sl >= 0) { const v4u* r = (const v4u*)(SLAB + ((size_t)e * 1024 + sl) * D) + F.lane;
#pragma unroll
                    for (int j = 0; j < 4; ++j) { const v4u q = r[64 * j];
                        y[8 * j + 0] += __uint_as_float(q.x << 16); y[8 * j + 1] += __uint_as_float(q.x & 0xffff0000u); y[8 * j + 2] += __uint_as_float(q.y << 16); y[8 * j + 3] += __uint_as_float(q.y & 0xffff0000u);
                        y[8 * j + 4] += __uint_as_float(q.z << 16); y[8 * j + 5] += __uint_as_float(q.z & 0xffff0000u); y[8 * j + 6] += __uint_as_float(q.w << 16); y[8 * j + 7] += __uint_as_float(q.w & 0xffff0000u); } } }
            float ss = 0.f;
#pragma unroll
            for (int i = 0; i < 32; ++i) ss += y[i] * y[i];
            const float r = rsqrtf(wave_sum(ss) * (1.f / D) + EPS);
#pragma unroll
            for (int j = 0; j < 4; ++j) { const int col = 8 * F.lane + 512 * j; float* op = F.out + (size_t)row * D + col;
#pragma unroll
                for (int hh = 0; hh < 2; ++hh) { f32x4 yy = {y[8 * j + 4 * hh], y[8 * j + 4 * hh + 1], y[8 * j + 4 * hh + 2], y[8 * j + 4 * hh + 3]};
                    *(f32x4*)(op + 4 * hh) = x1v[2 * j + hh] + gtv[2 * j + hh] * (yy * r * gpv[2 * j + hh]); } } } }
    }
}
typedef short bf16x8 __attribute__((ext_vector_type(8)));
typedef short s16x4 __attribute__((ext_vector_type(4)));
typedef short v4i16_t __attribute__((ext_vector_type(4)));
typedef float f32x16 __attribute__((ext_vector_type(16)));
typedef float f32x2m __attribute__((ext_vector_type(2)));
constexpr int RS = 272;
constexpr int RSA = 144;
constexpr float LOG2E = 1.4426950408889634f;
__device__ __forceinline__ s16x4 tr4(const LAS unsigned char* p) { return __builtin_bit_cast(s16x4, __builtin_amdgcn_ds_read_tr16_b64_v4i16((LAS v4i16_t*)p)); }
__device__ __forceinline__ bf16x8 tr8(const LAS unsigned char* p, int second) { const s16x4 a = tr4(p), b = tr4(p + second); return (bf16x8){a[0], a[1], a[2], a[3], b[0], b[1], b[2], b[3]}; }
__device__ __forceinline__ bf16x8 ld8(const LAS unsigned char* p) { return *(const LAS bf16x8*)p; }
__device__ __forceinline__ unsigned cvtpk(float lo, float hi) { return pg8::cvt_pk_bf16(lo, hi); }
__device__ __forceinline__ int crow(int r, int hi) { return (r & 3) + 8 * (r >> 2) + 4 * hi; }
#define MFMA16(a, b, c) __builtin_amdgcn_mfma_f32_16x16x32_bf16((a), (b), (c), 0, 0, 0)
#define MFMA32(a, b, c) __builtin_amdgcn_mfma_f32_32x32x16_bf16((a), (b), (c), 0, 0, 0)

__device__ __forceinline__ void rope_pass(Ctx& F) {
    const bf16* PROJ = (const bf16*)(F.ws + WS_PROJ); const float* ROPE = (const float*)(F.ws + WS_ROPE); bf16* QR = (bf16*)(F.ws + WS_QR); bf16* KR = (bf16*)(F.ws + WS_KR);
    const int NT = F.G * 512;
    for (int it0 = blockIdx.x * 512 + F.tid; it0 < T * 80; it0 += 2 * NT) {
        v4u a[2], bq[2]; f32x4 cs[2][4]; bool ok[2];
#pragma unroll
        for (int u = 0; u < 2; ++u) { const int it = it0 + u * NT; ok[u] = it < T * 80; if (ok[u]) { const int i8 = it & 7, hh = (it >> 3) % 10, t = it / 80;
            const bf16* src = PROJ + (size_t)t * INW + (hh < 8 ? C_AQ + hh * 128 : C_AK + (hh - 8) * 128) + i8 * 8;
            a[u] = *(const v4u*)src; bq[u] = *(const v4u*)(src + 64);
            const f32x4* rp = (const f32x4*)(ROPE + ((size_t)t * 64 + i8 * 8) * 2);
#pragma unroll
            for (int k = 0; k < 4; ++k) cs[u][k] = rp[k]; } }
#pragma unroll
        for (int u = 0; u < 2; ++u) { if (ok[u]) { const int it = it0 + u * NT; const int i8 = it & 7, hh = (it >> 3) % 10, t = it / 80;
            const unsigned aw[4] = {a[u].x, a[u].y, a[u].z, a[u].w}, bw[4] = {bq[u].x, bq[u].y, bq[u].z, bq[u].w};
            unsigned o1[4], o2[4];
#pragma unroll
            for (int k = 0; k < 4; ++k) { const f32x4 c4 = cs[u][k];
                const float x1a = __uint_as_float(aw[k] << 16), x1b = __uint_as_float(aw[k] & 0xffff0000u), x2a = __uint_as_float(bw[k] << 16), x2b = __uint_as_float(bw[k] & 0xffff0000u);
                o1[k] = pk2(x1a * c4.x - x2a * c4.y, x1b * c4.z - x2b * c4.w); o2[k] = pk2(x1a * c4.y + x2a * c4.x, x1b * c4.w + x2b * c4.z); }
            bf16* dst = (hh < 8 ? QR + (size_t)t * 1024 + hh * 128 : KR + (size_t)t * 256 + (hh - 8) * 128) + i8 * 8;
            *(v4u*)dst = (v4u){o1[0], o1[1], o1[2], o1[3]}; *(v4u*)(dst + 64) = (v4u){o2[0], o2[1], o2[2], o2[3]}; } }
    }
}
__device__ __forceinline__ void hgrn_a_phase(Ctx& F, LAS unsigned char* L) {
    const bf16* PROJ = (const bf16*)(F.ws + WS_PROJ); const float* LB = (const float*)(F.ws + WS_LB); bf16* CS = (bf16*)(F.ws + WS_CS); float* DEC = (float*)(F.ws + WS_DEC);
    LAS unsigned char* KD = L; LAS unsigned char* VV = L + 17408; LAS float* TOT = (LAS float*)(L + 34816);
    const int tid = F.tid, lane = F.lane, w = F.wave, dk0 = 2 * lane;
    const int tro16 = (8 * (lane >> 4) + ((lane & 15) >> 2)) * RS + (lane & 3) * 8;
    unsigned zraw[8]; v4u vr[2]; float lbA = 0.f, lbB = 0.f;
#define HA_LOAD(un) do { const int c_ = (un) & 63, dir_ = ((un) >> 6) & 1, h_ = ((un) >> 7) & 7, b_ = (un) >> 10; const size_t rb_ = (size_t)b_ * SEQ + c_ * 64; \
        { const float2 l2_ = *(const float2*)(LB + dir_ * 1024 + h_ * 128 + dk0); lbA = l2_.x; lbB = l2_.y; } \
        const bf16* zp_ = PROJ + (rb_ + 8 * w) * INW + (dir_ ? C_FB : C_FF) + h_ * 128; \
        _Pragma("unroll") for (int i = 0; i < 8; ++i) zraw[i] = *(const unsigned*)(zp_ + (size_t)i * INW + dk0); \
        _Pragma("unroll") for (int i = 0; i < 2; ++i) { const int idx = tid + 512 * i, row = idx >> 4, ch = idx & 15; vr[i] = *(const v4u*)(PROJ + (rb_ + row) * INW + C_HI + h_ * 128 + ch * 8); } } while (0)
    if ((int)blockIdx.x < 2048) HA_LOAD((int)blockIdx.x);
    for (int unit = blockIdx.x; unit < 2048; unit += F.G) {
        const int dir = (unit >> 6) & 1;
        float lfa[8], lfb[8], ka[8], kb[8];
#pragma unroll
        for (int i = 0; i < 8; ++i) { const float za = __uint_as_float(zraw[i] << 16), zb = __uint_as_float(zraw[i] & 0xffff0000u);
            const float fa = lbA + (1.f - lbA) * sigmoidf_(za), fb = lbB + (1.f - lbB) * sigmoidf_(zb); lfa[i] = __logf(fa); lfb[i] = __logf(fb); ka[i] = 1.f - fa; kb[i] = 1.f - fb; }
#pragma unroll
        for (int i = 0; i < 2; ++i) { const int idx = tid + 512 * i, row = idx >> 4, ch = idx & 15; *(LAS v4u*)(VV + row * RS + ch * 16) = vr[i]; }
        if (unit + F.G < 2048) HA_LOAD(unit + F.G);
        float runa = 0.f, runb = 0.f;
        if (dir == 0) {
#pragma unroll
            for (int i = 0; i < 8; ++i) { runa += lfa[i]; lfa[i] = runa; runb += lfb[i]; lfb[i] = runb; } }
        else {
#pragma unroll
            for (int i = 7; i >= 0; --i) { runa += lfa[i]; lfa[i] = runa; runb += lfb[i]; lfb[i] = runb; } }
        *(LAS f32x2m*)(TOT + w * 128 + dk0) = (f32x2m){runa, runb};
        __syncthreads();
        float totA = 0.f, totB = 0.f, offA = 0.f, offB = 0.f;
#pragma unroll
        for (int p = 0; p < 8; ++p) { const f32x2m t = *(const LAS f32x2m*)(TOT + p * 128 + dk0); totA += t.x; totB += t.y;
            const bool inoff = dir == 0 ? (p < w) : (p > w); offA += inoff ? t.x : 0.f; offB += inoff ? t.y : 0.f; }
#pragma unroll
        for (int i = 0; i < 8; ++i) { const float va = ka[i] * __expf(totA - (lfa[i] + offA)), vb = kb[i] * __expf(totB - (lfb[i] + offB));
            *(LAS unsigned*)(KD + (8 * w + i) * RS + dk0 * 2) = pk2(va, vb); }
        if (w == 0) *(float2*)(DEC + (size_t)unit * 128 + dk0) = make_float2(__expf(totA), __expf(totB));
        __syncthreads();
        f32x4 acc[2][4];
#pragma unroll
        for (int a = 0; a < 2; ++a)
#pragma unroll
            for (int t = 0; t < 4; ++t) acc[a][t] = (f32x4){0.f, 0.f, 0.f, 0.f};
        const int dvb = 32 * (w & 3), dkb = 64 * (w >> 2);
#pragma unroll
        for (int s = 0; s < 2; ++s) {
            bf16x8 af[2], bfr[4];
#pragma unroll
            for (int a = 0; a < 2; ++a) af[a] = tr8(VV + (32 * s) * RS + (dvb + 16 * a) * 2 + tro16, 4 * RS);
#pragma unroll
            for (int t = 0; t < 4; ++t) bfr[t] = tr8(KD + (32 * s) * RS + (dkb + 16 * t) * 2 + tro16, 4 * RS);
#pragma unroll
            for (int a = 0; a < 2; ++a)
#pragma unroll
                for (int t = 0; t < 4; ++t) acc[a][t] = MFMA16(af[a], bfr[t], acc[a][t]);
        }
        bf16* cso = CS + (size_t)unit * 16384;
        const int cc = lane & 15, rg = lane >> 4;
#pragma unroll
        for (int a = 0; a < 2; ++a)
#pragma unroll
            for (int t = 0; t < 4; ++t) { const int dkk = dkb + 16 * t + cc, dv0 = dvb + 16 * a + 4 * rg;
                uint2 o; o.x = cvtpk(acc[a][t][0], acc[a][t][1]); o.y = cvtpk(acc[a][t][2], acc[a][t][3]); *(uint2*)(cso + dkk * 128 + dv0) = o; }
        __syncthreads();
    }
#undef HA_LOAD
}
__device__ __forceinline__ void hgrn_scan_phase(Ctx& F) {
    const bf16* CS = (const bf16*)(F.ws + WS_CS); bf16* ST = (bf16*)(F.ws + WS_STATE); const float* DEC = (const float*)(F.ws + WS_DEC);
    const int NT = F.G * 512;
    for (int gt = blockIdx.x * 512 + F.tid; gt < 32 * 4096; gt += NT) {
        const int g = gt >> 12, e4 = (gt & 4095) * 4, dk = e4 >> 7, dir = g & 1;
        float s0 = 0.f, s1 = 0.f, s2 = 0.f, s3 = 0.f;
        for (int st = 0; st < 64; st += 8) {
            uint2 tmp[8]; float dc[8];
#pragma unroll
            for (int k = 0; k < 8; ++k) { const int c = dir ? 63 - (st + k) : st + k; const size_t unit = (size_t)g * 64 + c; tmp[k] = *(const uint2*)(CS + unit * 16384 + e4); dc[k] = DEC[unit * 128 + dk]; }
#pragma unroll
            for (int k = 0; k < 8; ++k) { const int c = dir ? 63 - (st + k) : st + k; const size_t unit = (size_t)g * 64 + c;
                uint2 o; o.x = pk2(s0, s1); o.y = pk2(s2, s3); *(uint2*)(ST + unit * 16384 + e4) = o;
                s0 = dc[k] * s0 + __uint_as_float(tmp[k].x << 16); s1 = dc[k] * s1 + __uint_as_float(tmp[k].x & 0xffff0000u);
                s2 = dc[k] * s2 + __uint_as_float(tmp[k].y << 16); s3 = dc[k] * s3 + __uint_as_float(tmp[k].y & 0xffff0000u); }
        }
    }
}
__device__ __forceinline__ void hgrn_c_phase(Ctx& F, LAS unsigned char* L) {
    const bf16* PROJ = (const bf16*)(F.ws + WS_PROJ); const float* LB = (const float*)(F.ws + WS_LB); const bf16* ST = (const bf16*)(F.ws + WS_STATE); bf16* YAIN = (bf16*)(F.ws + WS_YAIN);
    LAS unsigned char* QI = L; LAS unsigned char* KI = L + 17408; LAS unsigned char* QE = L + 34816; LAS unsigned char* VV = L + 52224; LAS unsigned char* SP = L + 69632; LAS unsigned char* AM = L + 104448;
    LAS float* TOT = (LAS float*)(L + 113664); LAS float* SSQ = (LAS float*)(L + 117760);
    const int tid = F.tid, lane = F.lane, w = F.wave, dk0 = 2 * lane, cc = lane & 15, rg = lane >> 4;
    const int tro16 = (8 * (lane >> 4) + ((lane & 15) >> 2)) * RS + (lane & 3) * 8;
    unsigned zraw[8], qraw[8]; v4u vr[2], sr[4]; float lbA = 0.f, lbB = 0.f;
#define HC_LOAD(un, dr) do { const int c_ = (un) & 63, h_ = ((un) >> 6) & 7, b_ = (un) >> 9; const size_t rb_ = (size_t)b_ * SEQ + c_ * 64; \
        { const float2 l2_ = *(const float2*)(LB + (dr) * 1024 + h_ * 128 + dk0); lbA = l2_.x; lbB = l2_.y; } \
        const bf16* zp_ = PROJ + (rb_ + 8 * w) * INW + h_ * 128; \
        _Pragma("unroll") for (int i = 0; i < 8; ++i) { const bf16* rp_ = zp_ + (size_t)i * INW; zraw[i] = *(const unsigned*)(rp_ + ((dr) ? C_FB : C_FF) + dk0); qraw[i] = *(const unsigned*)(rp_ + C_HQ + dk0); } \
        if ((dr) == 0) { _Pragma("unroll") for (int i = 0; i < 2; ++i) { const int idx = tid + 512 * i, row = idx >> 4, ch = idx & 15; vr[i] = *(const v4u*)(PROJ + (rb_ + row) * INW + C_HI + h_ * 128 + ch * 8); } } \
        { const bf16* sp_ = ST + ((size_t)((b_ * 8 + h_) * 2 + (dr)) * 64 + c_) * 16384; \
          _Pragma("unroll") for (int i = 0; i < 4; ++i) { const int idx = tid + 512 * i; sr[i] = *(const v4u*)(sp_ + idx * 8); } } } while (0)
    if ((int)blockIdx.x < 1024) HC_LOAD((int)blockIdx.x, 0);
    for (int unit = blockIdx.x; unit < 1024; unit += F.G) {
        const int c = unit & 63, h = (unit >> 6) & 7, b = unit >> 9;
        const size_t rb = (size_t)b * SEQ + c * 64;
        f32x4 o[4];
#pragma unroll
        for (int t = 0; t < 4; ++t) o[t] = (f32x4){0.f, 0.f, 0.f, 0.f};
        for (int dir = 0; dir < 2; ++dir) {
            float lfa[8], lfb[8], ka[8], kb[8], qa[8], qb[8];
#pragma unroll
            for (int i = 0; i < 8; ++i) { const float za = __uint_as_float(zraw[i] << 16), zb = __uint_as_float(zraw[i] & 0xffff0000u);
                const float fa = lbA + (1.f - lbA) * sigmoidf_(za), fb = lbB + (1.f - lbB) * sigmoidf_(zb); lfa[i] = __logf(fa); lfb[i] = __logf(fb); ka[i] = 1.f - fa; kb[i] = 1.f - fb;
                qa[i] = siluf_(__uint_as_float(qraw[i] << 16)); qb[i] = siluf_(__uint_as_float(qraw[i] & 0xffff0000u)); }
            if (dir == 0) {
#pragma unroll
                for (int i = 0; i < 2; ++i) { const int idx = tid + 512 * i, row = idx >> 4, ch = idx & 15; *(LAS v4u*)(VV + row * RS + ch * 16) = vr[i]; } }
#pragma unroll
            for (int i = 0; i < 4; ++i) { const int idx = tid + 512 * i, row = idx >> 4, ch = idx & 15; *(LAS v4u*)(SP + row * RS + ch * 16) = sr[i]; }
            if (dir == 0) HC_LOAD(unit, 1); else if (unit + F.G < 1024) HC_LOAD(unit + F.G, 0);
            float runa = 0.f, runb = 0.f;
            if (dir == 0) {
#pragma unroll
                for (int i = 0; i < 8; ++i) { runa += lfa[i]; lfa[i] = runa; runb += lfb[i]; lfb[i] = runb; } }
            else {
#pragma unroll
                for (int i = 7; i >= 0; --i) { runa += lfa[i]; lfa[i] = runa; runb += lfb[i]; lfb[i] = runb; } }
            *(LAS f32x2m*)(TOT + w * 128 + dk0) = (f32x2m){runa, runb};
            __syncthreads();
            {   float offA = 0.f, offB = 0.f, brA = 0.f, brB = 0.f;
#pragma unroll
                for (int p = 0; p < 8; ++p) { const f32x2m t = *(const LAS f32x2m*)(TOT + p * 128 + dk0);
                    const bool inoff = dir == 0 ? (p < w) : (p > w), inref = dir == 0 ? (p < 4) : (p >= 4);
                    offA += inoff ? t.x : 0.f; offB += inoff ? t.y : 0.f; brA += inref ? t.x : 0.f; brB += inref ? t.y : 0.f; }
#pragma unroll
                for (int i = 0; i < 8; ++i) { const float ba = lfa[i] + offA, bb = lfb[i] + offB; const int ro = (8 * w + i) * RS + dk0 * 2;
                    *(LAS unsigned*)(QI + ro) = pk2(qa[i] * __expf(ba - brA), qb[i] * __expf(bb - brB));
                    *(LAS unsigned*)(KI + ro) = pk2(ka[i] * __expf(brA - ba), kb[i] * __expf(brB - bb));
                    *(LAS unsigned*)(QE + ro) = pk2(qa[i] * __expf(ba), qb[i] * __expf(bb)); }
            }
            __syncthreads();
            {
                const int rt = w >> 1, ct0 = 2 * (w & 1);
                f32x4 am[2] = {(f32x4){0.f, 0.f, 0.f, 0.f}, (f32x4){0.f, 0.f, 0.f, 0.f}};
#pragma unroll
                for (int s = 0; s < 4; ++s) { const bf16x8 af = ld8(QI + (16 * rt + cc) * RS + (32 * s + 8 * rg) * 2);
#pragma unroll
                    for (int t = 0; t < 2; ++t) { const bf16x8 bfr = ld8(KI + (16 * (ct0 + t) + cc) * RS + (32 * s + 8 * rg) * 2); am[t] = MFMA16(af, bfr, am[t]); } }
#pragma unroll
                for (int t = 0; t < 2; ++t)
#pragma unroll
                    for (int i = 0; i < 4; ++i) { const int l = 16 * rt + 4 * rg + i, m = 16 * (ct0 + t) + cc; const bool keep = dir == 0 ? (m <= l) : (m >= l);
                        *(LAS bf16*)(AM + l * RSA + m * 2) = f2bf(keep ? am[t][i] : 0.f); }
            }
            __syncthreads();
            {
                const int rt = w & 3, cb = 64 * (w >> 2);
#pragma unroll
                for (int s = 0; s < 2; ++s) { const bf16x8 af = ld8(AM + (16 * rt + cc) * RSA + (32 * s + 8 * rg) * 2);
#pragma unroll
                    for (int t = 0; t < 4; ++t) { const bf16x8 bfr = tr8(VV + (32 * s) * RS + (cb + 16 * t) * 2 + tro16, 4 * RS); o[t] = MFMA16(af, bfr, o[t]); } }
#pragma unroll
                for (int s = 0; s < 4; ++s) { const bf16x8 af = ld8(QE + (16 * rt + cc) * RS + (32 * s + 8 * rg) * 2);
#pragma unroll
                    for (int t = 0; t < 4; ++t) { const bf16x8 bfr = tr8(SP + (32 * s) * RS + (cb + 16 * t) * 2 + tro16, 4 * RS); o[t] = MFMA16(af, bfr, o[t]); } }
            }
            __syncthreads();
        }
        const int rt = w & 3, chh = w >> 2, cb = 64 * chh;
        float ssv[4];
#pragma unroll
        for (int i = 0; i < 4; ++i) { float sq = 0.f;
#pragma unroll
            for (int t = 0; t < 4; ++t) sq += o[t][i] * o[t][i];
            sq += __shfl_xor(sq, 1); sq += __shfl_xor(sq, 2); sq += __shfl_xor(sq, 4); sq += __shfl_xor(sq, 8); ssv[i] = sq; }
        if (cc == 0) {
#pragma unroll
            for (int i = 0; i < 4; ++i) SSQ[chh * 64 + 16 * rt + 4 * rg + i] = ssv[i]; }
        __syncthreads();
#pragma unroll
        for (int i = 0; i < 4; ++i) { const int l = 16 * rt + 4 * rg + i; const float r = rsqrtf((SSQ[l] + SSQ[64 + l]) * (1.f / 128.f) + EPS);
#pragma unroll
            for (int t = 0; t < 4; ++t) { const int dv = cb + 16 * t + cc; const float g = bf2f(PROJ[(rb + l) * INW + C_HG + h * 128 + dv]);
                YAIN[(rb + l) * 1024 + h * 128 + dv] = f2bf(o[t][i] * r * F.onorm[h * 128 + dv] * siluf_(g)); } }
        __syncthreads();
    }
#undef HC_LOAD
}
__device__ __forceinline__ void rope8(v4u& a, v4u& bq, const f32x4 (&cs)[4]) {
    const unsigned aw[4] = {a.x, a.y, a.z, a.w}, bw[4] = {bq.x, bq.y, bq.z, bq.w}; unsigned o1[4], o2[4];
#pragma unroll
    for (int k = 0; k < 4; ++k) { const f32x4 c4 = cs[k];
        const float x1a = __uint_as_float(aw[k] << 16), x1b = __uint_as_float(aw[k] & 0xffff0000u), x2a = __uint_as_float(bw[k] << 16), x2b = __uint_as_float(bw[k] & 0xffff0000u);
        o1[k] = pk2(x1a * c4.x - x2a * c4.y, x1b * c4.z - x2b * c4.w); o2[k] = pk2(x1a * c4.y + x2a * c4.x, x1b * c4.w + x2b * c4.z); }
    a = (v4u){o1[0], o1[1], o1[2], o1[3]}; bq = (v4u){o2[0], o2[1], o2[2], o2[3]};
}
__device__ __forceinline__ void attn_phase(Ctx& F, LAS unsigned char* L) {
    const bf16* PROJ = (const bf16*)(F.ws + WS_PROJ); const float* ROPE = (const float*)(F.ws + WS_ROPE); bf16* ATT = (bf16*)(F.ws + WS_ATT);
    LAS unsigned char* KT = L; LAS unsigned char* VT = L + 17408; LAS float* AL = (LAS float*)(L + 34816) + F.wave * 32;
    const int tid = F.tid, lane = F.lane, w = F.wave, q32 = lane & 31, hh = lane >> 5;
    const int tro32 = (4 * hh + ((lane & 15) >> 2)) * RS + (16 * ((lane >> 4) & 1) + 4 * (lane & 3)) * 2;
    const int krow = tid >> 3, kc8 = tid & 7;
    constexpr float C2 = 0.08838834764831845f * LOG2E;
    for (int unit = blockIdx.x; unit < 256; unit += F.G) {
        const int qb = unit & 63, kvh = (unit >> 6) & 1, b = unit >> 7, q0 = qb * 64, h = kvh * 4 + (w >> 1);
        const int qp = q0 + 32 * (w & 1) + q32;
        bf16x8 qf[8];
        {
            const bf16* qptr = PROJ + ((size_t)b * SEQ + qp) * INW + C_AQ + h * 128 + 8 * hh;
            const f32x4* rp = (const f32x4*)(ROPE + (((size_t)b * SEQ + qp) * 64 + 8 * hh) * 2);
#pragma unroll
            for (int s = 0; s < 4; ++s) { v4u x1 = *(const v4u*)(qptr + 16 * s), x2 = *(const v4u*)(qptr + 16 * s + 64);
                f32x4 cs[4];
#pragma unroll
                for (int k = 0; k < 4; ++k) cs[k] = rp[8 * s + k];
                rope8(x1, x2, cs); qf[s] = __builtin_bit_cast(bf16x8, x1); qf[s + 4] = __builtin_bit_cast(bf16x8, x2); }
        }
        float m = F.sink[h] * LOG2E, l = 1.f;
        f32x16 o[4];
#pragma unroll
        for (int d = 0; d < 4; ++d)
#pragma unroll
            for (int r = 0; r < 16; ++r) o[d][r] = 0.f;
        int j = 0; while (j < 5 && (q0 - 128 + 64 * j < 0 || q0 - 128 + 64 * j >= SEQ)) ++j;
        v4u kr[2], vr[2]; f32x4 kcs[4];
#define ATT_LOAD(jj) do { const int kb_ = q0 - 128 + 64 * (jj); \
            { const size_t t_ = (size_t)b * SEQ + kb_ + krow; const bf16* kp_ = PROJ + t_ * INW + C_AK + kvh * 128 + kc8 * 8; kr[0] = *(const v4u*)kp_; kr[1] = *(const v4u*)(kp_ + 64); \
              const f32x4* rp_ = (const f32x4*)(ROPE + (t_ * 64 + kc8 * 8) * 2); _Pragma("unroll") for (int k = 0; k < 4; ++k) kcs[k] = rp_[k]; } \
            _Pragma("unroll") for (int i = 0; i < 2; ++i) { const int idx = tid + 512 * i, row = idx >> 4, ch = idx & 15; \
                vr[i] = *(const v4u*)(PROJ + ((size_t)b * SEQ + kb_ + row) * INW + C_AV + kvh * 128 + ch * 8); } } while (0)
        if (j < 5) ATT_LOAD(j);
        while (j < 5) {
            const int kb = q0 - 128 + 64 * j;
            __syncthreads();
            rope8(kr[0], kr[1], kcs);
            *(LAS v4u*)(KT + krow * RS + kc8 * 16) = kr[0]; *(LAS v4u*)(KT + krow * RS + (kc8 + 8) * 16) = kr[1];
#pragma unroll
            for (int i = 0; i < 2; ++i) { const int idx = tid + 512 * i, row = idx >> 4, ch = idx & 15; *(LAS v4u*)(VT + row * RS + ch * 16) = vr[i]; }
            __syncthreads();
            int jn = j + 1; while (jn < 5 && (q0 - 128 + 64 * jn < 0 || q0 - 128 + 64 * jn >= SEQ)) ++jn;
            if (jn < 5) ATT_LOAD(jn);
            f32x16 p0, p1;
#pragma unroll
            for (int r = 0; r < 16; ++r) { p0[r] = 0.f; p1[r] = 0.f; }
#pragma unroll
            for (int s = 0; s < 8; ++s) { const bf16x8 k0 = ld8(KT + q32 * RS + (16 * s + 8 * hh) * 2), k1 = ld8(KT + (32 + q32) * RS + (16 * s + 8 * hh) * 2);
                p0 = MFMA32(k0, qf[s], p0); p1 = MFMA32(k1, qf[s], p1); }
            float tmax = -INFINITY;
#pragma unroll
            for (int r = 0; r < 16; ++r) { const int d0 = kb + crow(r, hh) - qp;
                p0[r] = ((unsigned)(d0 + 128) <= 256u) ? p0[r] * C2 : -INFINITY; p1[r] = ((unsigned)(d0 + 32 + 128) <= 256u) ? p1[r] * C2 : -INFINITY;
                tmax = fmaxf(tmax, fmaxf(p0[r], p1[r])); }
            tmax = fmaxf(tmax, __shfl_xor(tmax, 32));
            const float mn = fmaxf(m, tmax), alpha = __builtin_amdgcn_exp2f(m - mn); m = mn;
            float rs = 0.f;
#pragma unroll
            for (int r = 0; r < 16; ++r) { p0[r] = __builtin_amdgcn_exp2f(p0[r] - mn); p1[r] = __builtin_amdgcn_exp2f(p1[r] - mn); rs += p0[r] + p1[r]; }
            rs += __shfl_xor(rs, 32);
            l = l * alpha + rs;
            if (hh == 0) AL[q32] = alpha;
            LDS_WAIT();
#pragma unroll
            for (int g4 = 0; g4 < 4; ++g4) { const f32x4 a4 = *(const LAS f32x4*)(AL + 8 * g4 + 4 * hh);
#pragma unroll
                for (int d = 0; d < 4; ++d) { o[d][4 * g4 + 0] *= a4.x; o[d][4 * g4 + 1] *= a4.y; o[d][4 * g4 + 2] *= a4.z; o[d][4 * g4 + 3] *= a4.w; } }
#pragma unroll
            for (int kb2 = 0; kb2 < 2; ++kb2)
#pragma unroll
                for (int s = 0; s < 2; ++s) {
                    unsigned pw[4];
#pragma unroll
                    for (int k = 0; k < 4; ++k) pw[k] = kb2 ? cvtpk(p1[8 * s + 2 * k], p1[8 * s + 2 * k + 1]) : cvtpk(p0[8 * s + 2 * k], p0[8 * s + 2 * k + 1]);
                    const bf16x8 pa = __builtin_bit_cast(bf16x8, (v4u){pw[0], pw[1], pw[2], pw[3]});
#pragma unroll
                    for (int d = 0; d < 4; ++d) { const bf16x8 vf = tr8(VT + (32 * kb2 + 16 * s) * RS + 64 * d + tro32, 8 * RS); o[d] = MFMA32(pa, vf, o[d]); }
                }
            j = jn;
        }
#undef ATT_LOAD
        if (hh == 0) AL[q32] = 1.f / l;
        LDS_WAIT();
#pragma unroll
        for (int g4 = 0; g4 < 4; ++g4) { const f32x4 a4 = *(const LAS f32x4*)(AL + 8 * g4 + 4 * hh); const float av[4] = {a4.x, a4.y, a4.z, a4.w};
#pragma unroll
            for (int i = 0; i < 4; ++i) { const int r = 4 * g4 + i; const int qrow = q0 + 32 * (w & 1) + crow(r, hh);
                bf16* op = ATT + ((size_t)b * SEQ + qrow) * 1024 + h * 128 + q32;
#pragma unroll
                for (int d = 0; d < 4; ++d) op[32 * d] = f2bf(o[d][r] * av[i]); } }
        __syncthreads();
    }
}

#ifdef TESTMODE
__global__ void __launch_bounds__(256) k_rope(const bf16* __restrict__ PROJ, const float* __restrict__ rope, bf16* __restrict__ QR, bf16* __restrict__ KR) {
    const int gid = blockIdx.x * 256 + threadIdx.x;
    const int i = gid & 63, hh = (gid >> 6) % 10, t = gid / 640;
    const float cs = rope[((size_t)t * 64 + i) * 2], sn = rope[((size_t)t * 64 + i) * 2 + 1];
    const bf16* src = PROJ + (size_t)t * INW + (hh < 8 ? C_AQ + hh * 128 : C_AK + (hh - 8) * 128);
    const float x1 = bf2f(src[i]), x2 = bf2f(src[i + 64]);
    bf16* dst = hh < 8 ? QR + (size_t)t * 1024 + hh * 128 : KR + (size_t)t * 256 + (hh - 8) * 128;
    dst[i] = f2bf(x1 * cs - x2 * sn); dst[i + 64] = f2bf(x1 * sn + x2 * cs);
}
__global__ void __launch_bounds__(256) k_hgrn_naive(const bf16* __restrict__ PROJ, const float* __restrict__ lb, float* __restrict__ OF, float* __restrict__ OB) {
    __shared__ float qs[128], fs[128], ks[128], part[128];
    const int dir = blockIdx.x & 1, h = (blockIdx.x >> 1) & 7, b = blockIdx.x >> 4, tid = threadIdx.x, dv = tid & 127, half = tid >> 7;
    float S[64];
#pragma unroll
    for (int i = 0; i < 64; ++i) S[i] = 0.f;
    float* O = dir ? OB : OF;
    const float lbv = tid < 128 ? lb[dir * 1024 + h * 128 + tid] : 0.f;
    bf16 nzq = 0, nzf = 0, nv = 0;
    { const int t = dir ? SEQ - 1 : 0; const bf16* pr = PROJ + ((size_t)b * SEQ + t) * INW;
      if (tid < 128) { nzq = pr[C_HQ + h * 128 + tid]; nzf = pr[(dir ? C_FB : C_FF) + h * 128 + tid]; } nv = pr[C_HI + h * 128 + dv]; }
    for (int tp = 0; tp < SEQ; ++tp) {
        const int t = dir ? SEQ - 1 - tp : tp; const size_t row = (size_t)b * SEQ + t;
        const bf16 czq = nzq, czf = nzf, cv = nv;
        if (tp + 1 < SEQ) { const int t2 = dir ? SEQ - 2 - tp : tp + 1; const bf16* pr = PROJ + ((size_t)b * SEQ + t2) * INW;
            if (tid < 128) { nzq = pr[C_HQ + h * 128 + tid]; nzf = pr[(dir ? C_FB : C_FF) + h * 128 + tid]; } nv = pr[C_HI + h * 128 + dv]; }
        if (tid < 128) { const float zq = bf2f(czq), zf = bf2f(czf);
            const float f = lbv + (1.f - lbv) * sigmoidf_(zf); qs[tid] = siluf_(zq); fs[tid] = f; ks[tid] = 1.f - f; }
        const float v = bf2f(cv);
        __syncthreads();
        float acc = 0.f;
#pragma unroll
        for (int i = 0; i < 64; ++i) { const int dk = half * 64 + i; S[i] = fs[dk] * S[i] + ks[dk] * v; acc += S[i] * qs[dk]; }
        if (half == 1) part[dv] = acc;
        __syncthreads();
        if (half == 0) O[row * 1024 + h * 128 + dv] = acc + part[dv];
    }
}
__global__ void __launch_bounds__(256) k_hgrn_post(const float* __restrict__ OF, const float* __restrict__ OB, const bf16* __restrict__ PROJ, const float* __restrict__ onorm, bf16* __restrict__ YAIN) {
    const int w = blockIdx.x * 4 + (threadIdx.x >> 6), lane = threadIdx.x & 63, row = w >> 3, h = w & 7;
    const size_t o = (size_t)row * 1024 + h * 128;
    const float a0 = OF[o + lane] + OB[o + lane], a1 = OF[o + 64 + lane] + OB[o + 64 + lane];
    float ss = a0 * a0 + a1 * a1;
    for (int s = 32; s > 0; s >>= 1) ss += __shfl_xor(ss, s);
    const float r = rsqrtf(ss * (1.f / 128.f) + EPS);
    const bf16* pg = PROJ + (size_t)row * INW + C_HG + h * 128;
    YAIN[o + lane] = f2bf(a0 * r * onorm[h * 128 + lane] * siluf_(bf2f(pg[lane])));
    YAIN[o + 64 + lane] = f2bf(a1 * r * onorm[h * 128 + 64 + lane] * siluf_(bf2f(pg[64 + lane])));
}
__global__ void __launch_bounds__(256) k_attn_naive(const bf16* __restrict__ QR, const bf16* __restrict__ KR, const bf16* __restrict__ PROJ, const float* __restrict__ sink, bf16* __restrict__ ATT) {
    __shared__ float sl[4][264];
    const int wv = threadIdx.x >> 6, lane = threadIdx.x & 63;
    const int w = blockIdx.x * 4 + wv;
    const int i = w & 4095, h = (w >> 12) & 7, b = w >> 15, kvh = h >> 2;
    const size_t qrow = (size_t)b * SEQ + i;
    const float q0 = bf2f(QR[qrow * 1024 + h * 128 + 2 * lane]), q1 = bf2f(QR[qrow * 1024 + h * 128 + 2 * lane + 1]);
    const int jlo = i - 128 < 0 ? 0 : i - 128, jhi = i + 128 > SEQ - 1 ? SEQ - 1 : i + 128;
    const float sk = sink[h];
    float m = sk;
    for (int j = jlo; j <= jhi; ++j) {
        const bf16* kr = KR + ((size_t)b * SEQ + j) * 256 + kvh * 128;
        float p = q0 * bf2f(kr[2 * lane]) + q1 * bf2f(kr[2 * lane + 1]);
        for (int s = 32; s > 0; s >>= 1) p += __shfl_xor(p, s);
        p *= 0.08838834764831845f;
        if (lane == 0) sl[wv][j - jlo] = p;
        m = fmaxf(m, p);
    }
    __syncthreads();
    float den = expf(sk - m), o0 = 0.f, o1 = 0.f;
    for (int j = jlo; j <= jhi; ++j) {
        const float p = expf(sl[wv][j - jlo] - m); den += p;
        const bf16* vr = PROJ + ((size_t)b * SEQ + j) * INW + C_AV + kvh * 128;
        o0 += p * bf2f(vr[2 * lane]); o1 += p * bf2f(vr[2 * lane + 1]);
    }
    ATT[qrow * 1024 + h * 128 + 2 * lane] = f2bf(o0 / den); ATT[qrow * 1024 + h * 128 + 2 * lane + 1] = f2bf(o1 / den);
}
#endif
__global__ void __launch_bounds__(NWAVES * 64, 2) mega(Args args) {
    extern __shared__ __attribute__((aligned(16))) unsigned char lds[];
    Ctx F;
    F.lds = lds; F.tid = threadIdx.x; F.lane = F.tid & 63; F.wave = __builtin_amdgcn_readfirstlane(F.tid >> 6); F.G = gridDim.x;
    F.gw = blockIdx.x * NWAVES + F.wave; F.NGW = F.G * NWAVES;
    F.x = (const float*)args.in[0]; F.c = (const float*)args.in[1]; F.pos = (const int*)args.in[2]; F.w_ada = (const float*)args.in[3]; F.b_ada = (const float*)args.in[4];
    F.g_pre_mix = (const float*)args.in[5]; F.g_post_mix = (const float*)args.in[6]; F.g_pre_ffn = (const float*)args.in[7]; F.g_post_ffn = (const float*)args.in[8];
    F.w_in = (const float*)args.in[9]; F.lbl = (const float*)args.in[10]; F.onorm = (const float*)args.in[11]; F.sink = (const float*)args.in[12];
    F.w_a = (const float*)args.in[13]; F.w_b = (const float*)args.in[14]; F.w_o = (const float*)args.in[15]; F.w_router = (const float*)args.in[16];
    F.w_eg = (const float*)args.in[17]; F.w_eu = (const float*)args.in[18]; F.w_ed = (const float*)args.in[19];
    F.out = args.out; F.ws = args.ws;
    LAS unsigned char* ldsl = (LAS unsigned char*)lds;
    for (int u = F.tid; u < (LDS_BYTES - LDSCTL_OFF) / 4; u += NWAVES * 64) ((LAS unsigned*)(ldsl + LDSCTL_OFF))[u] = 0u;
    __syncthreads();
    volatile LAS unsigned* MISC = (volatile LAS unsigned*)(ldsl + MISC_OFF);
    XcdBarrier bar = xcd_barrier_post((unsigned*)(args.ws + WS_CTL) + CW_BAR + args.li * XCD_BAR_WORDS, MISC + 8);
    const int lo = args.ph_lo, hi = args.ph_hi;
#ifdef PROBE_REP
#define REP(k) ((((PROBE_REP) >> (k)) & 1) ? 2 : 1)
#else
#define REP(k) 1
#endif
#define IN(k) (lo <= (k) && (k) < hi)
#define SEAM(k) do { if (IN(k) && IN((k) + 1)) xcd_barrier(bar); } while (0)
    unsigned char* ws = args.ws;
    bf16* H = (bf16*)(ws + WS_H); bf16* PROJ = (bf16*)(ws + WS_PROJ); bf16* WIN = (bf16*)(ws + WS_WIN); bf16* WA = (bf16*)(ws + WS_WA); bf16* WB = (bf16*)(ws + WS_WB); bf16* WO = (bf16*)(ws + WS_WO);
    bf16* WGU = (bf16*)(ws + WS_WGU); bf16* WD = (bf16*)(ws + WS_WD); bf16* YAIN = (bf16*)(ws + WS_YAIN); bf16* ATT = (bf16*)(ws + WS_ATT); bf16* MERGED = (bf16*)(ws + WS_MERGED);
    float* Y = (float*)(ws + WS_Y); bf16* XE = (bf16*)(ws + WS_XE); bf16* ACT = (bf16*)(ws + WS_ACT); bf16* SLAB = (bf16*)(ws + WS_SLAB); const float* SELAFF = (const float*)(ws + WS_SELAFF);
    const int vcu = (F.G % 8 == 0) ? ((int)blockIdx.x % 8) * (F.G / 8) + (int)blockIdx.x / 8 : (int)blockIdx.x;

    {
    if (IN(0)) { p0_prep(F); __syncthreads(); } SEAM(0);
#if defined(PROBE_DUP) && PROBE_DUP == 0
    if (IN(0)) { p0_prep(F); __syncthreads(); } SEAM(0);
#endif
    }
    {
    if (IN(2)) {
        if (F.G == 256 && blockIdx.x >= 256 - CONV_BLOCKS) { float* scr = (float*)(F.lds + F.wave * 16384); TailSeq seq{I_MIX + P0_EXPERT_ITEMS + ((int)blockIdx.x - (256 - CONV_BLOCKS)) * NWAVES + F.wave, CONV_BLOCKS * NWAVES}; transpose_stream(F, seq, scr); }
        else {
            const int gg = F.G == 256 ? 256 - CONV_BLOCKS : F.G;
            pg8::Gemm g{H, WIN, T, INW, D}; pg8::StaticOrder S; S.init(T, INW, gg, (int)blockIdx.x);
            pg8::EpiStore E{PROJ, INW, 0xffff, nullptr};
            pg8::gemm_phase<pg8::EpiStore, pg8::StaticOrder, PG8_ALIGN, PG8_SP2>(ldsl + RING_OFF, g, S, E);
            if (F.G != 256 && blockIdx.x == 0) { float* scr = (float*)(F.lds + F.wave * 16384); TailSeq seq{I_MIX + P0_EXPERT_ITEMS + F.wave, NWAVES}; transpose_stream(F, seq, scr); }
        }
    } SEAM(2);
    }
    {
    if (IN(3)) { if (args.mask & 2) hgrn_a_phase(F, ldsl); } SEAM(3);
#if defined(PROBE_DUP) && PROBE_DUP == 3
    if (IN(3)) { if (args.mask & 2) hgrn_a_phase(F, ldsl); } SEAM(3);
#endif
    }
    {
    if (IN(4)) { if (args.mask & 2) hgrn_scan_phase(F); if (args.mask & 1) attn_phase(F, ldsl); } SEAM(4);
#if defined(PROBE_DUP) && PROBE_DUP == 4
    if (IN(4)) { if (args.mask & 2) hgrn_scan_phase(F); if (args.mask & 1) attn_phase(F, ldsl); } SEAM(4);
#endif
    }
    {
    if (IN(5)) { if (args.mask & 2) hgrn_c_phase(F, ldsl); } SEAM(5);
#if defined(PROBE_DUP) && PROBE_DUP == 5
    if (IN(5)) { if (args.mask & 2) hgrn_c_phase(F, ldsl); } SEAM(5);
#endif
    }
    {
    if (IN(6)) {
        static_assert(WS_ATT == WS_YAIN + 16 * MiB && WS_WB == WS_WA + 4 * MiB, "branch operands must be contiguous");
        pg8::Gemm g{YAIN, WA, 2 * T, 2 * D, 1024}; pg8::BranchOrder S; S.S.init(T, D, F.G, (int)blockIdx.x);
        pg8::EpiGate2 E{MERGED, D, PROJ + C_GA, PROJ + C_GB, INW};
        pg8::gemm_phase<pg8::EpiGate2, pg8::BranchOrder, PG8_ALIGN, PG8_SP2>(ldsl + RING_OFF, g, S, E);
    } SEAM(6);
    }
    {
    if (IN(7)) {
        pg8::Gemm g{MERGED, WO, T, D, D}; pg8::StaticOrder S; S.init(T, D, F.G, (int)blockIdx.x);
        pg8::EpiStore E{(bf16*)Y, D, 0xffff, nullptr};
        pg8::gemm_phase<pg8::EpiStore, pg8::StaticOrder, PG8_ALIGN, PG8_SP2>(ldsl + RING_OFF, g, S, E);
    } SEAM(7);
#if defined(PROBE_DUP) && PROBE_DUP == 7
    if (IN(7)) {
        pg8::Gemm g{MERGED, WO, T, D, D}; pg8::StaticOrder S; S.init(T, D, F.G, (int)blockIdx.x);
        pg8::EpiStore E{(bf16*)Y, D, 0xffff, nullptr};
        pg8::gemm_phase<pg8::EpiStore, pg8::StaticOrder, PG8_ALIGN, PG8_SP2>(ldsl + RING_OFF, g, S, E);
    } SEAM(7);
#endif
    }
    {
    if (IN(8)) { p6_post1(F); } SEAM(8);
#if defined(PROBE_DUP) && PROBE_DUP == 8
    if (IN(8)) { p6_post1(F); } SEAM(8);
#endif
    }
    {
    if (IN(9)) { p7_topk_gather(F); } SEAM(9);
#if defined(PROBE_DUP) && PROBE_DUP == 9
    if (IN(9)) { p7_topk_gather(F); } SEAM(9);
#endif
    }
    {
    if (IN(10)) {
        pg8::Gemm g{(const bf16*)(ws + WS_H2), WGU, 16 * 1024, 16 * 2048, D / 2, (const int*)(ws + WS_GIDX)}; pg8::GroupedOrder S{F.G, vcu};
        pg8::EpiSwiglu8 E{(unsigned char*)ACT, 1.f / W8S_GU};
        pg8::gemm_phase<pg8::EpiSwiglu8, pg8::GroupedOrder, PG8_ALIGN, PG8_SP2, true, true>(ldsl + RING_OFF, g, S, E);
    } SEAM(10);
    }
    {
    if (IN(11)) {
        pg8::Gemm g{ACT, WD, 16 * 1024, 16 * 2048, 1024 / 2}; pg8::GroupedOrder S{F.G, vcu};
        pg8::EpiStore E{SLAB, D, 7, SELAFF, 1.f / W8S_D};
        pg8::gemm_phase<pg8::EpiStore, pg8::GroupedOrder, PG8_ALIGN, PG8_SP2, false, true>(ldsl + RING_OFF, g, S, E);
    } SEAM(11);
    }
    {
    if (IN(12)) { p10_final(F); }
    }
#undef IN
#undef SEAM
}

extern "C" void kernel_launch(void* const* d_in, const int* in_sizes, int n_in, void* d_out, int out_size, void* d_ws, size_t ws_size, hipStream_t stream) {
    static int grid = 0;
    if (grid == 0) {
        if (n_in != 20 || ws_size < WS_END) { fprintf(stderr, "kernel_launch: unexpected n_in %d or ws_size %zu\n", n_in, ws_size); grid = -1; return; }
        int dev = 0, cus = 0;
        if (hipGetDevice(&dev) != hipSuccess || hipDeviceGetAttribute(&cus, hipDeviceAttributeMultiprocessorCount, dev) != hipSuccess) { grid = -1; return; }
        if (hipFuncSetAttribute((const void*)mega, hipFuncAttributeMaxDynamicSharedMemorySize, LDS_BYTES) != hipSuccess) { fprintf(stderr, "kernel_launch: hipFuncSetAttribute failed\n"); grid = -1; return; }
        grid = cus;
    }
    if (grid < 0) return;
    char* ws = (char*)d_ws;
    (void)hipMemsetAsync(ws + WS_CTL, 0, CTL_ZERO_BYTES, stream);
    Args a{};
    for (int i = 0; i < 20; ++i) a.in[i] = d_in[i];
    a.out = (float*)d_out; a.ws = (unsigned char*)d_ws;
#ifndef TESTMODE
    a.ph_lo = 0; a.ph_hi = 13; a.li = 0; a.mask = 3;
#ifdef PROBE_REPEAT
    a.rep = PROBE_REPEAT;
#else
    a.rep = -1;
#endif
    hipLaunchKernelGGL(mega, dim3(grid), dim3(NWAVES * 64), LDS_BYTES, stream, a);
#ifdef PROBE_LO
    a.ph_lo = PROBE_LO; a.ph_hi = PROBE_HI; a.li = 1; a.mask = PROBE_MASK;
    hipLaunchKernelGGL(mega, dim3(grid), dim3(NWAVES * 64), LDS_BYTES, stream, a);
#endif
#else
    const float* LB = (const float*)(ws + WS_LB); const float* ROPE = (const float*)(ws + WS_ROPE);
    bf16* PROJ = (bf16*)(ws + WS_PROJ); bf16* QR = (bf16*)(ws + WS_QR); bf16* KR = (bf16*)(ws + WS_KR); bf16* YAIN = (bf16*)(ws + WS_YAIN); bf16* ATT = (bf16*)(ws + WS_ATT);
    float* OF = (float*)(ws + WS_CS); float* OB = (float*)(ws + WS_CS + 32 * MiB);
    a.ph_lo = 0; a.ph_hi = 3; a.li = 0; a.mask = 3;
    hipLaunchKernelGGL(mega, dim3(grid), dim3(NWAVES * 64), LDS_BYTES, stream, a);
#if TESTMODE == 1
    k_hgrn_naive<<<32, 256, 0, stream>>>(PROJ, LB, OF, OB);
    k_hgrn_post<<<T * 8 / 4, 256, 0, stream>>>(OF, OB, PROJ, (const float*)d_in[11], YAIN);
    a.ph_lo = 3; a.ph_hi = 6; a.li = 1; a.mask = 1;
    hipLaunchKernelGGL(mega, dim3(grid), dim3(NWAVES * 64), LDS_BYTES, stream, a);
#else
    k_rope<<<T * 640 / 256, 256, 0, stream>>>(PROJ, ROPE, QR, KR);
    k_attn_naive<<<BATCH * 8 * SEQ / 4, 256, 0, stream>>>(QR, KR, PROJ, (const float*)d_in[12], ATT);
    a.ph_lo = 3; a.ph_hi = 6; a.li = 1; a.mask = 2;
    hipLaunchKernelGGL(mega, dim3(grid), dim3(NWAVES * 64), LDS_BYTES, stream, a);
#endif
    a.ph_lo = 6; a.ph_hi = 13; a.li = 2; a.mask = 3;
    hipLaunchKernelGGL(mega, dim3(grid), dim3(NWAVES * 64), LDS_BYTES, stream, a);
#endif
}
```

```cpp
#include <hip/hip_runtime.h>
#include <cstdint>
#include <cstdio>

constexpr int D = 2048, BATCH = 2, SEQ = 4096, T = BATCH * SEQ;
constexpr int INW = 10752;
constexpr int C_HQ = 0, C_FF = 1024, C_FB = 2048, C_HI = 3072, C_HG = 4096, C_AQ = 5120, C_AK = 6144, C_AV = 6400, C_GA = 6656, C_GB = 8704;
constexpr int NE = 16, EFF = 1024, CAP = 512;
constexpr float EPS = 1e-6f;

typedef unsigned short bf16;
__device__ __forceinline__ float bf2f(bf16 v) { return __uint_as_float(((unsigned)v) << 16); }
typedef float f32x2h_t __attribute__((ext_vector_type(2))); typedef __bf16 bf16x2h_t __attribute__((ext_vector_type(2)));
__device__ __forceinline__ unsigned cvtpk2(float lo, float hi) { const f32x2h_t v = {lo, hi}; const bf16x2h_t b = __builtin_convertvector(v, bf16x2h_t); return __builtin_bit_cast(unsigned, b); }
__device__ __forceinline__ bf16 f2bf(float f) { return (bf16)(cvtpk2(f, 0.f) & 0xffffu); }
__device__ __forceinline__ float sigmoidf_(float x) { return __builtin_amdgcn_rcpf(1.f + __expf(-x)); }
__device__ __forceinline__ float siluf_(float x) { return x * __builtin_amdgcn_rcpf(1.f + __expf(-x)); }

constexpr size_t MiB = 1u << 20;
constexpr size_t WS_CTL = 0, CTL_ZERO_BYTES = 64 * 1024;
constexpr size_t WS_MOD = 1 * MiB;
constexpr size_t WS_LB = WS_MOD + 128 * 1024;
constexpr size_t WS_AFF = 2 * MiB;
constexpr size_t WS_GIDX = 3 * MiB;
constexpr size_t WS_SELAFF = WS_GIDX + 128 * 1024;
constexpr size_t WS_TOKSLOT = 4 * MiB;
constexpr size_t WS_DEC = 5 * MiB;
constexpr size_t WS_ROPE = 8 * MiB;
constexpr size_t WS_WIN = 16 * MiB;
constexpr size_t WS_WA = 60 * MiB, WS_WB = 64 * MiB, WS_WO = 68 * MiB;
constexpr size_t WS_WGU = 76 * MiB;
constexpr size_t WS_WD = 204 * MiB;
constexpr size_t WS_H = 268 * MiB;
constexpr size_t WS_PROJ = 300 * MiB;
constexpr size_t WS_Y = 520 * MiB;
constexpr size_t WS_XE = 300 * MiB;
constexpr size_t WS_ACT = 364 * MiB;
constexpr size_t WS_SLAB = 396 * MiB;
constexpr size_t WS_QR = 468 * MiB, WS_KR = 484 * MiB;
constexpr size_t WS_YAIN = 488 * MiB, WS_ATT = 504 * MiB;
constexpr size_t WS_CS = 520 * MiB;
constexpr size_t WS_STATE = 584 * MiB;
constexpr size_t WS_H2 = 584 * MiB;
constexpr size_t WS_MERGED = 268 * MiB;
constexpr size_t WS_END = 648 * MiB;
constexpr int CW_BAR = 4096;

namespace pg8 {
#define PG8_LAS __attribute__((address_space(3)))
typedef unsigned short bf16_t;
typedef short bf16x8 __attribute__((ext_vector_type(8)));
typedef float f32x4 __attribute__((ext_vector_type(4)));
typedef unsigned u32x4 __attribute__((ext_vector_type(4)));
constexpr int BM = 256, BK = 64, HALF = 128, HTB = HALF * BK * 2  , STAGE_BYTES = 8 * HTB, NXCD = 8, WGM = 8;

__host__ __device__ __forceinline__ int lds_byte(int r, int c) { const int st = (r >> 4) * 2 + (c >> 5), rr = r & 15, cc = c & 31, ob = rr * 64 + cc * 2; return st * 1024 + (ob ^ (((ob >> 9) & 1) << 5)); }
__host__ __device__ __forceinline__ void stage_rc(int b, int& R, int& C) { const int st = b / 1024, sb = b % 1024, swz = sb ^ (((sb >> 9) & 1) << 5); R = (st >> 1) * 16 + swz / 64; C = (st & 1) * 32 + (swz % 64) / 2; }
__host__ __device__ __forceinline__ int perm32(int rho) { const int n = rho >> 4, i = rho & 15; return 8 * (i >> 2) + 4 * n + (i & 3); }

struct Unit { int pm, pn; };
struct Gemm { const bf16_t* A; const bf16_t* Bt; int M, N, K; const int* gidx = nullptr; };

struct StaticOrder {
    int nM, nN, nwg, G, c;
    __host__ __device__ void init(int M, int N, int G_, int c_) { nM = M / BM; nN = N / BM; nwg = nM * nN; G = G_; c = c_; }
    __host__ __device__ bool next(int i, Unit& u) const {
        const long L = (long)i * G + c; if (L >= nwg) return false;
        int wgid = (int)L; { const int q = nwg / NXCD, r = nwg % NXCD, xcd = wgid % NXCD, off = wgid / NXCD; wgid = (xcd < r ? xcd * (q + 1) : r * (q + 1) + (xcd - r) * q) + off; }
        const int nig = WGM * nN, gid = wgid / nig, fm = gid * WGM, gsz = (nM - fm) < WGM ? (nM - fm) : WGM;
        u.pm = fm + ((wgid % nig) % gsz); u.pn = (wgid % nig) / gsz; return true;
    }
    __device__ __forceinline__ void a_ready(const Unit&) const {}
    __device__ __forceinline__ void done(const Unit&) const {}
};

typedef float f32x2c_t __attribute__((ext_vector_type(2))); typedef __bf16 bf16x2c_t __attribute__((ext_vector_type(2)));
__device__ __forceinline__ unsigned cvt_pk_bf16(float lo, float hi) { const f32x2c_t v = {lo, hi}; const bf16x2c_t b = __builtin_convertvector(v, bf16x2c_t); return __builtin_bit_cast(unsigned, b); }
typedef float f32x2 __attribute__((ext_vector_type(2)));

typedef unsigned u32x2 __attribute__((ext_vector_type(2)));
struct EpiStore {
    static constexpr bool PERM = true, AFTER_DRAIN = false;
    bf16_t* O; int ldc; int cmask; const float* rowscale; float osc = 1.f;
    __device__ __forceinline__ void operator()(const f32x4 (&acc)[2][2][4][2], const Unit& u, int wr, int wc, int fr, int fq) const {
        const int row0 = u.pm * BM + wr * 64 + fr, col0 = (u.pn & cmask) * BM + wc * 32 + 8 * fq;
        float scv[8];
#pragma unroll
        for (int q = 0; q < 8; ++q) scv[q] = (rowscale ? rowscale[row0 + (q >> 2) * HALF + (q & 3) * 16] : 1.f) * osc;
#pragma unroll
        for (int ai = 0; ai < 2; ++ai)
#pragma unroll
            for (int m = 0; m < 4; ++m) { const int row = row0 + ai * HALF + m * 16; const float sc = scv[ai * 4 + m]; bf16_t* rowp = O + (size_t)row * ldc + col0;
#pragma unroll
                for (int bj = 0; bj < 2; ++bj) { const f32x4 v0 = acc[ai][bj][m][0] * sc, v1 = acc[ai][bj][m][1] * sc;
                    u32x4 w; w.x = cvt_pk_bf16(v0[0], v0[1]); w.y = cvt_pk_bf16(v0[2], v0[3]); w.z = cvt_pk_bf16(v1[0], v1[1]); w.w = cvt_pk_bf16(v1[2], v1[3]);
                    *(u32x4*)(rowp + bj * HALF) = w; } }
    }
};
__device__ __forceinline__ float sigm(float x) { return __builtin_amdgcn_rcpf(1.f + __expf(-x)); }
struct EpiGate2 {
    static constexpr bool PERM = true, AFTER_DRAIN = false;
    bf16_t* O; int ldc; const bf16_t* Ga; const bf16_t* Gb; int ldg;
    __device__ __forceinline__ void operator()(const f32x4 (&acc)[2][2][4][2], const Unit& u, int wr, int wc, int fr, int fq) const {
        const bool second = u.pm >= 32; const bf16_t* G = second ? Gb : Ga;
        const int row0 = (u.pm & 31) * BM + wr * 64 + fr, col0 = (u.pn & 7) * BM + wc * 32 + 8 * fq;
        u32x4 gcur[2], tcur[2], gnxt[2], tnxt[2];
#define EG2_LOAD(gd, td, q) do { const int row_ = row0 + ((q) >> 2) * HALF + ((q) & 3) * 16; _Pragma("unroll") for (int bj = 0; bj < 2; ++bj) { \
            gd[bj] = *(const u32x4*)(G + (size_t)row_ * ldg + col0 + bj * HALF); td[bj] = second ? *(const u32x4*)(O + (size_t)row_ * ldc + col0 + bj * HALF) : (u32x4){0u, 0u, 0u, 0u}; } } while (0)
        EG2_LOAD(gcur, tcur, 0);
#pragma unroll
        for (int q = 0; q < 8; ++q) { const int ai = q >> 2, m = q & 3, row = row0 + ai * HALF + m * 16;
            if (q < 7) EG2_LOAD(gnxt, tnxt, q + 1);
#pragma unroll
            for (int bj = 0; bj < 2; ++bj) { const int col = col0 + bj * HALF; const u32x4 g = gcur[bj], tq = tcur[bj];
                const float gg[8] = {__uint_as_float(g.x << 16), __uint_as_float(g.x & 0xffff0000u), __uint_as_float(g.y << 16), __uint_as_float(g.y & 0xffff0000u),
                                     __uint_as_float(g.z << 16), __uint_as_float(g.z & 0xffff0000u), __uint_as_float(g.w << 16), __uint_as_float(g.w & 0xffff0000u)};
                const float t[8] = {__uint_as_float(tq.x << 16), __uint_as_float(tq.x & 0xffff0000u), __uint_as_float(tq.y << 16), __uint_as_float(tq.y & 0xffff0000u),
                                    __uint_as_float(tq.z << 16), __uint_as_float(tq.z & 0xffff0000u), __uint_as_float(tq.w << 16), __uint_as_float(tq.w & 0xffff0000u)};
                const f32x4 a0 = acc[ai][bj][m][0], a1 = acc[ai][bj][m][1];
                float o[8];
#pragma unroll
                for (int i = 0; i < 4; ++i) { o[i] = t[i] + sigm(gg[i]) * a0[i]; o[4 + i] = t[4 + i] + sigm(gg[4 + i]) * a1[i]; }
                u32x4 w; w.x = cvt_pk_bf16(o[0], o[1]); w.y = cvt_pk_bf16(o[2], o[3]); w.z = cvt_pk_bf16(o[4], o[5]); w.w = cvt_pk_bf16(o[6], o[7]);
                *(u32x4*)(O + (size_t)row * ldc + col) = w; }
#pragma unroll
            for (int bj = 0; bj < 2; ++bj) { gcur[bj] = gnxt[bj]; tcur[bj] = tnxt[bj]; } }
#undef EG2_LOAD
    }
};
struct BranchOrder {
    StaticOrder S;
    __device__ __forceinline__ bool next(int i, Unit& u) const { Unit t; if (!S.next(i >> 1, t)) return false; u.pm = t.pm + 32 * (i & 1); u.pn = t.pn + 8 * (i & 1); return true; }
    __device__ __forceinline__ void a_ready(const Unit&) const {}
    __device__ __forceinline__ void done(const Unit&) const {}
};
struct EpiF32 {
    static constexpr bool PERM = true, AFTER_DRAIN = false;
    float* O; int ldc;
    __device__ __forceinline__ void operator()(const f32x4 (&acc)[2][2][4][2], const Unit& u, int wr, int wc, int fr, int fq) const {
        const int row0 = u.pm * BM + wr * 64 + fr, col0 = u.pn * BM + wc * 32 + 8 * fq;
#pragma unroll
        for (int ai = 0; ai < 2; ++ai)
#pragma unroll
            for (int m = 0; m < 4; ++m) { float* rowp = O + (size_t)(row0 + ai * HALF + m * 16) * ldc + col0;
#pragma unroll
                for (int bj = 0; bj < 2; ++bj) { *(f32x4*)(rowp + bj * HALF) = acc[ai][bj][m][0]; *(f32x4*)(rowp + bj * HALF + 4) = acc[ai][bj][m][1]; } }
    }
};
__device__ __forceinline__ unsigned pk4_fp8(float a, float b, float c, float d) { int w = __builtin_amdgcn_cvt_pk_fp8_f32(a, b, 0, false); w = __builtin_amdgcn_cvt_pk_fp8_f32(c, d, w, true); return (unsigned)w; }
struct EpiSwiglu8 {
    static constexpr bool PERM = true, AFTER_DRAIN = false;
    unsigned char* O; float isc;
    __device__ __forceinline__ void operator()(const f32x4 (&acc)[2][2][4][2], const Unit& u, int wr, int wc, int fr, int fq) const {
        const int row0 = u.pm * BM + wr * 64 + fr, col0 = (u.pn & 7) * HALF + wc * 32 + 8 * fq;
#pragma unroll
        for (int ai = 0; ai < 2; ++ai)
#pragma unroll
            for (int m = 0; m < 4; ++m) { unsigned char* rowp = O + (size_t)(row0 + ai * HALF + m * 16) * 1024 + col0;
                float o[8];
#pragma unroll
                for (int n = 0; n < 2; ++n)
#pragma unroll
                    for (int i = 0; i < 4; ++i) { const float g = acc[ai][0][m][n][i] * isc, up = acc[ai][1][m][n][i] * isc; o[4 * n + i] = g * sigm(g) * up; }
                u32x2 w; w.x = pk4_fp8(o[0], o[1], o[2], o[3]); w.y = pk4_fp8(o[4], o[5], o[6], o[7]);
                *(u32x2*)rowp = w; }
    }
};
struct EpiSwiglu {
    static constexpr bool PERM = true, AFTER_DRAIN = false;
    bf16_t* O;
    __device__ __forceinline__ void operator()(const f32x4 (&acc)[2][2][4][2], const Unit& u, int wr, int wc, int fr, int fq) const {
        const int row0 = u.pm * BM + wr * 64 + fr, col0 = (u.pn & 7) * HALF + wc * 32 + 8 * fq;
#pragma unroll
        for (int ai = 0; ai < 2; ++ai)
#pragma unroll
            for (int m = 0; m < 4; ++m) { bf16_t* rowp = O + (size_t)(row0 + ai * HALF + m * 16) * 1024 + col0;
                float o[8];
#pragma unroll
                for (int n = 0; n < 2; ++n)
#pragma unroll
                    for (int i = 0; i < 4; ++i) { const float g = acc[ai][0][m][n][i], up = acc[ai][1][m][n][i]; o[4 * n + i] = g * sigm(g) * up; }
                u32x4 w; w.x = cvt_pk_bf16(o[0], o[1]); w.y = cvt_pk_bf16(o[2], o[3]); w.z = cvt_pk_bf16(o[4], o[5]); w.w = cvt_pk_bf16(o[6], o[7]);
                *(u32x4*)rowp = w; }
    }
};
struct GroupedOrder {
    int G, c;
    __device__ __forceinline__ bool next(int i, Unit& u) const { const int L = i * G + c; if (L >= 512) return false; const int e = L >> 5, r = L & 31; u.pm = e * 4 + (r & 3); u.pn = e * 8 + (r >> 2); return true; }
    __device__ __forceinline__ void a_ready(const Unit&) const {}
    __device__ __forceinline__ void done(const Unit&) const {}
};

typedef int v8i32 __attribute__((ext_vector_type(8)));
typedef int v4i32 __attribute__((ext_vector_type(4)));
__device__ __forceinline__ void mfma_f8(f32x4& acc, const v8i32& a, const v8i32& b, int sc) {
    asm volatile("v_mfma_scale_f32_16x16x128_f8f6f4 %0, %1, %2, %0, %3, %3 op_sel_hi:[0,0,0]" : "+v"(acc) : "v"(a), "v"(b), "v"(sc));
}
template <class Epi, class Sched, bool ALIGN_EPI = false, bool SP2 = false, bool GATHER = false, bool FP8 = false>
__device__ __forceinline__ void gemm_phase(PG8_LAS unsigned char* lds, const Gemm g, const Sched& S, const Epi& E) {
    const int tid = threadIdx.x, wid = __builtin_amdgcn_readfirstlane(tid >> 6), lane = tid & 63, wr = wid >> 2, wc = wid & 3, fr = lane & 15, fq = lane >> 4;
    const int K = g.K, nt = K / BK;
    unsigned voffA[2], voffB[2]; int Rr[2], Cc[2];
#pragma unroll
    for (int i = 0; i < 2; ++i) { int R, C; stage_rc(tid * 16 + i * 8192, R, C); const int Rb = Epi::PERM ? ((R & ~31) + perm32(R & 31)) : R; Rr[i] = R; Cc[i] = C;
        voffA[i] = (unsigned)(R * K + C) * 2u; voffB[i] = (unsigned)(Rb * K + C) * 2u; }
    unsigned cv0[2], cv1[2], nv0[2], nv1[2], sv0[2], sv1[2];
#define PG8_GOFF(o0, o1, pm_) do { _Pragma("unroll") for (int _i = 0; _i < 2; ++_i) { \
        o0[_i] = (unsigned)(g.gidx[(pm_) * BM + Rr[_i]] * K + Cc[_i]) * 2u; o1[_i] = (unsigned)(g.gidx[(pm_) * BM + HALF + Rr[_i]] * K + Cc[_i]) * 2u; } } while (0)
    const size_t kstep = (size_t)(BK * 2);
    const size_t hstep = (size_t)HALF * K * 2;
    const size_t tstep = 2 * hstep;
    const unsigned ldsw = (unsigned)wid * 1024u;
    const int aoff = FP8 ? lds_byte(wr * 64 + fr, fq * 16) : lds_byte(wr * 64 + fr, fq * 8), boff = FP8 ? lds_byte(wc * 32 + fr, fq * 16) : lds_byte(wc * 32 + fr, fq * 8);
#define PG8_SA(b, h) (((b) * 2 + (h)) * HTB)
#define PG8_SB(b, h) ((4 + (b) * 2 + (h)) * HTB)
#define PG8_STAGE(bufoff, gbase, voff) do { _Pragma("unroll") for (int _i = 0; _i < 2; ++_i) \
        __builtin_amdgcn_global_load_lds((const unsigned*)((const char*)(gbase) + (voff)[_i]), (PG8_LAS unsigned*)(lds + (bufoff) + ldsw + _i * 8192), 16, 0, 0); } while (0)
#define PG8_LDA(dst, b, h) do { if constexpr (FP8) { _Pragma("unroll") for (int m = 0; m < 4; ++m) { const PG8_LAS unsigned char* p_ = lds + PG8_SA(b, h) + aoff + m * 2048; \
            const v4i32 lo_ = *(const PG8_LAS v4i32*)p_, hi_ = *(const PG8_LAS v4i32*)(p_ + 16); dst##8[m] = __builtin_shufflevector(lo_, hi_, 0, 1, 2, 3, 4, 5, 6, 7); } } \
        else { _Pragma("unroll") for (int m = 0; m < 4; ++m) _Pragma("unroll") for (int k = 0; k < 2; ++k) dst[m][k] = *(const PG8_LAS bf16x8*)(lds + PG8_SA(b, h) + aoff + m * 2048 + k * 1024); } } while (0)
#define PG8_LDB(dst, b, h) do { if constexpr (FP8) { _Pragma("unroll") for (int n = 0; n < 2; ++n) { const PG8_LAS unsigned char* p_ = lds + PG8_SB(b, h) + boff + n * 2048; \
            const v4i32 lo_ = *(const PG8_LAS v4i32*)p_, hi_ = *(const PG8_LAS v4i32*)(p_ + 16); dst##8[n] = __builtin_shufflevector(lo_, hi_, 0, 1, 2, 3, 4, 5, 6, 7); } } \
        else { _Pragma("unroll") for (int n = 0; n < 2; ++n) _Pragma("unroll") for (int k = 0; k < 2; ++k) dst[n][k] = *(const PG8_LAS bf16x8*)(lds + PG8_SB(b, h) + boff + n * 2048 + k * 1024); } } while (0)
#define PG8_MMA(ai, bj, At, Bt) do { __builtin_amdgcn_s_setprio(1); \
        if constexpr (FP8) { _Pragma("unroll") for (int m = 0; m < 4; ++m) _Pragma("unroll") for (int n = 0; n < 2; ++n) \
            mfma_f8(acc[ai][bj][m][n], Bt##8[n], At##8[m], f8one); } \
        else { _Pragma("unroll") for (int m = 0; m < 4; ++m) _Pragma("unroll") for (int n = 0; n < 2; ++n) _Pragma("unroll") for (int k = 0; k < 2; ++k) \
            acc[ai][bj][m][n] = __builtin_amdgcn_mfma_f32_16x16x32_bf16(Bt[n][k], At[m][k], acc[ai][bj][m][n], 0, 0, 0); } \
        __builtin_amdgcn_s_setprio(0); } while (0)
#define PG8_WAIT_V(n) asm volatile("s_waitcnt vmcnt(" #n ")" ::: "memory")
#define PG8_WAIT_L(n) asm volatile("s_waitcnt lgkmcnt(" #n ")" ::: "memory")
#define PG8_BAR __builtin_amdgcn_s_barrier()
#define PG8_SCHED __builtin_amdgcn_sched_barrier(0)
    Unit cur, nxt; int ui = 0;
    if (!S.next(0, cur)) return;
    if constexpr (GATHER) { PG8_GOFF(cv0, cv1, cur.pm); }
    else {
#pragma unroll
        for (int i = 0; i < 2; ++i) { cv0[i] = voffA[i]; cv1[i] = voffA[i] + (unsigned)(HALF * K * 2); } }
    f32x4 acc[2][2][4][2];
#pragma unroll
    for (int a = 0; a < 2; ++a)
#pragma unroll
        for (int b = 0; b < 2; ++b)
#pragma unroll
            for (int m = 0; m < 4; ++m)
#pragma unroll
                for (int n = 0; n < 2; ++n) acc[a][b][m][n] = (f32x4){0.f, 0.f, 0.f, 0.f};
    bf16x8 At[4][2], B0[2][2], B1[2][2]; v8i32 At8[4], B08[2], B18[2]; int f8one = 0x7f7f7f7f; asm volatile("" : "+v"(f8one));
    const char* cA = (const char*)g.A + (GATHER ? (size_t)0 : (size_t)cur.pm * tstep); const char* cB = (const char*)g.Bt + (size_t)cur.pn * tstep;
    S.a_ready(cur);
    if constexpr (SP2) {
        PG8_STAGE(PG8_SB(0, 0), cB, voffB); PG8_STAGE(PG8_SB(0, 1), cB + hstep, voffB); PG8_STAGE(PG8_SA(0, 0), cA, cv0); PG8_STAGE(PG8_SA(0, 1), cA, cv1);
        if (wr == 1) PG8_BAR;
        PG8_WAIT_V(2); PG8_BAR;
        PG8_STAGE(PG8_SB(1, 0), cB + kstep, voffB); PG8_STAGE(PG8_SA(1, 0), cA + kstep, cv0); PG8_STAGE(PG8_SB(1, 1), cB + hstep + kstep, voffB);
        PG8_WAIT_V(6); PG8_BAR;
    } else {
        PG8_STAGE(PG8_SB(0, 0), cB, voffB); PG8_STAGE(PG8_SA(0, 0), cA, cv0); PG8_STAGE(PG8_SB(0, 1), cB + hstep, voffB); PG8_STAGE(PG8_SA(0, 1), cA, cv1);
        if (wr == 1) PG8_BAR;
        PG8_WAIT_V(4); PG8_BAR;
        PG8_STAGE(PG8_SB(1, 0), cB + kstep, voffB); PG8_STAGE(PG8_SA(1, 0), cA + kstep, cv0); PG8_STAGE(PG8_SB(1, 1), cB + hstep + kstep, voffB);
        PG8_WAIT_V(6); PG8_BAR;
    }
    for (;;) {
        const bool has_next = S.next(ui + 1, nxt);
        if (GATHER && has_next) { PG8_GOFF(nv0, nv1, nxt.pm); }
        else {
#pragma unroll
            for (int i = 0; i < 2; ++i) { nv0[i] = cv0[i]; nv1[i] = cv1[i]; } }
        const char* nA = (has_next && !GATHER) ? (const char*)g.A + (size_t)nxt.pm * tstep : cA; const char* nB = has_next ? (const char*)g.Bt + (size_t)nxt.pn * tstep : cB;
#pragma unroll 1
        for (int t = 0; t < nt; t += 2) {
            const bool last = (t == nt - 2);
            const char* a1 = cA + (size_t)(t + 1) * kstep;
            const char* a2 = last ? nA : cA + (size_t)(t + 2) * kstep; const char* b2 = last ? nB : cB + (size_t)(t + 2) * kstep;
            const char* a3 = a2 + kstep; const char* b3 = b2 + kstep;
#pragma unroll
            for (int i = 0; i < 2; ++i) { sv0[i] = last ? nv0[i] : cv0[i]; sv1[i] = last ? nv1[i] : cv1[i]; }
            if (last && has_next) S.a_ready(nxt);
            if constexpr (SP2) {
            PG8_LDB(B0, 0, 0); PG8_LDB(B1, 0, 1); PG8_SCHED; PG8_LDA(At, 0, 0); PG8_STAGE(PG8_SA(1, 1), a1, cv1);
            PG8_WAIT_V(8); PG8_WAIT_L(0); PG8_BAR; PG8_MMA(0, 0, At, B0); PG8_MMA(0, 1, At, B1); PG8_BAR; PG8_SCHED;
            PG8_LDA(At, 0, 1); PG8_STAGE(PG8_SB(0, 0), b2, voffB); PG8_STAGE(PG8_SB(0, 1), b2 + hstep, voffB); PG8_STAGE(PG8_SA(0, 0), a2, sv0);
            PG8_WAIT_V(8); PG8_WAIT_L(0); PG8_BAR; PG8_MMA(1, 0, At, B0); PG8_MMA(1, 1, At, B1); PG8_BAR; PG8_SCHED;
            PG8_LDB(B0, 1, 0); PG8_LDB(B1, 1, 1); PG8_SCHED; PG8_LDA(At, 1, 0); PG8_STAGE(PG8_SA(0, 1), a2, sv1);
            PG8_WAIT_V(8); PG8_WAIT_L(0); PG8_BAR; PG8_MMA(0, 0, At, B0); PG8_MMA(0, 1, At, B1); PG8_BAR; PG8_SCHED;
            PG8_LDA(At, 1, 1); PG8_STAGE(PG8_SB(1, 0), b3, voffB); PG8_STAGE(PG8_SB(1, 1), b3 + hstep, voffB); PG8_STAGE(PG8_SA(1, 0), a3, sv0);
            PG8_WAIT_V(8); PG8_WAIT_L(0); PG8_BAR; PG8_MMA(1, 0, At, B0); PG8_MMA(1, 1, At, B1); PG8_BAR; PG8_SCHED;
            } else {
            PG8_LDB(B0, 0, 0); PG8_SCHED; PG8_LDA(At, 0, 0); PG8_STAGE(PG8_SA(1, 1), a1, cv1);
            PG8_WAIT_L(8); PG8_BAR; PG8_WAIT_L(0); PG8_MMA(0, 0, At, B0); PG8_BAR; PG8_SCHED;
            PG8_LDB(B1, 0, 1); PG8_STAGE(PG8_SB(0, 0), b2, voffB);
            PG8_BAR; PG8_WAIT_L(0); PG8_MMA(0, 1, At, B1); PG8_BAR;
            PG8_LDA(At, 0, 1); PG8_STAGE(PG8_SA(0, 0), a2, sv0);
            PG8_BAR; PG8_WAIT_L(0); PG8_MMA(1, 0, At, B0); PG8_BAR; PG8_SCHED;
            PG8_STAGE(PG8_SB(0, 1), b2 + hstep, voffB);
            PG8_WAIT_V(6); PG8_BAR; PG8_MMA(1, 1, At, B1); PG8_BAR;
            PG8_LDB(B0, 1, 0); PG8_SCHED; PG8_LDA(At, 1, 0); PG8_STAGE(PG8_SA(0, 1), a2, sv1);
            PG8_WAIT_L(8); PG8_BAR; PG8_WAIT_L(0); PG8_MMA(0, 0, At, B0); PG8_BAR; PG8_SCHED;
            PG8_LDB(B1, 1, 1); PG8_STAGE(PG8_SB(1, 0), b3, voffB);
            PG8_BAR; PG8_WAIT_L(0); PG8_MMA(0, 1, At, B1); PG8_BAR;
            PG8_LDA(At, 1, 1); PG8_STAGE(PG8_SA(1, 0), a3, sv0);
            PG8_BAR; PG8_WAIT_L(0); PG8_MMA(1, 0, At, B0); PG8_BAR; PG8_SCHED;
            PG8_STAGE(PG8_SB(1, 1), b3 + hstep, voffB);
            PG8_WAIT_V(6); PG8_BAR; PG8_MMA(1, 1, At, B1); PG8_BAR;
            }
        }
        if constexpr (FP8) { asm volatile("s_nop 15\n\ts_nop 15\n\ts_nop 7" ::: "memory"); }
        if constexpr (ALIGN_EPI) { if (wr == 0) PG8_BAR; }
        if constexpr (!Epi::AFTER_DRAIN) { E(acc, cur, wr, wc, fr, fq); S.done(cur); }
        if (!has_next) break;
#pragma unroll
        for (int a = 0; a < 2; ++a)
#pragma unroll
            for (int b = 0; b < 2; ++b)
#pragma unroll
                for (int m = 0; m < 4; ++m)
#pragma unroll
                    for (int n = 0; n < 2; ++n) acc[a][b][m][n] = (f32x4){0.f, 0.f, 0.f, 0.f};
        cur = nxt; cA = nA; cB = nB; ++ui;
#pragma unroll
        for (int i = 0; i < 2; ++i) { cv0[i] = nv0[i]; cv1[i] = nv1[i]; }
        if constexpr (ALIGN_EPI) { if (wr == 1) PG8_BAR; }
    }
    PG8_WAIT_V(0);
    if constexpr (!ALIGN_EPI) { if (wr == 0) PG8_BAR; }
    PG8_BAR;
    if constexpr (Epi::AFTER_DRAIN) { E.fused(acc, cur, wr, wc, fr, fq, lds, wid, lane); S.done(cur); }
#undef PG8_GOFF
#undef PG8_SA
#undef PG8_SB
#undef PG8_STAGE
#undef PG8_LDA
#undef PG8_LDB
#undef PG8_MMA
#undef PG8_WAIT_V
#undef PG8_WAIT_L
#undef PG8_BAR
#undef PG8_SCHED
}
}

#ifndef PG8_SP2
#define PG8_SP2 true
#endif
#ifndef PG8_ALIGN
#define PG8_ALIGN true
#endif
constexpr int RING_OFF = 0, RING_BYTES = 131072;
constexpr int LDSCTL_OFF = RING_BYTES, MISC_OFF = LDSCTL_OFF + 320;
constexpr int LDS_BYTES = 163840;
constexpr int PARAM_OFF = 135168;
constexpr int NWAVES = 8;
#define GAS __attribute__((address_space(1)))
#define LAS __attribute__((address_space(3)))
typedef unsigned v4u __attribute__((ext_vector_type(4)));
typedef float f32x4 __attribute__((ext_vector_type(4)));
typedef GAS unsigned gu32;
#define RLX_AGENT __ATOMIC_RELAXED, __HIP_MEMORY_SCOPE_AGENT
#define LDS_WAIT() asm volatile("s_waitcnt lgkmcnt(0)" ::: "memory")
__device__ __forceinline__ unsigned pk2(float lo, float hi) { return cvtpk2(lo, hi); }

#define XB_TMO      128
#define XB_XCNT(j)  (256  + 64 * (j))
#define XB_XSUB(j)  (1280 + 64 * (j))
#define XB_XGEN(j)  (2304 + 64 * (j))
#define XB_TOP      3328
#define XB_TOPGEN   3392
#define XCD_BAR_WORDS 3456
#define XB_SPIN_CAP (1u << 18)

__device__ __forceinline__ unsigned xb_ld(unsigned* p)              { return __hip_atomic_load(p, __ATOMIC_RELAXED, __HIP_MEMORY_SCOPE_AGENT); }
__device__ __forceinline__ unsigned xb_add(unsigned* p, unsigned v) { return __hip_atomic_fetch_add(p, v, __ATOMIC_RELAXED, __HIP_MEMORY_SCOPE_AGENT); }
__device__ __forceinline__ unsigned xb_xcc_id() { return (unsigned)__builtin_amdgcn_s_getreg((3 << 11) | 20) & 0xFu; }
#define XB_SPIN(cond, bar) do { unsigned _sp = 0; while (cond) { __builtin_amdgcn_s_sleep(1); \
    if ((++_sp & 255u) == 0u) { if (xb_ld(&(bar)[XB_TMO])) break; if (_sp > XB_SPIN_CAP) { atomicAdd(&(bar)[XB_TMO], 1u); break; } } } } while (0)

struct XcdBarrier {
    unsigned* bar; unsigned x;
    volatile LAS unsigned* st;
};

__device__ __forceinline__ XcdBarrier xcd_barrier_post(unsigned* bar, volatile LAS unsigned* st) {
    XcdBarrier b; b.bar = bar; b.x = xb_xcc_id(); b.st = st;
    if (threadIdx.x == 0) (void)xb_add(&bar[XB_XCNT(b.x)], 1u);
    return b;
}
__device__ __forceinline__ void xcd_barrier_complete(unsigned* bar, unsigned x, unsigned& nloc, unsigned& nx) {
    const unsigned G = gridDim.x * gridDim.y * gridDim.z;
    unsigned sum, cnt, mine, sp = 0u;
    for (;;) {
        sum = 0u; cnt = 0u; mine = 0u;
#pragma unroll
        for (unsigned j = 0; j < 16; ++j) { const unsigned c = xb_ld(&bar[XB_XCNT(j)]); sum += c; cnt += (c > 0u) ? 1u : 0u; mine = (j == x) ? c : mine; }
        if (sum == G) break;
        __builtin_amdgcn_s_sleep(1);
        if ((++sp & 255u) == 0u) { if (xb_ld(&bar[XB_TMO])) break; if (sp > XB_SPIN_CAP) { atomicAdd(&bar[XB_TMO], 1u); break; } }
    }
    nloc = mine > 0u ? mine : 1u; nx = cnt > 0u ? cnt : 1u;
}

__device__ __forceinline__ void xcd_barrier(const XcdBarrier& b) {
    asm volatile("s_waitcnt vmcnt(0)" ::: "memory");
    __syncthreads();
    if (threadIdx.x == 0) {
        unsigned* bar = b.bar;
        __builtin_amdgcn_s_waitcnt(0);
        unsigned nloc = b.st[0], nx = b.st[1];
        if (nloc == 0u) { xcd_barrier_complete(bar, b.x, nloc, nx); b.st[0] = nloc; b.st[1] = nx; }
        const unsigned old = xb_add(&bar[XB_XSUB(b.x)], 1u);
        const unsigned gen = old / nloc;
        if (old + 1u == (gen + 1u) * nloc) {
            __builtin_amdgcn_fence(__ATOMIC_RELEASE, "agent");
            asm volatile("s_waitcnt vmcnt(0)" ::: "memory");
            const unsigned og = xb_add(&bar[XB_TOP], 1u);
            const unsigned tg = og / nx;
            if (og + 1u == (tg + 1u) * nx) xb_add(&bar[XB_TOPGEN], 1u);
            else XB_SPIN(xb_ld(&bar[XB_TOPGEN]) == tg, bar);
            __builtin_amdgcn_fence(__ATOMIC_ACQUIRE, "agent");
            xb_add(&bar[XB_XGEN(b.x)], 1u);
            asm volatile("s_waitcnt vmcnt(0)" ::: "memory");
        } else {
            XB_SPIN(xb_ld(&bar[XB_XGEN(b.x)]) == gen, bar);
            __builtin_amdgcn_fence(__ATOMIC_ACQUIRE, "agent");
            asm volatile("s_waitcnt vmcnt(0)" ::: "memory");
        }
    }
    __syncthreads();
}

struct Args { const void* in[20]; float* out; unsigned char* ws; int ph_lo, ph_hi, li, mask, rep, pad; };
struct Ctx {
    unsigned char* lds; int tid, lane, wave, G, gw, NGW;
    const float *x, *c, *w_ada, *b_ada, *g_pre_mix, *g_post_mix, *g_pre_ffn, *g_post_ffn, *w_in, *lbl, *onorm, *sink, *w_a, *w_b, *w_o, *w_router, *w_eg, *w_eu, *w_ed;
    const int* pos; float* out; unsigned char* ws;
};
__device__ __forceinline__ float wave_sum(float v) {
#pragma unroll
    for (int o = 1; o < 64; o <<= 1) v += __shfl_xor(v, o);
    return v;
}
struct TDesc { const float* src; bf16* dst; int N, K; float f8s; };
__device__ __forceinline__ void t_load(const TDesc& d, f32x4 (&r)[8], int lane) {
    const float* p = d.src + (size_t)(lane >> 3) * d.N + 4 * (lane & 7);
#pragma unroll
    for (int i = 0; i < 8; ++i) r[i] = *(const f32x4*)(p + (size_t)(8 * i) * d.N);
}
__device__ __forceinline__ void t_process(const TDesc& d, const f32x4 (&r)[8], float* scr, int lane) {
    { float* w = scr + (lane >> 3) * 33 + 4 * (lane & 7);
#pragma unroll
      for (int i = 0; i < 8; ++i) { float* q = w + (8 * i) * 33; q[0] = r[i].x; q[1] = r[i].y; q[2] = r[i].z; q[3] = r[i].w; } }
    LDS_WAIT(); asm volatile("" ::: "memory");
    if (d.f8s != 0.f) {
        const int c = lane & 3; const float f = d.f8s; unsigned char* dst8 = (unsigned char*)d.dst;
#pragma unroll
        for (int j = 0; j < 2; ++j) { const int n = (lane >> 2) + 16 * j; const float* s = scr + (16 * c) * 33 + n;
            v4u o; o.x = pg8::pk4_fp8(s[0 * 33] * f, s[1 * 33] * f, s[2 * 33] * f, s[3 * 33] * f); o.y = pg8::pk4_fp8(s[4 * 33] * f, s[5 * 33] * f, s[6 * 33] * f, s[7 * 33] * f);
            o.z = pg8::pk4_fp8(s[8 * 33] * f, s[9 * 33] * f, s[10 * 33] * f, s[11 * 33] * f); o.w = pg8::pk4_fp8(s[12 * 33] * f, s[13 * 33] * f, s[14 * 33] * f, s[15 * 33] * f);
            *(v4u*)(dst8 + (size_t)n * d.K + 16 * c) = o; }
    } else {
    const int c = lane & 7;
#pragma unroll
    for (int j = 0; j < 4; ++j) { const int n = (lane >> 3) + 8 * j; const float* s = scr + (8 * c) * 33 + n;
        v4u o; o.x = pk2(s[0 * 33], s[1 * 33]); o.y = pk2(s[2 * 33], s[3 * 33]); o.z = pk2(s[4 * 33], s[5 * 33]); o.w = pk2(s[6 * 33], s[7 * 33]);
        *(v4u*)(d.dst + (size_t)n * d.K + 8 * c) = o; }
    }
    LDS_WAIT(); asm volatile("" ::: "memory");
}
__device__ __forceinline__ void rope_entry(const int* pos, float* rope, int gid) {
    const int t = gid >> 6, i = gid & 63;
    double inv = 1.0, rr = 0.8659643233600653523531691834202299819398;
    for (int bit = 0; bit < 6; ++bit) { if ((i >> bit) & 1) inv *= rr; rr *= rr; }
    const double ang = (double)pos[t] * inv;
    const double kq = rint(ang * 0.3183098861837906715377675267450287);
    const double r = ang - kq * 3.141592653589793238462643383279502884;
    const double u = -(r * r);
    double s = 1.0 / 121645100408832000.0;
    s = s * u + 1.0 / 355687428096000.0; s = s * u + 1.0 / 1307674368000.0; s = s * u + 1.0 / 6227020800.0; s = s * u + 1.0 / 39916800.0; s = s * u + 1.0 / 362880.0;
    s = s * u + 1.0 / 5040.0; s = s * u + 1.0 / 120.0; s = s * u + 1.0 / 6.0; s = s * u + 1.0; s = s * r;
    double cz = 1.0 / 6402373705728000.0;
    cz = cz * u + 1.0 / 20922789888000.0; cz = cz * u + 1.0 / 87178291200.0; cz = cz * u + 1.0 / 479001600.0; cz = cz * u + 1.0 / 3628800.0; cz = cz * u + 1.0 / 40320.0;
    cz = cz * u + 1.0 / 720.0; cz = cz * u + 1.0 / 24.0; cz = cz * u + 0.5; cz = cz * u + 1.0;
    const double sg = (((long long)kq) & 1) ? -1.0 : 1.0;
    rope[(size_t)gid * 2] = (float)(sg * cz); rope[(size_t)gid * 2 + 1] = (float)(sg * s);
}
constexpr float W8S_GU = 64.f, W8S_D = 32.f;
constexpr int I_IN = 32 * 336, I_A = 16 * 64, I_O = 32 * 64, I_E = 1024, I_MIX = I_IN + 2 * I_A + I_O, I_EXP = 48 * I_E;
constexpr int CONV_BLOCKS = 32;
constexpr int CONV_ITEMS_PER_WAVE = 100;
constexpr int P0_EXPERT_ITEMS = I_EXP - CONV_BLOCKS * NWAVES * CONV_ITEMS_PER_WAVE;
constexpr int P0_GEMV_ROUNDS = 8;
constexpr int GEMV_BLOCKS = 96;
__device__ __forceinline__ TDesc transpose_desc(Ctx& F, int it) {
    bf16* WIN = (bf16*)(F.ws + WS_WIN); bf16* WA = (bf16*)(F.ws + WS_WA); bf16* WB = (bf16*)(F.ws + WS_WB); bf16* WO = (bf16*)(F.ws + WS_WO); bf16* WGU = (bf16*)(F.ws + WS_WGU); bf16* WD = (bf16*)(F.ws + WS_WD);
    int r = it; const float* W; bf16* WT; int K, N, kb, nb; size_t drow; float f8s = 0.f;
    if (r < I_IN) { W = F.w_in; WT = WIN; K = 2048; N = INW; kb = r / 336; nb = r % 336; drow = (size_t)32 * nb; }
    else if ((r -= I_IN) < I_A) { W = F.w_a; WT = WA; K = 1024; N = 2048; kb = r / 64; nb = r % 64; drow = (size_t)32 * nb; }
    else if ((r -= I_A) < I_A) { W = F.w_b; WT = WB; K = 1024; N = 2048; kb = r / 64; nb = r % 64; drow = (size_t)32 * nb; }
    else if ((r -= I_A) < I_O) { W = F.w_o; WT = WO; K = 2048; N = 2048; kb = r / 64; nb = r % 64; drow = (size_t)32 * nb; }
    else { r -= I_O; const int e = r / (3 * I_E), q = r % (3 * I_E), which = q / I_E, ii = q % I_E;
        if (which < 2) { kb = ii / 32; nb = ii % 32; const int n0 = 32 * nb; W = (which ? F.w_eu : F.w_eg) + (size_t)e * 2048 * 1024; WT = WGU; K = 2048; N = 1024; f8s = W8S_GU; drow = (size_t)e * 2048 + (n0 >> 7) * 256 + which * 128 + (n0 & 127); }
        else { kb = ii / 64; nb = ii % 64; W = F.w_ed + (size_t)e * 1024 * 2048; WT = WD; K = 1024; N = 2048; f8s = W8S_D; drow = (size_t)e * 2048 + 32 * nb; } }
    TDesc d; d.src = W + (size_t)(64 * kb) * N + 32 * nb; d.N = N; d.K = K; d.f8s = f8s;
    if (f8s != 0.f) d.dst = (bf16*)((unsigned char*)WT + drow * K + 64 * kb); else d.dst = WT + drow * K + 64 * kb;
    return d;
}
template <class Seq> __device__ __forceinline__ void transpose_stream(Ctx& F, const Seq& seq, float* scr) {
    f32x4 ra[8], rb[8]; TDesc da, db; int j = 0; int it = seq(j);
    if (it < 0) return;
    da = transpose_desc(F, it); t_load(da, ra, F.lane);
    for (;;) {
        const int itn = seq(++j);
        if (itn >= 0) { db = transpose_desc(F, itn); t_load(db, rb, F.lane); }
        t_process(da, ra, scr, F.lane);
        if (itn < 0) break;
        const int itnn = seq(++j);
        if (itnn >= 0) { da = transpose_desc(F, itnn); t_load(da, ra, F.lane); }
        t_process(db, rb, scr, F.lane);
        if (itnn < 0) break;
    }
}
struct P0Seq { int gw, NGW, ngv; bool gemv;
    __device__ __forceinline__ int operator()(int r) const { int it; if (r < P0_GEMV_ROUNDS) it = r * NGW + gw; else { if (gemv) return -1; it = P0_GEMV_ROUNDS * NGW + (r - P0_GEMV_ROUNDS) * (NGW - ngv) + (gw - ngv); }
        return it < I_MIX + P0_EXPERT_ITEMS ? it : -1; } };
struct TailSeq { int first, stride;
    __device__ __forceinline__ int operator()(int j) const { const int it = first + j * stride; return it < I_MIX + I_EXP ? it : -1; } };
__device__ __forceinline__ void p1_modnorm(Ctx& F, int first, int stride) {
    const float* MOD = (const float*)(F.ws + WS_MOD); bf16* H = (bf16*)(F.ws + WS_H);
    for (int row0 = first; row0 < T; row0 += 2 * stride) {
        f32x4 v[2][8];
#pragma unroll
        for (int k = 0; k < 2; ++k) { const int row = row0 + k * stride; if (row < T) { const f32x4* xr = (const f32x4*)(F.x + (size_t)row * D) + F.lane;
#pragma unroll
            for (int j = 0; j < 8; ++j) v[k][j] = xr[64 * j]; } }
#pragma unroll
        for (int k = 0; k < 2; ++k) { const int row = row0 + k * stride; if (row < T) {
            const int b = row / SEQ; float ss = 0.f;
#pragma unroll
            for (int j = 0; j < 8; ++j) ss += (v[k][j].x * v[k][j].x + v[k][j].y * v[k][j].y) + (v[k][j].z * v[k][j].z + v[k][j].w * v[k][j].w);
            const float r = rsqrtf(wave_sum(ss) * (1.f / D) + EPS);
            const f32x4* gp = (const f32x4*)F.g_pre_mix + F.lane; const f32x4* shp = (const f32x4*)(MOD + b * 12288) + F.lane; const f32x4* scp = (const f32x4*)(MOD + b * 12288 + 2048) + F.lane;
            uint2* o8 = (uint2*)(H + (size_t)row * D) + F.lane;
            f32x4 g[8], sh[8], sc[8];
#pragma unroll
            for (int j = 0; j < 8; ++j) { g[j] = gp[64 * j]; sh[j] = shp[64 * j]; sc[j] = scp[64 * j]; }
#pragma unroll
            for (int j = 0; j < 8; ++j) { const f32x4 h = v[k][j] * r * g[j] * (sc[j] + 1.f) + sh[j];
                uint2 w; w.x = pk2(h.x, h.y); w.y = pk2(h.z, h.w); o8[64 * j] = w; } } }
    }
}
__device__ __forceinline__ void p0_prep(Ctx& F) {
    float* MOD = (float*)(F.ws + WS_MOD); float* LB = (float*)(F.ws + WS_LB); float* ROPE = (float*)(F.ws + WS_ROPE);
    if (blockIdx.x < GEMV_BLOCKS) {
        float* sc = (float*)F.lds; float* red = (float*)(F.lds + 16384);
        for (int i = F.tid; i < 4096; i += 512) sc[i] = siluf_(F.c[i]);
        __syncthreads();
        const int j0 = blockIdx.x * 128, k0 = F.wave * 256, half = F.lane >> 5, l32 = F.lane & 31;
        f32x4 a0 = {0.f, 0.f, 0.f, 0.f}, a1 = {0.f, 0.f, 0.f, 0.f};
        const float* wp = F.w_ada + (size_t)(k0 + half) * 12288 + j0 + 4 * l32;
#pragma unroll 16
        for (int k = 0; k < 128; ++k) { const f32x4 w = *(const f32x4*)(wp + (size_t)(2 * k) * 12288); const float s0 = sc[k0 + 2 * k + half], s1 = sc[2048 + k0 + 2 * k + half]; a0 += w * s0; a1 += w * s1; }
        *(f32x4*)(red + ((F.wave * 2 + half) * 2 + 0) * 128 + 4 * l32) = a0; *(f32x4*)(red + ((F.wave * 2 + half) * 2 + 1) * 128 + 4 * l32) = a1;
        __syncthreads();
        if (F.tid < 256) { const int b = F.tid >> 7, jj = F.tid & 127; float s = 0.f;
#pragma unroll
          for (int p = 0; p < 16; ++p) s += red[(p * 2 + b) * 128 + jj];
          MOD[b * 12288 + j0 + jj] = s + F.b_ada[j0 + jj]; }
        __syncthreads();
    }
    { const int gt = blockIdx.x * 512 + F.tid, NT = F.G * 512;
      if (gt < 2048) { const int dir = gt >> 10, ch = gt & 1023; const float l0 = F.lbl[dir * 2048 + ch], l1 = F.lbl[dir * 2048 + 1024 + ch]; LB[gt] = 1.f / (1.f + expf(l1 - l0)); }
      for (int g = gt; g < T * 64; g += NT) rope_entry(F.pos, ROPE, g); }
    unsigned* cnt = (unsigned*)(F.ws + WS_CTL) + 1024;
    if (blockIdx.x < GEMV_BLOCKS) {
        asm volatile("s_waitcnt vmcnt(0)" ::: "memory"); __syncthreads();
        if (F.tid == 0) { __builtin_amdgcn_fence(__ATOMIC_RELEASE, "agent"); asm volatile("s_waitcnt vmcnt(0)" ::: "memory"); __hip_atomic_fetch_add(cnt, 1u, __ATOMIC_RELAXED, __HIP_MEMORY_SCOPE_AGENT); }
    }
    float* scr = (float*)(F.lds + F.wave * 16384);
    P0Seq seq{F.gw, F.NGW, GEMV_BLOCKS * NWAVES, blockIdx.x < GEMV_BLOCKS};
    transpose_stream(F, seq, scr);
    __syncthreads();
    if (F.tid == 0) { unsigned sp = 0; while (__hip_atomic_load(cnt, __ATOMIC_RELAXED, __HIP_MEMORY_SCOPE_AGENT) < (unsigned)GEMV_BLOCKS && ++sp < (1u << 22)) __builtin_amdgcn_s_sleep(2);
        __builtin_amdgcn_fence(__ATOMIC_ACQUIRE, "agent"); asm volatile("s_waitcnt vmcnt(0)" ::: "memory"); }
    __syncthreads();
    p1_modnorm(F, F.gw, F.NGW);
}
__device__ __forceinline__ void p6_post1(Ctx& F) {
    const float* MOD = (const float*)(F.ws + WS_MOD); const float* Y = (const float*)(F.ws + WS_Y); bf16* H2 = (bf16*)(F.ws + WS_H2); float* AFF = (float*)(F.ws + WS_AFF);
    float* wT = (float*)F.lds;
    float* PA = (float*)(F.lds + PARAM_OFF); float* PB = PA + 2048; float* PC = PB + 2048;
    for (int f = F.tid; f < 8192; f += 512) { const int d = f >> 2, q = f & 3; const f32x4 wv = *((const f32x4*)F.w_router + f);
        wT[(4 * q + 0) * 2048 + d] = wv.x; wT[(4 * q + 1) * 2048 + d] = wv.y; wT[(4 * q + 2) * 2048 + d] = wv.z; wT[(4 * q + 3) * 2048 + d] = wv.w; }
    uint2 ywn[8]; f32x4 xvn[8];
#define P6_LOAD(rr) do { const uint2* yr_ = (const uint2*)((const bf16*)Y + (size_t)(rr) * D) + F.lane; const f32x4* xr_ = (const f32x4*)(F.x + (size_t)(rr) * D) + F.lane; \
        _Pragma("unroll") for (int j = 0; j < 8; ++j) { ywn[j] = yr_[64 * j]; xvn[j] = xr_[64 * j]; } } while (0)
    for (int b = 0; b < BATCH; ++b) {
        const float* mb = MOD + b * 12288;
        __syncthreads();
        if (F.tid < 512) { const int d4 = F.tid;
            const f32x4 gt = *((const f32x4*)(mb + 4096) + d4), gp = *((const f32x4*)F.g_post_mix + d4), g2 = *((const f32x4*)F.g_pre_ffn + d4), sc = *((const f32x4*)(mb + 8192) + d4), sh = *((const f32x4*)(mb + 6144) + d4);
            *((f32x4*)PA + d4) = gt * gp; *((f32x4*)PB + d4) = g2 * (sc + 1.f); *((f32x4*)PC + d4) = sh; }
        const int rfirst = b * SEQ + F.gw;
        if (F.gw < SEQ) P6_LOAD(rfirst);
        __syncthreads();
        for (int rl = F.gw; rl < SEQ; rl += F.NGW) {
            const int row = b * SEQ + rl, s = rl;
            f32x4 xv[8]; float ss = 0.f;
            {   uint2 yc[8];
#pragma unroll
                for (int j = 0; j < 8; ++j) { yc[j] = ywn[j]; const float y0 = __uint_as_float(yc[j].x << 16), y1 = __uint_as_float(yc[j].x & 0xffff0000u), y2 = __uint_as_float(yc[j].y << 16), y3 = __uint_as_float(yc[j].y & 0xffff0000u);
                    xv[j] = xvn[j]; ss += (y0 * y0 + y1 * y1) + (y2 * y2 + y3 * y3); }
                if (rl + F.NGW < SEQ) P6_LOAD(row + F.NGW);
                const float r = rsqrtf(wave_sum(ss) * (1.f / D) + EPS);
                f32x4* op = (f32x4*)(F.out + (size_t)row * D) + F.lane;
                ss = 0.f;
#pragma unroll
                for (int j = 0; j < 8; ++j) { const f32x4 y = {__uint_as_float(yc[j].x << 16), __uint_as_float(yc[j].x & 0xffff0000u), __uint_as_float(yc[j].y << 16), __uint_as_float(yc[j].y & 0xffff0000u)};
                    const f32x4 pa = *((const f32x4*)PA + F.lane + 64 * j);
                    xv[j] = xv[j] + pa * (y * r); ss += (xv[j].x * xv[j].x + xv[j].y * xv[j].y) + (xv[j].z * xv[j].z + xv[j].w * xv[j].w); }
#pragma unroll
                for (int j = 0; j < 8; ++j) op[64 * j] = xv[j];
            }
            const float r2 = rsqrtf(wave_sum(ss) * (1.f / D) + EPS);
            unsigned* o4 = (unsigned*)((unsigned char*)H2 + (size_t)row * D) + F.lane;
            float lg[16];
#pragma unroll
            for (int j = 0; j < 8; ++j) { const f32x4 pb = *((const f32x4*)PB + F.lane + 64 * j), pc = *((const f32x4*)PC + F.lane + 64 * j); xv[j] = xv[j] * r2 * pb + pc; }
#pragma unroll
            for (int j = 0; j < 8; ++j) o4[64 * j] = pg8::pk4_fp8(xv[j].x, xv[j].y, xv[j].z, xv[j].w);
#pragma unroll
            for (int e = 0; e < 16; ++e) { float a = 0.f;
#pragma unroll
                for (int j = 0; j < 8; ++j) { const f32x4 wv = *((const f32x4*)(wT + e * 2048) + F.lane + 64 * j); a += (xv[j].x * wv.x + xv[j].y * wv.y) + (xv[j].z * wv.z + xv[j].w * wv.w); }
                lg[e] = a; asm volatile("" ::: "memory"); }
            float mx = -1e30f;
#pragma unroll
            for (int e = 0; e < 16; ++e) { lg[e] = wave_sum(lg[e]); mx = fmaxf(mx, lg[e]); }
            float sm = 0.f;
#pragma unroll
            for (int e = 0; e < 16; ++e) { lg[e] = expf(lg[e] - mx); sm += lg[e]; }
            float mine = 0.f;
#pragma unroll
            for (int e = 0; e < 16; ++e) mine = (F.lane == e) ? lg[e] : mine;
            if (F.lane < 16) AFF[((size_t)b * 16 + F.lane) * SEQ + s] = mine / sm;
        }
    }
#undef P6_LOAD
    __syncthreads();
}
__device__ __forceinline__ void p7_topk_gather(Ctx& F) {
    const float* AFF = (const float*)(F.ws + WS_AFF); int* GIDX = (int*)(F.ws + WS_GIDX); float* SELAFF = (float*)(F.ws + WS_SELAFF); int* TOKSLOT = (int*)(F.ws + WS_TOKSLOT);
        int* sh = (int*)F.lds; int* wsum = (int*)(F.lds + 64);
    for (int unit = blockIdx.x; unit < 256; unit += F.G) {
        const int be = unit >> 3, part = unit & 7, b = be >> 4, e = be & 15, tid = F.tid, lane = F.lane;
        if (F.wave == 0) {
            unsigned v[64];
#pragma unroll
            for (int i = 0; i < 64; ++i) v[i] = __float_as_uint(AFF[(size_t)be * SEQ + i * 64 + lane]);
            unsigned tau = 0u;
            for (int bit = 30; bit >= 0; --bit) { const unsigned cand = tau | (1u << bit); int cl = 0;
#pragma unroll
                for (int i = 0; i < 64; ++i) cl += (v[i] >= cand) ? 1 : 0;
                int c = 0;
#pragma unroll
                for (int q = 0; q < 7; ++q) c += __popcll(__ballot((cl >> q) & 1)) << q;
                if (c >= CAP) tau = cand; }
            int cgt = 0;
            { int cl = 0;
#pragma unroll
              for (int i = 0; i < 64; ++i) cl += (v[i] > tau) ? 1 : 0;
#pragma unroll
              for (int q = 0; q < 7; ++q) cgt += __popcll(__ballot((cl >> q) & 1)) << q; }
            if (lane == 0) { sh[0] = (int)tau; sh[1] = cgt; }
        }
        __syncthreads();
        const unsigned tau = (unsigned)sh[0]; const int need = CAP - sh[1];
        const f32x4* a = (const f32x4*)(AFF + (size_t)be * SEQ + tid * 8);
        const f32x4 a0 = a[0], a1 = a[1];
        const unsigned v[8] = {__float_as_uint(a0.x), __float_as_uint(a0.y), __float_as_uint(a0.z), __float_as_uint(a0.w), __float_as_uint(a1.x), __float_as_uint(a1.y), __float_as_uint(a1.z), __float_as_uint(a1.w)};
        int cg = 0, ce = 0;
#pragma unroll
        for (int i = 0; i < 8; ++i) { cg += (v[i] > tau) ? 1 : 0; ce += (v[i] == tau) ? 1 : 0; }
        const int pk = cg | (ce << 16); int inc = pk;
#pragma unroll
        for (int o = 1; o < 64; o <<= 1) { const int t = __shfl_up(inc, o); if (lane >= o) inc += t; }
        if (lane == 63) wsum[F.wave] = inc;
        __syncthreads();
        int base = 0;
#pragma unroll
        for (int w = 0; w < 8; ++w) base += (w < F.wave) ? wsum[w] : 0;
        const int excl = base + inc - pk, pg = excl & 0xffff, pe = excl >> 16;
        int tie_before = pe, sel_before = pg + (pe < need ? pe : need);
#pragma unroll
        for (int i = 0; i < 8; ++i) {
            const int tok = tid * 8 + i; bool sel = false;
            if (v[i] > tau) sel = true; else if (v[i] == tau) { sel = tie_before < need; ++tie_before; }
            int slot = -1;
            if (sel) { const int sl = sel_before; ++sel_before; slot = b * CAP + sl;
                if ((sl >> 6) == part) { GIDX[e * 1024 + slot] = b * SEQ + tok; SELAFF[e * 1024 + slot] = __uint_as_float(v[i]); } }
            if (F.wave == part) TOKSLOT[((size_t)b * 16 + e) * SEQ + tok] = slot;
        }
        __syncthreads();
    }
}
__device__ __forceinline__ void p10_final(Ctx& F) {
    const float* MOD = (const float*)(F.ws + WS_MOD); const bf16* SLAB = (const bf16*)(F.ws + WS_SLAB); const int* TOKSLOT = (const int*)(F.ws + WS_TOKSLOT);
    for (int row0 = F.gw; row0 < T; row0 += 4 * F.NGW) {
        int slotw[4];
#pragma unroll
        for (int k = 0; k < 4; ++k) { const int row = row0 + k * F.NGW; slotw[k] = (row < T && F.lane < 16) ? TOKSLOT[((size_t)(row / SEQ) * 16 + F.lane) * SEQ + (row % SEQ)] : -1; }
#pragma unroll
        for (int k = 0; k < 4; ++k) { const int row = row0 + k * F.NGW; if (row < T) {
            const int b = row / SEQ; const float* mb = MOD + b * 12288;
            f32x4 x1v[8], gtv[8], gpv[8];
#pragma unroll
            for (int j = 0; j < 4; ++j) { const int col = 8 * F.lane + 512 * j; const float* op = F.out + (size_t)row * D + col;
#pragma unroll
                for (int hh = 0; hh < 2; ++hh) { x1v[2 * j + hh] = *(const f32x4*)(op + 4 * hh); gtv[2 * j + hh] = *(const f32x4*)(mb + 10240 + col + 4 * hh); gpv[2 * j + hh] = *(const f32x4*)(F.g_post_ffn + col + 4 * hh); } }
            float y[32];
#pragma unroll
            for (int i = 0; i < 32; ++i) y[i] = 0.f;
            for (int e = 0; e < 16; ++e) { const int sl = __shfl(slotw[k], e); if (sl >= 0) { const v4u* r = (const v4u*)(SLAB + ((size_t)e * 1024 + sl) * D) + F.lane;
#pragma unroll
                    for (int j = 0; j < 4; ++j) { const v4u q = r[64 * j];
                        y[8 * j + 0] += __uint_as_float(q.x << 16); y[8 * j + 1] += __uint_as_float(q.x & 0xffff0000u); y[8 * j + 2] += __uint_as_float(q.y << 16); y[8 * j + 3] += __uint_as_float(q.y & 0xffff0000u);
                        y[8 * j + 4] += __uint_as_float(q.z << 16); y[8 * j + 5] += __uint_as_float(q.z & 0xffff0000u); y[8 * j + 6] += __uint_as_float(q.w << 16); y[8 * j + 7] += __uint_as_float(q.w & 0xffff0000u); } } }
            float ss = 0.f;
#pragma unroll
            for (int i = 0; i < 32; ++i) ss += y[i] * y[i];
            const float r = rsqrtf(wave_sum(ss) * (1.f / D) + EPS);
#pragma unroll
            for (int j = 0; j < 4; ++j) { const int col = 8 * F.lane + 512 * j; float* op = F.out + (size_t)row * D + col;
#pragma unroll
                for (int hh = 0; hh < 2; ++hh) { f32x4 yy = {y[8 * j + 4 * hh], y[8 * j + 4 * hh + 1], y[8 * j + 4 * hh + 2], y[8 * j + 4 * hh + 3]};
                    *(f32x4*)(op + 4 * hh) = x1v[2 * j + hh] + gtv[2 * j + hh] * (yy * r * gpv[2 * j + hh]); } } } }
    }
}
typedef short bf16x8 __attribute__((ext_vector_type(8)));
typedef short s16x4 __attribute__((ext_vector_type(4)));
typedef short v4i16_t __attribute__((ext_vector_type(4)));
typedef float f32x16 __attribute__((ext_vector_type(16)));
typedef float f32x2m __attribute__((ext_vector_type(2)));
constexpr int RS = 272;
constexpr int RSA = 144;
constexpr float LOG2E = 1.4426950408889634f;
__device__ __forceinline__ s16x4 tr4(const LAS unsigned char* p) { return __builtin_bit_cast(s16x4, __builtin_amdgcn_ds_read_tr16_b64_v4i16((LAS v4i16_t*)p)); }
__device__ __forceinline__ bf16x8 tr8(const LAS unsigned char* p, int second) { const s16x4 a = tr4(p), b = tr4(p + second); return (bf16x8){a[0], a[1], a[2], a[3], b[0], b[1], b[2], b[3]}; }
__device__ __forceinline__ bf16x8 ld8(const LAS unsigned char* p) { return *(const LAS bf16x8*)p; }
__device__ __forceinline__ unsigned cvtpk(float lo, float hi) { return pg8::cvt_pk_bf16(lo, hi); }
__device__ __forceinline__ int crow(int r, int hi) { return (r & 3) + 8 * (r >> 2) + 4 * hi; }
#define MFMA16(a, b, c) __builtin_amdgcn_mfma_f32_16x16x32_bf16((a), (b), (c), 0, 0, 0)
#define MFMA32(a, b, c) __builtin_amdgcn_mfma_f32_32x32x16_bf16((a), (b), (c), 0, 0, 0)

__device__ __forceinline__ void rope_pass(Ctx& F) {
    const bf16* PROJ = (const bf16*)(F.ws + WS_PROJ); const float* ROPE = (const float*)(F.ws + WS_ROPE); bf16* QR = (bf16*)(F.ws + WS_QR); bf16* KR = (bf16*)(F.ws + WS_KR);
    const int NT = F.G * 512;
    for (int it0 = blockIdx.x * 512 + F.tid; it0 < T * 80; it0 += 2 * NT) {
        v4u a[2], bq[2]; f32x4 cs[2][4]; bool ok[2];
#pragma unroll
        for (int u = 0; u < 2; ++u) { const int it = it0 + u * NT; ok[u] = it < T * 80; if (ok[u]) { const int i8 = it & 7, hh = (it >> 3) % 10, t = it / 80;
            const bf16* src = PROJ + (size_t)t * INW + (hh < 8 ? C_AQ + hh * 128 : C_AK + (hh - 8) * 128) + i8 * 8;
            a[u] = *(const v4u*)src; bq[u] = *(const v4u*)(src + 64);
            const f32x4* rp = (const f32x4*)(ROPE + ((size_t)t * 64 + i8 * 8) * 2);
#pragma unroll
            for (int k = 0; k < 4; ++k) cs[u][k] = rp[k]; } }
#pragma unroll
        for (int u = 0; u < 2; ++u) { if (ok[u]) { const int it = it0 + u * NT; const int i8 = it & 7, hh = (it >> 3) % 10, t = it / 80;
            const unsigned aw[4] = {a[u].x, a[u].y, a[u].z, a[u].w}, bw[4] = {bq[u].x, bq[u].y, bq[u].z, bq[u].w};
            unsigned o1[4], o2[4];
#pragma unroll
            for (int k = 0; k < 4; ++k) { const f32x4 c4 = cs[u][k];
                const float x1a = __uint_as_float(aw[k] << 16), x1b = __uint_as_float(aw[k] & 0xffff0000u), x2a = __uint_as_float(bw[k] << 16), x2b = __uint_as_float(bw[k] & 0xffff0000u);
                o1[k] = pk2(x1a * c4.x - x2a * c4.y, x1b * c4.z - x2b * c4.w); o2[k] = pk2(x1a * c4.y + x2a * c4.x, x1b * c4.w + x2b * c4.z); }
            bf16* dst = (hh < 8 ? QR + (size_t)t * 1024 + hh * 128 : KR + (size_t)t * 256 + (hh - 8) * 128) + i8 * 8;
            *(v4u*)dst = (v4u){o1[0], o1[1], o1[2], o1[3]}; *(v4u*)(dst + 64) = (v4u){o2[0], o2[1], o2[2], o2[3]}; } }
    }
}
__device__ __forceinline__ void hgrn_a_phase(Ctx& F, LAS unsigned char* L) {
    const bf16* PROJ = (const bf16*)(F.ws + WS_PROJ); const float* LB = (const float*)(F.ws + WS_LB); bf16* CS = (bf16*)(F.ws + WS_CS); float* DEC = (float*)(F.ws + WS_DEC);
    LAS unsigned char* KD = L; LAS unsigned char* VV = L + 17408; LAS float* TOT = (LAS float*)(L + 34816);
    const int tid = F.tid, lane = F.lane, w = F.wave, dk0 = 2 * lane;
    const int tro16 = (8 * (lane >> 4) + ((lane & 15) >> 2)) * RS + (lane & 3) * 8;
    unsigned zraw[8]; v4u vr[2]; float lbA = 0.f, lbB = 0.f;
#define HA_LOAD(un) do { const int c_ = (un) & 63, dir_ = ((un) >> 6) & 1, h_ = ((un) >> 7) & 7, b_ = (un) >> 10; const size_t rb_ = (size_t)b_ * SEQ + c_ * 64; \
        { const float2 l2_ = *(const float2*)(LB + dir_ * 1024 + h_ * 128 + dk0); lbA = l2_.x; lbB = l2_.y; } \
        const bf16* zp_ = PROJ + (rb_ + 8 * w) * INW + (dir_ ? C_FB : C_FF) + h_ * 128; \
        _Pragma("unroll") for (int i = 0; i < 8; ++i) zraw[i] = *(const unsigned*)(zp_ + (size_t)i * INW + dk0); \
        _Pragma("unroll") for (int i = 0; i < 2; ++i) { const int idx = tid + 512 * i, row = idx >> 4, ch = idx & 15; vr[i] = *(const v4u*)(PROJ + (rb_ + row) * INW + C_HI + h_ * 128 + ch * 8); } } while (0)
    if ((int)blockIdx.x < 2048) HA_LOAD((int)blockIdx.x);
    for (int unit = blockIdx.x; unit < 2048; unit += F.G) {
        const int dir = (unit >> 6) & 1;
        float lfa[8], lfb[8], ka[8], kb[8];
#pragma unroll
        for (int i = 0; i < 8; ++i) { const float za = __uint_as_float(zraw[i] << 16), zb = __uint_as_float(zraw[i] & 0xffff0000u);
            const float fa = lbA + (1.f - lbA) * sigmoidf_(za), fb = lbB + (1.f - lbB) * sigmoidf_(zb); lfa[i] = __logf(fa); lfb[i] = __logf(fb); ka[i] = 1.f - fa; kb[i] = 1.f - fb; }
#pragma unroll
        for (int i = 0; i < 2; ++i) { const int idx = tid + 512 * i, row = idx >> 4, ch = idx & 15; *(LAS v4u*)(VV + row * RS + ch * 16) = vr[i]; }
        if (unit + F.G < 2048) HA_LOAD(unit + F.G);
        float runa = 0.f, runb = 0.f;
        if (dir == 0) {
#pragma unroll
            for (int i = 0; i < 8; ++i) { runa += lfa[i]; lfa[i] = runa; runb += lfb[i]; lfb[i] = runb; } }
        else {
#pragma unroll
            for (int i = 7; i >= 0; --i) { runa += lfa[i]; lfa[i] = runa; runb += lfb[i]; lfb[i] = runb; } }
        *(LAS f32x2m*)(TOT + w * 128 + dk0) = (f32x2m){runa, runb};
        __syncthreads();
        float totA = 0.f, totB = 0.f, offA = 0.f, offB = 0.f;
#pragma unroll
        for (int p = 0; p < 8; ++p) { const f32x2m t = *(const LAS f32x2m*)(TOT + p * 128 + dk0); totA += t.x; totB += t.y;
            const bool inoff = dir == 0 ? (p < w) : (p > w); offA += inoff ? t.x : 0.f; offB += inoff ? t.y : 0.f; }
#pragma unroll
        for (int i = 0; i < 8; ++i) { const float va = ka[i] * __expf(totA - (lfa[i] + offA)), vb = kb[i] * __expf(totB - (lfb[i] + offB));
            *(LAS unsigned*)(KD + (8 * w + i) * RS + dk0 * 2) = pk2(va, vb); }
        if (w == 0) *(float2*)(DEC + (size_t)unit * 128 + dk0) = make_float2(__expf(totA), __expf(totB));
        __syncthreads();
        f32x4 acc[2][4];
#pragma unroll
        for (int a = 0; a < 2; ++a)
#pragma unroll
            for (int t = 0; t < 4; ++t) acc[a][t] = (f32x4){0.f, 0.f, 0.f, 0.f};
        const int dvb = 32 * (w & 3), dkb = 64 * (w >> 2);
#pragma unroll
        for (int s = 0; s < 2; ++s) {
            bf16x8 af[2], bfr[4];
#pragma unroll
            for (int a = 0; a < 2; ++a) af[a] = tr8(VV + (32 * s) * RS + (dvb + 16 * a) * 2 + tro16, 4 * RS);
#pragma unroll
            for (int t = 0; t < 4; ++t) bfr[t] = tr8(KD + (32 * s) * RS + (dkb + 16 * t) * 2 + tro16, 4 * RS);
#pragma unroll
            for (int a = 0; a < 2; ++a)
#pragma unroll
                for (int t = 0; t < 4; ++t) acc[a][t] = MFMA16(af[a], bfr[t], acc[a][t]);
        }
        bf16* cso = CS + (size_t)unit * 16384;
        const int cc = lane & 15, rg = lane >> 4;
#pragma unroll
        for (int a = 0; a < 2; ++a)
#pragma unroll
            for (int t = 0; t < 4; ++t) { const int dkk = dkb + 16 * t + cc, dv0 = dvb + 16 * a + 4 * rg;
                uint2 o; o.x = cvtpk(acc[a][t][0], acc[a][t][1]); o.y = cvtpk(acc[a][t][2], acc[a][t][3]); *(uint2*)(cso + dkk * 128 + dv0) = o; }
        __syncthreads();
    }
#undef HA_LOAD
}
__device__ __forceinline__ void hgrn_scan_phase(Ctx& F) {
    const bf16* CS = (const bf16*)(F.ws + WS_CS); bf16* ST = (bf16*)(F.ws + WS_STATE); const float* DEC = (const float*)(F.ws + WS_DEC);
    const int NT = F.G * 512;
    for (int gt = blockIdx.x * 512 + F.tid; gt < 32 * 4096; gt += NT) {
        const int g = gt >> 12, e4 = (gt & 4095) * 4, dk = e4 >> 7, dir = g & 1;
        float s0 = 0.f, s1 = 0.f, s2 = 0.f, s3 = 0.f;
        uint2 tn[8]; float dn[8];
#define SC_LOAD(st_) do { _Pragma("unroll") for (int k = 0; k < 8; ++k) { const int c_ = dir ? 63 - ((st_) + k) : (st_) + k; const size_t u_ = (size_t)g * 64 + c_; tn[k] = *(const uint2*)(CS + u_ * 16384 + e4); dn[k] = DEC[u_ * 128 + dk]; } } while (0)
        SC_LOAD(0);
        for (int st = 0; st < 64; st += 8) {
            uint2 tmp[8]; float dc[8];
#pragma unroll
            for (int k = 0; k < 8; ++k) { tmp[k] = tn[k]; dc[k] = dn[k]; }
            if (st + 8 < 64) SC_LOAD(st + 8);
#pragma unroll
            for (int k = 0; k < 8; ++k) { const int c = dir ? 63 - (st + k) : st + k; const size_t unit = (size_t)g * 64 + c;
                uint2 o; o.x = pk2(s0, s1); o.y = pk2(s2, s3); *(uint2*)(ST + unit * 16384 + e4) = o;
                s0 = dc[k] * s0 + __uint_as_float(tmp[k].x << 16); s1 = dc[k] * s1 + __uint_as_float(tmp[k].x & 0xffff0000u);
                s2 = dc[k] * s2 + __uint_as_float(tmp[k].y << 16); s3 = dc[k] * s3 + __uint_as_float(tmp[k].y & 0xffff0000u); }
        }
#undef SC_LOAD
    }
}
__device__ __forceinline__ void hgrn_c_phase(Ctx& F, LAS unsigned char* L) {
    const bf16* PROJ = (const bf16*)(F.ws + WS_PROJ); const float* LB = (const float*)(F.ws + WS_LB); const bf16* ST = (const bf16*)(F.ws + WS_STATE); bf16* YAIN = (bf16*)(F.ws + WS_YAIN);
    LAS unsigned char* QI = L; LAS unsigned char* KI = L + 17408; LAS unsigned char* QE = L + 34816; LAS unsigned char* VV = L + 52224; LAS unsigned char* SP = L + 69632; LAS unsigned char* AM = L + 104448;
    LAS float* TOT = (LAS float*)(L + 113664); LAS float* SSQ = (LAS float*)(L + 117760);
    const int tid = F.tid, lane = F.lane, w = F.wave, dk0 = 2 * lane, cc = lane & 15, rg = lane >> 4;
    const int tro16 = (8 * (lane >> 4) + ((lane & 15) >> 2)) * RS + (lane & 3) * 8;
    unsigned zraw[8], qraw[8]; v4u vr[2], sr[4]; float lbA = 0.f, lbB = 0.f;
#define HC_LOAD(un, dr) do { const int c_ = (un) & 63, h_ = ((un) >> 6) & 7, b_ = (un) >> 9; const size_t rb_ = (size_t)b_ * SEQ + c_ * 64; \
        { const float2 l2_ = *(const float2*)(LB + (dr) * 1024 + h_ * 128 + dk0); lbA = l2_.x; lbB = l2_.y; } \
        const bf16* zp_ = PROJ + (rb_ + 8 * w) * INW + h_ * 128; \
        _Pragma("unroll") for (int i = 0; i < 8; ++i) { const bf16* rp_ = zp_ + (size_t)i * INW; zraw[i] = *(const unsigned*)(rp_ + ((dr) ? C_FB : C_FF) + dk0); qraw[i] = *(const unsigned*)(rp_ + C_HQ + dk0); } \
        if ((dr) == 0) { _Pragma("unroll") for (int i = 0; i < 2; ++i) { const int idx = tid + 512 * i, row = idx >> 4, ch = idx & 15; vr[i] = *(const v4u*)(PROJ + (rb_ + row) * INW + C_HI + h_ * 128 + ch * 8); } } \
        { const bf16* sp_ = ST + ((size_t)((b_ * 8 + h_) * 2 + (dr)) * 64 + c_) * 16384; \
          _Pragma("unroll") for (int i = 0; i < 4; ++i) { const int idx = tid + 512 * i; sr[i] = *(const v4u*)(sp_ + idx * 8); } } } while (0)
    if ((int)blockIdx.x < 1024) HC_LOAD((int)blockIdx.x, 0);
    for (int unit = blockIdx.x; unit < 1024; unit += F.G) {
        const int c = unit & 63, h = (unit >> 6) & 7, b = unit >> 9;
        const size_t rb = (size_t)b * SEQ + c * 64;
        f32x4 o[4];
#pragma unroll
        for (int t = 0; t < 4; ++t) o[t] = (f32x4){0.f, 0.f, 0.f, 0.f};
        for (int dir = 0; dir < 2; ++dir) {
            float lfa[8], lfb[8], ka[8], kb[8], qa[8], qb[8];
#pragma unroll
            for (int i = 0; i < 8; ++i) { const float za = __uint_as_float(zraw[i] << 16), zb = __uint_as_float(zraw[i] & 0xffff0000u);
                const float fa = lbA + (1.f - lbA) * sigmoidf_(za), fb = lbB + (1.f - lbB) * sigmoidf_(zb); lfa[i] = __logf(fa); lfb[i] = __logf(fb); ka[i] = 1.f - fa; kb[i] = 1.f - fb;
                qa[i] = siluf_(__uint_as_float(qraw[i] << 16)); qb[i] = siluf_(__uint_as_float(qraw[i] & 0xffff0000u)); }
            if (dir == 0) {
#pragma unroll
                for (int i = 0; i < 2; ++i) { const int idx = tid + 512 * i, row = idx >> 4, ch = idx & 15; *(LAS v4u*)(VV + row * RS + ch * 16) = vr[i]; } }
#pragma unroll
            for (int i = 0; i < 4; ++i) { const int idx = tid + 512 * i, row = idx >> 4, ch = idx & 15; *(LAS v4u*)(SP + row * RS + ch * 16) = sr[i]; }
            if (dir == 0) HC_LOAD(unit, 1); else if (unit + F.G < 1024) HC_LOAD(unit + F.G, 0);
            float runa = 0.f, runb = 0.f;
            if (dir == 0) {
#pragma unroll
                for (int i = 0; i < 8; ++i) { runa += lfa[i]; lfa[i] = runa; runb += lfb[i]; lfb[i] = runb; } }
            else {
#pragma unroll
                for (int i = 7; i >= 0; --i) { runa += lfa[i]; lfa[i] = runa; runb += lfb[i]; lfb[i] = runb; } }
            *(LAS f32x2m*)(TOT + w * 128 + dk0) = (f32x2m){runa, runb};
            __syncthreads();
            {   float offA = 0.f, offB = 0.f, brA = 0.f, brB = 0.f;
#pragma unroll
                for (int p = 0; p < 8; ++p) { const f32x2m t = *(const LAS f32x2m*)(TOT + p * 128 + dk0);
                    const bool inoff = dir == 0 ? (p < w) : (p > w), inref = dir == 0 ? (p < 4) : (p >= 4);
                    offA += inoff ? t.x : 0.f; offB += inoff ? t.y : 0.f; brA += inref ? t.x : 0.f; brB += inref ? t.y : 0.f; }
#pragma unroll
                for (int i = 0; i < 8; ++i) { const float ba = lfa[i] + offA, bb = lfb[i] + offB; const int ro = (8 * w + i) * RS + dk0 * 2;
                    *(LAS unsigned*)(QI + ro) = pk2(qa[i] * __expf(ba - brA), qb[i] * __expf(bb - brB));
                    *(LAS unsigned*)(KI + ro) = pk2(ka[i] * __expf(brA - ba), kb[i] * __expf(brB - bb));
                    *(LAS unsigned*)(QE + ro) = pk2(qa[i] * __expf(ba), qb[i] * __expf(bb)); }
            }
            __syncthreads();
            {
                const int rt = w >> 1, ct0 = 2 * (w & 1);
                f32x4 am[2] = {(f32x4){0.f, 0.f, 0.f, 0.f}, (f32x4){0.f, 0.f, 0.f, 0.f}};
#pragma unroll
                for (int s = 0; s < 4; ++s) { const bf16x8 af = ld8(QI + (16 * rt + cc) * RS + (32 * s + 8 * rg) * 2);
#pragma unroll
                    for (int t = 0; t < 2; ++t) { const bf16x8 bfr = ld8(KI + (16 * (ct0 + t) + cc) * RS + (32 * s + 8 * rg) * 2); am[t] = MFMA16(af, bfr, am[t]); } }
#pragma unroll
                for (int t = 0; t < 2; ++t)
#pragma unroll
                    for (int i = 0; i < 4; ++i) { const int l = 16 * rt + 4 * rg + i, m = 16 * (ct0 + t) + cc; const bool keep = dir == 0 ? (m <= l) : (m >= l);
                        *(LAS bf16*)(AM + l * RSA + m * 2) = f2bf(keep ? am[t][i] : 0.f); }
            }
            __syncthreads();
            {
                const int rt = w & 3, cb = 64 * (w >> 2);
#pragma unroll
                for (int s = 0; s < 2; ++s) { const bf16x8 af = ld8(AM + (16 * rt + cc) * RSA + (32 * s + 8 * rg) * 2);
#pragma unroll
                    for (int t = 0; t < 4; ++t) { const bf16x8 bfr = tr8(VV + (32 * s) * RS + (cb + 16 * t) * 2 + tro16, 4 * RS); o[t] = MFMA16(af, bfr, o[t]); } }
#pragma unroll
                for (int s = 0; s < 4; ++s) { const bf16x8 af = ld8(QE + (16 * rt + cc) * RS + (32 * s + 8 * rg) * 2);
#pragma unroll
                    for (int t = 0; t < 4; ++t) { const bf16x8 bfr = tr8(SP + (32 * s) * RS + (cb + 16 * t) * 2 + tro16, 4 * RS); o[t] = MFMA16(af, bfr, o[t]); } }
            }
            __syncthreads();
        }
        const int rt = w & 3, chh = w >> 2, cb = 64 * chh;
        bf16 hgv[4][4]; float onv[4];
#pragma unroll
        for (int t = 0; t < 4; ++t) { const int dv = cb + 16 * t + cc; onv[t] = F.onorm[h * 128 + dv];
#pragma unroll
            for (int i = 0; i < 4; ++i) hgv[i][t] = PROJ[(rb + 16 * rt + 4 * rg + i) * INW + C_HG + h * 128 + dv]; }
        float ssv[4];
#pragma unroll
        for (int i = 0; i < 4; ++i) { float sq = 0.f;
#pragma unroll
            for (int t = 0; t < 4; ++t) sq += o[t][i] * o[t][i];
            sq += __shfl_xor(sq, 1); sq += __shfl_xor(sq, 2); sq += __shfl_xor(sq, 4); sq += __shfl_xor(sq, 8); ssv[i] = sq; }
        if (cc == 0) {
#pragma unroll
            for (int i = 0; i < 4; ++i) SSQ[chh * 64 + 16 * rt + 4 * rg + i] = ssv[i]; }
        __syncthreads();
        float rr[4];
#pragma unroll
        for (int i = 0; i < 4; ++i) { const int l = 16 * rt + 4 * rg + i; rr[i] = rsqrtf((SSQ[l] + SSQ[64 + l]) * (1.f / 128.f) + EPS); }
#pragma unroll
        for (int i = 0; i < 4; ++i) { const int l = 16 * rt + 4 * rg + i;
#pragma unroll
            for (int t = 0; t < 4; ++t) { const int dv = cb + 16 * t + cc;
                YAIN[(rb + l) * 1024 + h * 128 + dv] = f2bf(o[t][i] * rr[i] * onv[t] * siluf_(bf2f(hgv[i][t]))); } }
        __syncthreads();
    }
#undef HC_LOAD
}
__device__ __forceinline__ void rope8(v4u& a, v4u& bq, const f32x4 (&cs)[4]) {
    const unsigned aw[4] = {a.x, a.y, a.z, a.w}, bw[4] = {bq.x, bq.y, bq.z, bq.w}; unsigned o1[4], o2[4];
#pragma unroll
    for (int k = 0; k < 4; ++k) { const f32x4 c4 = cs[k];
        const float x1a = __uint_as_float(aw[k] << 16), x1b = __uint_as_float(aw[k] & 0xffff0000u), x2a = __uint_as_float(bw[k] << 16), x2b = __uint_as_float(bw[k] & 0xffff0000u);
        o1[k] = pk2(x1a * c4.x - x2a * c4.y, x1b * c4.z - x2b * c4.w); o2[k] = pk2(x1a * c4.y + x2a * c4.x, x1b * c4.w + x2b * c4.z); }
    a = (v4u){o1[0], o1[1], o1[2], o1[3]}; bq = (v4u){o2[0], o2[1], o2[2], o2[3]};
}
__device__ __forceinline__ void attn_phase(Ctx& F, LAS unsigned char* L) {
    const bf16* PROJ = (const bf16*)(F.ws + WS_PROJ); const float* ROPE = (const float*)(F.ws + WS_ROPE); bf16* ATT = (bf16*)(F.ws + WS_ATT);
    LAS unsigned char* KT = L; LAS unsigned char* VT = L + 17408; LAS float* AL = (LAS float*)(L + 34816) + F.wave * 32;
    const int tid = F.tid, lane = F.lane, w = F.wave, q32 = lane & 31, hh = lane >> 5;
    const int tro32 = (4 * hh + ((lane & 15) >> 2)) * RS + (16 * ((lane >> 4) & 1) + 4 * (lane & 3)) * 2;
    const int krow = tid >> 3, kc8 = tid & 7;
    constexpr float C2 = 0.08838834764831845f * LOG2E;
    for (int unit = blockIdx.x; unit < 256; unit += F.G) {
        const int qb = unit & 63, kvh = (unit >> 6) & 1, b = unit >> 7, q0 = qb * 64, h = kvh * 4 + (w >> 1);
        const int qp = q0 + 32 * (w & 1) + q32;
        bf16x8 qf[8];
        {
            const bf16* qptr = PROJ + ((size_t)b * SEQ + qp) * INW + C_AQ + h * 128 + 8 * hh;
            const f32x4* rp = (const f32x4*)(ROPE + (((size_t)b * SEQ + qp) * 64 + 8 * hh) * 2);
#pragma unroll
            for (int s = 0; s < 4; ++s) { v4u x1 = *(const v4u*)(qptr + 16 * s), x2 = *(const v4u*)(qptr + 16 * s + 64);
                f32x4 cs[4];
#pragma unroll
                for (int k = 0; k < 4; ++k) cs[k] = rp[8 * s + k];
                rope8(x1, x2, cs); qf[s] = __builtin_bit_cast(bf16x8, x1); qf[s + 4] = __builtin_bit_cast(bf16x8, x2); }
        }
        float m = F.sink[h] * LOG2E, l = 1.f;
        f32x16 o[4];
#pragma unroll
        for (int d = 0; d < 4; ++d)
#pragma unroll
            for (int r = 0; r < 16; ++r) o[d][r] = 0.f;
        int j = 0; while (j < 5 && (q0 - 128 + 64 * j < 0 || q0 - 128 + 64 * j >= SEQ)) ++j;
        v4u kr[2], vr[2]; f32x4 kcs[4];
#define ATT_LOAD(jj) do { const int kb_ = q0 - 128 + 64 * (jj); \
            { const size_t t_ = (size_t)b * SEQ + kb_ + krow; const bf16* kp_ = PROJ + t_ * INW + C_AK + kvh * 128 + kc8 * 8; kr[0] = *(const v4u*)kp_; kr[1] = *(const v4u*)(kp_ + 64); \
              const f32x4* rp_ = (const f32x4*)(ROPE + (t_ * 64 + kc8 * 8) * 2); _Pragma("unroll") for (int k = 0; k < 4; ++k) kcs[k] = rp_[k]; } \
            _Pragma("unroll") for (int i = 0; i < 2; ++i) { const int idx = tid + 512 * i, row = idx >> 4, ch = idx & 15; \
                vr[i] = *(const v4u*)(PROJ + ((size_t)b * SEQ + kb_ + row) * INW + C_AV + kvh * 128 + ch * 8); } } while (0)
        if (j < 5) ATT_LOAD(j);
        while (j < 5) {
            const int kb = q0 - 128 + 64 * j;
            __syncthreads();
            rope8(kr[0], kr[1], kcs);
            *(LAS v4u*)(KT + krow * RS + kc8 * 16) = kr[0]; *(LAS v4u*)(KT + krow * RS + (kc8 + 8) * 16) = kr[1];
#pragma unroll
            for (int i = 0; i < 2; ++i) { const int idx = tid + 512 * i, row = idx >> 4, ch = idx & 15; *(LAS v4u*)(VT + row * RS + ch * 16) = vr[i]; }
            __syncthreads();
            int jn = j + 1; while (jn < 5 && (q0 - 128 + 64 * jn < 0 || q0 - 128 + 64 * jn >= SEQ)) ++jn;
            if (jn < 5) ATT_LOAD(jn);
            f32x16 p0, p1;
#pragma unroll
            for (int r = 0; r < 16; ++r) { p0[r] = 0.f; p1[r] = 0.f; }
#pragma unroll
            for (int s = 0; s < 8; ++s) { const bf16x8 k0 = ld8(KT + q32 * RS + (16 * s + 8 * hh) * 2), k1 = ld8(KT + (32 + q32) * RS + (16 * s + 8 * hh) * 2);
                p0 = MFMA32(k0, qf[s], p0); p1 = MFMA32(k1, qf[s], p1); }
            float tmax = -INFINITY;
#pragma unroll
            for (int r = 0; r < 16; ++r) { const int d0 = kb + crow(r, hh) - qp;
                p0[r] = ((unsigned)(d0 + 128) <= 256u) ? p0[r] * C2 : -INFINITY; p1[r] = ((unsigned)(d0 + 32 + 128) <= 256u) ? p1[r] * C2 : -INFINITY;
                tmax = fmaxf(tmax, fmaxf(p0[r], p1[r])); }
            tmax = fmaxf(tmax, __shfl_xor(tmax, 32));
            const float mn = fmaxf(m, tmax), alpha = __builtin_amdgcn_exp2f(m - mn); m = mn;
            float rs = 0.f;
#pragma unroll
            for (int r = 0; r < 16; ++r) { p0[r] = __builtin_amdgcn_exp2f(p0[r] - mn); p1[r] = __builtin_amdgcn_exp2f(p1[r] - mn); rs += p0[r] + p1[r]; }
            rs += __shfl_xor(rs, 32);
            l = l * alpha + rs;
            if (hh == 0) AL[q32] = alpha;
            LDS_WAIT();
#pragma unroll
            for (int g4 = 0; g4 < 4; ++g4) { const f32x4 a4 = *(const LAS f32x4*)(AL + 8 * g4 + 4 * hh);
#pragma unroll
                for (int d = 0; d < 4; ++d) { o[d][4 * g4 + 0] *= a4.x; o[d][4 * g4 + 1] *= a4.y; o[d][4 * g4 + 2] *= a4.z; o[d][4 * g4 + 3] *= a4.w; } }
#pragma unroll
            for (int kb2 = 0; kb2 < 2; ++kb2)
#pragma unroll
                for (int s = 0; s < 2; ++s) {
                    unsigned pw[4];
#pragma unroll
                    for (int k = 0; k < 4; ++k) pw[k] = kb2 ? cvtpk(p1[8 * s + 2 * k], p1[8 * s + 2 * k + 1]) : cvtpk(p0[8 * s + 2 * k], p0[8 * s + 2 * k + 1]);
                    const bf16x8 pa = __builtin_bit_cast(bf16x8, (v4u){pw[0], pw[1], pw[2], pw[3]});
#pragma unroll
                    for (int d = 0; d < 4; ++d) { const bf16x8 vf = tr8(VT + (32 * kb2 + 16 * s) * RS + 64 * d + tro32, 8 * RS); o[d] = MFMA32(pa, vf, o[d]); }
                }
            j = jn;
        }
#undef ATT_LOAD
        if (hh == 0) AL[q32] = 1.f / l;
        LDS_WAIT();
#pragma unroll
        for (int g4 = 0; g4 < 4; ++g4) { const f32x4 a4 = *(const LAS f32x4*)(AL + 8 * g4 + 4 * hh); const float av[4] = {a4.x, a4.y, a4.z, a4.w};
#pragma unroll
            for (int i = 0; i < 4; ++i) { const int r = 4 * g4 + i; const int qrow = q0 + 32 * (w & 1) + crow(r, hh);
                bf16* op = ATT + ((size_t)b * SEQ + qrow) * 1024 + h * 128 + q32;
#pragma unroll
                for (int d = 0; d < 4; ++d) op[32 * d] = f2bf(o[d][r] * av[i]); } }
        __syncthreads();
    }
}

#ifdef TESTMODE
__global__ void __launch_bounds__(256) k_rope(const bf16* __restrict__ PROJ, const float* __restrict__ rope, bf16* __restrict__ QR, bf16* __restrict__ KR) {
    const int gid = blockIdx.x * 256 + threadIdx.x;
    const int i = gid & 63, hh = (gid >> 6) % 10, t = gid / 640;
    const float cs = rope[((size_t)t * 64 + i) * 2], sn = rope[((size_t)t * 64 + i) * 2 + 1];
    const bf16* src = PROJ + (size_t)t * INW + (hh < 8 ? C_AQ + hh * 128 : C_AK + (hh - 8) * 128);
    const float x1 = bf2f(src[i]), x2 = bf2f(src[i + 64]);
    bf16* dst = hh < 8 ? QR + (size_t)t * 1024 + hh * 128 : KR + (size_t)t * 256 + (hh - 8) * 128;
    dst[i] = f2bf(x1 * cs - x2 * sn); dst[i + 64] = f2bf(x1 * sn + x2 * cs);
}
__global__ void __launch_bounds__(256) k_hgrn_naive(const bf16* __restrict__ PROJ, const float* __restrict__ lb, float* __restrict__ OF, float* __restrict__ OB) {
    __shared__ float qs[128], fs[128], ks[128], part[128];
    const int dir = blockIdx.x & 1, h = (blockIdx.x >> 1) & 7, b = blockIdx.x >> 4, tid = threadIdx.x, dv = tid & 127, half = tid >> 7;
    float S[64];
#pragma unroll
    for (int i = 0; i < 64; ++i) S[i] = 0.f;
    float* O = dir ? OB : OF;
    const float lbv = tid < 128 ? lb[dir * 1024 + h * 128 + tid] : 0.f;
    bf16 nzq = 0, nzf = 0, nv = 0;
    { const int t = dir ? SEQ - 1 : 0; const bf16* pr = PROJ + ((size_t)b * SEQ + t) * INW;
      if (tid < 128) { nzq = pr[C_HQ + h * 128 + tid]; nzf = pr[(dir ? C_FB : C_FF) + h * 128 + tid]; } nv = pr[C_HI + h * 128 + dv]; }
    for (int tp = 0; tp < SEQ; ++tp) {
        const int t = dir ? SEQ - 1 - tp : tp; const size_t row = (size_t)b * SEQ + t;
        const bf16 czq = nzq, czf = nzf, cv = nv;
        if (tp + 1 < SEQ) { const int t2 = dir ? SEQ - 2 - tp : tp + 1; const bf16* pr = PROJ + ((size_t)b * SEQ + t2) * INW;
            if (tid < 128) { nzq = pr[C_HQ + h * 128 + tid]; nzf = pr[(dir ? C_FB : C_FF) + h * 128 + tid]; } nv = pr[C_HI + h * 128 + dv]; }
        if (tid < 128) { const float zq = bf2f(czq), zf = bf2f(czf);
            const float f = lbv + (1.f - lbv) * sigmoidf_(zf); qs[tid] = siluf_(zq); fs[tid] = f; ks[tid] = 1.f - f; }
        const float v = bf2f(cv);
        __syncthreads();
        float acc = 0.f;
#pragma unroll
        for (int i = 0; i < 64; ++i) { const int dk = half * 64 + i; S[i] = fs[dk] * S[i] + ks[dk] * v; acc += S[i] * qs[dk]; }
        if (half == 1) part[dv] = acc;
        __syncthreads();
        if (half == 0) O[row * 1024 + h * 128 + dv] = acc + part[dv];
    }
}
__global__ void __launch_bounds__(256) k_hgrn_post(const float* __restrict__ OF, const float* __restrict__ OB, const bf16* __restrict__ PROJ, const float* __restrict__ onorm, bf16* __restrict__ YAIN) {
    const int w = blockIdx.x * 4 + (threadIdx.x >> 6), lane = threadIdx.x & 63, row = w >> 3, h = w & 7;
    const size_t o = (size_t)row * 1024 + h * 128;
    const float a0 = OF[o + lane] + OB[o + lane], a1 = OF[o + 64 + lane] + OB[o + 64 + lane];
    float ss = a0 * a0 + a1 * a1;
    for (int s = 32; s > 0; s >>= 1) ss += __shfl_xor(ss, s);
    const float r = rsqrtf(ss * (1.f / 128.f) + EPS);
    const bf16* pg = PROJ + (size_t)row * INW + C_HG + h * 128;
    YAIN[o + lane] = f2bf(a0 * r * onorm[h * 128 + lane] * siluf_(bf2f(pg[lane])));
    YAIN[o + 64 + lane] = f2bf(a1 * r * onorm[h * 128 + 64 + lane] * siluf_(bf2f(pg[64 + lane])));
}
__global__ void __launch_bounds__(256) k_attn_naive(const bf16* __restrict__ QR, const bf16* __restrict__ KR, const bf16* __restrict__ PROJ, const float* __restrict__ sink, bf16* __restrict__ ATT) {
    __shared__ float sl[4][264];
    const int wv = threadIdx.x >> 6, lane = threadIdx.x & 63;
    const int w = blockIdx.x * 4 + wv;
    const int i = w & 4095, h = (w >> 12) & 7, b = w >> 15, kvh = h >> 2;
    const size_t qrow = (size_t)b * SEQ + i;
    const float q0 = bf2f(QR[qrow * 1024 + h * 128 + 2 * lane]), q1 = bf2f(QR[qrow * 1024 + h * 128 + 2 * lane + 1]);
    const int jlo = i - 128 < 0 ? 0 : i - 128, jhi = i + 128 > SEQ - 1 ? SEQ - 1 : i + 128;
    const float sk = sink[h];
    float m = sk;
    for (int j = jlo; j <= jhi; ++j) {
        const bf16* kr = KR + ((size_t)b * SEQ + j) * 256 + kvh * 128;
        float p = q0 * bf2f(kr[2 * lane]) + q1 * bf2f(kr[2 * lane + 1]);
        for (int s = 32; s > 0; s >>= 1) p += __shfl_xor(p, s);
        p *= 0.08838834764831845f;
        if (lane == 0) sl[wv][j - jlo] = p;
        m = fmaxf(m, p);
    }
    __syncthreads();
    float den = expf(sk - m), o0 = 0.f, o1 = 0.f;
    for (int j = jlo; j <= jhi; ++j) {
        const float p = expf(sl[wv][j - jlo] - m); den += p;
        const bf16* vr = PROJ + ((size_t)b * SEQ + j) * INW + C_AV + kvh * 128;
        o0 += p * bf2f(vr[2 * lane]); o1 += p * bf2f(vr[2 * lane + 1]);
    }
    ATT[qrow * 1024 + h * 128 + 2 * lane] = f2bf(o0 / den); ATT[qrow * 1024 + h * 128 + 2 * lane + 1] = f2bf(o1 / den);
}
#endif
__global__ void __launch_bounds__(NWAVES * 64, 2) mega(Args args) {
    extern __shared__ __attribute__((aligned(16))) unsigned char lds[];
    Ctx F;
    F.lds = lds; F.tid = threadIdx.x; F.lane = F.tid & 63; F.wave = __builtin_amdgcn_readfirstlane(F.tid >> 6); F.G = gridDim.x;
    F.gw = blockIdx.x * NWAVES + F.wave; F.NGW = F.G * NWAVES;
    F.x = (const float*)args.in[0]; F.c = (const float*)args.in[1]; F.pos = (const int*)args.in[2]; F.w_ada = (const float*)args.in[3]; F.b_ada = (const float*)args.in[4];
    F.g_pre_mix = (const float*)args.in[5]; F.g_post_mix = (const float*)args.in[6]; F.g_pre_ffn = (const float*)args.in[7]; F.g_post_ffn = (const float*)args.in[8];
    F.w_in = (const float*)args.in[9]; F.lbl = (const float*)args.in[10]; F.onorm = (const float*)args.in[11]; F.sink = (const float*)args.in[12];
    F.w_a = (const float*)args.in[13]; F.w_b = (const float*)args.in[14]; F.w_o = (const float*)args.in[15]; F.w_router = (const float*)args.in[16];
    F.w_eg = (const float*)args.in[17]; F.w_eu = (const float*)args.in[18]; F.w_ed = (const float*)args.in[19];
    F.out = args.out; F.ws = args.ws;
    LAS unsigned char* ldsl = (LAS unsigned char*)lds;
    for (int u = F.tid; u < (LDS_BYTES - LDSCTL_OFF) / 4; u += NWAVES * 64) ((LAS unsigned*)(ldsl + LDSCTL_OFF))[u] = 0u;
    __syncthreads();
    volatile LAS unsigned* MISC = (volatile LAS unsigned*)(ldsl + MISC_OFF);
    XcdBarrier bar = xcd_barrier_post((unsigned*)(args.ws + WS_CTL) + CW_BAR + args.li * XCD_BAR_WORDS, MISC + 8);
    const int lo = args.ph_lo, hi = args.ph_hi;
#ifdef PROBE_REP
#define REP(k) ((((PROBE_REP) >> (k)) & 1) ? 2 : 1)
#else
#define REP(k) 1
#endif
#define IN(k) (lo <= (k) && (k) < hi)
#define SEAM(k) do { if (IN(k) && IN((k) + 1)) xcd_barrier(bar); } while (0)
    unsigned char* ws = args.ws;
    bf16* H = (bf16*)(ws + WS_H); bf16* PROJ = (bf16*)(ws + WS_PROJ); bf16* WIN = (bf16*)(ws + WS_WIN); bf16* WA = (bf16*)(ws + WS_WA); bf16* WB = (bf16*)(ws + WS_WB); bf16* WO = (bf16*)(ws + WS_WO);
    bf16* WGU = (bf16*)(ws + WS_WGU); bf16* WD = (bf16*)(ws + WS_WD); bf16* YAIN = (bf16*)(ws + WS_YAIN); bf16* ATT = (bf16*)(ws + WS_ATT); bf16* MERGED = (bf16*)(ws + WS_MERGED);
    float* Y = (float*)(ws + WS_Y); bf16* XE = (bf16*)(ws + WS_XE); bf16* ACT = (bf16*)(ws + WS_ACT); bf16* SLAB = (bf16*)(ws + WS_SLAB); const float* SELAFF = (const float*)(ws + WS_SELAFF);
    const int vcu = (F.G % 8 == 0) ? ((int)blockIdx.x % 8) * (F.G / 8) + (int)blockIdx.x / 8 : (int)blockIdx.x;

    {
    if (IN(0)) { p0_prep(F); __syncthreads(); } SEAM(0);
#if defined(PROBE_DUP) && PROBE_DUP == 0
    if (IN(0)) { p0_prep(F); __syncthreads(); } SEAM(0);
#endif
    }
    {
    if (IN(2)) {
        if (F.G == 256 && blockIdx.x >= 256 - CONV_BLOCKS) { float* scr = (float*)(F.lds + F.wave * 16384); TailSeq seq{I_MIX + P0_EXPERT_ITEMS + ((int)blockIdx.x - (256 - CONV_BLOCKS)) * NWAVES + F.wave, CONV_BLOCKS * NWAVES}; transpose_stream(F, seq, scr); }
        else {
            const int gg = F.G == 256 ? 256 - CONV_BLOCKS : F.G;
            pg8::Gemm g{H, WIN, T, INW, D}; pg8::StaticOrder S; S.init(T, INW, gg, (int)blockIdx.x);
            pg8::EpiStore E{PROJ, INW, 0xffff, nullptr};
            pg8::gemm_phase<pg8::EpiStore, pg8::StaticOrder, PG8_ALIGN, PG8_SP2>(ldsl + RING_OFF, g, S, E);
            if (F.G != 256 && blockIdx.x == 0) { float* scr = (float*)(F.lds + F.wave * 16384); TailSeq seq{I_MIX + P0_EXPERT_ITEMS + F.wave, NWAVES}; transpose_stream(F, seq, scr); }
        }
    } SEAM(2);
    }
    {
    if (IN(3)) { if (args.mask & 2) hgrn_a_phase(F, ldsl); } SEAM(3);
#if defined(PROBE_DUP) && PROBE_DUP == 3
    if (IN(3)) { if (args.mask & 2) hgrn_a_phase(F, ldsl); } SEAM(3);
#endif
    }
    {
    if (IN(4)) { if (args.mask & 2) hgrn_scan_phase(F); if (args.mask & 1) attn_phase(F, ldsl); } SEAM(4);
#if defined(PROBE_DUP) && PROBE_DUP == 4
    if (IN(4)) { if (args.mask & 2) hgrn_scan_phase(F); if (args.mask & 1) attn_phase(F, ldsl); } SEAM(4);
#endif
    }
    {
    if (IN(5)) { if (args.mask & 2) hgrn_c_phase(F, ldsl); } SEAM(5);
#if defined(PROBE_DUP) && PROBE_DUP == 5
    if (IN(5)) { if (args.mask & 2) hgrn_c_phase(F, ldsl); } SEAM(5);
#endif
    }
    {
    if (IN(6)) {
        static_assert(WS_ATT == WS_YAIN + 16 * MiB && WS_WB == WS_WA + 4 * MiB, "branch operands must be contiguous");
        pg8::Gemm g{YAIN, WA, 2 * T, 2 * D, 1024}; pg8::BranchOrder S; S.S.init(T, D, F.G, (int)blockIdx.x);
        pg8::EpiGate2 E{MERGED, D, PROJ + C_GA, PROJ + C_GB, INW};
        pg8::gemm_phase<pg8::EpiGate2, pg8::BranchOrder, PG8_ALIGN, PG8_SP2>(ldsl + RING_OFF, g, S, E);
    } SEAM(6);
    }
    {
    if (IN(7)) {
        pg8::Gemm g{MERGED, WO, T, D, D}; pg8::StaticOrder S; S.init(T, D, F.G, (int)blockIdx.x);
        pg8::EpiStore E{(bf16*)Y, D, 0xffff, nullptr};
        pg8::gemm_phase<pg8::EpiStore, pg8::StaticOrder, PG8_ALIGN, PG8_SP2>(ldsl + RING_OFF, g, S, E);
    } SEAM(7);
#if defined(PROBE_DUP) && PROBE_DUP == 7
    if (IN(7)) {
        pg8::Gemm g{MERGED, WO, T, D, D}; pg8::StaticOrder S; S.init(T, D, F.G, (int)blockIdx.x);
        pg8::EpiStore E{(bf16*)Y, D, 0xffff, nullptr};
        pg8::gemm_phase<pg8::EpiStore, pg8::StaticOrder, PG8_ALIGN, PG8_SP2>(ldsl + RING_OFF, g, S, E);
    } SEAM(7);
#endif
    }
    {
    if (IN(8)) { p6_post1(F); } SEAM(8);
#if defined(PROBE_DUP) && PROBE_DUP == 8
    if (IN(8)) { p6_post1(F); } SEAM(8);
#endif
    }
    {
    if (IN(9)) { p7_topk_gather(F); } SEAM(9);
#if defined(PROBE_DUP) && PROBE_DUP == 9
    if (IN(9)) { p7_topk_gather(F); } SEAM(9);
#endif
    }
    {
    if (IN(10)) {
        pg8::Gemm g{(const bf16*)(ws + WS_H2), WGU, 16 * 1024, 16 * 2048, D / 2, (const int*)(ws + WS_GIDX)}; pg8::GroupedOrder S{F.G, vcu};
        pg8::EpiSwiglu8 E{(unsigned char*)ACT, 1.f / W8S_GU};
        pg8::gemm_phase<pg8::EpiSwiglu8, pg8::GroupedOrder, PG8_ALIGN, PG8_SP2, true, true>(ldsl + RING_OFF, g, S, E);
    } SEAM(10);
    }
    {
    if (IN(11)) {
        pg8::Gemm g{ACT, WD, 16 * 1024, 16 * 2048, 1024 / 2}; pg8::GroupedOrder S{F.G, vcu};
        pg8::EpiStore E{SLAB, D, 7, SELAFF, 1.f / W8S_D};
        pg8::gemm_phase<pg8::EpiStore, pg8::GroupedOrder, PG8_ALIGN, PG8_SP2, false, true>(ldsl + RING_OFF, g, S, E);
    } SEAM(11);
    }
    {
    if (IN(12)) { p10_final(F); }
    }
#undef IN
#undef SEAM
}

extern "C" void kernel_launch(void* const* d_in, const int* in_sizes, int n_in, void* d_out, int out_size, void* d_ws, size_t ws_size, hipStream_t stream) {
    static int grid = 0;
    if (grid == 0) {
        if (n_in != 20 || ws_size < WS_END) { fprintf(stderr, "kernel_launch: unexpected n_in %d or ws_size %zu\n", n_in, ws_size); grid = -1; return; }
        int dev = 0, cus = 0;
        if (hipGetDevice(&dev) != hipSuccess || hipDeviceGetAttribute(&cus, hipDeviceAttributeMultiprocessorCount, dev) != hipSuccess) { grid = -1; return; }
        if (hipFuncSetAttribute((const void*)mega, hipFuncAttributeMaxDynamicSharedMemorySize, LDS_BYTES) != hipSuccess) { fprintf(stderr, "kernel_launch: hipFuncSetAttribute failed\n"); grid = -1; return; }
        grid = cus;
    }
    if (grid < 0) return;
    char* ws = (char*)d_ws;
    (void)hipMemsetAsync(ws + WS_CTL, 0, CTL_ZERO_BYTES, stream);
    Args a{};
    for (int i = 0; i < 20; ++i) a.in[i] = d_in[i];
    a.out = (float*)d_out; a.ws = (unsigned char*)d_ws;
#ifndef TESTMODE
    a.ph_lo = 0; a.ph_hi = 13; a.li = 0; a.mask = 3;
#ifdef PROBE_REPEAT
    a.rep = PROBE_REPEAT;
#else
    a.rep = -1;
#endif
    hipLaunchKernelGGL(mega, dim3(grid), dim3(NWAVES * 64), LDS_BYTES, stream, a);
#ifdef PROBE_LO
    a.ph_lo = PROBE_LO; a.ph_hi = PROBE_HI; a.li = 1; a.mask = PROBE_MASK;
    hipLaunchKernelGGL(mega, dim3(grid), dim3(NWAVES * 64), LDS_BYTES, stream, a);
#endif
#else
    const float* LB = (const float*)(ws + WS_LB); const float* ROPE = (const float*)(ws + WS_ROPE);
    bf16* PROJ = (bf16*)(ws + WS_PROJ); bf16* QR = (bf16*)(ws + WS_QR); bf16* KR = (bf16*)(ws + WS_KR); bf16* YAIN = (bf16*)(ws + WS_YAIN); bf16* ATT = (bf16*)(ws + WS_ATT);
    float* OF = (float*)(ws + WS_CS); float* OB = (float*)(ws + WS_CS + 32 * MiB);
    a.ph_lo = 0; a.ph_hi = 3; a.li = 0; a.mask = 3;
    hipLaunchKernelGGL(mega, dim3(grid), dim3(NWAVES * 64), LDS_BYTES, stream, a);
#if TESTMODE == 1
    k_hgrn_naive<<<32, 256, 0, stream>>>(PROJ, LB, OF, OB);
    k_hgrn_post<<<T * 8 / 4, 256, 0, stream>>>(OF, OB, PROJ, (const float*)d_in[11], YAIN);
    a.ph_lo = 3; a.ph_hi = 6; a.li = 1; a.mask = 1;
    hipLaunchKernelGGL(mega, dim3(grid), dim3(NWAVES * 64), LDS_BYTES, stream, a);
#else
    k_rope<<<T * 640 / 256, 256, 0, stream>>>(PROJ, ROPE, QR, KR);
    k_attn_naive<<<BATCH * 8 * SEQ / 4, 256, 0, stream>>>(QR, KR, PROJ, (const float*)d_in[12], ATT);
    a.ph_lo = 3; a.ph_hi = 6; a.li = 1; a.mask = 2;
    hipLaunchKernelGGL(mega, dim3(grid), dim3(NWAVES * 64), LDS_BYTES, stream, a);
#endif
    a.ph_lo = 6; a.ph_hi = 13; a.li = 2; a.mask = 3;
    hipLaunchKernelGGL(mega, dim3(grid), dim3(NWAVES * 64), LDS_BYTES, stream, a);
#endif
}
```

```cpp
#include <hip/hip_runtime.h>
#include <cstdint>
#include <cstdio>

constexpr int D = 2048, BATCH = 2, SEQ = 4096, T = BATCH * SEQ;
constexpr int INW = 10752;
constexpr int C_HQ = 0, C_FF = 1024, C_FB = 2048, C_HI = 3072, C_HG = 4096, C_AQ = 5120, C_AK = 6144, C_AV = 6400, C_GA = 6656, C_GB = 8704;
constexpr int NE = 16, EFF = 1024, CAP = 512;
constexpr float EPS = 1e-6f;

typedef unsigned short bf16;
__device__ __forceinline__ float bf2f(bf16 v) { return __uint_as_float(((unsigned)v) << 16); }
typedef float f32x2h_t __attribute__((ext_vector_type(2))); typedef __bf16 bf16x2h_t __attribute__((ext_vector_type(2)));
__device__ __forceinline__ unsigned cvtpk2(float lo, float hi) { const f32x2h_t v = {lo, hi}; const bf16x2h_t b = __builtin_convertvector(v, bf16x2h_t); return __builtin_bit_cast(unsigned, b); }
__device__ __forceinline__ bf16 f2bf(float f) { return (bf16)(cvtpk2(f, 0.f) & 0xffffu); }
__device__ __forceinline__ float sigmoidf_(float x) { return __builtin_amdgcn_rcpf(1.f + __expf(-x)); }
__device__ __forceinline__ float siluf_(float x) { return x * __builtin_amdgcn_rcpf(1.f + __expf(-x)); }

constexpr size_t MiB = 1u << 20;
constexpr size_t WS_CTL = 0, CTL_ZERO_BYTES = 64 * 1024;
constexpr size_t WS_MOD = 1 * MiB;
constexpr size_t WS_LB = WS_MOD + 128 * 1024;
constexpr size_t WS_AFF = 2 * MiB;
constexpr size_t WS_GIDX = 3 * MiB;
constexpr size_t WS_SELAFF = WS_GIDX + 128 * 1024;
constexpr size_t WS_TOKSLOT = 4 * MiB;
constexpr size_t WS_DEC = 5 * MiB;
constexpr size_t WS_ROPE = 8 * MiB;
constexpr size_t WS_WIN = 16 * MiB;
constexpr size_t WS_WA = 60 * MiB, WS_WB = 64 * MiB, WS_WO = 68 * MiB;
constexpr size_t WS_WGU = 76 * MiB;
constexpr size_t WS_WD = 204 * MiB;
constexpr size_t WS_H = 268 * MiB;
constexpr size_t WS_PROJ = 300 * MiB;
constexpr size_t WS_Y = 520 * MiB;
constexpr size_t WS_XE = 300 * MiB;
constexpr size_t WS_ACT = 364 * MiB;
constexpr size_t WS_SLAB = 396 * MiB;
constexpr size_t WS_QR = 468 * MiB, WS_KR = 484 * MiB;
constexpr size_t WS_YAIN = 488 * MiB, WS_ATT = 504 * MiB;
constexpr size_t WS_CS = 520 * MiB;
constexpr size_t WS_STATE = 584 * MiB;
constexpr size_t WS_H2 = 584 * MiB;
constexpr size_t WS_MERGED = 268 * MiB;
constexpr size_t WS_END = 648 * MiB;
constexpr int CW_BAR = 4096;

namespace pg8 {
#define PG8_LAS __attribute__((address_space(3)))
typedef unsigned short bf16_t;
typedef short bf16x8 __attribute__((ext_vector_type(8)));
typedef float f32x4 __attribute__((ext_vector_type(4)));
typedef unsigned u32x4 __attribute__((ext_vector_type(4)));
constexpr int BM = 256, BK = 64, HALF = 128, HTB = HALF * BK * 2  , STAGE_BYTES = 8 * HTB, NXCD = 8, WGM = 8;

__host__ __device__ __forceinline__ int lds_byte(int r, int c) { const int st = (r >> 4) * 2 + (c >> 5), rr = r & 15, cc = c & 31, ob = rr * 64 + cc * 2; return st * 1024 + (ob ^ (((ob >> 9) & 1) << 5)); }
__host__ __device__ __forceinline__ void stage_rc(int b, int& R, int& C) { const int st = b / 1024, sb = b % 1024, swz = sb ^ (((sb >> 9) & 1) << 5); R = (st >> 1) * 16 + swz / 64; C = (st & 1) * 32 + (swz % 64) / 2; }
__host__ __device__ __forceinline__ int perm32(int rho) { const int n = rho >> 4, i = rho & 15; return 8 * (i >> 2) + 4 * n + (i & 3); }

struct Unit { int pm, pn; };
struct Gemm { const bf16_t* A; const bf16_t* Bt; int M, N, K; const int* gidx = nullptr; };

struct StaticOrder {
    int nM, nN, nwg, G, c;
    __host__ __device__ void init(int M, int N, int G_, int c_) { nM = M / BM; nN = N / BM; nwg = nM * nN; G = G_; c = c_; }
    __host__ __device__ bool next(int i, Unit& u) const {
        const long L = (long)i * G + c; if (L >= nwg) return false;
        int wgid = (int)L; { const int q = nwg / NXCD, r = nwg % NXCD, xcd = wgid % NXCD, off = wgid / NXCD; wgid = (xcd < r ? xcd * (q + 1) : r * (q + 1) + (xcd - r) * q) + off; }
        const int nig = WGM * nN, gid = wgid / nig, fm = gid * WGM, gsz = (nM - fm) < WGM ? (nM - fm) : WGM;
        u.pm = fm + ((wgid % nig) % gsz); u.pn = (wgid % nig) / gsz; return true;
    }
    __device__ __forceinline__ void a_ready(const Unit&) const {}
    __device__ __forceinline__ void done(const Unit&) const {}
};

typedef float f32x2c_t __attribute__((ext_vector_type(2))); typedef __bf16 bf16x2c_t __attribute__((ext_vector_type(2)));
__device__ __forceinline__ unsigned cvt_pk_bf16(float lo, float hi) { const f32x2c_t v = {lo, hi}; const bf16x2c_t b = __builtin_convertvector(v, bf16x2c_t); return __builtin_bit_cast(unsigned, b); }
typedef float f32x2 __attribute__((ext_vector_type(2)));

typedef unsigned u32x2 __attribute__((ext_vector_type(2)));
struct EpiStore {
    static constexpr bool PERM = true, AFTER_DRAIN = false;
    bf16_t* O; int ldc; int cmask; const float* rowscale; float osc = 1.f;
    __device__ __forceinline__ void operator()(const f32x4 (&acc)[2][2][4][2], const Unit& u, int wr, int wc, int fr, int fq) const {
        const int row0 = u.pm * BM + wr * 64 + fr, col0 = (u.pn & cmask) * BM + wc * 32 + 8 * fq;
        float scv[8];
#pragma unroll
        for (int q = 0; q < 8; ++q) scv[q] = (rowscale ? rowscale[row0 + (q >> 2) * HALF + (q & 3) * 16] : 1.f) * osc;
#pragma unroll
        for (int ai = 0; ai < 2; ++ai)
#pragma unroll
            for (int m = 0; m < 4; ++m) { const int row = row0 + ai * HALF + m * 16; const float sc = scv[ai * 4 + m]; bf16_t* rowp = O + (size_t)row * ldc + col0;
#pragma unroll
                for (int bj = 0; bj < 2; ++bj) { const f32x4 v0 = acc[ai][bj][m][0] * sc, v1 = acc[ai][bj][m][1] * sc;
                    u32x4 w; w.x = cvt_pk_bf16(v0[0], v0[1]); w.y = cvt_pk_bf16(v0[2], v0[3]); w.z = cvt_pk_bf16(v1[0], v1[1]); w.w = cvt_pk_bf16(v1[2], v1[3]);
                    *(u32x4*)(rowp + bj * HALF) = w; } }
    }
};
__device__ __forceinline__ float sigm(float x) { return __builtin_amdgcn_rcpf(1.f + __expf(-x)); }
struct EpiGate2 {
    static constexpr bool PERM = true, AFTER_DRAIN = false;
    bf16_t* O; int ldc; const bf16_t* Ga; const bf16_t* Gb; int ldg;
    __device__ __forceinline__ void operator()(const f32x4 (&acc)[2][2][4][2], const Unit& u, int wr, int wc, int fr, int fq) const {
        const bool second = u.pm >= 32; const bf16_t* G = second ? Gb : Ga;
        const int row0 = (u.pm & 31) * BM + wr * 64 + fr, col0 = (u.pn & 7) * BM + wc * 32 + 8 * fq;
        u32x4 gcur[2], tcur[2], gnxt[2], tnxt[2];
#define EG2_LOAD(gd, td, q) do { const int row_ = row0 + ((q) >> 2) * HALF + ((q) & 3) * 16; _Pragma("unroll") for (int bj = 0; bj < 2; ++bj) { \
            gd[bj] = *(const u32x4*)(G + (size_t)row_ * ldg + col0 + bj * HALF); td[bj] = second ? *(const u32x4*)(O + (size_t)row_ * ldc + col0 + bj * HALF) : (u32x4){0u, 0u, 0u, 0u}; } } while (0)
        EG2_LOAD(gcur, tcur, 0);
#pragma unroll
        for (int q = 0; q < 8; ++q) { const int ai = q >> 2, m = q & 3, row = row0 + ai * HALF + m * 16;
            if (q < 7) EG2_LOAD(gnxt, tnxt, q + 1);
#pragma unroll
            for (int bj = 0; bj < 2; ++bj) { const int col = col0 + bj * HALF; const u32x4 g = gcur[bj], tq = tcur[bj];
                const float gg[8] = {__uint_as_float(g.x << 16), __uint_as_float(g.x & 0xffff0000u), __uint_as_float(g.y << 16), __uint_as_float(g.y & 0xffff0000u),
                                     __uint_as_float(g.z << 16), __uint_as_float(g.z & 0xffff0000u), __uint_as_float(g.w << 16), __uint_as_float(g.w & 0xffff0000u)};
                const float t[8] = {__uint_as_float(tq.x << 16), __uint_as_float(tq.x & 0xffff0000u), __uint_as_float(tq.y << 16), __uint_as_float(tq.y & 0xffff0000u),
                                    __uint_as_float(tq.z << 16), __uint_as_float(tq.z & 0xffff0000u), __uint_as_float(tq.w << 16), __uint_as_float(tq.w & 0xffff0000u)};
                const f32x4 a0 = acc[ai][bj][m][0], a1 = acc[ai][bj][m][1];
                float o[8];
#pragma unroll
                for (int i = 0; i < 4; ++i) { o[i] = t[i] + sigm(gg[i]) * a0[i]; o[4 + i] = t[4 + i] + sigm(gg[4 + i]) * a1[i]; }
                u32x4 w; w.x = cvt_pk_bf16(o[0], o[1]); w.y = cvt_pk_bf16(o[2], o[3]); w.z = cvt_pk_bf16(o[4], o[5]); w.w = cvt_pk_bf16(o[6], o[7]);
                *(u32x4*)(O + (size_t)row * ldc + col) = w; }
#pragma unroll
            for (int bj = 0; bj < 2; ++bj) { gcur[bj] = gnxt[bj]; tcur[bj] = tnxt[bj]; } }
#undef EG2_LOAD
    }
};
struct BranchOrder {
    StaticOrder S;
    __device__ __forceinline__ bool next(int i, Unit& u) const { Unit t; if (!S.next(i >> 1, t)) return false; u.pm = t.pm + 32 * (i & 1); u.pn = t.pn + 8 * (i & 1); return true; }
    __device__ __forceinline__ void a_ready(const Unit&) const {}
    __device__ __forceinline__ void done(const Unit&) const {}
};
struct EpiF32 {
    static constexpr bool PERM = true, AFTER_DRAIN = false;
    float* O; int ldc;
    __device__ __forceinline__ void operator()(const f32x4 (&acc)[2][2][4][2], const Unit& u, int wr, int wc, int fr, int fq) const {
        const int row0 = u.pm * BM + wr * 64 + fr, col0 = u.pn * BM + wc * 32 + 8 * fq;
#pragma unroll
        for (int ai = 0; ai < 2; ++ai)
#pragma unroll
            for (int m = 0; m < 4; ++m) { float* rowp = O + (size_t)(row0 + ai * HALF + m * 16) * ldc + col0;
#pragma unroll
                for (int bj = 0; bj < 2; ++bj) { *(f32x4*)(rowp + bj * HALF) = acc[ai][bj][m][0]; *(f32x4*)(rowp + bj * HALF + 4) = acc[ai][bj][m][1]; } }
    }
};
__device__ __forceinline__ unsigned pk4_fp8(float a, float b, float c, float d) { int w = __builtin_amdgcn_cvt_pk_fp8_f32(a, b, 0, false); w = __builtin_amdgcn_cvt_pk_fp8_f32(c, d, w, true); return (unsigned)w; }
struct EpiSwiglu8 {
    static constexpr bool PERM = true, AFTER_DRAIN = false;
    unsigned char* O; float isc;
    __device__ __forceinline__ void operator()(const f32x4 (&acc)[2][2][4][2], const Unit& u, int wr, int wc, int fr, int fq) const {
        const int row0 = u.pm * BM + wr * 64 + fr, col0 = (u.pn & 7) * HALF + wc * 32 + 8 * fq;
#pragma unroll
        for (int ai = 0; ai < 2; ++ai)
#pragma unroll
            for (int m = 0; m < 4; ++m) { unsigned char* rowp = O + (size_t)(row0 + ai * HALF + m * 16) * 1024 + col0;
                float o[8];
#pragma unroll
                for (int n = 0; n < 2; ++n)
#pragma unroll
                    for (int i = 0; i < 4; ++i) { const float g = acc[ai][0][m][n][i] * isc, up = acc[ai][1][m][n][i] * isc; o[4 * n + i] = g * sigm(g) * up; }
                u32x2 w; w.x = pk4_fp8(o[0], o[1], o[2], o[3]); w.y = pk4_fp8(o[4], o[5], o[6], o[7]);
                *(u32x2*)rowp = w; }
    }
};
struct EpiSwiglu {
    static constexpr bool PERM = true, AFTER_DRAIN = false;
    bf16_t* O;
    __device__ __forceinline__ void operator()(const f32x4 (&acc)[2][2][4][2], const Unit& u, int wr, int wc, int fr, int fq) const {
        const int row0 = u.pm * BM + wr * 64 + fr, col0 = (u.pn & 7) * HALF + wc * 32 + 8 * fq;
#pragma unroll
        for (int ai = 0; ai < 2; ++ai)
#pragma unroll
            for (int m = 0; m < 4; ++m) { bf16_t* rowp = O + (size_t)(row0 + ai * HALF + m * 16) * 1024 + col0;
                float o[8];
#pragma unroll
                for (int n = 0; n < 2; ++n)
#pragma unroll
                    for (int i = 0; i < 4; ++i) { const float g = acc[ai][0][m][n][i], up = acc[ai][1][m][n][i]; o[4 * n + i] = g * sigm(g) * up; }
                u32x4 w; w.x = cvt_pk_bf16(o[0], o[1]); w.y = cvt_pk_bf16(o[2], o[3]); w.z = cvt_pk_bf16(o[4], o[5]); w.w = cvt_pk_bf16(o[6], o[7]);
                *(u32x4*)rowp = w; }
    }
};
struct GroupedOrder {
    int G, c;
    __device__ __forceinline__ bool next(int i, Unit& u) const { const int L = i * G + c; if (L >= 512) return false; const int e = L >> 5, r = L & 31; u.pm = e * 4 + (r & 3); u.pn = e * 8 + (r >> 2); return true; }
    __device__ __forceinline__ void a_ready(const Unit&) const {}
    __device__ __forceinline__ void done(const Unit&) const {}
};

typedef int v8i32 __attribute__((ext_vector_type(8)));
typedef int v4i32 __attribute__((ext_vector_type(4)));
__device__ __forceinline__ void mfma_f8(f32x4& acc, const v8i32& a, const v8i32& b, int sc) {
    asm volatile("v_mfma_scale_f32_16x16x128_f8f6f4 %0, %1, %2, %0, %3, %3 op_sel_hi:[0,0,0]" : "+v"(acc) : "v"(a), "v"(b), "v"(sc));
}
template <class Epi, class Sched, bool ALIGN_EPI = false, bool SP2 = false, bool GATHER = false, bool FP8 = false>
__device__ __forceinline__ void gemm_phase(PG8_LAS unsigned char* lds, const Gemm g, const Sched& S, const Epi& E) {
    const int tid = threadIdx.x, wid = __builtin_amdgcn_readfirstlane(tid >> 6), lane = tid & 63, wr = wid >> 2, wc = wid & 3, fr = lane & 15, fq = lane >> 4;
    const int K = g.K, nt = K / BK;
    unsigned voffA[2], voffB[2]; int Rr[2], Cc[2];
#pragma unroll
    for (int i = 0; i < 2; ++i) { int R, C; stage_rc(tid * 16 + i * 8192, R, C); const int Rb = Epi::PERM ? ((R & ~31) + perm32(R & 31)) : R; Rr[i] = R; Cc[i] = C;
        voffA[i] = (unsigned)(R * K + C) * 2u; voffB[i] = (unsigned)(Rb * K + C) * 2u; }
    unsigned cv0[2], cv1[2], nv0[2], nv1[2], sv0[2], sv1[2];
#define PG8_GOFF(o0, o1, pm_) do { _Pragma("unroll") for (int _i = 0; _i < 2; ++_i) { \
        o0[_i] = (unsigned)(g.gidx[(pm_) * BM + Rr[_i]] * K + Cc[_i]) * 2u; o1[_i] = (unsigned)(g.gidx[(pm_) * BM + HALF + Rr[_i]] * K + Cc[_i]) * 2u; } } while (0)
    const size_t kstep = (size_t)(BK * 2);
    const size_t hstep = (size_t)HALF * K * 2;
    const size_t tstep = 2 * hstep;
    const unsigned ldsw = (unsigned)wid * 1024u;
    const int aoff = FP8 ? lds_byte(wr * 64 + fr, fq * 16) : lds_byte(wr * 64 + fr, fq * 8), boff = FP8 ? lds_byte(wc * 32 + fr, fq * 16) : lds_byte(wc * 32 + fr, fq * 8);
#define PG8_SA(b, h) (((b) * 2 + (h)) * HTB)
#define PG8_SB(b, h) ((4 + (b) * 2 + (h)) * HTB)
#define PG8_STAGE(bufoff, gbase, voff) do { _Pragma("unroll") for (int _i = 0; _i < 2; ++_i) \
        __builtin_amdgcn_global_load_lds((const unsigned*)((const char*)(gbase) + (voff)[_i]), (PG8_LAS unsigned*)(lds + (bufoff) + ldsw + _i * 8192), 16, 0, 0); } while (0)
#define PG8_LDA(dst, b, h) do { if constexpr (FP8) { _Pragma("unroll") for (int m = 0; m < 4; ++m) { const PG8_LAS unsigned char* p_ = lds + PG8_SA(b, h) + aoff + m * 2048; \
            const v4i32 lo_ = *(const PG8_LAS v4i32*)p_, hi_ = *(const PG8_LAS v4i32*)(p_ + 16); dst##8[m] = __builtin_shufflevector(lo_, hi_, 0, 1, 2, 3, 4, 5, 6, 7); } } \
        else { _Pragma("unroll") for (int m = 0; m < 4; ++m) _Pragma("unroll") for (int k = 0; k < 2; ++k) dst[m][k] = *(const PG8_LAS bf16x8*)(lds + PG8_SA(b, h) + aoff + m * 2048 + k * 1024); } } while (0)
#define PG8_LDB(dst, b, h) do { if constexpr (FP8) { _Pragma("unroll") for (int n = 0; n < 2; ++n) { const PG8_LAS unsigned char* p_ = lds + PG8_SB(b, h) + boff + n * 2048; \
            const v4i32 lo_ = *(const PG8_LAS v4i32*)p_, hi_ = *(const PG8_LAS v4i32*)(p_ + 16); dst##8[n] = __builtin_shufflevector(lo_, hi_, 0, 1, 2, 3, 4, 5, 6, 7); } } \
        else { _Pragma("unroll") for (int n = 0; n < 2; ++n) _Pragma("unroll") for (int k = 0; k < 2; ++k) dst[n][k] = *(const PG8_LAS bf16x8*)(lds + PG8_SB(b, h) + boff + n * 2048 + k * 1024); } } while (0)
#define PG8_MMA(ai, bj, At, Bt) do { __builtin_amdgcn_s_setprio(1); \
        if constexpr (FP8) { _Pragma("unroll") for (int m = 0; m < 4; ++m) _Pragma("unroll") for (int n = 0; n < 2; ++n) \
            mfma_f8(acc[ai][bj][m][n], Bt##8[n], At##8[m], f8one); } \
        else { _Pragma("unroll") for (int m = 0; m < 4; ++m) _Pragma("unroll") for (int n = 0; n < 2; ++n) _Pragma("unroll") for (int k = 0; k < 2; ++k) \
            acc[ai][bj][m][n] = __builtin_amdgcn_mfma_f32_16x16x32_bf16(Bt[n][k], At[m][k], acc[ai][bj][m][n], 0, 0, 0); } \
        __builtin_amdgcn_s_setprio(0); } while (0)
#define PG8_WAIT_V(n) asm volatile("s_waitcnt vmcnt(" #n ")" ::: "memory")
#define PG8_WAIT_L(n) asm volatile("s_waitcnt lgkmcnt(" #n ")" ::: "memory")
#define PG8_BAR __builtin_amdgcn_s_barrier()
#define PG8_SCHED __builtin_amdgcn_sched_barrier(0)
    Unit cur, nxt; int ui = 0;
    if (!S.next(0, cur)) return;
    if constexpr (GATHER) { PG8_GOFF(cv0, cv1, cur.pm); }
    else {
#pragma unroll
        for (int i = 0; i < 2; ++i) { cv0[i] = voffA[i]; cv1[i] = voffA[i] + (unsigned)(HALF * K * 2); } }
    f32x4 acc[2][2][4][2];
#pragma unroll
    for (int a = 0; a < 2; ++a)
#pragma unroll
        for (int b = 0; b < 2; ++b)
#pragma unroll
            for (int m = 0; m < 4; ++m)
#pragma unroll
                for (int n = 0; n < 2; ++n) acc[a][b][m][n] = (f32x4){0.f, 0.f, 0.f, 0.f};
    bf16x8 At[4][2], B0[2][2], B1[2][2]; v8i32 At8[4], B08[2], B18[2]; int f8one = 0x7f7f7f7f; asm volatile("" : "+v"(f8one));
    const char* cA = (const char*)g.A + (GATHER ? (size_t)0 : (size_t)cur.pm * tstep); const char* cB = (const char*)g.Bt + (size_t)cur.pn * tstep;
    S.a_ready(cur);
    if constexpr (SP2) {
        PG8_STAGE(PG8_SB(0, 0), cB, voffB); PG8_STAGE(PG8_SB(0, 1), cB + hstep, voffB); PG8_STAGE(PG8_SA(0, 0), cA, cv0); PG8_STAGE(PG8_SA(0, 1), cA, cv1);
        if (wr == 1) PG8_BAR;
        PG8_WAIT_V(2); PG8_BAR;
        PG8_STAGE(PG8_SB(1, 0), cB + kstep, voffB); PG8_STAGE(PG8_SA(1, 0), cA + kstep, cv0); PG8_STAGE(PG8_SB(1, 1), cB + hstep + kstep, voffB);
        PG8_WAIT_V(6); PG8_BAR;
    } else {
        PG8_STAGE(PG8_SB(0, 0), cB, voffB); PG8_STAGE(PG8_SA(0, 0), cA, cv0); PG8_STAGE(PG8_SB(0, 1), cB + hstep, voffB); PG8_STAGE(PG8_SA(0, 1), cA, cv1);
        if (wr == 1) PG8_BAR;
        PG8_WAIT_V(4); PG8_BAR;
        PG8_STAGE(PG8_SB(1, 0), cB + kstep, voffB); PG8_STAGE(PG8_SA(1, 0), cA + kstep, cv0); PG8_STAGE(PG8_SB(1, 1), cB + hstep + kstep, voffB);
        PG8_WAIT_V(6); PG8_BAR;
    }
    for (;;) {
        const bool has_next = S.next(ui + 1, nxt);
        if (GATHER && has_next) { PG8_GOFF(nv0, nv1, nxt.pm); }
        else {
#pragma unroll
            for (int i = 0; i < 2; ++i) { nv0[i] = cv0[i]; nv1[i] = cv1[i]; } }
        const char* nA = (has_next && !GATHER) ? (const char*)g.A + (size_t)nxt.pm * tstep : cA; const char* nB = has_next ? (const char*)g.Bt + (size_t)nxt.pn * tstep : cB;
#pragma unroll 1
        for (int t = 0; t < nt; t += 2) {
            const bool last = (t == nt - 2);
            const char* a1 = cA + (size_t)(t + 1) * kstep;
            const char* a2 = last ? nA : cA + (size_t)(t + 2) * kstep; const char* b2 = last ? nB : cB + (size_t)(t + 2) * kstep;
            const char* a3 = a2 + kstep; const char* b3 = b2 + kstep;
#pragma unroll
            for (int i = 0; i < 2; ++i) { sv0[i] = last ? nv0[i] : cv0[i]; sv1[i] = last ? nv1[i] : cv1[i]; }
            if (last && has_next) S.a_ready(nxt);
            if constexpr (SP2) {
            PG8_LDB(B0, 0, 0); PG8_LDB(B1, 0, 1); PG8_SCHED; PG8_LDA(At, 0, 0); PG8_STAGE(PG8_SA(1, 1), a1, cv1);
            PG8_WAIT_V(8); PG8_WAIT_L(0); PG8_BAR; PG8_MMA(0, 0, At, B0); PG8_MMA(0, 1, At, B1); PG8_BAR; PG8_SCHED;
            PG8_LDA(At, 0, 1); PG8_STAGE(PG8_SB(0, 0), b2, voffB); PG8_STAGE(PG8_SB(0, 1), b2 + hstep, voffB); PG8_STAGE(PG8_SA(0, 0), a2, sv0);
            PG8_WAIT_V(8); PG8_WAIT_L(0); PG8_BAR; PG8_MMA(1, 0, At, B0); PG8_MMA(1, 1, At, B1); PG8_BAR; PG8_SCHED;
            PG8_LDB(B0, 1, 0); PG8_LDB(B1, 1, 1); PG8_SCHED; PG8_LDA(At, 1, 0); PG8_STAGE(PG8_SA(0, 1), a2, sv1);
            PG8_WAIT_V(8); PG8_WAIT_L(0); PG8_BAR; PG8_MMA(0, 0, At, B0); PG8_MMA(0, 1, At, B1); PG8_BAR; PG8_SCHED;
            PG8_LDA(At, 1, 1); PG8_STAGE(PG8_SB(1, 0), b3, voffB); PG8_STAGE(PG8_SB(1, 1), b3 + hstep, voffB); PG8_STAGE(PG8_SA(1, 0), a3, sv0);
            PG8_WAIT_V(8); PG8_WAIT_L(0); PG8_BAR; PG8_MMA(1, 0, At, B0); PG8_MMA(1, 1, At, B1); PG8_BAR; PG8_SCHED;
            } else {
            PG8_LDB(B0, 0, 0); PG8_SCHED; PG8_LDA(At, 0, 0); PG8_STAGE(PG8_SA(1, 1), a1, cv1);
            PG8_WAIT_L(8); PG8_BAR; PG8_WAIT_L(0); PG8_MMA(0, 0, At, B0); PG8_BAR; PG8_SCHED;
            PG8_LDB(B1, 0, 1); PG8_STAGE(PG8_SB(0, 0), b2, voffB);
            PG8_BAR; PG8_WAIT_L(0); PG8_MMA(0, 1, At, B1); PG8_BAR;
            PG8_LDA(At, 0, 1); PG8_STAGE(PG8_SA(0, 0), a2, sv0);
            PG8_BAR; PG8_WAIT_L(0); PG8_MMA(1, 0, At, B0); PG8_BAR; PG8_SCHED;
            PG8_STAGE(PG8_SB(0, 1), b2 + hstep, voffB);
            PG8_WAIT_V(6); PG8_BAR; PG8_MMA(1, 1, At, B1); PG8_BAR;
            PG8_LDB(B0, 1, 0); PG8_SCHED; PG8_LDA(At, 1, 0); PG8_STAGE(PG8_SA(0, 1), a2, sv1);
            PG8_WAIT_L(8); PG8_BAR; PG8_WAIT_L(0); PG8_MMA(0, 0, At, B0); PG8_BAR; PG8_SCHED;
            PG8_LDB(B1, 1, 1); PG8_STAGE(PG8_SB(1, 0), b3, voffB);
            PG8_BAR; PG8_WAIT_L(0); PG8_MMA(0, 1, At, B1); PG8_BAR;
            PG8_LDA(At, 1, 1); PG8_STAGE(PG8_SA(1, 0), a3, sv0);
            PG8_BAR; PG8_WAIT_L(0); PG8_MMA(1, 0, At, B0); PG8_BAR; PG8_SCHED;
            PG8_STAGE(PG8_SB(1, 1), b3 + hstep, voffB);
            PG8_WAIT_V(6); PG8_BAR; PG8_MMA(1, 1, At, B1); PG8_BAR;
            }
        }
        if constexpr (FP8) { asm volatile("s_nop 15\n\ts_nop 15\n\ts_nop 7" ::: "memory"); }
        if constexpr (ALIGN_EPI) { if (wr == 0) PG8_BAR; }
        if constexpr (!Epi::AFTER_DRAIN) { E(acc, cur, wr, wc, fr, fq); S.done(cur); }
        if (!has_next) break;
#pragma unroll
        for (int a = 0; a < 2; ++a)
#pragma unroll
            for (int b = 0; b < 2; ++b)
#pragma unroll
                for (int m = 0; m < 4; ++m)
#pragma unroll
                    for (int n = 0; n < 2; ++n) acc[a][b][m][n] = (f32x4){0.f, 0.f, 0.f, 0.f};
        cur = nxt; cA = nA; cB = nB; ++ui;
#pragma unroll
        for (int i = 0; i < 2; ++i) { cv0[i] = nv0[i]; cv1[i] = nv1[i]; }
        if constexpr (ALIGN_EPI) { if (wr == 1) PG8_BAR; }
    }
    PG8_WAIT_V(0);
    if constexpr (!ALIGN_EPI) { if (wr == 0) PG8_BAR; }
    PG8_BAR;
    if constexpr (Epi::AFTER_DRAIN) { E.fused(acc, cur, wr, wc, fr, fq, lds, wid, lane); S.done(cur); }
#undef PG8_GOFF
#undef PG8_SA
#undef PG8_SB
#undef PG8_STAGE
#undef PG8_LDA
#undef PG8_LDB
#undef PG8_MMA
#undef PG8_WAIT_V
#undef PG8_WAIT_L
#undef PG8_BAR
#undef PG8_SCHED
}
}

#ifndef PG8_SP2
#define PG8_SP2 true
#endif
#ifndef PG8_ALIGN
#define PG8_ALIGN true
#endif
constexpr int RING_OFF = 0, RING_BYTES = 131072;
constexpr int LDSCTL_OFF = RING_BYTES, MISC_OFF = LDSCTL_OFF + 320;
constexpr int LDS_BYTES = 163840;
constexpr int PARAM_OFF = 135168;
constexpr int NWAVES = 8;
#define GAS __attribute__((address_space(1)))
#define LAS __attribute__((address_space(3)))
typedef unsigned v4u __attribute__((ext_vector_type(4)));
typedef unsigned u2v_t __attribute__((ext_vector_type(2)));
typedef float f32x4 __attribute__((ext_vector_type(4)));
typedef GAS unsigned gu32;
#define RLX_AGENT __ATOMIC_RELAXED, __HIP_MEMORY_SCOPE_AGENT
#define LDS_WAIT() asm volatile("s_waitcnt lgkmcnt(0)" ::: "memory")
__device__ __forceinline__ unsigned pk2(float lo, float hi) { return cvtpk2(lo, hi); }

#define XB_TMO      128
#define XB_XCNT(j)  (256  + 64 * (j))
#define XB_XSUB(j)  (1280 + 64 * (j))
#define XB_XGEN(j)  (2304 + 64 * (j))
#define XB_TOP      3328
#define XB_TOPGEN   3392
#define XCD_BAR_WORDS 3456
#define XB_SPIN_CAP (1u << 18)

__device__ __forceinline__ unsigned xb_ld(unsigned* p)              { return __hip_atomic_load(p, __ATOMIC_RELAXED, __HIP_MEMORY_SCOPE_AGENT); }
__device__ __forceinline__ unsigned xb_add(unsigned* p, unsigned v) { return __hip_atomic_fetch_add(p, v, __ATOMIC_RELAXED, __HIP_MEMORY_SCOPE_AGENT); }
__device__ __forceinline__ unsigned xb_xcc_id() { return (unsigned)__builtin_amdgcn_s_getreg((3 << 11) | 20) & 0xFu; }
#define XB_SPIN(cond, bar) do { unsigned _sp = 0; while (cond) { __builtin_amdgcn_s_sleep(1); \
    if ((++_sp & 255u) == 0u) { if (xb_ld(&(bar)[XB_TMO])) break; if (_sp > XB_SPIN_CAP) { atomicAdd(&(bar)[XB_TMO], 1u); break; } } } } while (0)

struct XcdBarrier {
    unsigned* bar; unsigned x;
    volatile LAS unsigned* st;
};

__device__ __forceinline__ XcdBarrier xcd_barrier_post(unsigned* bar, volatile LAS unsigned* st) {
    XcdBarrier b; b.bar = bar; b.x = xb_xcc_id(); b.st = st;
    if (threadIdx.x == 0) (void)xb_add(&bar[XB_XCNT(b.x)], 1u);
    return b;
}
__device__ __forceinline__ void xcd_barrier_complete(unsigned* bar, unsigned x, unsigned& nloc, unsigned& nx) {
    const unsigned G = gridDim.x * gridDim.y * gridDim.z;
    unsigned sum, cnt, mine, sp = 0u;
    for (;;) {
        sum = 0u; cnt = 0u; mine = 0u;
#pragma unroll
        for (unsigned j = 0; j < 16; ++j) { const unsigned c = xb_ld(&bar[XB_XCNT(j)]); sum += c; cnt += (c > 0u) ? 1u : 0u; mine = (j == x) ? c : mine; }
        if (sum == G) break;
        __builtin_amdgcn_s_sleep(1);
        if ((++sp & 255u) == 0u) { if (xb_ld(&bar[XB_TMO])) break; if (sp > XB_SPIN_CAP) { atomicAdd(&bar[XB_TMO], 1u); break; } }
    }
    nloc = mine > 0u ? mine : 1u; nx = cnt > 0u ? cnt : 1u;
}

__device__ __forceinline__ void xcd_barrier(const XcdBarrier& b) {
    asm volatile("s_waitcnt vmcnt(0)" ::: "memory");
    __syncthreads();
    if (threadIdx.x == 0) {
        unsigned* bar = b.bar;
        __builtin_amdgcn_s_waitcnt(0);
        unsigned nloc = b.st[0], nx = b.st[1];
        if (nloc == 0u) { xcd_barrier_complete(bar, b.x, nloc, nx); b.st[0] = nloc; b.st[1] = nx; }
        const unsigned old = xb_add(&bar[XB_XSUB(b.x)], 1u);
        const unsigned gen = old / nloc;
        if (old + 1u == (gen + 1u) * nloc) {
            __builtin_amdgcn_fence(__ATOMIC_RELEASE, "agent");
            asm volatile("s_waitcnt vmcnt(0)" ::: "memory");
            const unsigned og = xb_add(&bar[XB_TOP], 1u);
            const unsigned tg = og / nx;
            if (og + 1u == (tg + 1u) * nx) xb_add(&bar[XB_TOPGEN], 1u);
            else XB_SPIN(xb_ld(&bar[XB_TOPGEN]) == tg, bar);
            __builtin_amdgcn_fence(__ATOMIC_ACQUIRE, "agent");
            xb_add(&bar[XB_XGEN(b.x)], 1u);
            asm volatile("s_waitcnt vmcnt(0)" ::: "memory");
        } else {
            XB_SPIN(xb_ld(&bar[XB_XGEN(b.x)]) == gen, bar);
            __builtin_amdgcn_fence(__ATOMIC_ACQUIRE, "agent");
            asm volatile("s_waitcnt vmcnt(0)" ::: "memory");
        }
    }
    __syncthreads();
}

struct Args { const void* in[20]; float* out; unsigned char* ws; int ph_lo, ph_hi, li, mask, rep, pad; };
struct Ctx {
    unsigned char* lds; int tid, lane, wave, G, gw, NGW;
    const float *x, *c, *w_ada, *b_ada, *g_pre_mix, *g_post_mix, *g_pre_ffn, *g_post_ffn, *w_in, *lbl, *onorm, *sink, *w_a, *w_b, *w_o, *w_router, *w_eg, *w_eu, *w_ed;
    const int* pos; float* out; unsigned char* ws;
};
__device__ __forceinline__ float wave_sum(float v) {
#pragma unroll
    for (int o = 1; o < 64; o <<= 1) v += __shfl_xor(v, o);
    return v;
}
struct TDesc { const float* src; bf16* dst; int N, K; float f8s; };
__device__ __forceinline__ void t_load(const TDesc& d, f32x4 (&r)[8], int lane) {
    const float* p = d.src + (size_t)(lane >> 3) * d.N + 4 * (lane & 7);
#pragma unroll
    for (int i = 0; i < 8; ++i) r[i] = __builtin_nontemporal_load((const f32x4*)(p + (size_t)(8 * i) * d.N));
}
__device__ __forceinline__ void t_process(const TDesc& d, const f32x4 (&r)[8], float* scr, int lane) {
    { float* w = scr + (lane >> 3) * 33 + 4 * (lane & 7);
#pragma unroll
      for (int i = 0; i < 8; ++i) { float* q = w + (8 * i) * 33; q[0] = r[i].x; q[1] = r[i].y; q[2] = r[i].z; q[3] = r[i].w; } }
    LDS_WAIT(); asm volatile("" ::: "memory");
    if (d.f8s != 0.f) {
        const int c = lane & 3; const float f = d.f8s; unsigned char* dst8 = (unsigned char*)d.dst;
#pragma unroll
        for (int j = 0; j < 2; ++j) { const int n = (lane >> 2) + 16 * j; const float* s = scr + (16 * c) * 33 + n;
            v4u o; o.x = pg8::pk4_fp8(s[0 * 33] * f, s[1 * 33] * f, s[2 * 33] * f, s[3 * 33] * f); o.y = pg8::pk4_fp8(s[4 * 33] * f, s[5 * 33] * f, s[6 * 33] * f, s[7 * 33] * f);
            o.z = pg8::pk4_fp8(s[8 * 33] * f, s[9 * 33] * f, s[10 * 33] * f, s[11 * 33] * f); o.w = pg8::pk4_fp8(s[12 * 33] * f, s[13 * 33] * f, s[14 * 33] * f, s[15 * 33] * f);
            __builtin_nontemporal_store(o, (v4u*)(dst8 + (size_t)n * d.K + 16 * c)); }
    } else {
    const int c = lane & 7;
#pragma unroll
    for (int j = 0; j < 4; ++j) { const int n = (lane >> 3) + 8 * j; const float* s = scr + (8 * c) * 33 + n;
        v4u o; o.x = pk2(s[0 * 33], s[1 * 33]); o.y = pk2(s[2 * 33], s[3 * 33]); o.z = pk2(s[4 * 33], s[5 * 33]); o.w = pk2(s[6 * 33], s[7 * 33]);
        *(v4u*)(d.dst + (size_t)n * d.K + 8 * c) = o; }
    }
    LDS_WAIT(); asm volatile("" ::: "memory");
}
__device__ __forceinline__ void rope_entry(const int* pos, float* rope, int gid) {
    const int t = gid >> 6, i = gid & 63;
    double inv = 1.0, rr = 0.8659643233600653523531691834202299819398;
    for (int bit = 0; bit < 6; ++bit) { if ((i >> bit) & 1) inv *= rr; rr *= rr; }
    const double ang = (double)pos[t] * inv;
    const double kq = rint(ang * 0.3183098861837906715377675267450287);
    const double r = ang - kq * 3.141592653589793238462643383279502884;
    const double u = -(r * r);
    double s = 1.0 / 121645100408832000.0;
    s = s * u + 1.0 / 355687428096000.0; s = s * u + 1.0 / 1307674368000.0; s = s * u + 1.0 / 6227020800.0; s = s * u + 1.0 / 39916800.0; s = s * u + 1.0 / 362880.0;
    s = s * u + 1.0 / 5040.0; s = s * u + 1.0 / 120.0; s = s * u + 1.0 / 6.0; s = s * u + 1.0; s = s * r;
    double cz = 1.0 / 6402373705728000.0;
    cz = cz * u + 1.0 / 20922789888000.0; cz = cz * u + 1.0 / 87178291200.0; cz = cz * u + 1.0 / 479001600.0; cz = cz * u + 1.0 / 3628800.0; cz = cz * u + 1.0 / 40320.0;
    cz = cz * u + 1.0 / 720.0; cz = cz * u + 1.0 / 24.0; cz = cz * u + 0.5; cz = cz * u + 1.0;
    const double sg = (((long long)kq) & 1) ? -1.0 : 1.0;
    rope[(size_t)gid * 2] = (float)(sg * cz); rope[(size_t)gid * 2 + 1] = (float)(sg * s);
}
constexpr float W8S_GU = 64.f, W8S_D = 32.f;
constexpr int I_IN = 32 * 336, I_A = 16 * 64, I_O = 32 * 64, I_E = 1024, I_MIX = I_IN + 2 * I_A + I_O, I_EXP = 48 * I_E;
constexpr int CONV_BLOCKS = 32;
constexpr int CONV_ITEMS_PER_WAVE = 100;
constexpr int P0_EXPERT_ITEMS = I_EXP - CONV_BLOCKS * NWAVES * CONV_ITEMS_PER_WAVE;
constexpr int P0_GEMV_ROUNDS = 8;
constexpr int GEMV_BLOCKS = 96;
__device__ __forceinline__ TDesc transpose_desc(Ctx& F, int it) {
    bf16* WIN = (bf16*)(F.ws + WS_WIN); bf16* WA = (bf16*)(F.ws + WS_WA); bf16* WB = (bf16*)(F.ws + WS_WB); bf16* WO = (bf16*)(F.ws + WS_WO); bf16* WGU = (bf16*)(F.ws + WS_WGU); bf16* WD = (bf16*)(F.ws + WS_WD);
    int r = it; const float* W; bf16* WT; int K, N, kb, nb; size_t drow; float f8s = 0.f;
    if (r < I_IN) { W = F.w_in; WT = WIN; K = 2048; N = INW; kb = r / 336; nb = r % 336; drow = (size_t)32 * nb; }
    else if ((r -= I_IN) < I_A) { W = F.w_a; WT = WA; K = 1024; N = 2048; kb = r / 64; nb = r % 64; drow = (size_t)32 * nb; }
    else if ((r -= I_A) < I_A) { W = F.w_b; WT = WB; K = 1024; N = 2048; kb = r / 64; nb = r % 64; drow = (size_t)32 * nb; }
    else if ((r -= I_A) < I_O) { W = F.w_o; WT = WO; K = 2048; N = 2048; kb = r / 64; nb = r % 64; drow = (size_t)32 * nb; }
    else { r -= I_O; const int e = r / (3 * I_E), q = r % (3 * I_E), which = q / I_E, ii = q % I_E;
        if (which < 2) { kb = ii / 32; nb = ii % 32; const int n0 = 32 * nb; W = (which ? F.w_eu : F.w_eg) + (size_t)e * 2048 * 1024; WT = WGU; K = 2048; N = 1024; f8s = W8S_GU; drow = (size_t)e * 2048 + (n0 >> 7) * 256 + which * 128 + (n0 & 127); }
        else { kb = ii / 64; nb = ii % 64; W = F.w_ed + (size_t)e * 1024 * 2048; WT = WD; K = 1024; N = 2048; f8s = W8S_D; drow = (size_t)e * 2048 + 32 * nb; } }
    TDesc d; d.src = W + (size_t)(64 * kb) * N + 32 * nb; d.N = N; d.K = K; d.f8s = f8s;
    if (f8s != 0.f) d.dst = (bf16*)((unsigned char*)WT + drow * K + 64 * kb); else d.dst = WT + drow * K + 64 * kb;
    return d;
}
template <class Seq> __device__ __forceinline__ void transpose_stream(Ctx& F, const Seq& seq, float* scr) {
    f32x4 ra[8], rb[8]; TDesc da, db; int j = 0; int it = seq(j);
    if (it < 0) return;
    da = transpose_desc(F, it); t_load(da, ra, F.lane);
    for (;;) {
        const int itn = seq(++j);
        if (itn >= 0) { db = transpose_desc(F, itn); t_load(db, rb, F.lane); }
        t_process(da, ra, scr, F.lane);
        if (itn < 0) break;
        const int itnn = seq(++j);
        if (itnn >= 0) { da = transpose_desc(F, itnn); t_load(da, ra, F.lane); }
        t_process(db, rb, scr, F.lane);
        if (itnn < 0) break;
    }
}
struct P0Seq { int gw, NGW, ngv; bool gemv;
    __device__ __forceinline__ int operator()(int r) const { int it; if (r < P0_GEMV_ROUNDS) it = r * NGW + gw; else { if (gemv) return -1; it = P0_GEMV_ROUNDS * NGW + (r - P0_GEMV_ROUNDS) * (NGW - ngv) + (gw - ngv); }
        return it < I_MIX + P0_EXPERT_ITEMS ? it : -1; } };
struct TailSeq { int first, stride;
    __device__ __forceinline__ int operator()(int j) const { const int it = first + j * stride; return it < I_MIX + I_EXP ? it : -1; } };
__device__ __forceinline__ void p1_modnorm(Ctx& F, int first, int stride) {
    const float* MOD = (const float*)(F.ws + WS_MOD); bf16* H = (bf16*)(F.ws + WS_H);
    for (int row0 = first; row0 < T; row0 += 2 * stride) {
        f32x4 v[2][8];
#pragma unroll
        for (int k = 0; k < 2; ++k) { const int row = row0 + k * stride; if (row < T) { const f32x4* xr = (const f32x4*)(F.x + (size_t)row * D) + F.lane;
#pragma unroll
            for (int j = 0; j < 8; ++j) v[k][j] = __builtin_nontemporal_load(xr + 64 * j); } }
#pragma unroll
        for (int k = 0; k < 2; ++k) { const int row = row0 + k * stride; if (row < T) {
            const int b = row / SEQ; float ss = 0.f;
#pragma unroll
            for (int j = 0; j < 8; ++j) ss += (v[k][j].x * v[k][j].x + v[k][j].y * v[k][j].y) + (v[k][j].z * v[k][j].z + v[k][j].w * v[k][j].w);
            const float r = rsqrtf(wave_sum(ss) * (1.f / D) + EPS);
            const f32x4* gp = (const f32x4*)F.g_pre_mix + F.lane; const f32x4* shp = (const f32x4*)(MOD + b * 12288) + F.lane; const f32x4* scp = (const f32x4*)(MOD + b * 12288 + 2048) + F.lane;
            uint2* o8 = (uint2*)(H + (size_t)row * D) + F.lane;
            f32x4 g[8], sh[8], sc[8];
#pragma unroll
            for (int j = 0; j < 8; ++j) { g[j] = gp[64 * j]; sh[j] = shp[64 * j]; sc[j] = scp[64 * j]; }
#pragma unroll
            for (int j = 0; j < 8; ++j) { const f32x4 h = v[k][j] * r * g[j] * (sc[j] + 1.f) + sh[j];
                uint2 w; w.x = pk2(h.x, h.y); w.y = pk2(h.z, h.w); o8[64 * j] = w; } } }
    }
}
__device__ __forceinline__ void p0_prep(Ctx& F) {
    float* MOD = (float*)(F.ws + WS_MOD); float* LB = (float*)(F.ws + WS_LB); float* ROPE = (float*)(F.ws + WS_ROPE);
    if (blockIdx.x < GEMV_BLOCKS) {
        float* sc = (float*)F.lds; float* red = (float*)(F.lds + 16384);
        for (int i = F.tid; i < 4096; i += 512) sc[i] = siluf_(F.c[i]);
        __syncthreads();
        const int j0 = blockIdx.x * 128, k0 = F.wave * 256, half = F.lane >> 5, l32 = F.lane & 31;
        f32x4 a0 = {0.f, 0.f, 0.f, 0.f}, a1 = {0.f, 0.f, 0.f, 0.f};
        const float* wp = F.w_ada + (size_t)(k0 + half) * 12288 + j0 + 4 * l32;
#pragma unroll 16
        for (int k = 0; k < 128; ++k) { const f32x4 w = __builtin_nontemporal_load((const f32x4*)(wp + (size_t)(2 * k) * 12288)); const float s0 = sc[k0 + 2 * k + half], s1 = sc[2048 + k0 + 2 * k + half]; a0 += w * s0; a1 += w * s1; }
        *(f32x4*)(red + ((F.wave * 2 + half) * 2 + 0) * 128 + 4 * l32) = a0; *(f32x4*)(red + ((F.wave * 2 + half) * 2 + 1) * 128 + 4 * l32) = a1;
        __syncthreads();
        if (F.tid < 256) { const int b = F.tid >> 7, jj = F.tid & 127; float s = 0.f;
#pragma unroll
          for (int p = 0; p < 16; ++p) s += red[(p * 2 + b) * 128 + jj];
          MOD[b * 12288 + j0 + jj] = s + F.b_ada[j0 + jj]; }
        __syncthreads();
    }
    { const int gt = blockIdx.x * 512 + F.tid, NT = F.G * 512;
      if (gt < 2048) { const int dir = gt >> 10, ch = gt & 1023; const float l0 = F.lbl[dir * 2048 + ch], l1 = F.lbl[dir * 2048 + 1024 + ch]; LB[gt] = 1.f / (1.f + expf(l1 - l0)); }
      for (int g = gt; g < T * 64; g += NT) rope_entry(F.pos, ROPE, g); }
    unsigned* cnt = (unsigned*)(F.ws + WS_CTL) + 1024;
    if (blockIdx.x < GEMV_BLOCKS) {
        asm volatile("s_waitcnt vmcnt(0)" ::: "memory"); __syncthreads();
        if (F.tid == 0) { __builtin_amdgcn_fence(__ATOMIC_RELEASE, "agent"); asm volatile("s_waitcnt vmcnt(0)" ::: "memory"); __hip_atomic_fetch_add(cnt, 1u, __ATOMIC_RELAXED, __HIP_MEMORY_SCOPE_AGENT); }
    }
    float* scr = (float*)(F.lds + F.wave * 16384);
    P0Seq seq{F.gw, F.NGW, GEMV_BLOCKS * NWAVES, blockIdx.x < GEMV_BLOCKS};
    transpose_stream(F, seq, scr);
    __syncthreads();
    if (F.tid == 0) { unsigned sp = 0; while (__hip_atomic_load(cnt, __ATOMIC_RELAXED, __HIP_MEMORY_SCOPE_AGENT) < (unsigned)GEMV_BLOCKS && ++sp < (1u << 22)) __builtin_amdgcn_s_sleep(2);
        __builtin_amdgcn_fence(__ATOMIC_ACQUIRE, "agent"); asm volatile("s_waitcnt vmcnt(0)" ::: "memory"); }
    __syncthreads();
    p1_modnorm(F, F.gw, F.NGW);
}
__device__ __forceinline__ void p6_post1(Ctx& F) {
    const float* MOD = (const float*)(F.ws + WS_MOD); const float* Y = (const float*)(F.ws + WS_Y); bf16* H2 = (bf16*)(F.ws + WS_H2); float* AFF = (float*)(F.ws + WS_AFF);
    float* wT = (float*)F.lds;
    float* PA = (float*)(F.lds + PARAM_OFF); float* PB = PA + 2048; float* PC = PB + 2048;
    for (int f = F.tid; f < 8192; f += 512) { const int d = f >> 2, q = f & 3; const f32x4 wv = *((const f32x4*)F.w_router + f);
        wT[(4 * q + 0) * 2048 + d] = wv.x; wT[(4 * q + 1) * 2048 + d] = wv.y; wT[(4 * q + 2) * 2048 + d] = wv.z; wT[(4 * q + 3) * 2048 + d] = wv.w; }
    uint2 ywn[8]; f32x4 xvn[8];
#define P6_LOAD(rr) do { const uint2* yr_ = (const uint2*)((const bf16*)Y + (size_t)(rr) * D) + F.lane; const f32x4* xr_ = (const f32x4*)(F.x + (size_t)(rr) * D) + F.lane; \
        _Pragma("unroll") for (int j = 0; j < 8; ++j) { { const u2v_t t2_ = __builtin_nontemporal_load((const u2v_t*)(yr_ + 64 * j)); ywn[j].x = t2_.x; ywn[j].y = t2_.y; } xvn[j] = __builtin_nontemporal_load(xr_ + 64 * j); } } while (0)
    for (int b = 0; b < BATCH; ++b) {
        const float* mb = MOD + b * 12288;
        __syncthreads();
        if (F.tid < 512) { const int d4 = F.tid;
            const f32x4 gt = *((const f32x4*)(mb + 4096) + d4), gp = *((const f32x4*)F.g_post_mix + d4), g2 = *((const f32x4*)F.g_pre_ffn + d4), sc = *((const f32x4*)(mb + 8192) + d4), sh = *((const f32x4*)(mb + 6144) + d4);
            *((f32x4*)PA + d4) = gt * gp; *((f32x4*)PB + d4) = g2 * (sc + 1.f); *((f32x4*)PC + d4) = sh; }
        const int rfirst = b * SEQ + F.gw;
        if (F.gw < SEQ) P6_LOAD(rfirst);
        __syncthreads();
        for (int rl = F.gw; rl < SEQ; rl += F.NGW) {
            const int row = b * SEQ + rl, s = rl;
            f32x4 xv[8]; float ss = 0.f;
            {   uint2 yc[8];
#pragma unroll
                for (int j = 0; j < 8; ++j) { yc[j] = ywn[j]; const float y0 = __uint_as_float(yc[j].x << 16), y1 = __uint_as_float(yc[j].x & 0xffff0000u), y2 = __uint_as_float(yc[j].y << 16), y3 = __uint_as_float(yc[j].y & 0xffff0000u);
                    xv[j] = xvn[j]; ss += (y0 * y0 + y1 * y1) + (y2 * y2 + y3 * y3); }
                if (rl + F.NGW < SEQ) P6_LOAD(row + F.NGW);
                const float r = rsqrtf(wave_sum(ss) * (1.f / D) + EPS);
                f32x4* op = (f32x4*)(F.out + (size_t)row * D) + F.lane;
                ss = 0.f;
#pragma unroll
                for (int j = 0; j < 8; ++j) { const f32x4 y = {__uint_as_float(yc[j].x << 16), __uint_as_float(yc[j].x & 0xffff0000u), __uint_as_float(yc[j].y << 16), __uint_as_float(yc[j].y & 0xffff0000u)};
                    const f32x4 pa = *((const f32x4*)PA + F.lane + 64 * j);
                    xv[j] = xv[j] + pa * (y * r); ss += (xv[j].x * xv[j].x + xv[j].y * xv[j].y) + (xv[j].z * xv[j].z + xv[j].w * xv[j].w); }
#pragma unroll
                for (int j = 0; j < 8; ++j) op[64 * j] = xv[j];
            }
            const float r2 = rsqrtf(wave_sum(ss) * (1.f / D) + EPS);
            unsigned* o4 = (unsigned*)((unsigned char*)H2 + (size_t)row * D) + F.lane;
            float lg[16];
#pragma unroll
            for (int j = 0; j < 8; ++j) { const f32x4 pb = *((const f32x4*)PB + F.lane + 64 * j), pc = *((const f32x4*)PC + F.lane + 64 * j); xv[j] = xv[j] * r2 * pb + pc; }
#pragma unroll
            for (int j = 0; j < 8; ++j) o4[64 * j] = pg8::pk4_fp8(xv[j].x, xv[j].y, xv[j].z, xv[j].w);
#pragma unroll
            for (int e = 0; e < 16; ++e) { float a = 0.f;
#pragma unroll
                for (int j = 0; j < 8; ++j) { const f32x4 wv = *((const f32x4*)(wT + e * 2048) + F.lane + 64 * j); a += (xv[j].x * wv.x + xv[j].y * wv.y) + (xv[j].z * wv.z + xv[j].w * wv.w); }
                lg[e] = a; asm volatile("" ::: "memory"); }
            float mx = -1e30f;
#pragma unroll
            for (int e = 0; e < 16; ++e) { lg[e] = wave_sum(lg[e]); mx = fmaxf(mx, lg[e]); }
            float sm = 0.f;
#pragma unroll
            for (int e = 0; e < 16; ++e) { lg[e] = expf(lg[e] - mx); sm += lg[e]; }
            float mine = 0.f;
#pragma unroll
            for (int e = 0; e < 16; ++e) mine = (F.lane == e) ? lg[e] : mine;
            if (F.lane < 16) AFF[((size_t)b * 16 + F.lane) * SEQ + s] = mine / sm;
        }
    }
#undef P6_LOAD
    __syncthreads();
}
__device__ __forceinline__ void p7_topk_gather(Ctx& F) {
    const float* AFF = (const float*)(F.ws + WS_AFF); int* GIDX = (int*)(F.ws + WS_GIDX); float* SELAFF = (float*)(F.ws + WS_SELAFF); int* TOKSLOT = (int*)(F.ws + WS_TOKSLOT);
        int* sh = (int*)F.lds; int* wsum = (int*)(F.lds + 64);
    for (int unit = blockIdx.x; unit < 256; unit += F.G) {
        const int be = unit >> 3, part = unit & 7, b = be >> 4, e = be & 15, tid = F.tid, lane = F.lane;
        if (F.wave == 0) {
            unsigned v[64];
#pragma unroll
            for (int i = 0; i < 64; ++i) v[i] = __float_as_uint(AFF[(size_t)be * SEQ + i * 64 + lane]);
            unsigned tau = 0u;
            for (int bit = 30; bit >= 0; --bit) { const unsigned cand = tau | (1u << bit); int cl = 0;
#pragma unroll
                for (int i = 0; i < 64; ++i) cl += (v[i] >= cand) ? 1 : 0;
                int c = 0;
#pragma unroll
                for (int q = 0; q < 7; ++q) c += __popcll(__ballot((cl >> q) & 1)) << q;
                if (c >= CAP) tau = cand; }
            int cgt = 0;
            { int cl = 0;
#pragma unroll
              for (int i = 0; i < 64; ++i) cl += (v[i] > tau) ? 1 : 0;
#pragma unroll
              for (int q = 0; q < 7; ++q) cgt += __popcll(__ballot((cl >> q) & 1)) << q; }
            if (lane == 0) { sh[0] = (int)tau; sh[1] = cgt; }
        }
        __syncthreads();
        const unsigned tau = (unsigned)sh[0]; const int need = CAP - sh[1];
        const f32x4* a = (const f32x4*)(AFF + (size_t)be * SEQ + tid * 8);
        const f32x4 a0 = a[0], a1 = a[1];
        const unsigned v[8] = {__float_as_uint(a0.x), __float_as_uint(a0.y), __float_as_uint(a0.z), __float_as_uint(a0.w), __float_as_uint(a1.x), __float_as_uint(a1.y), __float_as_uint(a1.z), __float_as_uint(a1.w)};
        int cg = 0, ce = 0;
#pragma unroll
        for (int i = 0; i < 8; ++i) { cg += (v[i] > tau) ? 1 : 0; ce += (v[i] == tau) ? 1 : 0; }
        const int pk = cg | (ce << 16); int inc = pk;
#pragma unroll
        for (int o = 1; o < 64; o <<= 1) { const int t = __shfl_up(inc, o); if (lane >= o) inc += t; }
        if (lane == 63) wsum[F.wave] = inc;
        __syncthreads();
        int base = 0;
#pragma unroll
        for (int w = 0; w < 8; ++w) base += (w < F.wave) ? wsum[w] : 0;
        const int excl = base + inc - pk, pg = excl & 0xffff, pe = excl >> 16;
        int tie_before = pe, sel_before = pg + (pe < need ? pe : need);
#pragma unroll
        for (int i = 0; i < 8; ++i) {
            const int tok = tid * 8 + i; bool sel = false;
            if (v[i] > tau) sel = true; else if (v[i] == tau) { sel = tie_before < need; ++tie_before; }
            int slot = -1;
            if (sel) { const int sl = sel_before; ++sel_before; slot = b * CAP + sl;
                if ((sl >> 6) == part) { GIDX[e * 1024 + slot] = b * SEQ + tok; SELAFF[e * 1024 + slot] = __uint_as_float(v[i]); } }
            if (F.wave == part) TOKSLOT[((size_t)b * 16 + e) * SEQ + tok] = slot;
        }
        __syncthreads();
    }
}
__device__ __forceinline__ void p10_final(Ctx& F) {
    const float* MOD = (const float*)(F.ws + WS_MOD); const bf16* SLAB = (const bf16*)(F.ws + WS_SLAB); const int* TOKSLOT = (const int*)(F.ws + WS_TOKSLOT);
    for (int row0 = F.gw; row0 < T; row0 += 4 * F.NGW) {
        int slotw[4];
#pragma unroll
        for (int k = 0; k < 4; ++k) { const int row = row0 + k * F.NGW; slotw[k] = (row < T && F.lane < 16) ? TOKSLOT[((size_t)(row / SEQ) * 16 + F.lane) * SEQ + (row % SEQ)] : -1; }
#pragma unroll
        for (int k = 0; k < 4; ++k) { const int row = row0 + k * F.NGW; if (row < T) {
            const int b = row / SEQ; const float* mb = MOD + b * 12288;
            f32x4 x1v[8], gtv[8], gpv[8];
#pragma unroll
            for (int j = 0; j < 4; ++j) { const int col = 8 * F.lane + 512 * j; const float* op = F.out + (size_t)row * D + col;
#pragma unroll
                for (int hh = 0; hh < 2; ++hh) { x1v[2 * j + hh] = *(const f32x4*)(op + 4 * hh); gtv[2 * j + hh] = *(const f32x4*)(mb + 10240 + col + 4 * hh); gpv[2 * j + hh] = *(const f32x4*)(F.g_post_ffn + col + 4 * hh); } }
            float y[32];
#pragma unroll
            for (int i = 0; i < 32; ++i) y[i] = 0.f;
            for (int e = 0; e < 16; ++e) { const int sl = __shfl(slotw[k], e); if (sl >= 0) { const v4u* r = (const v4u*)(SLAB + ((size_t)e * 1024 + sl) * D) + F.lane;
#pragma unroll
                    for (int j = 0; j < 4; ++j) { const v4u q = r[64 * j];
                        y[8 * j + 0] += __uint_as_float(q.x << 16); y[8 * j + 1] += __uint_as_float(q.x & 0xffff0000u); y[8 * j + 2] += __uint_as_float(q.y << 16); y[8 * j + 3] += __uint_as_float(q.y & 0xffff0000u);
                        y[8 * j + 4] += __uint_as_float(q.z << 16); y[8 * j + 5] += __uint_as_float(q.z & 0xffff0000u); y[8 * j + 6] += __uint_as_float(q.w << 16); y[8 * j + 7] += __uint_as_float(q.w & 0xffff0000u); } } }
            float ss = 0.f;
#pragma unroll
            for (int i = 0; i < 32; ++i) ss += y[i] * y[i];
            const float r = rsqrtf(wave_sum(ss) * (1.f / D) + EPS);
#pragma unroll
            for (int j = 0; j < 4; ++j) { const int col = 8 * F.lane + 512 * j; float* op = F.out + (size_t)row * D + col;
#pragma unroll
                for (int hh = 0; hh < 2; ++hh) { f32x4 yy = {y[8 * j + 4 * hh], y[8 * j + 4 * hh + 1], y[8 * j + 4 * hh + 2], y[8 * j + 4 * hh + 3]};
                    *(f32x4*)(op + 4 * hh) = x1v[2 * j + hh] + gtv[2 * j + hh] * (yy * r * gpv[2 * j + hh]); } } } }
    }
}
typedef short bf16x8 __attribute__((ext_vector_type(8)));
typedef short s16x4 __attribute__((ext_vector_type(4)));
typedef short v4i16_t __attribute__((ext_vector_type(4)));
typedef float f32x16 __attribute__((ext_vector_type(16)));
typedef float f32x2m __attribute__((ext_vector_type(2)));
constexpr int RS = 272;
constexpr int RSA = 144;
constexpr float LOG2E = 1.4426950408889634f;
__device__ __forceinline__ s16x4 tr4(const LAS unsigned char* p) { return __builtin_bit_cast(s16x4, __builtin_amdgcn_ds_read_tr16_b64_v4i16((LAS v4i16_t*)p)); }
__device__ __forceinline__ bf16x8 tr8(const LAS unsigned char* p, int second) { const s16x4 a = tr4(p), b = tr4(p + second); return (bf16x8){a[0], a[1], a[2], a[3], b[0], b[1], b[2], b[3]}; }
__device__ __forceinline__ bf16x8 ld8(const LAS unsigned char* p) { return *(const LAS bf16x8*)p; }
__device__ __forceinline__ unsigned cvtpk(float lo, float hi) { return pg8::cvt_pk_bf16(lo, hi); }
__device__ __forceinline__ int crow(int r, int hi) { return (r & 3) + 8 * (r >> 2) + 4 * hi; }
#define MFMA16(a, b, c) __builtin_amdgcn_mfma_f32_16x16x32_bf16((a), (b), (c), 0, 0, 0)
#define MFMA32(a, b, c) __builtin_amdgcn_mfma_f32_32x32x16_bf16((a), (b), (c), 0, 0, 0)

__device__ __forceinline__ void rope_pass(Ctx& F) {
    const bf16* PROJ = (const bf16*)(F.ws + WS_PROJ); const float* ROPE = (const float*)(F.ws + WS_ROPE); bf16* QR = (bf16*)(F.ws + WS_QR); bf16* KR = (bf16*)(F.ws + WS_KR);
    const int NT = F.G * 512;
    for (int it0 = blockIdx.x * 512 + F.tid; it0 < T * 80; it0 += 2 * NT) {
        v4u a[2], bq[2]; f32x4 cs[2][4]; bool ok[2];
#pragma unroll
        for (int u = 0; u < 2; ++u) { const int it = it0 + u * NT; ok[u] = it < T * 80; if (ok[u]) { const int i8 = it & 7, hh = (it >> 3) % 10, t = it / 80;
            const bf16* src = PROJ + (size_t)t * INW + (hh < 8 ? C_AQ + hh * 128 : C_AK + (hh - 8) * 128) + i8 * 8;
            a[u] = *(const v4u*)src; bq[u] = *(const v4u*)(src + 64);
            const f32x4* rp = (const f32x4*)(ROPE + ((size_t)t * 64 + i8 * 8) * 2);
#pragma unroll
            for (int k = 0; k < 4; ++k) cs[u][k] = rp[k]; } }
#pragma unroll
        for (int u = 0; u < 2; ++u) { if (ok[u]) { const int it = it0 + u * NT; const int i8 = it & 7, hh = (it >> 3) % 10, t = it / 80;
            const unsigned aw[4] = {a[u].x, a[u].y, a[u].z, a[u].w}, bw[4] = {bq[u].x, bq[u].y, bq[u].z, bq[u].w};
            unsigned o1[4], o2[4];
#pragma unroll
            for (int k = 0; k < 4; ++k) { const f32x4 c4 = cs[u][k];
                const float x1a = __uint_as_float(aw[k] << 16), x1b = __uint_as_float(aw[k] & 0xffff0000u), x2a = __uint_as_float(bw[k] << 16), x2b = __uint_as_float(bw[k] & 0xffff0000u);
                o1[k] = pk2(x1a * c4.x - x2a * c4.y, x1b * c4.z - x2b * c4.w); o2[k] = pk2(x1a * c4.y + x2a * c4.x, x1b * c4.w + x2b * c4.z); }
            bf16* dst = (hh < 8 ? QR + (size_t)t * 1024 + hh * 128 : KR + (size_t)t * 256 + (hh - 8) * 128) + i8 * 8;
            *(v4u*)dst = (v4u){o1[0], o1[1], o1[2], o1[3]}; *(v4u*)(dst + 64) = (v4u){o2[0], o2[1], o2[2], o2[3]}; } }
    }
}
__device__ __forceinline__ void hgrn_a_phase(Ctx& F, LAS unsigned char* L) {
    const bf16* PROJ = (const bf16*)(F.ws + WS_PROJ); const float* LB = (const float*)(F.ws + WS_LB); bf16* CS = (bf16*)(F.ws + WS_CS); float* DEC = (float*)(F.ws + WS_DEC);
    LAS unsigned char* KD = L; LAS unsigned char* VV = L + 17408; LAS float* TOT = (LAS float*)(L + 34816);
    const int tid = F.tid, lane = F.lane, w = F.wave, dk0 = 2 * lane;
    const int tro16 = (8 * (lane >> 4) + ((lane & 15) >> 2)) * RS + (lane & 3) * 8;
    unsigned zraw[8]; v4u vr[2]; float lbA = 0.f, lbB = 0.f;
#define HA_LOAD(un) do { const int c_ = (un) & 63, dir_ = ((un) >> 6) & 1, h_ = ((un) >> 7) & 7, b_ = (un) >> 10; const size_t rb_ = (size_t)b_ * SEQ + c_ * 64; \
        { const float2 l2_ = *(const float2*)(LB + dir_ * 1024 + h_ * 128 + dk0); lbA = l2_.x; lbB = l2_.y; } \
        const bf16* zp_ = PROJ + (rb_ + 8 * w) * INW + (dir_ ? C_FB : C_FF) + h_ * 128; \
        _Pragma("unroll") for (int i = 0; i < 8; ++i) zraw[i] = *(const unsigned*)(zp_ + (size_t)i * INW + dk0); \
        _Pragma("unroll") for (int i = 0; i < 2; ++i) { const int idx = tid + 512 * i, row = idx >> 4, ch = idx & 15; vr[i] = *(const v4u*)(PROJ + (rb_ + row) * INW + C_HI + h_ * 128 + ch * 8); } } while (0)
    if ((int)blockIdx.x < 2048) HA_LOAD((int)blockIdx.x);
    for (int unit = blockIdx.x; unit < 2048; unit += F.G) {
        const int dir = (unit >> 6) & 1;
        float lfa[8], lfb[8], ka[8], kb[8];
#pragma unroll
        for (int i = 0; i < 8; ++i) { const float za = __uint_as_float(zraw[i] << 16), zb = __uint_as_float(zraw[i] & 0xffff0000u);
            const float fa = lbA + (1.f - lbA) * sigmoidf_(za), fb = lbB + (1.f - lbB) * sigmoidf_(zb); lfa[i] = __logf(fa); lfb[i] = __logf(fb); ka[i] = 1.f - fa; kb[i] = 1.f - fb; }
#pragma unroll
        for (int i = 0; i < 2; ++i) { const int idx = tid + 512 * i, row = idx >> 4, ch = idx & 15; *(LAS v4u*)(VV + row * RS + ch * 16) = vr[i]; }
        if (unit + F.G < 2048) HA_LOAD(unit + F.G);
        float runa = 0.f, runb = 0.f;
        if (dir == 0) {
#pragma unroll
            for (int i = 0; i < 8; ++i) { runa += lfa[i]; lfa[i] = runa; runb += lfb[i]; lfb[i] = runb; } }
        else {
#pragma unroll
            for (int i = 7; i >= 0; --i) { runa += lfa[i]; lfa[i] = runa; runb += lfb[i]; lfb[i] = runb; } }
        *(LAS f32x2m*)(TOT + w * 128 + dk0) = (f32x2m){runa, runb};
        __syncthreads();
        float totA = 0.f, totB = 0.f, offA = 0.f, offB = 0.f;
#pragma unroll
        for (int p = 0; p < 8; ++p) { const f32x2m t = *(const LAS f32x2m*)(TOT + p * 128 + dk0); totA += t.x; totB += t.y;
            const bool inoff = dir == 0 ? (p < w) : (p > w); offA += inoff ? t.x : 0.f; offB += inoff ? t.y : 0.f; }
#pragma unroll
        for (int i = 0; i < 8; ++i) { const float va = ka[i] * __expf(totA - (lfa[i] + offA)), vb = kb[i] * __expf(totB - (lfb[i] + offB));
            *(LAS unsigned*)(KD + (8 * w + i) * RS + dk0 * 2) = pk2(va, vb); }
        if (w == 0) *(float2*)(DEC + (size_t)unit * 128 + dk0) = make_float2(__expf(totA), __expf(totB));
        __syncthreads();
        f32x4 acc[2][4];
#pragma unroll
        for (int a = 0; a < 2; ++a)
#pragma unroll
            for (int t = 0; t < 4; ++t) acc[a][t] = (f32x4){0.f, 0.f, 0.f, 0.f};
        const int dvb = 32 * (w & 3), dkb = 64 * (w >> 2);
#pragma unroll
        for (int s = 0; s < 2; ++s) {
            bf16x8 af[2], bfr[4];
#pragma unroll
            for (int a = 0; a < 2; ++a) af[a] = tr8(VV + (32 * s) * RS + (dvb + 16 * a) * 2 + tro16, 4 * RS);
#pragma unroll
            for (int t = 0; t < 4; ++t) bfr[t] = tr8(KD + (32 * s) * RS + (dkb + 16 * t) * 2 + tro16, 4 * RS);
#pragma unroll
            for (int a = 0; a < 2; ++a)
#pragma unroll
                for (int t = 0; t < 4; ++t) acc[a][t] = MFMA16(af[a], bfr[t], acc[a][t]);
        }
        bf16* cso = CS + (size_t)unit * 16384;
        const int cc = lane & 15, rg = lane >> 4;
#pragma unroll
        for (int a = 0; a < 2; ++a)
#pragma unroll
            for (int t = 0; t < 4; ++t) { const int dkk = dkb + 16 * t + cc, dv0 = dvb + 16 * a + 4 * rg;
                uint2 o; o.x = cvtpk(acc[a][t][0], acc[a][t][1]); o.y = cvtpk(acc[a][t][2], acc[a][t][3]); *(uint2*)(cso + dkk * 128 + dv0) = o; }
        __syncthreads();
    }
#undef HA_LOAD
}
__device__ __forceinline__ void hgrn_scan_phase(Ctx& F) {
    const bf16* CS = (const bf16*)(F.ws + WS_CS); bf16* ST = (bf16*)(F.ws + WS_STATE); const float* DEC = (const float*)(F.ws + WS_DEC);
    const int NT = F.G * 512;
    for (int gt = blockIdx.x * 512 + F.tid; gt < 32 * 4096; gt += NT) {
        const int g = gt >> 12, e4 = (gt & 4095) * 4, dk = e4 >> 7, dir = g & 1;
        float s0 = 0.f, s1 = 0.f, s2 = 0.f, s3 = 0.f;
        uint2 tn[8]; float dn[8];
#define SC_LOAD(st_) do { _Pragma("unroll") for (int k = 0; k < 8; ++k) { const int c_ = dir ? 63 - ((st_) + k) : (st_) + k; const size_t u_ = (size_t)g * 64 + c_; { const u2v_t t2_ = __builtin_nontemporal_load((const u2v_t*)(CS + u_ * 16384 + e4)); tn[k].x = t2_.x; tn[k].y = t2_.y; } dn[k] = DEC[u_ * 128 + dk]; } } while (0)
        SC_LOAD(0);
        for (int st = 0; st < 64; st += 8) {
            uint2 tmp[8]; float dc[8];
#pragma unroll
            for (int k = 0; k < 8; ++k) { tmp[k] = tn[k]; dc[k] = dn[k]; }
            if (st + 8 < 64) SC_LOAD(st + 8);
#pragma unroll
            for (int k = 0; k < 8; ++k) { const int c = dir ? 63 - (st + k) : st + k; const size_t unit = (size_t)g * 64 + c;
                uint2 o; o.x = pk2(s0, s1); o.y = pk2(s2, s3); *(uint2*)(ST + unit * 16384 + e4) = o;
                s0 = dc[k] * s0 + __uint_as_float(tmp[k].x << 16); s1 = dc[k] * s1 + __uint_as_float(tmp[k].x & 0xffff0000u);
                s2 = dc[k] * s2 + __uint_as_float(tmp[k].y << 16); s3 = dc[k] * s3 + __uint_as_float(tmp[k].y & 0xffff0000u); }
        }
#undef SC_LOAD
    }
}
__device__ __forceinline__ void hgrn_c_phase(Ctx& F, LAS unsigned char* L) {
    const bf16* PROJ = (const bf16*)(F.ws + WS_PROJ); const float* LB = (const float*)(F.ws + WS_LB); const bf16* ST = (const bf16*)(F.ws + WS_STATE); bf16* YAIN = (bf16*)(F.ws + WS_YAIN);
    LAS unsigned char* QI = L; LAS unsigned char* KI = L + 17408; LAS unsigned char* QE = L + 34816; LAS unsigned char* VV = L + 52224; LAS unsigned char* SP = L + 69632; LAS unsigned char* AM = L + 104448;
    LAS float* TOT = (LAS float*)(L + 113664); LAS float* SSQ = (LAS float*)(L + 117760);
    const int tid = F.tid, lane = F.lane, w = F.wave, dk0 = 2 * lane, cc = lane & 15, rg = lane >> 4;
    const int tro16 = (8 * (lane >> 4) + ((lane & 15) >> 2)) * RS + (lane & 3) * 8;
    unsigned zraw[8], qraw[8]; v4u vr[2], sr[4]; float lbA = 0.f, lbB = 0.f;
#define HC_LOAD(un, dr) do { const int c_ = (un) & 63, h_ = ((un) >> 6) & 7, b_ = (un) >> 9; const size_t rb_ = (size_t)b_ * SEQ + c_ * 64; \
        { const float2 l2_ = *(const float2*)(LB + (dr) * 1024 + h_ * 128 + dk0); lbA = l2_.x; lbB = l2_.y; } \
        const bf16* zp_ = PROJ + (rb_ + 8 * w) * INW + h_ * 128; \
        _Pragma("unroll") for (int i = 0; i < 8; ++i) { const bf16* rp_ = zp_ + (size_t)i * INW; zraw[i] = *(const unsigned*)(rp_ + ((dr) ? C_FB : C_FF) + dk0); qraw[i] = *(const unsigned*)(rp_ + C_HQ + dk0); } \
        if ((dr) == 0) { _Pragma("unroll") for (int i = 0; i < 2; ++i) { const int idx = tid + 512 * i, row = idx >> 4, ch = idx & 15; vr[i] = *(const v4u*)(PROJ + (rb_ + row) * INW + C_HI + h_ * 128 + ch * 8); } } \
        { const bf16* sp_ = ST + ((size_t)((b_ * 8 + h_) * 2 + (dr)) * 64 + c_) * 16384; \
          _Pragma("unroll") for (int i = 0; i < 4; ++i) { const int idx = tid + 512 * i; sr[i] = __builtin_nontemporal_load((const v4u*)(sp_ + idx * 8)); } } } while (0)
    if ((int)blockIdx.x < 1024) HC_LOAD((int)blockIdx.x, 0);
    for (int unit = blockIdx.x; unit < 1024; unit += F.G) {
        const int c = unit & 63, h = (unit >> 6) & 7, b = unit >> 9;
        const size_t rb = (size_t)b * SEQ + c * 64;
        f32x4 o[4];
#pragma unroll
        for (int t = 0; t < 4; ++t) o[t] = (f32x4){0.f, 0.f, 0.f, 0.f};
        for (int dir = 0; dir < 2; ++dir) {
            float lfa[8], lfb[8], ka[8], kb[8], qa[8], qb[8];
#pragma unroll
            for (int i = 0; i < 8; ++i) { const float za = __uint_as_float(zraw[i] << 16), zb = __uint_as_float(zraw[i] & 0xffff0000u);
                const float fa = lbA + (1.f - lbA) * sigmoidf_(za), fb = lbB + (1.f - lbB) * sigmoidf_(zb); lfa[i] = __logf(fa); lfb[i] = __logf(fb); ka[i] = 1.f - fa; kb[i] = 1.f - fb;
                qa[i] = siluf_(__uint_as_float(qraw[i] << 16)); qb[i] = siluf_(__uint_as_float(qraw[i] & 0xffff0000u)); }
            if (dir == 0) {
#pragma unroll
                for (int i = 0; i < 2; ++i) { const int idx = tid + 512 * i, row = idx >> 4, ch = idx & 15; *(LAS v4u*)(VV + row * RS + ch * 16) = vr[i]; } }
#pragma unroll
            for (int i = 0; i < 4; ++i) { const int idx = tid + 512 * i, row = idx >> 4, ch = idx & 15; *(LAS v4u*)(SP + row * RS + ch * 16) = sr[i]; }
            if (dir == 0) HC_LOAD(unit, 1); else if (unit + F.G < 1024) HC_LOAD(unit + F.G, 0);
            float runa = 0.f, runb = 0.f;
            if (dir == 0) {
#pragma unroll
                for (int i = 0; i < 8; ++i) { runa += lfa[i]; lfa[i] = runa; runb += lfb[i]; lfb[i] = runb; } }
            else {
#pragma unroll
                for (int i = 7; i >= 0; --i) { runa += lfa[i]; lfa[i] = runa; runb += lfb[i]; lfb[i] = runb; } }
            *(LAS f32x2m*)(TOT + w * 128 + dk0) = (f32x2m){runa, runb};
            __syncthreads();
            {   float offA = 0.f, offB = 0.f, brA = 0.f, brB = 0.f;
#pragma unroll
                for (int p = 0; p < 8; ++p) { const f32x2m t = *(const LAS f32x2m*)(TOT + p * 128 + dk0);
                    const bool inoff = dir == 0 ? (p < w) : (p > w), inref = dir == 0 ? (p < 4) : (p >= 4);
                    offA += inoff ? t.x : 0.f; offB += inoff ? t.y : 0.f; brA += inref ? t.x : 0.f; brB += inref ? t.y : 0.f; }
#pragma unroll
                for (int i = 0; i < 8; ++i) { const float ba = lfa[i] + offA, bb = lfb[i] + offB; const int ro = (8 * w + i) * RS + dk0 * 2;
                    *(LAS unsigned*)(QI + ro) = pk2(qa[i] * __expf(ba - brA), qb[i] * __expf(bb - brB));
                    *(LAS unsigned*)(KI + ro) = pk2(ka[i] * __expf(brA - ba), kb[i] * __expf(brB - bb));
                    *(LAS unsigned*)(QE + ro) = pk2(qa[i] * __expf(ba), qb[i] * __expf(bb)); }
            }
            __syncthreads();
            {
                const int rt = w >> 1, ct0 = 2 * (w & 1);
                f32x4 am[2] = {(f32x4){0.f, 0.f, 0.f, 0.f}, (f32x4){0.f, 0.f, 0.f, 0.f}};
#pragma unroll
                for (int s = 0; s < 4; ++s) { const bf16x8 af = ld8(QI + (16 * rt + cc) * RS + (32 * s + 8 * rg) * 2);
#pragma unroll
                    for (int t = 0; t < 2; ++t) { const bf16x8 bfr = ld8(KI + (16 * (ct0 + t) + cc) * RS + (32 * s + 8 * rg) * 2); am[t] = MFMA16(af, bfr, am[t]); } }
#pragma unroll
                for (int t = 0; t < 2; ++t)
#pragma unroll
                    for (int i = 0; i < 4; ++i) { const int l = 16 * rt + 4 * rg + i, m = 16 * (ct0 + t) + cc; const bool keep = dir == 0 ? (m <= l) : (m >= l);
                        *(LAS bf16*)(AM + l * RSA + m * 2) = f2bf(keep ? am[t][i] : 0.f); }
            }
            __syncthreads();
            {
                const int rt = w & 3, cb = 64 * (w >> 2);
#pragma unroll
                for (int s = 0; s < 2; ++s) { const bf16x8 af = ld8(AM + (16 * rt + cc) * RSA + (32 * s + 8 * rg) * 2);
#pragma unroll
                    for (int t = 0; t < 4; ++t) { const bf16x8 bfr = tr8(VV + (32 * s) * RS + (cb + 16 * t) * 2 + tro16, 4 * RS); o[t] = MFMA16(af, bfr, o[t]); } }
#pragma unroll
                for (int s = 0; s < 4; ++s) { const bf16x8 af = ld8(QE + (16 * rt + cc) * RS + (32 * s + 8 * rg) * 2);
#pragma unroll
                    for (int t = 0; t < 4; ++t) { const bf16x8 bfr = tr8(SP + (32 * s) * RS + (cb + 16 * t) * 2 + tro16, 4 * RS); o[t] = MFMA16(af, bfr, o[t]); } }
            }
            __syncthreads();
        }
        const int rt = w & 3, chh = w >> 2, cb = 64 * chh;
        bf16 hgv[4][4]; float onv[4];
#pragma unroll
        for (int t = 0; t < 4; ++t) { const int dv = cb + 16 * t + cc; onv[t] = F.onorm[h * 128 + dv];
#pragma unroll
            for (int i = 0; i < 4; ++i) hgv[i][t] = PROJ[(rb + 16 * rt + 4 * rg + i) * INW + C_HG + h * 128 + dv]; }
        float ssv[4];
#pragma unroll
        for (int i = 0; i < 4; ++i) { float sq = 0.f;
#pragma unroll
            for (int t = 0; t < 4; ++t) sq += o[t][i] * o[t][i];
            sq += __shfl_xor(sq, 1); sq += __shfl_xor(sq, 2); sq += __shfl_xor(sq, 4); sq += __shfl_xor(sq, 8); ssv[i] = sq; }
        if (cc == 0) {
#pragma unroll
            for (int i = 0; i < 4; ++i) SSQ[chh * 64 + 16 * rt + 4 * rg + i] = ssv[i]; }
        __syncthreads();
        float rr[4];
#pragma unroll
        for (int i = 0; i < 4; ++i) { const int l = 16 * rt + 4 * rg + i; rr[i] = rsqrtf((SSQ[l] + SSQ[64 + l]) * (1.f / 128.f) + EPS); }
#pragma unroll
        for (int i = 0; i < 4; ++i) { const int l = 16 * rt + 4 * rg + i;
#pragma unroll
            for (int t = 0; t < 4; ++t) { const int dv = cb + 16 * t + cc;
                YAIN[(rb + l) * 1024 + h * 128 + dv] = f2bf(o[t][i] * rr[i] * onv[t] * siluf_(bf2f(hgv[i][t]))); } }
        __syncthreads();
    }
#undef HC_LOAD
}
__device__ __forceinline__ void rope8(v4u& a, v4u& bq, const f32x4 (&cs)[4]) {
    const unsigned aw[4] = {a.x, a.y, a.z, a.w}, bw[4] = {bq.x, bq.y, bq.z, bq.w}; unsigned o1[4], o2[4];
#pragma unroll
    for (int k = 0; k < 4; ++k) { const f32x4 c4 = cs[k];
        const float x1a = __uint_as_float(aw[k] << 16), x1b = __uint_as_float(aw[k] & 0xffff0000u), x2a = __uint_as_float(bw[k] << 16), x2b = __uint_as_float(bw[k] & 0xffff0000u);
        o1[k] = pk2(x1a * c4.x - x2a * c4.y, x1b * c4.z - x2b * c4.w); o2[k] = pk2(x1a * c4.y + x2a * c4.x, x1b * c4.w + x2b * c4.z); }
    a = (v4u){o1[0], o1[1], o1[2], o1[3]}; bq = (v4u){o2[0], o2[1], o2[2], o2[3]};
}
__device__ __forceinline__ void attn_phase(Ctx& F, LAS unsigned char* L) {
    const bf16* PROJ = (const bf16*)(F.ws + WS_PROJ); const float* ROPE = (const float*)(F.ws + WS_ROPE); bf16* ATT = (bf16*)(F.ws + WS_ATT);
    LAS unsigned char* KT = L; LAS unsigned char* VT = L + 17408; LAS float* AL = (LAS float*)(L + 34816) + F.wave * 32;
    const int tid = F.tid, lane = F.lane, w = F.wave, q32 = lane & 31, hh = lane >> 5;
    const int tro32 = (4 * hh + ((lane & 15) >> 2)) * RS + (16 * ((lane >> 4) & 1) + 4 * (lane & 3)) * 2;
    const int krow = tid >> 3, kc8 = tid & 7;
    constexpr float C2 = 0.08838834764831845f * LOG2E;
    for (int unit = blockIdx.x; unit < 256; unit += F.G) {
        const int qb = unit & 63, kvh = (unit >> 6) & 1, b = unit >> 7, q0 = qb * 64, h = kvh * 4 + (w >> 1);
        const int qp = q0 + 32 * (w & 1) + q32;
        bf16x8 qf[8];
        {
            const bf16* qptr = PROJ + ((size_t)b * SEQ + qp) * INW + C_AQ + h * 128 + 8 * hh;
            const f32x4* rp = (const f32x4*)(ROPE + (((size_t)b * SEQ + qp) * 64 + 8 * hh) * 2);
#pragma unroll
            for (int s = 0; s < 4; ++s) { v4u x1 = *(const v4u*)(qptr + 16 * s), x2 = *(const v4u*)(qptr + 16 * s + 64);
                f32x4 cs[4];
#pragma unroll
                for (int k = 0; k < 4; ++k) cs[k] = rp[8 * s + k];
                rope8(x1, x2, cs); qf[s] = __builtin_bit_cast(bf16x8, x1); qf[s + 4] = __builtin_bit_cast(bf16x8, x2); }
        }
        float m = F.sink[h] * LOG2E, l = 1.f;
        f32x16 o[4];
#pragma unroll
        for (int d = 0; d < 4; ++d)
#pragma unroll
            for (int r = 0; r < 16; ++r) o[d][r] = 0.f;
        int j = 0; while (j < 5 && (q0 - 128 + 64 * j < 0 || q0 - 128 + 64 * j >= SEQ)) ++j;
        v4u kr[2], vr[2]; f32x4 kcs[4];
#define ATT_LOAD(jj) do { const int kb_ = q0 - 128 + 64 * (jj); \
            { const size_t t_ = (size_t)b * SEQ + kb_ + krow; const bf16* kp_ = PROJ + t_ * INW + C_AK + kvh * 128 + kc8 * 8; kr[0] = *(const v4u*)kp_; kr[1] = *(const v4u*)(kp_ + 64); \
              const f32x4* rp_ = (const f32x4*)(ROPE + (t_ * 64 + kc8 * 8) * 2); _Pragma("unroll") for (int k = 0; k < 4; ++k) kcs[k] = rp_[k]; } \
            _Pragma("unroll") for (int i = 0; i < 2; ++i) { const int idx = tid + 512 * i, row = idx >> 4, ch = idx & 15; \
                vr[i] = *(const v4u*)(PROJ + ((size_t)b * SEQ + kb_ + row) * INW + C_AV + kvh * 128 + ch * 8); } } while (0)
        if (j < 5) ATT_LOAD(j);
        while (j < 5) {
            const int kb = q0 - 128 + 64 * j;
            __syncthreads();
            rope8(kr[0], kr[1], kcs);
            *(LAS v4u*)(KT + krow * RS + kc8 * 16) = kr[0]; *(LAS v4u*)(KT + krow * RS + (kc8 + 8) * 16) = kr[1];
#pragma unroll
            for (int i = 0; i < 2; ++i) { const int idx = tid + 512 * i, row = idx >> 4, ch = idx & 15; *(LAS v4u*)(VT + row * RS + ch * 16) = vr[i]; }
            __syncthreads();
            int jn = j + 1; while (jn < 5 && (q0 - 128 + 64 * jn < 0 || q0 - 128 + 64 * jn >= SEQ)) ++jn;
            if (jn < 5) ATT_LOAD(jn);
            f32x16 p0, p1;
#pragma unroll
            for (int r = 0; r < 16; ++r) { p0[r] = 0.f; p1[r] = 0.f; }
#pragma unroll
            for (int s = 0; s < 8; ++s) { const bf16x8 k0 = ld8(KT + q32 * RS + (16 * s + 8 * hh) * 2), k1 = ld8(KT + (32 + q32) * RS + (16 * s + 8 * hh) * 2);
                p0 = MFMA32(k0, qf[s], p0); p1 = MFMA32(k1, qf[s], p1); }
            float tmax = -INFINITY;
#pragma unroll
            for (int r = 0; r < 16; ++r) { const int d0 = kb + crow(r, hh) - qp;
                p0[r] = ((unsigned)(d0 + 128) <= 256u) ? p0[r] * C2 : -INFINITY; p1[r] = ((unsigned)(d0 + 32 + 128) <= 256u) ? p1[r] * C2 : -INFINITY;
                tmax = fmaxf(tmax, fmaxf(p0[r], p1[r])); }
            tmax = fmaxf(tmax, __shfl_xor(tmax, 32));
            const float mn = fmaxf(m, tmax), alpha = __builtin_amdgcn_exp2f(m - mn); m = mn;
            float rs = 0.f;
#pragma unroll
            for (int r = 0; r < 16; ++r) { p0[r] = __builtin_amdgcn_exp2f(p0[r] - mn); p1[r] = __builtin_amdgcn_exp2f(p1[r] - mn); rs += p0[r] + p1[r]; }
            rs += __shfl_xor(rs, 32);
            l = l * alpha + rs;
            if (hh == 0) AL[q32] = alpha;
            LDS_WAIT();
#pragma unroll
            for (int g4 = 0; g4 < 4; ++g4) { const f32x4 a4 = *(const LAS f32x4*)(AL + 8 * g4 + 4 * hh);
#pragma unroll
                for (int d = 0; d < 4; ++d) { o[d][4 * g4 + 0] *= a4.x; o[d][4 * g4 + 1] *= a4.y; o[d][4 * g4 + 2] *= a4.z; o[d][4 * g4 + 3] *= a4.w; } }
#pragma unroll
            for (int kb2 = 0; kb2 < 2; ++kb2)
#pragma unroll
                for (int s = 0; s < 2; ++s) {
                    unsigned pw[4];
#pragma unroll
                    for (int k = 0; k < 4; ++k) pw[k] = kb2 ? cvtpk(p1[8 * s + 2 * k], p1[8 * s + 2 * k + 1]) : cvtpk(p0[8 * s + 2 * k], p0[8 * s + 2 * k + 1]);
                    const bf16x8 pa = __builtin_bit_cast(bf16x8, (v4u){pw[0], pw[1], pw[2], pw[3]});
#pragma unroll
                    for (int d = 0; d < 4; ++d) { const bf16x8 vf = tr8(VT + (32 * kb2 + 16 * s) * RS + 64 * d + tro32, 8 * RS); o[d] = MFMA32(pa, vf, o[d]); }
                }
            j = jn;
        }
#undef ATT_LOAD
        if (hh == 0) AL[q32] = 1.f / l;
        LDS_WAIT();
#pragma unroll
        for (int g4 = 0; g4 < 4; ++g4) { const f32x4 a4 = *(const LAS f32x4*)(AL + 8 * g4 + 4 * hh); const float av[4] = {a4.x, a4.y, a4.z, a4.w};
#pragma unroll
            for (int i = 0; i < 4; ++i) { const int r = 4 * g4 + i; const int qrow = q0 + 32 * (w & 1) + crow(r, hh);
                bf16* op = ATT + ((size_t)b * SEQ + qrow) * 1024 + h * 128 + q32;
#pragma unroll
                for (int d = 0; d < 4; ++d) op[32 * d] = f2bf(o[d][r] * av[i]); } }
        __syncthreads();
    }
}

#ifdef TESTMODE
__global__ void __launch_bounds__(256) k_rope(const bf16* __restrict__ PROJ, const float* __restrict__ rope, bf16* __restrict__ QR, bf16* __restrict__ KR) {
    const int gid = blockIdx.x * 256 + threadIdx.x;
    const int i = gid & 63, hh = (gid >> 6) % 10, t = gid / 640;
    const float cs = rope[((size_t)t * 64 + i) * 2], sn = rope[((size_t)t * 64 + i) * 2 + 1];
    const bf16* src = PROJ + (size_t)t * INW + (hh < 8 ? C_AQ + hh * 128 : C_AK + (hh - 8) * 128);
    const float x1 = bf2f(src[i]), x2 = bf2f(src[i + 64]);
    bf16* dst = hh < 8 ? QR + (size_t)t * 1024 + hh * 128 : KR + (size_t)t * 256 + (hh - 8) * 128;
    dst[i] = f2bf(x1 * cs - x2 * sn); dst[i + 64] = f2bf(x1 * sn + x2 * cs);
}
__global__ void __launch_bounds__(256) k_hgrn_naive(const bf16* __restrict__ PROJ, const float* __restrict__ lb, float* __restrict__ OF, float* __restrict__ OB) {
    __shared__ float qs[128], fs[128], ks[128], part[128];
    const int dir = blockIdx.x & 1, h = (blockIdx.x >> 1) & 7, b = blockIdx.x >> 4, tid = threadIdx.x, dv = tid & 127, half = tid >> 7;
    float S[64];
#pragma unroll
    for (int i = 0; i < 64; ++i) S[i] = 0.f;
    float* O = dir ? OB : OF;
    const float lbv = tid < 128 ? lb[dir * 1024 + h * 128 + tid] : 0.f;
    bf16 nzq = 0, nzf = 0, nv = 0;
    { const int t = dir ? SEQ - 1 : 0; const bf16* pr = PROJ + ((size_t)b * SEQ + t) * INW;
      if (tid < 128) { nzq = pr[C_HQ + h * 128 + tid]; nzf = pr[(dir ? C_FB : C_FF) + h * 128 + tid]; } nv = pr[C_HI + h * 128 + dv]; }
    for (int tp = 0; tp < SEQ; ++tp) {
        const int t = dir ? SEQ - 1 - tp : tp; const size_t row = (size_t)b * SEQ + t;
        const bf16 czq = nzq, czf = nzf, cv = nv;
        if (tp + 1 < SEQ) { const int t2 = dir ? SEQ - 2 - tp : tp + 1; const bf16* pr = PROJ + ((size_t)b * SEQ + t2) * INW;
            if (tid < 128) { nzq = pr[C_HQ + h * 128 + tid]; nzf = pr[(dir ? C_FB : C_FF) + h * 128 + tid]; } nv = pr[C_HI + h * 128 + dv]; }
        if (tid < 128) { const float zq = bf2f(czq), zf = bf2f(czf);
            const float f = lbv + (1.f - lbv) * sigmoidf_(zf); qs[tid] = siluf_(zq); fs[tid] = f; ks[tid] = 1.f - f; }
        const float v = bf2f(cv);
        __syncthreads();
        float acc = 0.f;
#pragma unroll
        for (int i = 0; i < 64; ++i) { const int dk = half * 64 + i; S[i] = fs[dk] * S[i] + ks[dk] * v; acc += S[i] * qs[dk]; }
        if (half == 1) part[dv] = acc;
        __syncthreads();
        if (half == 0) O[row * 1024 + h * 128 + dv] = acc + part[dv];
    }
}
__global__ void __launch_bounds__(256) k_hgrn_post(const float* __restrict__ OF, const float* __restrict__ OB, const bf16* __restrict__ PROJ, const float* __restrict__ onorm, bf16* __restrict__ YAIN) {
    const int w = blockIdx.x * 4 + (threadIdx.x >> 6), lane = threadIdx.x & 63, row = w >> 3, h = w & 7;
    const size_t o = (size_t)row * 1024 + h * 128;
    const float a0 = OF[o + lane] + OB[o + lane], a1 = OF[o + 64 + lane] + OB[o + 64 + lane];
    float ss = a0 * a0 + a1 * a1;
    for (int s = 32; s > 0; s >>= 1) ss += __shfl_xor(ss, s);
    const float r = rsqrtf(ss * (1.f / 128.f) + EPS);
    const bf16* pg = PROJ + (size_t)row * INW + C_HG + h * 128;
    YAIN[o + lane] = f2bf(a0 * r * onorm[h * 128 + lane] * siluf_(bf2f(pg[lane])));
    YAIN[o + 64 + lane] = f2bf(a1 * r * onorm[h * 128 + 64 + lane] * siluf_(bf2f(pg[64 + lane])));
}
__global__ void __launch_bounds__(256) k_attn_naive(const bf16* __restrict__ QR, const bf16* __restrict__ KR, const bf16* __restrict__ PROJ, const float* __restrict__ sink, bf16* __restrict__ ATT) {
    __shared__ float sl[4][264];
    const int wv = threadIdx.x >> 6, lane = threadIdx.x & 63;
    const int w = blockIdx.x * 4 + wv;
    const int i = w & 4095, h = (w >> 12) & 7, b = w >> 15, kvh = h >> 2;
    const size_t qrow = (size_t)b * SEQ + i;
    const float q0 = bf2f(QR[qrow * 1024 + h * 128 + 2 * lane]), q1 = bf2f(QR[qrow * 1024 + h * 128 + 2 * lane + 1]);
    const int jlo = i - 128 < 0 ? 0 : i - 128, jhi = i + 128 > SEQ - 1 ? SEQ - 1 : i + 128;
    const float sk = sink[h];
    float m = sk;
    for (int j = jlo; j <= jhi; ++j) {
        const bf16* kr = KR + ((size_t)b * SEQ + j) * 256 + kvh * 128;
        float p = q0 * bf2f(kr[2 * lane]) + q1 * bf2f(kr[2 * lane + 1]);
        for (int s = 32; s > 0; s >>= 1) p += __shfl_xor(p, s);
        p *= 0.08838834764831845f;
        if (lane == 0) sl[wv][j - jlo] = p;
        m = fmaxf(m, p);
    }
    __syncthreads();
    float den = expf(sk - m), o0 = 0.f, o1 = 0.f;
    for (int j = jlo; j <= jhi; ++j) {
        const float p = expf(sl[wv][j - jlo] - m); den += p;
        const bf16* vr = PROJ + ((size_t)b * SEQ + j) * INW + C_AV + kvh * 128;
        o0 += p * bf2f(vr[2 * lane]); o1 += p * bf2f(vr[2 * lane + 1]);
    }
    ATT[qrow * 1024 + h * 128 + 2 * lane] = f2bf(o0 / den); ATT[qrow * 1024 + h * 128 + 2 * lane + 1] = f2bf(o1 / den);
}
#endif
__global__ void __launch_bounds__(NWAVES * 64, 2) mega(Args args) {
    extern __shared__ __attribute__((aligned(16))) unsigned char lds[];
    Ctx F;
    F.lds = lds; F.tid = threadIdx.x; F.lane = F.tid & 63; F.wave = __builtin_amdgcn_readfirstlane(F.tid >> 6); F.G = gridDim.x;
    F.gw = blockIdx.x * NWAVES + F.wave; F.NGW = F.G * NWAVES;
    F.x = (const float*)args.in[0]; F.c = (const float*)args.in[1]; F.pos = (const int*)args.in[2]; F.w_ada = (const float*)args.in[3]; F.b_ada = (const float*)args.in[4];
    F.g_pre_mix = (const float*)args.in[5]; F.g_post_mix = (const float*)args.in[6]; F.g_pre_ffn = (const float*)args.in[7]; F.g_post_ffn = (const float*)args.in[8];
    F.w_in = (const float*)args.in[9]; F.lbl = (const float*)args.in[10]; F.onorm = (const float*)args.in[11]; F.sink = (const float*)args.in[12];
    F.w_a = (const float*)args.in[13]; F.w_b = (const float*)args.in[14]; F.w_o = (const float*)args.in[15]; F.w_router = (const float*)args.in[16];
    F.w_eg = (const float*)args.in[17]; F.w_eu = (const float*)args.in[18]; F.w_ed = (const float*)args.in[19];
    F.out = args.out; F.ws = args.ws;
    LAS unsigned char* ldsl = (LAS unsigned char*)lds;
    for (int u = F.tid; u < (LDS_BYTES - LDSCTL_OFF) / 4; u += NWAVES * 64) ((LAS unsigned*)(ldsl + LDSCTL_OFF))[u] = 0u;
    __syncthreads();
    volatile LAS unsigned* MISC = (volatile LAS unsigned*)(ldsl + MISC_OFF);
    XcdBarrier bar = xcd_barrier_post((unsigned*)(args.ws + WS_CTL) + CW_BAR + args.li * XCD_BAR_WORDS, MISC + 8);
    const int lo = args.ph_lo, hi = args.ph_hi;
#ifdef PROBE_REP
#define REP(k) ((((PROBE_REP) >> (k)) & 1) ? 2 : 1)
#else
#define REP(k) 1
#endif
#define IN(k) (lo <= (k) && (k) < hi)
#define SEAM(k) do { if (IN(k) && IN((k) + 1)) xcd_barrier(bar); } while (0)
    unsigned char* ws = args.ws;
    bf16* H = (bf16*)(ws + WS_H); bf16* PROJ = (bf16*)(ws + WS_PROJ); bf16* WIN = (bf16*)(ws + WS_WIN); bf16* WA = (bf16*)(ws + WS_WA); bf16* WB = (bf16*)(ws + WS_WB); bf16* WO = (bf16*)(ws + WS_WO);
    bf16* WGU = (bf16*)(ws + WS_WGU); bf16* WD = (bf16*)(ws + WS_WD); bf16* YAIN = (bf16*)(ws + WS_YAIN); bf16* ATT = (bf16*)(ws + WS_ATT); bf16* MERGED = (bf16*)(ws + WS_MERGED);
    float* Y = (float*)(ws + WS_Y); bf16* XE = (bf16*)(ws + WS_XE); bf16* ACT = (bf16*)(ws + WS_ACT); bf16* SLAB = (bf16*)(ws + WS_SLAB); const float* SELAFF = (const float*)(ws + WS_SELAFF);
    const int vcu = (F.G % 8 == 0) ? ((int)blockIdx.x % 8) * (F.G / 8) + (int)blockIdx.x / 8 : (int)blockIdx.x;

    {
    if (IN(0)) { p0_prep(F); __syncthreads(); } SEAM(0);
#if defined(PROBE_DUP) && PROBE_DUP == 0
    if (IN(0)) { p0_prep(F); __syncthreads(); } SEAM(0);
#endif
    }
    {
    if (IN(2)) {
        if (F.G == 256 && blockIdx.x >= 256 - CONV_BLOCKS) { float* scr = (float*)(F.lds + F.wave * 16384); TailSeq seq{I_MIX + P0_EXPERT_ITEMS + ((int)blockIdx.x - (256 - CONV_BLOCKS)) * NWAVES + F.wave, CONV_BLOCKS * NWAVES}; transpose_stream(F, seq, scr); }
        else {
            const int gg = F.G == 256 ? 256 - CONV_BLOCKS : F.G;
            pg8::Gemm g{H, WIN, T, INW, D}; pg8::StaticOrder S; S.init(T, INW, gg, (int)blockIdx.x);
            pg8::EpiStore E{PROJ, INW, 0xffff, nullptr};
            pg8::gemm_phase<pg8::EpiStore, pg8::StaticOrder, PG8_ALIGN, PG8_SP2>(ldsl + RING_OFF, g, S, E);
            if (F.G != 256 && blockIdx.x == 0) { float* scr = (float*)(F.lds + F.wave * 16384); TailSeq seq{I_MIX + P0_EXPERT_ITEMS + F.wave, NWAVES}; transpose_stream(F, seq, scr); }
        }
    } SEAM(2);
    }
    {
    if (IN(3)) { if (args.mask & 2) hgrn_a_phase(F, ldsl); } SEAM(3);
#if defined(PROBE_DUP) && PROBE_DUP == 3
    if (IN(3)) { if (args.mask & 2) hgrn_a_phase(F, ldsl); } SEAM(3);
#endif
    }
    {
    if (IN(4)) { if (args.mask & 2) hgrn_scan_phase(F); if (args.mask & 1) attn_phase(F, ldsl); } SEAM(4);
#if defined(PROBE_DUP) && PROBE_DUP == 4
    if (IN(4)) { if (args.mask & 2) hgrn_scan_phase(F); if (args.mask & 1) attn_phase(F, ldsl); } SEAM(4);
#endif
    }
    {
    if (IN(5)) { if (args.mask & 2) hgrn_c_phase(F, ldsl); } SEAM(5);
#if defined(PROBE_DUP) && PROBE_DUP == 5
    if (IN(5)) { if (args.mask & 2) hgrn_c_phase(F, ldsl); } SEAM(5);
#endif
    }
    {
    if (IN(6)) {
        static_assert(WS_ATT == WS_YAIN + 16 * MiB && WS_WB == WS_WA + 4 * MiB, "branch operands must be contiguous");
        pg8::Gemm g{YAIN, WA, 2 * T, 2 * D, 1024}; pg8::BranchOrder S; S.S.init(T, D, F.G, (int)blockIdx.x);
        pg8::EpiGate2 E{MERGED, D, PROJ + C_GA, PROJ + C_GB, INW};
        pg8::gemm_phase<pg8::EpiGate2, pg8::BranchOrder, PG8_ALIGN, PG8_SP2>(ldsl + RING_OFF, g, S, E);
    } SEAM(6);
    }
    {
    if (IN(7)) {
        pg8::Gemm g{MERGED, WO, T, D, D}; pg8::StaticOrder S; S.init(T, D, F.G, (int)blockIdx.x);
        pg8::EpiStore E{(bf16*)Y, D, 0xffff, nullptr};
        pg8::gemm_phase<pg8::EpiStore, pg8::StaticOrder, PG8_ALIGN, PG8_SP2>(ldsl + RING_OFF, g, S, E);
    } SEAM(7);
#if defined(PROBE_DUP) && PROBE_DUP == 7
    if (IN(7)) {
        pg8::Gemm g{MERGED, WO, T, D, D}; pg8::StaticOrder S; S.init(T, D, F.G, (int)blockIdx.x);
        pg8::EpiStore E{(bf16*)Y, D, 0xffff, nullptr};
        pg8::gemm_phase<pg8::EpiStore, pg8::StaticOrder, PG8_ALIGN, PG8_SP2>(ldsl + RING_OFF, g, S, E);
    } SEAM(7);
#endif
    }
    {
    if (IN(8)) { p6_post1(F); } SEAM(8);
#if defined(PROBE_DUP) && PROBE_DUP == 8
    if (IN(8)) { p6_post1(F); } SEAM(8);
#endif
    }
    {
    if (IN(9)) { p7_topk_gather(F); } SEAM(9);
#if defined(PROBE_DUP) && PROBE_DUP == 9
    if (IN(9)) { p7_topk_gather(F); } SEAM(9);
#endif
    }
    {
    if (IN(10)) {
        pg8::Gemm g{(const bf16*)(ws + WS_H2), WGU, 16 * 1024, 16 * 2048, D / 2, (const int*)(ws + WS_GIDX)}; pg8::GroupedOrder S{F.G, vcu};
        pg8::EpiSwiglu8 E{(unsigned char*)ACT, 1.f / W8S_GU};
        pg8::gemm_phase<pg8::EpiSwiglu8, pg8::GroupedOrder, PG8_ALIGN, PG8_SP2, true, true>(ldsl + RING_OFF, g, S, E);
    } SEAM(10);
    }
    {
    if (IN(11)) {
        pg8::Gemm g{ACT, WD, 16 * 1024, 16 * 2048, 1024 / 2}; pg8::GroupedOrder S{F.G, vcu};
        pg8::EpiStore E{SLAB, D, 7, SELAFF, 1.f / W8S_D};
        pg8::gemm_phase<pg8::EpiStore, pg8::GroupedOrder, PG8_ALIGN, PG8_SP2, false, true>(ldsl + RING_OFF, g, S, E);
    } SEAM(11);
    }
    {
    if (IN(12)) { p10_final(F); }
    }
#undef IN
#undef SEAM
}

extern "C" void kernel_launch(void* const* d_in, const int* in_sizes, int n_in, void* d_out, int out_size, void* d_ws, size_t ws_size, hipStream_t stream) {
    static int grid = 0;
    if (grid == 0) {
        if (n_in != 20 || ws_size < WS_END) { fprintf(stderr, "kernel_launch: unexpected n_in %d or ws_size %zu\n", n_in, ws_size); grid = -1; return; }
        int dev = 0, cus = 0;
        if (hipGetDevice(&dev) != hipSuccess || hipDeviceGetAttribute(&cus, hipDeviceAttributeMultiprocessorCount, dev) != hipSuccess) { grid = -1; return; }
        if (hipFuncSetAttribute((const void*)mega, hipFuncAttributeMaxDynamicSharedMemorySize, LDS_BYTES) != hipSuccess) { fprintf(stderr, "kernel_launch: hipFuncSetAttribute failed\n"); grid = -1; return; }
        grid = cus;
    }
    if (grid < 0) return;
    char* ws = (char*)d_ws;
    (void)hipMemsetAsync(ws + WS_CTL, 0, CTL_ZERO_BYTES, stream);
    Args a{};
    for (int i = 0; i < 20; ++i) a.in[i] = d_in[i];
    a.out = (float*)d_out; a.ws = (unsigned char*)d_ws;
#ifndef TESTMODE
    a.ph_lo = 0; a.ph_hi = 13; a.li = 0; a.mask = 3;
#ifdef PROBE_REPEAT
    a.rep = PROBE_REPEAT;
#else
    a.rep = -1;
#endif
    hipLaunchKernelGGL(mega, dim3(grid), dim3(NWAVES * 64), LDS_BYTES, stream, a);
#ifdef PROBE_LO
    a.ph_lo = PROBE_LO; a.ph_hi = PROBE_HI; a.li = 1; a.mask = PROBE_MASK;
    hipLaunchKernelGGL(mega, dim3(grid), dim3(NWAVES * 64), LDS_BYTES, stream, a);
#endif
#else
    const float* LB = (const float*)(ws + WS_LB); const float* ROPE = (const float*)(ws + WS_ROPE);
    bf16* PROJ = (bf16*)(ws + WS_PROJ); bf16* QR = (bf16*)(ws + WS_QR); bf16* KR = (bf16*)(ws + WS_KR); bf16* YAIN = (bf16*)(ws + WS_YAIN); bf16* ATT = (bf16*)(ws + WS_ATT);
    float* OF = (float*)(ws + WS_CS); float* OB = (float*)(ws + WS_CS + 32 * MiB);
    a.ph_lo = 0; a.ph_hi = 3; a.li = 0; a.mask = 3;
    hipLaunchKernelGGL(mega, dim3(grid), dim3(NWAVES * 64), LDS_BYTES, stream, a);
#if TESTMODE == 1
    k_hgrn_naive<<<32, 256, 0, stream>>>(PROJ, LB, OF, OB);
    k_hgrn_post<<<T * 8 / 4, 256, 0, stream>>>(OF, OB, PROJ, (const float*)d_in[11], YAIN);
    a.ph_lo = 3; a.ph_hi = 6; a.li = 1; a.mask = 1;
    hipLaunchKernelGGL(mega, dim3(grid), dim3(NWAVES * 64), LDS_BYTES, stream, a);
#else
    k_rope<<<T * 640 / 256, 256, 0, stream>>>(PROJ, ROPE, QR, KR);
    k_attn_naive<<<BATCH * 8 * SEQ / 4, 256, 0, stream>>>(QR, KR, PROJ, (const float*)d_in[12], ATT);
    a.ph_lo = 3; a.ph_hi = 6; a.li = 1; a.mask = 2;
    hipLaunchKernelGGL(mega, dim3(grid), dim3(NWAVES * 64), LDS_BYTES, stream, a);
#endif
    a.ph_lo = 6; a.ph_hi = 13; a.li = 2; a.mask = 3;
    hipLaunchKernelGGL(mega, dim3(grid), dim3(NWAVES * 64), LDS_BYTES, stream, a);
#endif
}
```

```cpp
#include <hip/hip_runtime.h>
#include <cstdint>
#include <cstdio>

constexpr int D = 2048, BATCH = 2, SEQ = 4096, T = BATCH * SEQ;
constexpr int INW = 10752;
constexpr int C_HQ = 0, C_FF = 1024, C_FB = 2048, C_HI = 3072, C_HG = 4096, C_AQ = 5120, C_AK = 6144, C_AV = 6400, C_GA = 6656, C_GB = 8704;
constexpr int NE = 16, EFF = 1024, CAP = 512;
constexpr float EPS = 1e-6f;

typedef unsigned short bf16;
__device__ __forceinline__ float bf2f(bf16 v) { return __uint_as_float(((unsigned)v) << 16); }
typedef float f32x2h_t __attribute__((ext_vector_type(2))); typedef __bf16 bf16x2h_t __attribute__((ext_vector_type(2)));
__device__ __forceinline__ unsigned cvtpk2(float lo, float hi) { const f32x2h_t v = {lo, hi}; const bf16x2h_t b = __builtin_convertvector(v, bf16x2h_t); return __builtin_bit_cast(unsigned, b); }
__device__ __forceinline__ bf16 f2bf(float f) { return (bf16)(cvtpk2(f, 0.f) & 0xffffu); }
__device__ __forceinline__ float sigmoidf_(float x) { return __builtin_amdgcn_rcpf(1.f + __expf(-x)); }
__device__ __forceinline__ float siluf_(float x) { return x * __builtin_amdgcn_rcpf(1.f + __expf(-x)); }

constexpr size_t MiB = 1u << 20;
constexpr size_t WS_CTL = 0, CTL_ZERO_BYTES = 64 * 1024;
constexpr size_t WS_MOD = 1 * MiB;
constexpr size_t WS_LB = WS_MOD + 128 * 1024;
constexpr size_t WS_AFF = 2 * MiB;
constexpr size_t WS_GIDX = 3 * MiB;
constexpr size_t WS_SELAFF = WS_GIDX + 128 * 1024;
constexpr size_t WS_TOKSLOT = 4 * MiB;
constexpr size_t WS_DEC = 5 * MiB;
constexpr size_t WS_ROPE = 8 * MiB;
constexpr size_t WS_WIN = 16 * MiB;
constexpr size_t WS_WA = 60 * MiB, WS_WB = 64 * MiB, WS_WO = 68 * MiB;
constexpr size_t WS_WGU = 76 * MiB;
constexpr size_t WS_WD = 204 * MiB;
constexpr size_t WS_H = 268 * MiB;
constexpr size_t WS_PROJ = 300 * MiB;
constexpr size_t WS_Y = 520 * MiB;
constexpr size_t WS_XE = 300 * MiB;
constexpr size_t WS_ACT = 364 * MiB;
constexpr size_t WS_SLAB = 396 * MiB;
constexpr size_t WS_QR = 468 * MiB, WS_KR = 484 * MiB;
constexpr size_t WS_YAIN = 488 * MiB, WS_ATT = 504 * MiB;
constexpr size_t WS_CS = 520 * MiB;
constexpr size_t WS_STATE = 584 * MiB;
constexpr size_t WS_H2 = 584 * MiB;
constexpr size_t WS_MERGED = 268 * MiB;
constexpr size_t WS_END = 648 * MiB;
constexpr int CW_BAR = 4096;

namespace pg8 {
#define PG8_LAS __attribute__((address_space(3)))
typedef unsigned short bf16_t;
typedef short bf16x8 __attribute__((ext_vector_type(8)));
typedef float f32x4 __attribute__((ext_vector_type(4)));
typedef unsigned u32x4 __attribute__((ext_vector_type(4)));
constexpr int BM = 256, BK = 64, HALF = 128, HTB = HALF * BK * 2  , STAGE_BYTES = 8 * HTB, NXCD = 8, WGM = 8;

__host__ __device__ __forceinline__ int lds_byte(int r, int c) { const int st = (r >> 4) * 2 + (c >> 5), rr = r & 15, cc = c & 31, ob = rr * 64 + cc * 2; return st * 1024 + (ob ^ (((ob >> 9) & 1) << 5)); }
__host__ __device__ __forceinline__ void stage_rc(int b, int& R, int& C) { const int st = b / 1024, sb = b % 1024, swz = sb ^ (((sb >> 9) & 1) << 5); R = (st >> 1) * 16 + swz / 64; C = (st & 1) * 32 + (swz % 64) / 2; }
__host__ __device__ __forceinline__ int perm32(int rho) { const int n = rho >> 4, i = rho & 15; return 8 * (i >> 2) + 4 * n + (i & 3); }

struct Unit { int pm, pn; };
struct Gemm { const bf16_t* A; const bf16_t* Bt; int M, N, K; const int* gidx = nullptr; };

struct StaticOrder {
    int nM, nN, nwg, G, c;
    __host__ __device__ void init(int M, int N, int G_, int c_) { nM = M / BM; nN = N / BM; nwg = nM * nN; G = G_; c = c_; }
    __host__ __device__ bool next(int i, Unit& u) const {
        const long L = (long)i * G + c; if (L >= nwg) return false;
        int wgid = (int)L; { const int q = nwg / NXCD, r = nwg % NXCD, xcd = wgid % NXCD, off = wgid / NXCD; wgid = (xcd < r ? xcd * (q + 1) : r * (q + 1) + (xcd - r) * q) + off; }
        const int nig = WGM * nN, gid = wgid / nig, fm = gid * WGM, gsz = (nM - fm) < WGM ? (nM - fm) : WGM;
        u.pm = fm + ((wgid % nig) % gsz); u.pn = (wgid % nig) / gsz; return true;
    }
    __device__ __forceinline__ void a_ready(const Unit&) const {}
    __device__ __forceinline__ void done(const Unit&) const {}
};

typedef float f32x2c_t __attribute__((ext_vector_type(2))); typedef __bf16 bf16x2c_t __attribute__((ext_vector_type(2)));
__device__ __forceinline__ unsigned cvt_pk_bf16(float lo, float hi) { const f32x2c_t v = {lo, hi}; const bf16x2c_t b = __builtin_convertvector(v, bf16x2c_t); return __builtin_bit_cast(unsigned, b); }
typedef float f32x2 __attribute__((ext_vector_type(2)));

typedef unsigned u32x2 __attribute__((ext_vector_type(2)));
struct EpiStore {
    static constexpr bool PERM = true, AFTER_DRAIN = false;
    bf16_t* O; int ldc; int cmask; const float* rowscale; float osc = 1.f;
    __device__ __forceinline__ void operator()(const f32x4 (&acc)[2][2][4][2], const Unit& u, int wr, int wc, int fr, int fq) const {
        const int row0 = u.pm * BM + wr * 64 + fr, col0 = (u.pn & cmask) * BM + wc * 32 + 8 * fq;
        float scv[8];
#pragma unroll
        for (int q = 0; q < 8; ++q) scv[q] = (rowscale ? rowscale[row0 + (q >> 2) * HALF + (q & 3) * 16] : 1.f) * osc;
#pragma unroll
        for (int ai = 0; ai < 2; ++ai)
#pragma unroll
            for (int m = 0; m < 4; ++m) { const int row = row0 + ai * HALF + m * 16; const float sc = scv[ai * 4 + m]; bf16_t* rowp = O + (size_t)row * ldc + col0;
#pragma unroll
                for (int bj = 0; bj < 2; ++bj) { const f32x4 v0 = acc[ai][bj][m][0] * sc, v1 = acc[ai][bj][m][1] * sc;
                    u32x4 w; w.x = cvt_pk_bf16(v0[0], v0[1]); w.y = cvt_pk_bf16(v0[2], v0[3]); w.z = cvt_pk_bf16(v1[0], v1[1]); w.w = cvt_pk_bf16(v1[2], v1[3]);
                    *(u32x4*)(rowp + bj * HALF) = w; } }
    }
};
__device__ __forceinline__ float sigm(float x) { return __builtin_amdgcn_rcpf(1.f + __expf(-x)); }
struct EpiGate2 {
    static constexpr bool PERM = true, AFTER_DRAIN = false;
    bf16_t* O; int ldc; const bf16_t* Ga; const bf16_t* Gb; int ldg;
    __device__ __forceinline__ void operator()(const f32x4 (&acc)[2][2][4][2], const Unit& u, int wr, int wc, int fr, int fq) const {
        const bool second = u.pm >= 32; const bf16_t* G = second ? Gb : Ga;
        const int row0 = (u.pm & 31) * BM + wr * 64 + fr, col0 = (u.pn & 7) * BM + wc * 32 + 8 * fq;
        u32x4 gcur[2], tcur[2], gnxt[2], tnxt[2];
#define EG2_LOAD(gd, td, q) do { const int row_ = row0 + ((q) >> 2) * HALF + ((q) & 3) * 16; _Pragma("unroll") for (int bj = 0; bj < 2; ++bj) { \
            gd[bj] = *(const u32x4*)(G + (size_t)row_ * ldg + col0 + bj * HALF); td[bj] = second ? *(const u32x4*)(O + (size_t)row_ * ldc + col0 + bj * HALF) : (u32x4){0u, 0u, 0u, 0u}; } } while (0)
        EG2_LOAD(gcur, tcur, 0);
#pragma unroll
        for (int q = 0; q < 8; ++q) { const int ai = q >> 2, m = q & 3, row = row0 + ai * HALF + m * 16;
            if (q < 7) EG2_LOAD(gnxt, tnxt, q + 1);
#pragma unroll
            for (int bj = 0; bj < 2; ++bj) { const int col = col0 + bj * HALF; const u32x4 g = gcur[bj], tq = tcur[bj];
                const float gg[8] = {__uint_as_float(g.x << 16), __uint_as_float(g.x & 0xffff0000u), __uint_as_float(g.y << 16), __uint_as_float(g.y & 0xffff0000u),
                                     __uint_as_float(g.z << 16), __uint_as_float(g.z & 0xffff0000u), __uint_as_float(g.w << 16), __uint_as_float(g.w & 0xffff0000u)};
                const float t[8] = {__uint_as_float(tq.x << 16), __uint_as_float(tq.x & 0xffff0000u), __uint_as_float(tq.y << 16), __uint_as_float(tq.y & 0xffff0000u),
                                    __uint_as_float(tq.z << 16), __uint_as_float(tq.z & 0xffff0000u), __uint_as_float(tq.w << 16), __uint_as_float(tq.w & 0xffff0000u)};
                const f32x4 a0 = acc[ai][bj][m][0], a1 = acc[ai][bj][m][1];
                float o[8];
#pragma unroll
                for (int i = 0; i < 4; ++i) { o[i] = t[i] + sigm(gg[i]) * a0[i]; o[4 + i] = t[4 + i] + sigm(gg[4 + i]) * a1[i]; }
                u32x4 w; w.x = cvt_pk_bf16(o[0], o[1]); w.y = cvt_pk_bf16(o[2], o[3]); w.z = cvt_pk_bf16(o[4], o[5]); w.w = cvt_pk_bf16(o[6], o[7]);
                *(u32x4*)(O + (size_t)row * ldc + col) = w; }
#pragma unroll
            for (int bj = 0; bj < 2; ++bj) { gcur[bj] = gnxt[bj]; tcur[bj] = tnxt[bj]; } }
#undef EG2_LOAD
    }
};
struct BranchOrder {
    StaticOrder S;
    __device__ __forceinline__ bool next(int i, Unit& u) const { Unit t; if (!S.next(i >> 1, t)) return false; u.pm = t.pm + 32 * (i & 1); u.pn = t.pn + 8 * (i & 1); return true; }
    __device__ __forceinline__ void a_ready(const Unit&) const {}
    __device__ __forceinline__ void done(const Unit&) const {}
};
struct EpiF32 {
    static constexpr bool PERM = true, AFTER_DRAIN = false;
    float* O; int ldc;
    __device__ __forceinline__ void operator()(const f32x4 (&acc)[2][2][4][2], const Unit& u, int wr, int wc, int fr, int fq) const {
        const int row0 = u.pm * BM + wr * 64 + fr, col0 = u.pn * BM + wc * 32 + 8 * fq;
#pragma unroll
        for (int ai = 0; ai < 2; ++ai)
#pragma unroll
            for (int m = 0; m < 4; ++m) { float* rowp = O + (size_t)(row0 + ai * HALF + m * 16) * ldc + col0;
#pragma unroll
                for (int bj = 0; bj < 2; ++bj) { *(f32x4*)(rowp + bj * HALF) = acc[ai][bj][m][0]; *(f32x4*)(rowp + bj * HALF + 4) = acc[ai][bj][m][1]; } }
    }
};
__device__ __forceinline__ unsigned pk4_fp8(float a, float b, float c, float d) { int w = __builtin_amdgcn_cvt_pk_fp8_f32(a, b, 0, false); w = __builtin_amdgcn_cvt_pk_fp8_f32(c, d, w, true); return (unsigned)w; }
struct EpiSwiglu8 {
    static constexpr bool PERM = true, AFTER_DRAIN = false;
    unsigned char* O; float isc;
    __device__ __forceinline__ void operator()(const f32x4 (&acc)[2][2][4][2], const Unit& u, int wr, int wc, int fr, int fq) const {
        const int row0 = u.pm * BM + wr * 64 + fr, col0 = (u.pn & 7) * HALF + wc * 32 + 8 * fq;
#pragma unroll
        for (int ai = 0; ai < 2; ++ai)
#pragma unroll
            for (int m = 0; m < 4; ++m) { unsigned char* rowp = O + (size_t)(row0 + ai * HALF + m * 16) * 1024 + col0;
                float o[8];
#pragma unroll
                for (int n = 0; n < 2; ++n)
#pragma unroll
                    for (int i = 0; i < 4; ++i) { const float g = acc[ai][0][m][n][i] * isc, up = acc[ai][1][m][n][i] * isc; o[4 * n + i] = g * sigm(g) * up; }
                u32x2 w; w.x = pk4_fp8(o[0], o[1], o[2], o[3]); w.y = pk4_fp8(o[4], o[5], o[6], o[7]);
                *(u32x2*)rowp = w; }
    }
};
struct EpiSwiglu {
    static constexpr bool PERM = true, AFTER_DRAIN = false;
    bf16_t* O;
    __device__ __forceinline__ void operator()(const f32x4 (&acc)[2][2][4][2], const Unit& u, int wr, int wc, int fr, int fq) const {
        const int row0 = u.pm * BM + wr * 64 + fr, col0 = (u.pn & 7) * HALF + wc * 32 + 8 * fq;
#pragma unroll
        for (int ai = 0; ai < 2; ++ai)
#pragma unroll
            for (int m = 0; m < 4; ++m) { bf16_t* rowp = O + (size_t)(row0 + ai * HALF + m * 16) * 1024 + col0;
                float o[8];
#pragma unroll
                for (int n = 0; n < 2; ++n)
#pragma unroll
                    for (int i = 0; i < 4; ++i) { const float g = acc[ai][0][m][n][i], up = acc[ai][1][m][n][i]; o[4 * n + i] = g * sigm(g) * up; }
                u32x4 w; w.x = cvt_pk_bf16(o[0], o[1]); w.y = cvt_pk_bf16(o[2], o[3]); w.z = cvt_pk_bf16(o[4], o[5]); w.w = cvt_pk_bf16(o[6], o[7]);
                *(u32x4*)rowp = w; }
    }
};
struct GroupedOrder {
    int G, c;
    __device__ __forceinline__ bool next(int i, Unit& u) const { const int L = i * G + c; if (L >= 512) return false; const int e = L >> 5, r = L & 31; u.pm = e * 4 + (r & 3); u.pn = e * 8 + (r >> 2); return true; }
    __device__ __forceinline__ void a_ready(const Unit&) const {}
    __device__ __forceinline__ void done(const Unit&) const {}
};

typedef int v8i32 __attribute__((ext_vector_type(8)));
typedef int v4i32 __attribute__((ext_vector_type(4)));
__device__ __forceinline__ void mfma_f8(f32x4& acc, const v8i32& a, const v8i32& b, int sc) {
    asm volatile("v_mfma_scale_f32_16x16x128_f8f6f4 %0, %1, %2, %0, %3, %3 op_sel_hi:[0,0,0]" : "+v"(acc) : "v"(a), "v"(b), "v"(sc));
}
template <class Epi, class Sched, bool ALIGN_EPI = false, bool SP2 = false, bool GATHER = false, bool FP8 = false>
__device__ __forceinline__ void gemm_phase(PG8_LAS unsigned char* lds, const Gemm g, const Sched& S, const Epi& E) {
    const int tid = threadIdx.x, wid = __builtin_amdgcn_readfirstlane(tid >> 6), lane = tid & 63, wr = wid >> 2, wc = wid & 3, fr = lane & 15, fq = lane >> 4;
    const int K = g.K, nt = K / BK;
    unsigned voffA[2], voffB[2]; int Rr[2], Cc[2];
#pragma unroll
    for (int i = 0; i < 2; ++i) { int R, C; stage_rc(tid * 16 + i * 8192, R, C); const int Rb = Epi::PERM ? ((R & ~31) + perm32(R & 31)) : R; Rr[i] = R; Cc[i] = C;
        voffA[i] = (unsigned)(R * K + C) * 2u; voffB[i] = (unsigned)(Rb * K + C) * 2u; }
    unsigned cv0[2], cv1[2], nv0[2], nv1[2], sv0[2], sv1[2];
#define PG8_GOFF(o0, o1, pm_) do { _Pragma("unroll") for (int _i = 0; _i < 2; ++_i) { \
        o0[_i] = (unsigned)(g.gidx[(pm_) * BM + Rr[_i]] * K + Cc[_i]) * 2u; o1[_i] = (unsigned)(g.gidx[(pm_) * BM + HALF + Rr[_i]] * K + Cc[_i]) * 2u; } } while (0)
    const size_t kstep = (size_t)(BK * 2);
    const size_t hstep = (size_t)HALF * K * 2;
    const size_t tstep = 2 * hstep;
    const unsigned ldsw = (unsigned)wid * 1024u;
    const int aoff = FP8 ? lds_byte(wr * 64 + fr, fq * 16) : lds_byte(wr * 64 + fr, fq * 8), boff = FP8 ? lds_byte(wc * 32 + fr, fq * 16) : lds_byte(wc * 32 + fr, fq * 8);
#define PG8_SA(b, h) (((b) * 2 + (h)) * HTB)
#define PG8_SB(b, h) ((4 + (b) * 2 + (h)) * HTB)
#define PG8_STAGE(bufoff, gbase, voff) do { _Pragma("unroll") for (int _i = 0; _i < 2; ++_i) \
        __builtin_amdgcn_global_load_lds((const unsigned*)((const char*)(gbase) + (voff)[_i]), (PG8_LAS unsigned*)(lds + (bufoff) + ldsw + _i * 8192), 16, 0, 0); } while (0)
#define PG8_LDA(dst, b, h) do { if constexpr (FP8) { _Pragma("unroll") for (int m = 0; m < 4; ++m) { const PG8_LAS unsigned char* p_ = lds + PG8_SA(b, h) + aoff + m * 2048; \
            const v4i32 lo_ = *(const PG8_LAS v4i32*)p_, hi_ = *(const PG8_LAS v4i32*)(p_ + 16); dst##8[m] = __builtin_shufflevector(lo_, hi_, 0, 1, 2, 3, 4, 5, 6, 7); } } \
        else { _Pragma("unroll") for (int m = 0; m < 4; ++m) _Pragma("unroll") for (int k = 0; k < 2; ++k) dst[m][k] = *(const PG8_LAS bf16x8*)(lds + PG8_SA(b, h) + aoff + m * 2048 + k * 1024); } } while (0)
#define PG8_LDB(dst, b, h) do { if constexpr (FP8) { _Pragma("unroll") for (int n = 0; n < 2; ++n) { const PG8_LAS unsigned char* p_ = lds + PG8_SB(b, h) + boff + n * 2048; \
            const v4i32 lo_ = *(const PG8_LAS v4i32*)p_, hi_ = *(const PG8_LAS v4i32*)(p_ + 16); dst##8[n] = __builtin_shufflevector(lo_, hi_, 0, 1, 2, 3, 4, 5, 6, 7); } } \
        else { _Pragma("unroll") for (int n = 0; n < 2; ++n) _Pragma("unroll") for (int k = 0; k < 2; ++k) dst[n][k] = *(const PG8_LAS bf16x8*)(lds + PG8_SB(b, h) + boff + n * 2048 + k * 1024); } } while (0)
#define PG8_MMA(ai, bj, At, Bt) do { __builtin_amdgcn_s_setprio(1); \
        if constexpr (FP8) { _Pragma("unroll") for (int m = 0; m < 4; ++m) _Pragma("unroll") for (int n = 0; n < 2; ++n) \
            mfma_f8(acc[ai][bj][m][n], Bt##8[n], At##8[m], f8one); } \
        else { _Pragma("unroll") for (int m = 0; m < 4; ++m) _Pragma("unroll") for (int n = 0; n < 2; ++n) _Pragma("unroll") for (int k = 0; k < 2; ++k) \
            acc[ai][bj][m][n] = __builtin_amdgcn_mfma_f32_16x16x32_bf16(Bt[n][k], At[m][k], acc[ai][bj][m][n], 0, 0, 0); } \
        __builtin_amdgcn_s_setprio(0); } while (0)
#define PG8_WAIT_V(n) asm volatile("s_waitcnt vmcnt(" #n ")" ::: "memory")
#define PG8_WAIT_L(n) asm volatile("s_waitcnt lgkmcnt(" #n ")" ::: "memory")
#define PG8_BAR __builtin_amdgcn_s_barrier()
#define PG8_SCHED __builtin_amdgcn_sched_barrier(0)
    Unit cur, nxt; int ui = 0;
    if (!S.next(0, cur)) return;
    if constexpr (GATHER) { PG8_GOFF(cv0, cv1, cur.pm); }
    else {
#pragma unroll
        for (int i = 0; i < 2; ++i) { cv0[i] = voffA[i]; cv1[i] = voffA[i] + (unsigned)(HALF * K * 2); } }
    f32x4 acc[2][2][4][2];
#pragma unroll
    for (int a = 0; a < 2; ++a)
#pragma unroll
        for (int b = 0; b < 2; ++b)
#pragma unroll
            for (int m = 0; m < 4; ++m)
#pragma unroll
                for (int n = 0; n < 2; ++n) acc[a][b][m][n] = (f32x4){0.f, 0.f, 0.f, 0.f};
    bf16x8 At[4][2], B0[2][2], B1[2][2]; v8i32 At8[4], B08[2], B18[2]; int f8one = 0x7f7f7f7f; asm volatile("" : "+v"(f8one));
    const char* cA = (const char*)g.A + (GATHER ? (size_t)0 : (size_t)cur.pm * tstep); const char* cB = (const char*)g.Bt + (size_t)cur.pn * tstep;
    S.a_ready(cur);
    if constexpr (SP2) {
        PG8_STAGE(PG8_SB(0, 0), cB, voffB); PG8_STAGE(PG8_SB(0, 1), cB + hstep, voffB); PG8_STAGE(PG8_SA(0, 0), cA, cv0); PG8_STAGE(PG8_SA(0, 1), cA, cv1);
        if (wr == 1) PG8_BAR;
        PG8_WAIT_V(2); PG8_BAR;
        PG8_STAGE(PG8_SB(1, 0), cB + kstep, voffB); PG8_STAGE(PG8_SA(1, 0), cA + kstep, cv0); PG8_STAGE(PG8_SB(1, 1), cB + hstep + kstep, voffB);
        PG8_WAIT_V(6); PG8_BAR;
    } else {
        PG8_STAGE(PG8_SB(0, 0), cB, voffB); PG8_STAGE(PG8_SA(0, 0), cA, cv0); PG8_STAGE(PG8_SB(0, 1), cB + hstep, voffB); PG8_STAGE(PG8_SA(0, 1), cA, cv1);
        if (wr == 1) PG8_BAR;
        PG8_WAIT_V(4); PG8_BAR;
        PG8_STAGE(PG8_SB(1, 0), cB + kstep, voffB); PG8_STAGE(PG8_SA(1, 0), cA + kstep, cv0); PG8_STAGE(PG8_SB(1, 1), cB + hstep + kstep, voffB);
        PG8_WAIT_V(6); PG8_BAR;
    }
    for (;;) {
        const bool has_next = S.next(ui + 1, nxt);
        if (GATHER && has_next) { PG8_GOFF(nv0, nv1, nxt.pm); }
        else {
#pragma unroll
            for (int i = 0; i < 2; ++i) { nv0[i] = cv0[i]; nv1[i] = cv1[i]; } }
        const char* nA = (has_next && !GATHER) ? (const char*)g.A + (size_t)nxt.pm * tstep : cA; const char* nB = has_next ? (const char*)g.Bt + (size_t)nxt.pn * tstep : cB;
#pragma unroll 1
        for (int t = 0; t < nt; t += 2) {
            const bool last = (t == nt - 2);
            const char* a1 = cA + (size_t)(t + 1) * kstep;
            const char* a2 = last ? nA : cA + (size_t)(t + 2) * kstep; const char* b2 = last ? nB : cB + (size_t)(t + 2) * kstep;
            const char* a3 = a2 + kstep; const char* b3 = b2 + kstep;
#pragma unroll
            for (int i = 0; i < 2; ++i) { sv0[i] = last ? nv0[i] : cv0[i]; sv1[i] = last ? nv1[i] : cv1[i]; }
            if (last && has_next) S.a_ready(nxt);
            if constexpr (SP2) {
            PG8_LDB(B0, 0, 0); PG8_LDB(B1, 0, 1); PG8_SCHED; PG8_LDA(At, 0, 0); PG8_STAGE(PG8_SA(1, 1), a1, cv1);
            PG8_WAIT_V(8); PG8_WAIT_L(0); PG8_BAR; PG8_MMA(0, 0, At, B0); PG8_MMA(0, 1, At, B1); PG8_BAR; PG8_SCHED;
            PG8_LDA(At, 0, 1); PG8_STAGE(PG8_SB(0, 0), b2, voffB); PG8_STAGE(PG8_SB(0, 1), b2 + hstep, voffB); PG8_STAGE(PG8_SA(0, 0), a2, sv0);
            PG8_WAIT_V(8); PG8_WAIT_L(0); PG8_BAR; PG8_MMA(1, 0, At, B0); PG8_MMA(1, 1, At, B1); PG8_BAR; PG8_SCHED;
            PG8_LDB(B0, 1, 0); PG8_LDB(B1, 1, 1); PG8_SCHED; PG8_LDA(At, 1, 0); PG8_STAGE(PG8_SA(0, 1), a2, sv1);
            PG8_WAIT_V(8); PG8_WAIT_L(0); PG8_BAR; PG8_MMA(0, 0, At, B0); PG8_MMA(0, 1, At, B1); PG8_BAR; PG8_SCHED;
            PG8_LDA(At, 1, 1); PG8_STAGE(PG8_SB(1, 0), b3, voffB); PG8_STAGE(PG8_SB(1, 1), b3 + hstep, voffB); PG8_STAGE(PG8_SA(1, 0), a3, sv0);
            PG8_WAIT_V(8); PG8_WAIT_L(0); PG8_BAR; PG8_MMA(1, 0, At, B0); PG8_MMA(1, 1, At, B1); PG8_BAR; PG8_SCHED;
            } else {
            PG8_LDB(B0, 0, 0); PG8_SCHED; PG8_LDA(At, 0, 0); PG8_STAGE(PG8_SA(1, 1), a1, cv1);
            PG8_WAIT_L(8); PG8_BAR; PG8_WAIT_L(0); PG8_MMA(0, 0, At, B0); PG8_BAR; PG8_SCHED;
            PG8_LDB(B1, 0, 1); PG8_STAGE(PG8_SB(0, 0), b2, voffB);
            PG8_BAR; PG8_WAIT_L(0); PG8_MMA(0, 1, At, B1); PG8_BAR;
            PG8_LDA(At, 0, 1); PG8_STAGE(PG8_SA(0, 0), a2, sv0);
            PG8_BAR; PG8_WAIT_L(0); PG8_MMA(1, 0, At, B0); PG8_BAR; PG8_SCHED;
            PG8_STAGE(PG8_SB(0, 1), b2 + hstep, voffB);
            PG8_WAIT_V(6); PG8_BAR; PG8_MMA(1, 1, At, B1); PG8_BAR;
            PG8_LDB(B0, 1, 0); PG8_SCHED; PG8_LDA(At, 1, 0); PG8_STAGE(PG8_SA(0, 1), a2, sv1);
            PG8_WAIT_L(8); PG8_BAR; PG8_WAIT_L(0); PG8_MMA(0, 0, At, B0); PG8_BAR; PG8_SCHED;
            PG8_LDB(B1, 1, 1); PG8_STAGE(PG8_SB(1, 0), b3, voffB);
            PG8_BAR; PG8_WAIT_L(0); PG8_MMA(0, 1, At, B1); PG8_BAR;
            PG8_LDA(At, 1, 1); PG8_STAGE(PG8_SA(1, 0), a3, sv0);
            PG8_BAR; PG8_WAIT_L(0); PG8_MMA(1, 0, At, B0); PG8_BAR; PG8_SCHED;
            PG8_STAGE(PG8_SB(1, 1), b3 + hstep, voffB);
            PG8_WAIT_V(6); PG8_BAR; PG8_MMA(1, 1, At, B1); PG8_BAR;
            }
        }
        if constexpr (FP8) { asm volatile("s_nop 15\n\ts_nop 15\n\ts_nop 7" ::: "memory"); }
        if constexpr (ALIGN_EPI) { if (wr == 0) PG8_BAR; }
        if constexpr (!Epi::AFTER_DRAIN) { E(acc, cur, wr, wc, fr, fq); S.done(cur); }
        if (!has_next) break;
#pragma unroll
        for (int a = 0; a < 2; ++a)
#pragma unroll
            for (int b = 0; b < 2; ++b)
#pragma unroll
                for (int m = 0; m < 4; ++m)
#pragma unroll
                    for (int n = 0; n < 2; ++n) acc[a][b][m][n] = (f32x4){0.f, 0.f, 0.f, 0.f};
        cur = nxt; cA = nA; cB = nB; ++ui;
#pragma unroll
        for (int i = 0; i < 2; ++i) { cv0[i] = nv0[i]; cv1[i] = nv1[i]; }
        if constexpr (ALIGN_EPI) { if (wr == 1) PG8_BAR; }
    }
    PG8_WAIT_V(0);
    if constexpr (!ALIGN_EPI) { if (wr == 0) PG8_BAR; }
    PG8_BAR;
    if constexpr (Epi::AFTER_DRAIN) { E.fused(acc, cur, wr, wc, fr, fq, lds, wid, lane); S.done(cur); }
#undef PG8_GOFF
#undef PG8_SA
#undef PG8_SB
#undef PG8_STAGE
#undef PG8_LDA
#undef PG8_LDB
#undef PG8_MMA
#undef PG8_WAIT_V
#undef PG8_WAIT_L
#undef PG8_BAR
#undef PG8_SCHED
}
}

#ifndef PG8_SP2
#define PG8_SP2 true
#endif
#ifndef PG8_ALIGN
#define PG8_ALIGN true
#endif
constexpr int RING_OFF = 0, RING_BYTES = 131072;
constexpr int LDSCTL_OFF = RING_BYTES, MISC_OFF = LDSCTL_OFF + 320;
constexpr int LDS_BYTES = 163840;
constexpr int PARAM_OFF = 135168;
constexpr int NWAVES = 8;
#define GAS __attribute__((address_space(1)))
#define LAS __attribute__((address_space(3)))
typedef unsigned v4u __attribute__((ext_vector_type(4)));
typedef unsigned u2v_t __attribute__((ext_vector_type(2)));
typedef float f32x4 __attribute__((ext_vector_type(4)));
typedef GAS unsigned gu32;
#define RLX_AGENT __ATOMIC_RELAXED, __HIP_MEMORY_SCOPE_AGENT
#define LDS_WAIT() asm volatile("s_waitcnt lgkmcnt(0)" ::: "memory")
__device__ __forceinline__ unsigned pk2(float lo, float hi) { return cvtpk2(lo, hi); }

#define XB_TMO      128
#define XB_XCNT(j)  (256  + 64 * (j))
#define XB_XSUB(j)  (1280 + 64 * (j))
#define XB_XGEN(j)  (2304 + 64 * (j))
#define XB_TOP      3328
#define XB_TOPGEN   3392
#define XCD_BAR_WORDS 3456
#define XB_SPIN_CAP (1u << 18)

__device__ __forceinline__ unsigned xb_ld(unsigned* p)              { return __hip_atomic_load(p, __ATOMIC_RELAXED, __HIP_MEMORY_SCOPE_AGENT); }
__device__ __forceinline__ unsigned xb_add(unsigned* p, unsigned v) { return __hip_atomic_fetch_add(p, v, __ATOMIC_RELAXED, __HIP_MEMORY_SCOPE_AGENT); }
__device__ __forceinline__ unsigned xb_xcc_id() { return (unsigned)__builtin_amdgcn_s_getreg((3 << 11) | 20) & 0xFu; }
#define XB_SPIN(cond, bar) do { unsigned _sp = 0; while (cond) { __builtin_amdgcn_s_sleep(1); \
    if ((++_sp & 255u) == 0u) { if (xb_ld(&(bar)[XB_TMO])) break; if (_sp > XB_SPIN_CAP) { atomicAdd(&(bar)[XB_TMO], 1u); break; } } } } while (0)

struct XcdBarrier {
    unsigned* bar; unsigned x;
    volatile LAS unsigned* st;
};

__device__ __forceinline__ XcdBarrier xcd_barrier_post(unsigned* bar, volatile LAS unsigned* st) {
    XcdBarrier b; b.bar = bar; b.x = xb_xcc_id(); b.st = st;
    if (threadIdx.x == 0) (void)xb_add(&bar[XB_XCNT(b.x)], 1u);
    return b;
}
__device__ __forceinline__ void xcd_barrier_complete(unsigned* bar, unsigned x, unsigned& nloc, unsigned& nx) {
    const unsigned G = gridDim.x * gridDim.y * gridDim.z;
    unsigned sum, cnt, mine, sp = 0u;
    for (;;) {
        sum = 0u; cnt = 0u; mine = 0u;
#pragma unroll
        for (unsigned j = 0; j < 16; ++j) { const unsigned c = xb_ld(&bar[XB_XCNT(j)]); sum += c; cnt += (c > 0u) ? 1u : 0u; mine = (j == x) ? c : mine; }
        if (sum == G) break;
        __builtin_amdgcn_s_sleep(1);
        if ((++sp & 255u) == 0u) { if (xb_ld(&bar[XB_TMO])) break; if (sp > XB_SPIN_CAP) { atomicAdd(&bar[XB_TMO], 1u); break; } }
    }
    nloc = mine > 0u ? mine : 1u; nx = cnt > 0u ? cnt : 1u;
}

__device__ __forceinline__ void xcd_barrier(const XcdBarrier& b) {
    asm volatile("s_waitcnt vmcnt(0)" ::: "memory");
    __syncthreads();
    if (threadIdx.x == 0) {
        unsigned* bar = b.bar;
        __builtin_amdgcn_s_waitcnt(0);
        unsigned nloc = b.st[0], nx = b.st[1];
        if (nloc == 0u) { xcd_barrier_complete(bar, b.x, nloc, nx); b.st[0] = nloc; b.st[1] = nx; }
        const unsigned old = xb_add(&bar[XB_XSUB(b.x)], 1u);
        const unsigned gen = old / nloc;
        if (old + 1u == (gen + 1u) * nloc) {
            __builtin_amdgcn_fence(__ATOMIC_RELEASE, "agent");
            asm volatile("s_waitcnt vmcnt(0)" ::: "memory");
            const unsigned og = xb_add(&bar[XB_TOP], 1u);
            const unsigned tg = og / nx;
            if (og + 1u == (tg + 1u) * nx) xb_add(&bar[XB_TOPGEN], 1u);
            else XB_SPIN(xb_ld(&bar[XB_TOPGEN]) == tg, bar);
            __builtin_amdgcn_fence(__ATOMIC_ACQUIRE, "agent");
            xb_add(&bar[XB_XGEN(b.x)], 1u);
            asm volatile("s_waitcnt vmcnt(0)" ::: "memory");
        } else {
            XB_SPIN(xb_ld(&bar[XB_XGEN(b.x)]) == gen, bar);
            __builtin_amdgcn_fence(__ATOMIC_ACQUIRE, "agent");
            asm volatile("s_waitcnt vmcnt(0)" ::: "memory");
        }
    }
    __syncthreads();
}

struct Args { const void* in[20]; float* out; unsigned char* ws; int ph_lo, ph_hi, li, mask, rep, pad; };
struct Ctx {
    unsigned char* lds; int tid, lane, wave, G, gw, NGW;
    const float *x, *c, *w_ada, *b_ada, *g_pre_mix, *g_post_mix, *g_pre_ffn, *g_post_ffn, *w_in, *lbl, *onorm, *sink, *w_a, *w_b, *w_o, *w_router, *w_eg, *w_eu, *w_ed;
    const int* pos; float* out; unsigned char* ws;
};
__device__ __forceinline__ float wave_sum(float v) {
#pragma unroll
    for (int o = 1; o < 64; o <<= 1) v += __shfl_xor(v, o);
    return v;
}
struct TDesc { const float* src; bf16* dst; int N, K; float f8s; };
__device__ __forceinline__ void t_load(const TDesc& d, f32x4 (&r)[8], int lane) {
    const float* p = d.src + (size_t)(lane >> 3) * d.N + 4 * (lane & 7);
#pragma unroll
    for (int i = 0; i < 8; ++i) r[i] = __builtin_nontemporal_load((const f32x4*)(p + (size_t)(8 * i) * d.N));
}
__device__ __forceinline__ void t_process(const TDesc& d, const f32x4 (&r)[8], float* scr, int lane) {
    { float* w = scr + (lane >> 3) * 33 + 4 * (lane & 7);
#pragma unroll
      for (int i = 0; i < 8; ++i) { float* q = w + (8 * i) * 33; q[0] = r[i].x; q[1] = r[i].y; q[2] = r[i].z; q[3] = r[i].w; } }
    LDS_WAIT(); asm volatile("" ::: "memory");
    if (d.f8s != 0.f) {
        const int c = lane & 3; const float f = d.f8s; unsigned char* dst8 = (unsigned char*)d.dst;
#pragma unroll
        for (int j = 0; j < 2; ++j) { const int n = (lane >> 2) + 16 * j; const float* s = scr + (16 * c) * 33 + n;
            v4u o; o.x = pg8::pk4_fp8(s[0 * 33] * f, s[1 * 33] * f, s[2 * 33] * f, s[3 * 33] * f); o.y = pg8::pk4_fp8(s[4 * 33] * f, s[5 * 33] * f, s[6 * 33] * f, s[7 * 33] * f);
            o.z = pg8::pk4_fp8(s[8 * 33] * f, s[9 * 33] * f, s[10 * 33] * f, s[11 * 33] * f); o.w = pg8::pk4_fp8(s[12 * 33] * f, s[13 * 33] * f, s[14 * 33] * f, s[15 * 33] * f);
            __builtin_nontemporal_store(o, (v4u*)(dst8 + (size_t)n * d.K + 16 * c)); }
    } else {
    const int c = lane & 7;
#pragma unroll
    for (int j = 0; j < 4; ++j) { const int n = (lane >> 3) + 8 * j; const float* s = scr + (8 * c) * 33 + n;
        v4u o; o.x = pk2(s[0 * 33], s[1 * 33]); o.y = pk2(s[2 * 33], s[3 * 33]); o.z = pk2(s[4 * 33], s[5 * 33]); o.w = pk2(s[6 * 33], s[7 * 33]);
        *(v4u*)(d.dst + (size_t)n * d.K + 8 * c) = o; }
    }
    LDS_WAIT(); asm volatile("" ::: "memory");
}
__device__ __forceinline__ void rope_entry(const int* pos, float* rope, int gid) {
    const int t = gid >> 6, i = gid & 63;
    double inv = 1.0, rr = 0.8659643233600653523531691834202299819398;
    for (int bit = 0; bit < 6; ++bit) { if ((i >> bit) & 1) inv *= rr; rr *= rr; }
    const double ang = (double)pos[t] * inv;
    const double kq = rint(ang * 0.3183098861837906715377675267450287);
    const double r = ang - kq * 3.141592653589793238462643383279502884;
    const double u = -(r * r);
    double s = 1.0 / 121645100408832000.0;
    s = s * u + 1.0 / 355687428096000.0; s = s * u + 1.0 / 1307674368000.0; s = s * u + 1.0 / 6227020800.0; s = s * u + 1.0 / 39916800.0; s = s * u + 1.0 / 362880.0;
    s = s * u + 1.0 / 5040.0; s = s * u + 1.0 / 120.0; s = s * u + 1.0 / 6.0; s = s * u + 1.0; s = s * r;
    double cz = 1.0 / 6402373705728000.0;
    cz = cz * u + 1.0 / 20922789888000.0; cz = cz * u + 1.0 / 87178291200.0; cz = cz * u + 1.0 / 479001600.0; cz = cz * u + 1.0 / 3628800.0; cz = cz * u + 1.0 / 40320.0;
    cz = cz * u + 1.0 / 720.0; cz = cz * u + 1.0 / 24.0; cz = cz * u + 0.5; cz = cz * u + 1.0;
    const double sg = (((long long)kq) & 1) ? -1.0 : 1.0;
    rope[(size_t)gid * 2] = (float)(sg * cz); rope[(size_t)gid * 2 + 1] = (float)(sg * s);
}
constexpr float W8S_GU = 64.f, W8S_D = 32.f, W8S_IN = 64.f, X8S_IN = 16.f;
constexpr int I_IN = 32 * 336, I_A = 16 * 64, I_O = 32 * 64, I_E = 1024, I_MIX = I_IN + 2 * I_A + I_O, I_EXP = 48 * I_E;
constexpr int CONV_BLOCKS = 32;
constexpr int CONV_ITEMS_PER_WAVE = 48;
constexpr int P0_EXPERT_ITEMS = I_EXP - CONV_BLOCKS * NWAVES * CONV_ITEMS_PER_WAVE;
constexpr int P0_GEMV_ROUNDS = 8;
constexpr int GEMV_BLOCKS = 96;
__device__ __forceinline__ TDesc transpose_desc(Ctx& F, int it) {
    bf16* WIN = (bf16*)(F.ws + WS_WIN); bf16* WA = (bf16*)(F.ws + WS_WA); bf16* WB = (bf16*)(F.ws + WS_WB); bf16* WO = (bf16*)(F.ws + WS_WO); bf16* WGU = (bf16*)(F.ws + WS_WGU); bf16* WD = (bf16*)(F.ws + WS_WD);
    int r = it; const float* W; bf16* WT; int K, N, kb, nb; size_t drow; float f8s = 0.f;
    if (r < I_IN) { W = F.w_in; WT = WIN; K = 2048; N = INW; kb = r / 336; nb = r % 336; drow = (size_t)32 * nb; f8s = W8S_IN; }
    else if ((r -= I_IN) < I_A) { W = F.w_a; WT = WA; K = 1024; N = 2048; kb = r / 64; nb = r % 64; drow = (size_t)32 * nb; }
    else if ((r -= I_A) < I_A) { W = F.w_b; WT = WB; K = 1024; N = 2048; kb = r / 64; nb = r % 64; drow = (size_t)32 * nb; }
    else if ((r -= I_A) < I_O) { W = F.w_o; WT = WO; K = 2048; N = 2048; kb = r / 64; nb = r % 64; drow = (size_t)32 * nb; }
    else { r -= I_O; const int e = r / (3 * I_E), q = r % (3 * I_E), which = q / I_E, ii = q % I_E;
        if (which < 2) { kb = ii / 32; nb = ii % 32; const int n0 = 32 * nb; W = (which ? F.w_eu : F.w_eg) + (size_t)e * 2048 * 1024; WT = WGU; K = 2048; N = 1024; f8s = W8S_GU; drow = (size_t)e * 2048 + (n0 >> 7) * 256 + which * 128 + (n0 & 127); }
        else { kb = ii / 64; nb = ii % 64; W = F.w_ed + (size_t)e * 1024 * 2048; WT = WD; K = 1024; N = 2048; f8s = W8S_D; drow = (size_t)e * 2048 + 32 * nb; } }
    TDesc d; d.src = W + (size_t)(64 * kb) * N + 32 * nb; d.N = N; d.K = K; d.f8s = f8s;
    if (f8s != 0.f) d.dst = (bf16*)((unsigned char*)WT + drow * K + 64 * kb); else d.dst = WT + drow * K + 64 * kb;
    return d;
}
template <class Seq> __device__ __forceinline__ void transpose_stream(Ctx& F, const Seq& seq, float* scr) {
    f32x4 ra[8], rb[8]; TDesc da, db; int j = 0; int it = seq(j);
    if (it < 0) return;
    da = transpose_desc(F, it); t_load(da, ra, F.lane);
    for (;;) {
        const int itn = seq(++j);
        if (itn >= 0) { db = transpose_desc(F, itn); t_load(db, rb, F.lane); }
        t_process(da, ra, scr, F.lane);
        if (itn < 0) break;
        const int itnn = seq(++j);
        if (itnn >= 0) { da = transpose_desc(F, itnn); t_load(da, ra, F.lane); }
        t_process(db, rb, scr, F.lane);
        if (itnn < 0) break;
    }
}
struct P0Seq { int gw, NGW, ngv; bool gemv;
    __device__ __forceinline__ int operator()(int r) const { int it; if (r < P0_GEMV_ROUNDS) it = r * NGW + gw; else { if (gemv) return -1; it = P0_GEMV_ROUNDS * NGW + (r - P0_GEMV_ROUNDS) * (NGW - ngv) + (gw - ngv); }
        return it < I_MIX + P0_EXPERT_ITEMS ? it : -1; } };
struct TailSeq { int first, stride;
    __device__ __forceinline__ int operator()(int j) const { const int it = first + j * stride; return it < I_MIX + I_EXP ? it : -1; } };
__device__ __forceinline__ void p1_modnorm(Ctx& F, int first, int stride) {
    const float* MOD = (const float*)(F.ws + WS_MOD); bf16* H = (bf16*)(F.ws + WS_H);
    for (int row0 = first; row0 < T; row0 += 2 * stride) {
        f32x4 v[2][8];
#pragma unroll
        for (int k = 0; k < 2; ++k) { const int row = row0 + k * stride; if (row < T) { const f32x4* xr = (const f32x4*)(F.x + (size_t)row * D) + F.lane;
#pragma unroll
            for (int j = 0; j < 8; ++j) v[k][j] = __builtin_nontemporal_load(xr + 64 * j); } }
#pragma unroll
        for (int k = 0; k < 2; ++k) { const int row = row0 + k * stride; if (row < T) {
            const int b = row / SEQ; float ss = 0.f;
#pragma unroll
            for (int j = 0; j < 8; ++j) ss += (v[k][j].x * v[k][j].x + v[k][j].y * v[k][j].y) + (v[k][j].z * v[k][j].z + v[k][j].w * v[k][j].w);
            const float r = rsqrtf(wave_sum(ss) * (1.f / D) + EPS);
            const f32x4* gp = (const f32x4*)F.g_pre_mix + F.lane; const f32x4* shp = (const f32x4*)(MOD + b * 12288) + F.lane; const f32x4* scp = (const f32x4*)(MOD + b * 12288 + 2048) + F.lane;
            unsigned* o8 = (unsigned*)((unsigned char*)H + (size_t)row * D) + F.lane;
            f32x4 g[8], sh[8], sc[8];
#pragma unroll
            for (int j = 0; j < 8; ++j) { g[j] = gp[64 * j]; sh[j] = shp[64 * j]; sc[j] = scp[64 * j]; }
#pragma unroll
            for (int j = 0; j < 8; ++j) { const f32x4 h = (v[k][j] * r * g[j] * (sc[j] + 1.f) + sh[j]) * X8S_IN;
                o8[64 * j] = pg8::pk4_fp8(h.x, h.y, h.z, h.w); } } }
    }
}
__device__ __forceinline__ void p0_prep(Ctx& F) {
    float* MOD = (float*)(F.ws + WS_MOD); float* LB = (float*)(F.ws + WS_LB); float* ROPE = (float*)(F.ws + WS_ROPE);
    if (blockIdx.x < GEMV_BLOCKS) {
        float* sc = (float*)F.lds; float* red = (float*)(F.lds + 16384);
        for (int i = F.tid; i < 4096; i += 512) sc[i] = siluf_(F.c[i]);
        __syncthreads();
        const int j0 = blockIdx.x * 128, k0 = F.wave * 256, half = F.lane >> 5, l32 = F.lane & 31;
        f32x4 a0 = {0.f, 0.f, 0.f, 0.f}, a1 = {0.f, 0.f, 0.f, 0.f};
        const float* wp = F.w_ada + (size_t)(k0 + half) * 12288 + j0 + 4 * l32;
#pragma unroll 16
        for (int k = 0; k < 128; ++k) { const f32x4 w = __builtin_nontemporal_load((const f32x4*)(wp + (size_t)(2 * k) * 12288)); const float s0 = sc[k0 + 2 * k + half], s1 = sc[2048 + k0 + 2 * k + half]; a0 += w * s0; a1 += w * s1; }
        *(f32x4*)(red + ((F.wave * 2 + half) * 2 + 0) * 128 + 4 * l32) = a0; *(f32x4*)(red + ((F.wave * 2 + half) * 2 + 1) * 128 + 4 * l32) = a1;
        __syncthreads();
        if (F.tid < 256) { const int b = F.tid >> 7, jj = F.tid & 127; float s = 0.f;
#pragma unroll
          for (int p = 0; p < 16; ++p) s += red[(p * 2 + b) * 128 + jj];
          MOD[b * 12288 + j0 + jj] = s + F.b_ada[j0 + jj]; }
        __syncthreads();
    }
    { const int gt = blockIdx.x * 512 + F.tid, NT = F.G * 512;
      if (gt < 2048) { const int dir = gt >> 10, ch = gt & 1023; const float l0 = F.lbl[dir * 2048 + ch], l1 = F.lbl[dir * 2048 + 1024 + ch]; LB[gt] = 1.f / (1.f + expf(l1 - l0)); }
      for (int g = gt; g < T * 64; g += NT) rope_entry(F.pos, ROPE, g); }
    unsigned* cnt = (unsigned*)(F.ws + WS_CTL) + 1024;
    if (blockIdx.x < GEMV_BLOCKS) {
        asm volatile("s_waitcnt vmcnt(0)" ::: "memory"); __syncthreads();
        if (F.tid == 0) { __builtin_amdgcn_fence(__ATOMIC_RELEASE, "agent"); asm volatile("s_waitcnt vmcnt(0)" ::: "memory"); __hip_atomic_fetch_add(cnt, 1u, __ATOMIC_RELAXED, __HIP_MEMORY_SCOPE_AGENT); }
    }
    float* scr = (float*)(F.lds + F.wave * 16384);
    P0Seq seq{F.gw, F.NGW, GEMV_BLOCKS * NWAVES, blockIdx.x < GEMV_BLOCKS};
    transpose_stream(F, seq, scr);
    __syncthreads();
    if (F.tid == 0) { unsigned sp = 0; while (__hip_atomic_load(cnt, __ATOMIC_RELAXED, __HIP_MEMORY_SCOPE_AGENT) < (unsigned)GEMV_BLOCKS && ++sp < (1u << 22)) __builtin_amdgcn_s_sleep(2);
        __builtin_amdgcn_fence(__ATOMIC_ACQUIRE, "agent"); asm volatile("s_waitcnt vmcnt(0)" ::: "memory"); }
    __syncthreads();
    p1_modnorm(F, F.gw, F.NGW);
}
__device__ __forceinline__ void p6_post1(Ctx& F) {
    const float* MOD = (const float*)(F.ws + WS_MOD); const float* Y = (const float*)(F.ws + WS_Y); bf16* H2 = (bf16*)(F.ws + WS_H2); float* AFF = (float*)(F.ws + WS_AFF);
    float* wT = (float*)F.lds;
    float* PA = (float*)(F.lds + PARAM_OFF); float* PB = PA + 2048; float* PC = PB + 2048;
    for (int f = F.tid; f < 8192; f += 512) { const int d = f >> 2, q = f & 3; const f32x4 wv = *((const f32x4*)F.w_router + f);
        wT[(4 * q + 0) * 2048 + d] = wv.x; wT[(4 * q + 1) * 2048 + d] = wv.y; wT[(4 * q + 2) * 2048 + d] = wv.z; wT[(4 * q + 3) * 2048 + d] = wv.w; }
    uint2 ywn[8]; f32x4 xvn[8];
#define P6_LOAD(rr) do { const uint2* yr_ = (const uint2*)((const bf16*)Y + (size_t)(rr) * D) + F.lane; const f32x4* xr_ = (const f32x4*)(F.x + (size_t)(rr) * D) + F.lane; \
        _Pragma("unroll") for (int j = 0; j < 8; ++j) { { const u2v_t t2_ = __builtin_nontemporal_load((const u2v_t*)(yr_ + 64 * j)); ywn[j].x = t2_.x; ywn[j].y = t2_.y; } xvn[j] = __builtin_nontemporal_load(xr_ + 64 * j); } } while (0)
    for (int b = 0; b < BATCH; ++b) {
        const float* mb = MOD + b * 12288;
        __syncthreads();
        if (F.tid < 512) { const int d4 = F.tid;
            const f32x4 gt = *((const f32x4*)(mb + 4096) + d4), gp = *((const f32x4*)F.g_post_mix + d4), g2 = *((const f32x4*)F.g_pre_ffn + d4), sc = *((const f32x4*)(mb + 8192) + d4), sh = *((const f32x4*)(mb + 6144) + d4);
            *((f32x4*)PA + d4) = gt * gp; *((f32x4*)PB + d4) = g2 * (sc + 1.f); *((f32x4*)PC + d4) = sh; }
        const int rfirst = b * SEQ + F.gw;
        if (F.gw < SEQ) P6_LOAD(rfirst);
        __syncthreads();
        for (int rl = F.gw; rl < SEQ; rl += F.NGW) {
            const int row = b * SEQ + rl, s = rl;
            f32x4 xv[8]; float ss = 0.f;
            {   uint2 yc[8];
#pragma unroll
                for (int j = 0; j < 8; ++j) { yc[j] = ywn[j]; const float y0 = __uint_as_float(yc[j].x << 16), y1 = __uint_as_float(yc[j].x & 0xffff0000u), y2 = __uint_as_float(yc[j].y << 16), y3 = __uint_as_float(yc[j].y & 0xffff0000u);
                    xv[j] = xvn[j]; ss += (y0 * y0 + y1 * y1) + (y2 * y2 + y3 * y3); }
                if (rl + F.NGW < SEQ) P6_LOAD(row + F.NGW);
                const float r = rsqrtf(wave_sum(ss) * (1.f / D) + EPS);
                f32x4* op = (f32x4*)(F.out + (size_t)row * D) + F.lane;
                ss = 0.f;
#pragma unroll
                for (int j = 0; j < 8; ++j) { const f32x4 y = {__uint_as_float(yc[j].x << 16), __uint_as_float(yc[j].x & 0xffff0000u), __uint_as_float(yc[j].y << 16), __uint_as_float(yc[j].y & 0xffff0000u)};
                    const f32x4 pa = *((const f32x4*)PA + F.lane + 64 * j);
                    xv[j] = xv[j] + pa * (y * r); ss += (xv[j].x * xv[j].x + xv[j].y * xv[j].y) + (xv[j].z * xv[j].z + xv[j].w * xv[j].w); }
#pragma unroll
                for (int j = 0; j < 8; ++j) op[64 * j] = xv[j];
            }
            const float r2 = rsqrtf(wave_sum(ss) * (1.f / D) + EPS);
            unsigned* o4 = (unsigned*)((unsigned char*)H2 + (size_t)row * D) + F.lane;
            float lg[16];
#pragma unroll
            for (int j = 0; j < 8; ++j) { const f32x4 pb = *((const f32x4*)PB + F.lane + 64 * j), pc = *((const f32x4*)PC + F.lane + 64 * j); xv[j] = xv[j] * r2 * pb + pc; }
#pragma unroll
            for (int j = 0; j < 8; ++j) o4[64 * j] = pg8::pk4_fp8(xv[j].x, xv[j].y, xv[j].z, xv[j].w);
#pragma unroll
            for (int e = 0; e < 16; ++e) { float a = 0.f;
#pragma unroll
                for (int j = 0; j < 8; ++j) { const f32x4 wv = *((const f32x4*)(wT + e * 2048) + F.lane + 64 * j); a += (xv[j].x * wv.x + xv[j].y * wv.y) + (xv[j].z * wv.z + xv[j].w * wv.w); }
                lg[e] = a; asm volatile("" ::: "memory"); }
            float mx = -1e30f;
#pragma unroll
            for (int e = 0; e < 16; ++e) { lg[e] = wave_sum(lg[e]); mx = fmaxf(mx, lg[e]); }
            float sm = 0.f;
#pragma unroll
            for (int e = 0; e < 16; ++e) { lg[e] = expf(lg[e] - mx); sm += lg[e]; }
            float mine = 0.f;
#pragma unroll
            for (int e = 0; e < 16; ++e) mine = (F.lane == e) ? lg[e] : mine;
            if (F.lane < 16) AFF[((size_t)b * 16 + F.lane) * SEQ + s] = mine / sm;
        }
    }
#undef P6_LOAD
    __syncthreads();
}
__device__ __forceinline__ void p7_topk_gather(Ctx& F) {
    const float* AFF = (const float*)(F.ws + WS_AFF); int* GIDX = (int*)(F.ws + WS_GIDX); float* SELAFF = (float*)(F.ws + WS_SELAFF); int* TOKSLOT = (int*)(F.ws + WS_TOKSLOT);
        int* sh = (int*)F.lds; int* wsum = (int*)(F.lds + 64);
    for (int unit = blockIdx.x; unit < 256; unit += F.G) {
        const int be = unit >> 3, part = unit & 7, b = be >> 4, e = be & 15, tid = F.tid, lane = F.lane;
        if (F.wave == 0) {
            unsigned v[64];
#pragma unroll
            for (int i = 0; i < 64; ++i) v[i] = __float_as_uint(AFF[(size_t)be * SEQ + i * 64 + lane]);
            unsigned tau = 0u;
            for (int bit = 30; bit >= 0; --bit) { const unsigned cand = tau | (1u << bit); int cl = 0;
#pragma unroll
                for (int i = 0; i < 64; ++i) cl += (v[i] >= cand) ? 1 : 0;
                int c = 0;
#pragma unroll
                for (int q = 0; q < 7; ++q) c += __popcll(__ballot((cl >> q) & 1)) << q;
                if (c >= CAP) tau = cand; }
            int cgt = 0;
            { int cl = 0;
#pragma unroll
              for (int i = 0; i < 64; ++i) cl += (v[i] > tau) ? 1 : 0;
#pragma unroll
              for (int q = 0; q < 7; ++q) cgt += __popcll(__ballot((cl >> q) & 1)) << q; }
            if (lane == 0) { sh[0] = (int)tau; sh[1] = cgt; }
        }
        __syncthreads();
        const unsigned tau = (unsigned)sh[0]; const int need = CAP - sh[1];
        const f32x4* a = (const f32x4*)(AFF + (size_t)be * SEQ + tid * 8);
        const f32x4 a0 = a[0], a1 = a[1];
        const unsigned v[8] = {__float_as_uint(a0.x), __float_as_uint(a0.y), __float_as_uint(a0.z), __float_as_uint(a0.w), __float_as_uint(a1.x), __float_as_uint(a1.y), __float_as_uint(a1.z), __float_as_uint(a1.w)};
        int cg = 0, ce = 0;
#pragma unroll
        for (int i = 0; i < 8; ++i) { cg += (v[i] > tau) ? 1 : 0; ce += (v[i] == tau) ? 1 : 0; }
        const int pk = cg | (ce << 16); int inc = pk;
#pragma unroll
        for (int o = 1; o < 64; o <<= 1) { const int t = __shfl_up(inc, o); if (lane >= o) inc += t; }
        if (lane == 63) wsum[F.wave] = inc;
        __syncthreads();
        int base = 0;
#pragma unroll
        for (int w = 0; w < 8; ++w) base += (w < F.wave) ? wsum[w] : 0;
        const int excl = base + inc - pk, pg = excl & 0xffff, pe = excl >> 16;
        int tie_before = pe, sel_before = pg + (pe < need ? pe : need);
#pragma unroll
        for (int i = 0; i < 8; ++i) {
            const int tok = tid * 8 + i; bool sel = false;
            if (v[i] > tau) sel = true; else if (v[i] == tau) { sel = tie_before < need; ++tie_before; }
            int slot = -1;
            if (sel) { const int sl = sel_before; ++sel_before; slot = b * CAP + sl;
                if ((sl >> 6) == part) { GIDX[e * 1024 + slot] = b * SEQ + tok; SELAFF[e * 1024 + slot] = __uint_as_float(v[i]); } }
            if (F.wave == part) TOKSLOT[((size_t)b * 16 + e) * SEQ + tok] = slot;
        }
        __syncthreads();
    }
}
__device__ __forceinline__ void p10_final(Ctx& F) {
    const float* MOD = (const float*)(F.ws + WS_MOD); const bf16* SLAB = (const bf16*)(F.ws + WS_SLAB); const int* TOKSLOT = (const int*)(F.ws + WS_TOKSLOT);
    for (int row0 = F.gw; row0 < T; row0 += 4 * F.NGW) {
        int slotw[4];
#pragma unroll
        for (int k = 0; k < 4; ++k) { const int row = row0 + k * F.NGW; slotw[k] = (row < T && F.lane < 16) ? TOKSLOT[((size_t)(row / SEQ) * 16 + F.lane) * SEQ + (row % SEQ)] : -1; }
#pragma unroll
        for (int k = 0; k < 4; ++k) { const int row = row0 + k * F.NGW; if (row < T) {
            const int b = row / SEQ; const float* mb = MOD + b * 12288;
            f32x4 x1v[8], gtv[8], gpv[8];
#pragma unroll
            for (int j = 0; j < 4; ++j) { const int col = 8 * F.lane + 512 * j; const float* op = F.out + (size_t)row * D + col;
#pragma unroll
                for (int hh = 0; hh < 2; ++hh) { x1v[2 * j + hh] = *(const f32x4*)(op + 4 * hh); gtv[2 * j + hh] = *(const f32x4*)(mb + 10240 + col + 4 * hh); gpv[2 * j + hh] = *(const f32x4*)(F.g_post_ffn + col + 4 * hh); } }
            float y[32];
#pragma unroll
            for (int i = 0; i < 32; ++i) y[i] = 0.f;
            for (int e = 0; e < 16; ++e) { const int sl = __shfl(slotw[k], e); if (sl >= 0) { const v4u* r = (const v4u*)(SLAB + ((size_t)e * 1024 + sl) * D) + F.lane;
#pragma unroll
                    for (int j = 0; j < 4; ++j) { const v4u q = r[64 * j];
                        y[8 * j + 0] += __uint_as_float(q.x << 16); y[8 * j + 1] += __uint_as_float(q.x & 0xffff0000u); y[8 * j + 2] += __uint_as_float(q.y << 16); y[8 * j + 3] += __uint_as_float(q.y & 0xffff0000u);
                        y[8 * j + 4] += __uint_as_float(q.z << 16); y[8 * j + 5] += __uint_as_float(q.z & 0xffff0000u); y[8 * j + 6] += __uint_as_float(q.w << 16); y[8 * j + 7] += __uint_as_float(q.w & 0xffff0000u); } } }
            float ss = 0.f;
#pragma unroll
            for (int i = 0; i < 32; ++i) ss += y[i] * y[i];
            const float r = rsqrtf(wave_sum(ss) * (1.f / D) + EPS);
#pragma unroll
            for (int j = 0; j < 4; ++j) { const int col = 8 * F.lane + 512 * j; float* op = F.out + (size_t)row * D + col;
#pragma unroll
                for (int hh = 0; hh < 2; ++hh) { f32x4 yy = {y[8 * j + 4 * hh], y[8 * j + 4 * hh + 1], y[8 * j + 4 * hh + 2], y[8 * j + 4 * hh + 3]};
                    *(f32x4*)(op + 4 * hh) = x1v[2 * j + hh] + gtv[2 * j + hh] * (yy * r * gpv[2 * j + hh]); } } } }
    }
}
typedef short bf16x8 __attribute__((ext_vector_type(8)));
typedef short s16x4 __attribute__((ext_vector_type(4)));
typedef short v4i16_t __attribute__((ext_vector_type(4)));
typedef float f32x16 __attribute__((ext_vector_type(16)));
typedef float f32x2m __attribute__((ext_vector_type(2)));
constexpr int RS = 272;
constexpr int RSA = 144;
constexpr float LOG2E = 1.4426950408889634f;
__device__ __forceinline__ s16x4 tr4(const LAS unsigned char* p) { return __builtin_bit_cast(s16x4, __builtin_amdgcn_ds_read_tr16_b64_v4i16((LAS v4i16_t*)p)); }
__device__ __forceinline__ bf16x8 tr8(const LAS unsigned char* p, int second) { const s16x4 a = tr4(p), b = tr4(p + second); return (bf16x8){a[0], a[1], a[2], a[3], b[0], b[1], b[2], b[3]}; }
__device__ __forceinline__ bf16x8 ld8(const LAS unsigned char* p) { return *(const LAS bf16x8*)p; }
__device__ __forceinline__ unsigned cvtpk(float lo, float hi) { return pg8::cvt_pk_bf16(lo, hi); }
__device__ __forceinline__ int crow(int r, int hi) { return (r & 3) + 8 * (r >> 2) + 4 * hi; }
#define MFMA16(a, b, c) __builtin_amdgcn_mfma_f32_16x16x32_bf16((a), (b), (c), 0, 0, 0)
#define MFMA32(a, b, c) __builtin_amdgcn_mfma_f32_32x32x16_bf16((a), (b), (c), 0, 0, 0)

__device__ __forceinline__ void rope_pass(Ctx& F) {
    const bf16* PROJ = (const bf16*)(F.ws + WS_PROJ); const float* ROPE = (const float*)(F.ws + WS_ROPE); bf16* QR = (bf16*)(F.ws + WS_QR); bf16* KR = (bf16*)(F.ws + WS_KR);
    const int NT = F.G * 512;
    for (int it0 = blockIdx.x * 512 + F.tid; it0 < T * 80; it0 += 2 * NT) {
        v4u a[2], bq[2]; f32x4 cs[2][4]; bool ok[2];
#pragma unroll
        for (int u = 0; u < 2; ++u) { const int it = it0 + u * NT; ok[u] = it < T * 80; if (ok[u]) { const int i8 = it & 7, hh = (it >> 3) % 10, t = it / 80;
            const bf16* src = PROJ + (size_t)t * INW + (hh < 8 ? C_AQ + hh * 128 : C_AK + (hh - 8) * 128) + i8 * 8;
            a[u] = *(const v4u*)src; bq[u] = *(const v4u*)(src + 64);
            const f32x4* rp = (const f32x4*)(ROPE + ((size_t)t * 64 + i8 * 8) * 2);
#pragma unroll
            for (int k = 0; k < 4; ++k) cs[u][k] = rp[k]; } }
#pragma unroll
        for (int u = 0; u < 2; ++u) { if (ok[u]) { const int it = it0 + u * NT; const int i8 = it & 7, hh = (it >> 3) % 10, t = it / 80;
            const unsigned aw[4] = {a[u].x, a[u].y, a[u].z, a[u].w}, bw[4] = {bq[u].x, bq[u].y, bq[u].z, bq[u].w};
            unsigned o1[4], o2[4];
#pragma unroll
            for (int k = 0; k < 4; ++k) { const f32x4 c4 = cs[u][k];
                const float x1a = __uint_as_float(aw[k] << 16), x1b = __uint_as_float(aw[k] & 0xffff0000u), x2a = __uint_as_float(bw[k] << 16), x2b = __uint_as_float(bw[k] & 0xffff0000u);
                o1[k] = pk2(x1a * c4.x - x2a * c4.y, x1b * c4.z - x2b * c4.w); o2[k] = pk2(x1a * c4.y + x2a * c4.x, x1b * c4.w + x2b * c4.z); }
            bf16* dst = (hh < 8 ? QR + (size_t)t * 1024 + hh * 128 : KR + (size_t)t * 256 + (hh - 8) * 128) + i8 * 8;
            *(v4u*)dst = (v4u){o1[0], o1[1], o1[2], o1[3]}; *(v4u*)(dst + 64) = (v4u){o2[0], o2[1], o2[2], o2[3]}; } }
    }
}
__device__ __forceinline__ void hgrn_a_phase(Ctx& F, LAS unsigned char* L) {
    const bf16* PROJ = (const bf16*)(F.ws + WS_PROJ); const float* LB = (const float*)(F.ws + WS_LB); bf16* CS = (bf16*)(F.ws + WS_CS); float* DEC = (float*)(F.ws + WS_DEC);
    LAS unsigned char* KD = L; LAS unsigned char* VV = L + 17408; LAS float* TOT = (LAS float*)(L + 34816);
    const int tid = F.tid, lane = F.lane, w = F.wave, dk0 = 2 * lane;
    const int tro16 = (8 * (lane >> 4) + ((lane & 15) >> 2)) * RS + (lane & 3) * 8;
    unsigned zraw[8]; v4u vr[2]; float lbA = 0.f, lbB = 0.f;
#define HA_LOAD(un) do { const int c_ = (un) & 63, dir_ = ((un) >> 6) & 1, h_ = ((un) >> 7) & 7, b_ = (un) >> 10; const size_t rb_ = (size_t)b_ * SEQ + c_ * 64; \
        { const float2 l2_ = *(const float2*)(LB + dir_ * 1024 + h_ * 128 + dk0); lbA = l2_.x; lbB = l2_.y; } \
        const bf16* zp_ = PROJ + (rb_ + 8 * w) * INW + (dir_ ? C_FB : C_FF) + h_ * 128; \
        _Pragma("unroll") for (int i = 0; i < 8; ++i) zraw[i] = *(const unsigned*)(zp_ + (size_t)i * INW + dk0); \
        _Pragma("unroll") for (int i = 0; i < 2; ++i) { const int idx = tid + 512 * i, row = idx >> 4, ch = idx & 15; vr[i] = *(const v4u*)(PROJ + (rb_ + row) * INW + C_HI + h_ * 128 + ch * 8); } } while (0)
    if ((int)blockIdx.x < 2048) HA_LOAD((int)blockIdx.x);
    for (int unit = blockIdx.x; unit < 2048; unit += F.G) {
        const int dir = (unit >> 6) & 1;
        float lfa[8], lfb[8], ka[8], kb[8];
#pragma unroll
        for (int i = 0; i < 8; ++i) { const float za = __uint_as_float(zraw[i] << 16), zb = __uint_as_float(zraw[i] & 0xffff0000u);
            const float fa = lbA + (1.f - lbA) * sigmoidf_(za), fb = lbB + (1.f - lbB) * sigmoidf_(zb); lfa[i] = __logf(fa); lfb[i] = __logf(fb); ka[i] = 1.f - fa; kb[i] = 1.f - fb; }
#pragma unroll
        for (int i = 0; i < 2; ++i) { const int idx = tid + 512 * i, row = idx >> 4, ch = idx & 15; *(LAS v4u*)(VV + row * RS + ch * 16) = vr[i]; }
        if (unit + F.G < 2048) HA_LOAD(unit + F.G);
        float runa = 0.f, runb = 0.f;
        if (dir == 0) {
#pragma unroll
            for (int i = 0; i < 8; ++i) { runa += lfa[i]; lfa[i] = runa; runb += lfb[i]; lfb[i] = runb; } }
        else {
#pragma unroll
            for (int i = 7; i >= 0; --i) { runa += lfa[i]; lfa[i] = runa; runb += lfb[i]; lfb[i] = runb; } }
        *(LAS f32x2m*)(TOT + w * 128 + dk0) = (f32x2m){runa, runb};
        __syncthreads();
        float totA = 0.f, totB = 0.f, offA = 0.f, offB = 0.f;
#pragma unroll
        for (int p = 0; p < 8; ++p) { const f32x2m t = *(const LAS f32x2m*)(TOT + p * 128 + dk0); totA += t.x; totB += t.y;
            const bool inoff = dir == 0 ? (p < w) : (p > w); offA += inoff ? t.x : 0.f; offB += inoff ? t.y : 0.f; }
#pragma unroll
        for (int i = 0; i < 8; ++i) { const float va = ka[i] * __expf(totA - (lfa[i] + offA)), vb = kb[i] * __expf(totB - (lfb[i] + offB));
            *(LAS unsigned*)(KD + (8 * w + i) * RS + dk0 * 2) = pk2(va, vb); }
        if (w == 0) *(float2*)(DEC + (size_t)unit * 128 + dk0) = make_float2(__expf(totA), __expf(totB));
        __syncthreads();
        f32x4 acc[2][4];
#pragma unroll
        for (int a = 0; a < 2; ++a)
#pragma unroll
            for (int t = 0; t < 4; ++t) acc[a][t] = (f32x4){0.f, 0.f, 0.f, 0.f};
        const int dvb = 32 * (w & 3), dkb = 64 * (w >> 2);
#pragma unroll
        for (int s = 0; s < 2; ++s) {
            bf16x8 af[2], bfr[4];
#pragma unroll
            for (int a = 0; a < 2; ++a) af[a] = tr8(VV + (32 * s) * RS + (dvb + 16 * a) * 2 + tro16, 4 * RS);
#pragma unroll
            for (int t = 0; t < 4; ++t) bfr[t] = tr8(KD + (32 * s) * RS + (dkb + 16 * t) * 2 + tro16, 4 * RS);
#pragma unroll
            for (int a = 0; a < 2; ++a)
#pragma unroll
                for (int t = 0; t < 4; ++t) acc[a][t] = MFMA16(af[a], bfr[t], acc[a][t]);
        }
        bf16* cso = CS + (size_t)unit * 16384;
        const int cc = lane & 15, rg = lane >> 4;
#pragma unroll
        for (int a = 0; a < 2; ++a)
#pragma unroll
            for (int t = 0; t < 4; ++t) { const int dkk = dkb + 16 * t + cc, dv0 = dvb + 16 * a + 4 * rg;
                uint2 o; o.x = cvtpk(acc[a][t][0], acc[a][t][1]); o.y = cvtpk(acc[a][t][2], acc[a][t][3]); *(uint2*)(cso + dkk * 128 + dv0) = o; }
        __syncthreads();
    }
#undef HA_LOAD
}
__device__ __forceinline__ void hgrn_scan_phase(Ctx& F) {
    const bf16* CS = (const bf16*)(F.ws + WS_CS); bf16* ST = (bf16*)(F.ws + WS_STATE); const float* DEC = (const float*)(F.ws + WS_DEC);
    const int NT = F.G * 512;
    for (int gt = blockIdx.x * 512 + F.tid; gt < 32 * 4096; gt += NT) {
        const int g = gt >> 12, e4 = (gt & 4095) * 4, dk = e4 >> 7, dir = g & 1;
        float s0 = 0.f, s1 = 0.f, s2 = 0.f, s3 = 0.f;
        uint2 tn[8]; float dn[8];
#define SC_LOAD(st_) do { _Pragma("unroll") for (int k = 0; k < 8; ++k) { const int c_ = dir ? 63 - ((st_) + k) : (st_) + k; const size_t u_ = (size_t)g * 64 + c_; { const u2v_t t2_ = __builtin_nontemporal_load((const u2v_t*)(CS + u_ * 16384 + e4)); tn[k].x = t2_.x; tn[k].y = t2_.y; } dn[k] = DEC[u_ * 128 + dk]; } } while (0)
        SC_LOAD(0);
        for (int st = 0; st < 64; st += 8) {
            uint2 tmp[8]; float dc[8];
#pragma unroll
            for (int k = 0; k < 8; ++k) { tmp[k] = tn[k]; dc[k] = dn[k]; }
            if (st + 8 < 64) SC_LOAD(st + 8);
#pragma unroll
            for (int k = 0; k < 8; ++k) { const int c = dir ? 63 - (st + k) : st + k; const size_t unit = (size_t)g * 64 + c;
                uint2 o; o.x = pk2(s0, s1); o.y = pk2(s2, s3); *(uint2*)(ST + unit * 16384 + e4) = o;
                s0 = dc[k] * s0 + __uint_as_float(tmp[k].x << 16); s1 = dc[k] * s1 + __uint_as_float(tmp[k].x & 0xffff0000u);
                s2 = dc[k] * s2 + __uint_as_float(tmp[k].y << 16); s3 = dc[k] * s3 + __uint_as_float(tmp[k].y & 0xffff0000u); }
        }
#undef SC_LOAD
    }
}
__device__ __forceinline__ void hgrn_c_phase(Ctx& F, LAS unsigned char* L) {
    const bf16* PROJ = (const bf16*)(F.ws + WS_PROJ); const float* LB = (const float*)(F.ws + WS_LB); const bf16* ST = (const bf16*)(F.ws + WS_STATE); bf16* YAIN = (bf16*)(F.ws + WS_YAIN);
    LAS unsigned char* QI = L; LAS unsigned char* KI = L + 17408; LAS unsigned char* QE = L + 34816; LAS unsigned char* VV = L + 52224; LAS unsigned char* SP = L + 69632; LAS unsigned char* AM = L + 104448;
    LAS float* TOT = (LAS float*)(L + 113664); LAS float* SSQ = (LAS float*)(L + 117760);
    const int tid = F.tid, lane = F.lane, w = F.wave, dk0 = 2 * lane, cc = lane & 15, rg = lane >> 4;
    const int tro16 = (8 * (lane >> 4) + ((lane & 15) >> 2)) * RS + (lane & 3) * 8;
    unsigned zraw[8], qraw[8]; v4u vr[2], sr[4]; float lbA = 0.f, lbB = 0.f;
#define HC_LOAD(un, dr) do { const int c_ = (un) & 63, h_ = ((un) >> 6) & 7, b_ = (un) >> 9; const size_t rb_ = (size_t)b_ * SEQ + c_ * 64; \
        { const float2 l2_ = *(const float2*)(LB + (dr) * 1024 + h_ * 128 + dk0); lbA = l2_.x; lbB = l2_.y; } \
        const bf16* zp_ = PROJ + (rb_ + 8 * w) * INW + h_ * 128; \
        _Pragma("unroll") for (int i = 0; i < 8; ++i) { const bf16* rp_ = zp_ + (size_t)i * INW; zraw[i] = *(const unsigned*)(rp_ + ((dr) ? C_FB : C_FF) + dk0); qraw[i] = *(const unsigned*)(rp_ + C_HQ + dk0); } \
        if ((dr) == 0) { _Pragma("unroll") for (int i = 0; i < 2; ++i) { const int idx = tid + 512 * i, row = idx >> 4, ch = idx & 15; vr[i] = *(const v4u*)(PROJ + (rb_ + row) * INW + C_HI + h_ * 128 + ch * 8); } } \
        { const bf16* sp_ = ST + ((size_t)((b_ * 8 + h_) * 2 + (dr)) * 64 + c_) * 16384; \
          _Pragma("unroll") for (int i = 0; i < 4; ++i) { const int idx = tid + 512 * i; sr[i] = __builtin_nontemporal_load((const v4u*)(sp_ + idx * 8)); } } } while (0)
    if ((int)blockIdx.x < 1024) HC_LOAD((int)blockIdx.x, 0);
    for (int unit = blockIdx.x; unit < 1024; unit += F.G) {
        const int c = unit & 63, h = (unit >> 6) & 7, b = unit >> 9;
        const size_t rb = (size_t)b * SEQ + c * 64;
        f32x4 o[4];
#pragma unroll
        for (int t = 0; t < 4; ++t) o[t] = (f32x4){0.f, 0.f, 0.f, 0.f};
        for (int dir = 0; dir < 2; ++dir) {
            float lfa[8], lfb[8], ka[8], kb[8], qa[8], qb[8];
#pragma unroll
            for (int i = 0; i < 8; ++i) { const float za = __uint_as_float(zraw[i] << 16), zb = __uint_as_float(zraw[i] & 0xffff0000u);
                const float fa = lbA + (1.f - lbA) * sigmoidf_(za), fb = lbB + (1.f - lbB) * sigmoidf_(zb); lfa[i] = __logf(fa); lfb[i] = __logf(fb); ka[i] = 1.f - fa; kb[i] = 1.f - fb;
                qa[i] = siluf_(__uint_as_float(qraw[i] << 16)); qb[i] = siluf_(__uint_as_float(qraw[i] & 0xffff0000u)); }
            if (dir == 0) {
#pragma unroll
                for (int i = 0; i < 2; ++i) { const int idx = tid + 512 * i, row = idx >> 4, ch = idx & 15; *(LAS v4u*)(VV + row * RS + ch * 16) = vr[i]; } }
#pragma unroll
            for (int i = 0; i < 4; ++i) { const int idx = tid + 512 * i, row = idx >> 4, ch = idx & 15; *(LAS v4u*)(SP + row * RS + ch * 16) = sr[i]; }
            if (dir == 0) HC_LOAD(unit, 1); else if (unit + F.G < 1024) HC_LOAD(unit + F.G, 0);
            float runa = 0.f, runb = 0.f;
            if (dir == 0) {
#pragma unroll
                for (int i = 0; i < 8; ++i) { runa += lfa[i]; lfa[i] = runa; runb += lfb[i]; lfb[i] = runb; } }
            else {
#pragma unroll
                for (int i = 7; i >= 0; --i) { runa += lfa[i]; lfa[i] = runa; runb += lfb[i]; lfb[i] = runb; } }
            *(LAS f32x2m*)(TOT + w * 128 + dk0) = (f32x2m){runa, runb};
            __syncthreads();
            {   float offA = 0.f, offB = 0.f, brA = 0.f, brB = 0.f;
#pragma unroll
                for (int p = 0; p < 8; ++p) { const f32x2m t = *(const LAS f32x2m*)(TOT + p * 128 + dk0);
                    const bool inoff = dir == 0 ? (p < w) : (p > w), inref = dir == 0 ? (p < 4) : (p >= 4);
                    offA += inoff ? t.x : 0.f; offB += inoff ? t.y : 0.f; brA += inref ? t.x : 0.f; brB += inref ? t.y : 0.f; }
#pragma unroll
                for (int i = 0; i < 8; ++i) { const float ba = lfa[i] + offA, bb = lfb[i] + offB; const int ro = (8 * w + i) * RS + dk0 * 2;
                    *(LAS unsigned*)(QI + ro) = pk2(qa[i] * __expf(ba - brA), qb[i] * __expf(bb - brB));
                    *(LAS unsigned*)(KI + ro) = pk2(ka[i] * __expf(brA - ba), kb[i] * __expf(brB - bb));
                    *(LAS unsigned*)(QE + ro) = pk2(qa[i] * __expf(ba), qb[i] * __expf(bb)); }
            }
            __syncthreads();
            {
                const int rt = w >> 1, ct0 = 2 * (w & 1);
                f32x4 am[2] = {(f32x4){0.f, 0.f, 0.f, 0.f}, (f32x4){0.f, 0.f, 0.f, 0.f}};
#pragma unroll
                for (int s = 0; s < 4; ++s) { const bf16x8 af = ld8(QI + (16 * rt + cc) * RS + (32 * s + 8 * rg) * 2);
#pragma unroll
                    for (int t = 0; t < 2; ++t) { const bf16x8 bfr = ld8(KI + (16 * (ct0 + t) + cc) * RS + (32 * s + 8 * rg) * 2); am[t] = MFMA16(af, bfr, am[t]); } }
#pragma unroll
                for (int t = 0; t < 2; ++t)
#pragma unroll
                    for (int i = 0; i < 4; ++i) { const int l = 16 * rt + 4 * rg + i, m = 16 * (ct0 + t) + cc; const bool keep = dir == 0 ? (m <= l) : (m >= l);
                        *(LAS bf16*)(AM + l * RSA + m * 2) = f2bf(keep ? am[t][i] : 0.f); }
            }
            __syncthreads();
            {
                const int rt = w & 3, cb = 64 * (w >> 2);
#pragma unroll
                for (int s = 0; s < 2; ++s) { const bf16x8 af = ld8(AM + (16 * rt + cc) * RSA + (32 * s + 8 * rg) * 2);
#pragma unroll
                    for (int t = 0; t < 4; ++t) { const bf16x8 bfr = tr8(VV + (32 * s) * RS + (cb + 16 * t) * 2 + tro16, 4 * RS); o[t] = MFMA16(af, bfr, o[t]); } }
#pragma unroll
                for (int s = 0; s < 4; ++s) { const bf16x8 af = ld8(QE + (16 * rt + cc) * RS + (32 * s + 8 * rg) * 2);
#pragma unroll
                    for (int t = 0; t < 4; ++t) { const bf16x8 bfr = tr8(SP + (32 * s) * RS + (cb + 16 * t) * 2 + tro16, 4 * RS); o[t] = MFMA16(af, bfr, o[t]); } }
            }
            __syncthreads();
        }
        const int rt = w & 3, chh = w >> 2, cb = 64 * chh;
        bf16 hgv[4][4]; float onv[4];
#pragma unroll
        for (int t = 0; t < 4; ++t) { const int dv = cb + 16 * t + cc; onv[t] = F.onorm[h * 128 + dv];
#pragma unroll
            for (int i = 0; i < 4; ++i) hgv[i][t] = PROJ[(rb + 16 * rt + 4 * rg + i) * INW + C_HG + h * 128 + dv]; }
        float ssv[4];
#pragma unroll
        for (int i = 0; i < 4; ++i) { float sq = 0.f;
#pragma unroll
            for (int t = 0; t < 4; ++t) sq += o[t][i] * o[t][i];
            sq += __shfl_xor(sq, 1); sq += __shfl_xor(sq, 2); sq += __shfl_xor(sq, 4); sq += __shfl_xor(sq, 8); ssv[i] = sq; }
        if (cc == 0) {
#pragma unroll
            for (int i = 0; i < 4; ++i) SSQ[chh * 64 + 16 * rt + 4 * rg + i] = ssv[i]; }
        __syncthreads();
        float rr[4];
#pragma unroll
        for (int i = 0; i < 4; ++i) { const int l = 16 * rt + 4 * rg + i; rr[i] = rsqrtf((SSQ[l] + SSQ[64 + l]) * (1.f / 128.f) + EPS); }
#pragma unroll
        for (int i = 0; i < 4; ++i) { const int l = 16 * rt + 4 * rg + i;
#pragma unroll
            for (int t = 0; t < 4; ++t) { const int dv = cb + 16 * t + cc;
                YAIN[(rb + l) * 1024 + h * 128 + dv] = f2bf(o[t][i] * rr[i] * onv[t] * siluf_(bf2f(hgv[i][t]))); } }
        __syncthreads();
    }
#undef HC_LOAD
}
__device__ __forceinline__ void rope8(v4u& a, v4u& bq, const f32x4 (&cs)[4]) {
    const unsigned aw[4] = {a.x, a.y, a.z, a.w}, bw[4] = {bq.x, bq.y, bq.z, bq.w}; unsigned o1[4], o2[4];
#pragma unroll
    for (int k = 0; k < 4; ++k) { const f32x4 c4 = cs[k];
        const float x1a = __uint_as_float(aw[k] << 16), x1b = __uint_as_float(aw[k] & 0xffff0000u), x2a = __uint_as_float(bw[k] << 16), x2b = __uint_as_float(bw[k] & 0xffff0000u);
        o1[k] = pk2(x1a * c4.x - x2a * c4.y, x1b * c4.z - x2b * c4.w); o2[k] = pk2(x1a * c4.y + x2a * c4.x, x1b * c4.w + x2b * c4.z); }
    a = (v4u){o1[0], o1[1], o1[2], o1[3]}; bq = (v4u){o2[0], o2[1], o2[2], o2[3]};
}
__device__ __forceinline__ void attn_phase(Ctx& F, LAS unsigned char* L) {
    const bf16* PROJ = (const bf16*)(F.ws + WS_PROJ); const float* ROPE = (const float*)(F.ws + WS_ROPE); bf16* ATT = (bf16*)(F.ws + WS_ATT);
    LAS unsigned char* KT = L; LAS unsigned char* VT = L + 17408; LAS float* AL = (LAS float*)(L + 34816) + F.wave * 32;
    const int tid = F.tid, lane = F.lane, w = F.wave, q32 = lane & 31, hh = lane >> 5;
    const int tro32 = (4 * hh + ((lane & 15) >> 2)) * RS + (16 * ((lane >> 4) & 1) + 4 * (lane & 3)) * 2;
    const int krow = tid >> 3, kc8 = tid & 7;
    constexpr float C2 = 0.08838834764831845f * LOG2E;
    for (int unit = blockIdx.x; unit < 256; unit += F.G) {
        const int qb = unit & 63, kvh = (unit >> 6) & 1, b = unit >> 7, q0 = qb * 64, h = kvh * 4 + (w >> 1);
        const int qp = q0 + 32 * (w & 1) + q32;
        bf16x8 qf[8];
        {
            const bf16* qptr = PROJ + ((size_t)b * SEQ + qp) * INW + C_AQ + h * 128 + 8 * hh;
            const f32x4* rp = (const f32x4*)(ROPE + (((size_t)b * SEQ + qp) * 64 + 8 * hh) * 2);
#pragma unroll
            for (int s = 0; s < 4; ++s) { v4u x1 = *(const v4u*)(qptr + 16 * s), x2 = *(const v4u*)(qptr + 16 * s + 64);
                f32x4 cs[4];
#pragma unroll
                for (int k = 0; k < 4; ++k) cs[k] = rp[8 * s + k];
                rope8(x1, x2, cs); qf[s] = __builtin_bit_cast(bf16x8, x1); qf[s + 4] = __builtin_bit_cast(bf16x8, x2); }
        }
        float m = F.sink[h] * LOG2E, l = 1.f;
        f32x16 o[4];
#pragma unroll
        for (int d = 0; d < 4; ++d)
#pragma unroll
            for (int r = 0; r < 16; ++r) o[d][r] = 0.f;
        int j = 0; while (j < 5 && (q0 - 128 + 64 * j < 0 || q0 - 128 + 64 * j >= SEQ)) ++j;
        v4u kr[2], vr[2]; f32x4 kcs[4];
#define ATT_LOAD(jj) do { const int kb_ = q0 - 128 + 64 * (jj); \
            { const size_t t_ = (size_t)b * SEQ + kb_ + krow; const bf16* kp_ = PROJ + t_ * INW + C_AK + kvh * 128 + kc8 * 8; kr[0] = *(const v4u*)kp_; kr[1] = *(const v4u*)(kp_ + 64); \
              const f32x4* rp_ = (const f32x4*)(ROPE + (t_ * 64 + kc8 * 8) * 2); _Pragma("unroll") for (int k = 0; k < 4; ++k) kcs[k] = rp_[k]; } \
            _Pragma("unroll") for (int i = 0; i < 2; ++i) { const int idx = tid + 512 * i, row = idx >> 4, ch = idx & 15; \
                vr[i] = *(const v4u*)(PROJ + ((size_t)b * SEQ + kb_ + row) * INW + C_AV + kvh * 128 + ch * 8); } } while (0)
        if (j < 5) ATT_LOAD(j);
        while (j < 5) {
            const int kb = q0 - 128 + 64 * j;
            __syncthreads();
            rope8(kr[0], kr[1], kcs);
            *(LAS v4u*)(KT + krow * RS + kc8 * 16) = kr[0]; *(LAS v4u*)(KT + krow * RS + (kc8 + 8) * 16) = kr[1];
#pragma unroll
            for (int i = 0; i < 2; ++i) { const int idx = tid + 512 * i, row = idx >> 4, ch = idx & 15; *(LAS v4u*)(VT + row * RS + ch * 16) = vr[i]; }
            __syncthreads();
            int jn = j + 1; while (jn < 5 && (q0 - 128 + 64 * jn < 0 || q0 - 128 + 64 * jn >= SEQ)) ++jn;
            if (jn < 5) ATT_LOAD(jn);
            f32x16 p0, p1;
#pragma unroll
            for (int r = 0; r < 16; ++r) { p0[r] = 0.f; p1[r] = 0.f; }
#pragma unroll
            for (int s = 0; s < 8; ++s) { const bf16x8 k0 = ld8(KT + q32 * RS + (16 * s + 8 * hh) * 2), k1 = ld8(KT + (32 + q32) * RS + (16 * s + 8 * hh) * 2);
                p0 = MFMA32(k0, qf[s], p0); p1 = MFMA32(k1, qf[s], p1); }
            float tmax = -INFINITY;
#pragma unroll
            for (int r = 0; r < 16; ++r) { const int d0 = kb + crow(r, hh) - qp;
                p0[r] = ((unsigned)(d0 + 128) <= 256u) ? p0[r] * C2 : -INFINITY; p1[r] = ((unsigned)(d0 + 32 + 128) <= 256u) ? p1[r] * C2 : -INFINITY;
                tmax = fmaxf(tmax, fmaxf(p0[r], p1[r])); }
            tmax = fmaxf(tmax, __shfl_xor(tmax, 32));
            const float mn = fmaxf(m, tmax), alpha = __builtin_amdgcn_exp2f(m - mn); m = mn;
            float rs = 0.f;
#pragma unroll
            for (int r = 0; r < 16; ++r) { p0[r] = __builtin_amdgcn_exp2f(p0[r] - mn); p1[r] = __builtin_amdgcn_exp2f(p1[r] - mn); rs += p0[r] + p1[r]; }
            rs += __shfl_xor(rs, 32);
            l = l * alpha + rs;
            if (hh == 0) AL[q32] = alpha;
            LDS_WAIT();
#pragma unroll
            for (int g4 = 0; g4 < 4; ++g4) { const f32x4 a4 = *(const LAS f32x4*)(AL + 8 * g4 + 4 * hh);
#pragma unroll
                for (int d = 0; d < 4; ++d) { o[d][4 * g4 + 0] *= a4.x; o[d][4 * g4 + 1] *= a4.y; o[d][4 * g4 + 2] *= a4.z; o[d][4 * g4 + 3] *= a4.w; } }
#pragma unroll
            for (int kb2 = 0; kb2 < 2; ++kb2)
#pragma unroll
                for (int s = 0; s < 2; ++s) {
                    unsigned pw[4];
#pragma unroll
                    for (int k = 0; k < 4; ++k) pw[k] = kb2 ? cvtpk(p1[8 * s + 2 * k], p1[8 * s + 2 * k + 1]) : cvtpk(p0[8 * s + 2 * k], p0[8 * s + 2 * k + 1]);
                    const bf16x8 pa = __builtin_bit_cast(bf16x8, (v4u){pw[0], pw[1], pw[2], pw[3]});
#pragma unroll
                    for (int d = 0; d < 4; ++d) { const bf16x8 vf = tr8(VT + (32 * kb2 + 16 * s) * RS + 64 * d + tro32, 8 * RS); o[d] = MFMA32(pa, vf, o[d]); }
                }
            j = jn;
        }
#undef ATT_LOAD
        if (hh == 0) AL[q32] = 1.f / l;
        LDS_WAIT();
#pragma unroll
        for (int g4 = 0; g4 < 4; ++g4) { const f32x4 a4 = *(const LAS f32x4*)(AL + 8 * g4 + 4 * hh); const float av[4] = {a4.x, a4.y, a4.z, a4.w};
#pragma unroll
            for (int i = 0; i < 4; ++i) { const int r = 4 * g4 + i; const int qrow = q0 + 32 * (w & 1) + crow(r, hh);
                bf16* op = ATT + ((size_t)b * SEQ + qrow) * 1024 + h * 128 + q32;
#pragma unroll
                for (int d = 0; d < 4; ++d) op[32 * d] = f2bf(o[d][r] * av[i]); } }
        __syncthreads();
    }
}

#ifdef TESTMODE
__global__ void __launch_bounds__(256) k_rope(const bf16* __restrict__ PROJ, const float* __restrict__ rope, bf16* __restrict__ QR, bf16* __restrict__ KR) {
    const int gid = blockIdx.x * 256 + threadIdx.x;
    const int i = gid & 63, hh = (gid >> 6) % 10, t = gid / 640;
    const float cs = rope[((size_t)t * 64 + i) * 2], sn = rope[((size_t)t * 64 + i) * 2 + 1];
    const bf16* src = PROJ + (size_t)t * INW + (hh < 8 ? C_AQ + hh * 128 : C_AK + (hh - 8) * 128);
    const float x1 = bf2f(src[i]), x2 = bf2f(src[i + 64]);
    bf16* dst = hh < 8 ? QR + (size_t)t * 1024 + hh * 128 : KR + (size_t)t * 256 + (hh - 8) * 128;
    dst[i] = f2bf(x1 * cs - x2 * sn); dst[i + 64] = f2bf(x1 * sn + x2 * cs);
}
__global__ void __launch_bounds__(256) k_hgrn_naive(const bf16* __restrict__ PROJ, const float* __restrict__ lb, float* __restrict__ OF, float* __restrict__ OB) {
    __shared__ float qs[128], fs[128], ks[128], part[128];
    const int dir = blockIdx.x & 1, h = (blockIdx.x >> 1) & 7, b = blockIdx.x >> 4, tid = threadIdx.x, dv = tid & 127, half = tid >> 7;
    float S[64];
#pragma unroll
    for (int i = 0; i < 64; ++i) S[i] = 0.f;
    float* O = dir ? OB : OF;
    const float lbv = tid < 128 ? lb[dir * 1024 + h * 128 + tid] : 0.f;
    bf16 nzq = 0, nzf = 0, nv = 0;
    { const int t = dir ? SEQ - 1 : 0; const bf16* pr = PROJ + ((size_t)b * SEQ + t) * INW;
      if (tid < 128) { nzq = pr[C_HQ + h * 128 + tid]; nzf = pr[(dir ? C_FB : C_FF) + h * 128 + tid]; } nv = pr[C_HI + h * 128 + dv]; }
    for (int tp = 0; tp < SEQ; ++tp) {
        const int t = dir ? SEQ - 1 - tp : tp; const size_t row = (size_t)b * SEQ + t;
        const bf16 czq = nzq, czf = nzf, cv = nv;
        if (tp + 1 < SEQ) { const int t2 = dir ? SEQ - 2 - tp : tp + 1; const bf16* pr = PROJ + ((size_t)b * SEQ + t2) * INW;
            if (tid < 128) { nzq = pr[C_HQ + h * 128 + tid]; nzf = pr[(dir ? C_FB : C_FF) + h * 128 + tid]; } nv = pr[C_HI + h * 128 + dv]; }
        if (tid < 128) { const float zq = bf2f(czq), zf = bf2f(czf);
            const float f = lbv + (1.f - lbv) * sigmoidf_(zf); qs[tid] = siluf_(zq); fs[tid] = f; ks[tid] = 1.f - f; }
        const float v = bf2f(cv);
        __syncthreads();
        float acc = 0.f;
#pragma unroll
        for (int i = 0; i < 64; ++i) { const int dk = half * 64 + i; S[i] = fs[dk] * S[i] + ks[dk] * v; acc += S[i] * qs[dk]; }
        if (half == 1) part[dv] = acc;
        __syncthreads();
        if (half == 0) O[row * 1024 + h * 128 + dv] = acc + part[dv];
    }
}
__global__ void __launch_bounds__(256) k_hgrn_post(const float* __restrict__ OF, const float* __restrict__ OB, const bf16* __restrict__ PROJ, const float* __restrict__ onorm, bf16* __restrict__ YAIN) {
    const int w = blockIdx.x * 4 + (threadIdx.x >> 6), lane = threadIdx.x & 63, row = w >> 3, h = w & 7;
    const size_t o = (size_t)row * 1024 + h * 128;
    const float a0 = OF[o + lane] + OB[o + lane], a1 = OF[o + 64 + lane] + OB[o + 64 + lane];
    float ss = a0 * a0 + a1 * a1;
    for (int s = 32; s > 0; s >>= 1) ss += __shfl_xor(ss, s);
    const float r = rsqrtf(ss * (1.f / 128.f) + EPS);
    const bf16* pg = PROJ + (size_t)row * INW + C_HG + h * 128;
    YAIN[o + lane] = f2bf(a0 * r * onorm[h * 128 + lane] * siluf_(bf2f(pg[lane])));
    YAIN[o + 64 + lane] = f2bf(a1 * r * onorm[h * 128 + 64 + lane] * siluf_(bf2f(pg[64 + lane])));
}
__global__ void __launch_bounds__(256) k_attn_naive(const bf16* __restrict__ QR, const bf16* __restrict__ KR, const bf16* __restrict__ PROJ, const float* __restrict__ sink, bf16* __restrict__ ATT) {
    __shared__ float sl[4][264];
    const int wv = threadIdx.x >> 6, lane = threadIdx.x & 63;
    const int w = blockIdx.x * 4 + wv;
    const int i = w & 4095, h = (w >> 12) & 7, b = w >> 15, kvh = h >> 2;
    const size_t qrow = (size_t)b * SEQ + i;
    const float q0 = bf2f(QR[qrow * 1024 + h * 128 + 2 * lane]), q1 = bf2f(QR[qrow * 1024 + h * 128 + 2 * lane + 1]);
    const int jlo = i - 128 < 0 ? 0 : i - 128, jhi = i + 128 > SEQ - 1 ? SEQ - 1 : i + 128;
    const float sk = sink[h];
    float m = sk;
    for (int j = jlo; j <= jhi; ++j) {
        const bf16* kr = KR + ((size_t)b * SEQ + j) * 256 + kvh * 128;
        float p = q0 * bf2f(kr[2 * lane]) + q1 * bf2f(kr[2 * lane + 1]);
        for (int s = 32; s > 0; s >>= 1) p += __shfl_xor(p, s);
        p *= 0.08838834764831845f;
        if (lane == 0) sl[wv][j - jlo] = p;
        m = fmaxf(m, p);
    }
    __syncthreads();
    float den = expf(sk - m), o0 = 0.f, o1 = 0.f;
    for (int j = jlo; j <= jhi; ++j) {
        const float p = expf(sl[wv][j - jlo] - m); den += p;
        const bf16* vr = PROJ + ((size_t)b * SEQ + j) * INW + C_AV + kvh * 128;
        o0 += p * bf2f(vr[2 * lane]); o1 += p * bf2f(vr[2 * lane + 1]);
    }
    ATT[qrow * 1024 + h * 128 + 2 * lane] = f2bf(o0 / den); ATT[qrow * 1024 + h * 128 + 2 * lane + 1] = f2bf(o1 / den);
}
#endif
__global__ void __launch_bounds__(NWAVES * 64, 2) mega(Args args) {
    extern __shared__ __attribute__((aligned(16))) unsigned char lds[];
    Ctx F;
    F.lds = lds; F.tid = threadIdx.x; F.lane = F.tid & 63; F.wave = __builtin_amdgcn_readfirstlane(F.tid >> 6); F.G = gridDim.x;
    F.gw = blockIdx.x * NWAVES + F.wave; F.NGW = F.G * NWAVES;
    F.x = (const float*)args.in[0]; F.c = (const float*)args.in[1]; F.pos = (const int*)args.in[2]; F.w_ada = (const float*)args.in[3]; F.b_ada = (const float*)args.in[4];
    F.g_pre_mix = (const float*)args.in[5]; F.g_post_mix = (const float*)args.in[6]; F.g_pre_ffn = (const float*)args.in[7]; F.g_post_ffn = (const float*)args.in[8];
    F.w_in = (const float*)args.in[9]; F.lbl = (const float*)args.in[10]; F.onorm = (const float*)args.in[11]; F.sink = (const float*)args.in[12];
    F.w_a = (const float*)args.in[13]; F.w_b = (const float*)args.in[14]; F.w_o = (const float*)args.in[15]; F.w_router = (const float*)args.in[16];
    F.w_eg = (const float*)args.in[17]; F.w_eu = (const float*)args.in[18]; F.w_ed = (const float*)args.in[19];
    F.out = args.out; F.ws = args.ws;
    LAS unsigned char* ldsl = (LAS unsigned char*)lds;
    for (int u = F.tid; u < (LDS_BYTES - LDSCTL_OFF) / 4; u += NWAVES * 64) ((LAS unsigned*)(ldsl + LDSCTL_OFF))[u] = 0u;
    __syncthreads();
    volatile LAS unsigned* MISC = (volatile LAS unsigned*)(ldsl + MISC_OFF);
    XcdBarrier bar = xcd_barrier_post((unsigned*)(args.ws + WS_CTL) + CW_BAR + args.li * XCD_BAR_WORDS, MISC + 8);
    const int lo = args.ph_lo, hi = args.ph_hi;
#ifdef PROBE_REP
#define REP(k) ((((PROBE_REP) >> (k)) & 1) ? 2 : 1)
#else
#define REP(k) 1
#endif
#define IN(k) (lo <= (k) && (k) < hi)
#define SEAM(k) do { if (IN(k) && IN((k) + 1)) xcd_barrier(bar); } while (0)
    unsigned char* ws = args.ws;
    bf16* H = (bf16*)(ws + WS_H); bf16* PROJ = (bf16*)(ws + WS_PROJ); bf16* WIN = (bf16*)(ws + WS_WIN); bf16* WA = (bf16*)(ws + WS_WA); bf16* WB = (bf16*)(ws + WS_WB); bf16* WO = (bf16*)(ws + WS_WO);
    bf16* WGU = (bf16*)(ws + WS_WGU); bf16* WD = (bf16*)(ws + WS_WD); bf16* YAIN = (bf16*)(ws + WS_YAIN); bf16* ATT = (bf16*)(ws + WS_ATT); bf16* MERGED = (bf16*)(ws + WS_MERGED);
    float* Y = (float*)(ws + WS_Y); bf16* XE = (bf16*)(ws + WS_XE); bf16* ACT = (bf16*)(ws + WS_ACT); bf16* SLAB = (bf16*)(ws + WS_SLAB); const float* SELAFF = (const float*)(ws + WS_SELAFF);
    const int vcu = (F.G % 8 == 0) ? ((int)blockIdx.x % 8) * (F.G / 8) + (int)blockIdx.x / 8 : (int)blockIdx.x;

    {
    if (IN(0)) { p0_prep(F); __syncthreads(); } SEAM(0);
#if defined(PROBE_DUP) && PROBE_DUP == 0
    if (IN(0)) { p0_prep(F); __syncthreads(); } SEAM(0);
#endif
    }
    {
    if (IN(2)) {
        if (F.G == 256 && blockIdx.x >= 256 - CONV_BLOCKS) { float* scr = (float*)(F.lds + F.wave * 16384); TailSeq seq{I_MIX + P0_EXPERT_ITEMS + ((int)blockIdx.x - (256 - CONV_BLOCKS)) * NWAVES + F.wave, CONV_BLOCKS * NWAVES}; transpose_stream(F, seq, scr); }
        else {
            const int gg = F.G == 256 ? 256 - CONV_BLOCKS : F.G;
            pg8::Gemm g{H, WIN, T, INW, D / 2}; pg8::StaticOrder S; S.init(T, INW, gg, (int)blockIdx.x);
            pg8::EpiStore E{PROJ, INW, 0xffff, nullptr, 1.f / (W8S_IN * X8S_IN)};
            pg8::gemm_phase<pg8::EpiStore, pg8::StaticOrder, PG8_ALIGN, PG8_SP2, false, true>(ldsl + RING_OFF, g, S, E);
            if (F.G != 256 && blockIdx.x == 0) { float* scr = (float*)(F.lds + F.wave * 16384); TailSeq seq{I_MIX + P0_EXPERT_ITEMS + F.wave, NWAVES}; transpose_stream(F, seq, scr); }
        }
    } SEAM(2);
    }
    {
    if (IN(3)) { if (args.mask & 2) hgrn_a_phase(F, ldsl); } SEAM(3);
#if defined(PROBE_DUP) && PROBE_DUP == 3
    if (IN(3)) { if (args.mask & 2) hgrn_a_phase(F, ldsl); } SEAM(3);
#endif
    }
    {
    if (IN(4)) { if (args.mask & 2) hgrn_scan_phase(F); if (args.mask & 1) attn_phase(F, ldsl); } SEAM(4);
#if defined(PROBE_DUP) && PROBE_DUP == 4
    if (IN(4)) { if (args.mask & 2) hgrn_scan_phase(F); if (args.mask & 1) attn_phase(F, ldsl); } SEAM(4);
#endif
    }
    {
    if (IN(5)) { if (args.mask & 2) hgrn_c_phase(F, ldsl); } SEAM(5);
#if defined(PROBE_DUP) && PROBE_DUP == 5
    if (IN(5)) { if (args.mask & 2) hgrn_c_phase(F, ldsl); } SEAM(5);
#endif
    }
    {
    if (IN(6)) {
        static_assert(WS_ATT == WS_YAIN + 16 * MiB && WS_WB == WS_WA + 4 * MiB, "branch operands must be contiguous");
        pg8::Gemm g{YAIN, WA, 2 * T, 2 * D, 1024}; pg8::BranchOrder S; S.S.init(T, D, F.G, (int)blockIdx.x);
        pg8::EpiGate2 E{MERGED, D, PROJ + C_GA, PROJ + C_GB, INW};
        pg8::gemm_phase<pg8::EpiGate2, pg8::BranchOrder, PG8_ALIGN, PG8_SP2>(ldsl + RING_OFF, g, S, E);
    } SEAM(6);
    }
    {
    if (IN(7)) {
        pg8::Gemm g{MERGED, WO, T, D, D}; pg8::StaticOrder S; S.init(T, D, F.G, (int)blockIdx.x);
        pg8::EpiStore E{(bf16*)Y, D, 0xffff, nullptr};
        pg8::gemm_phase<pg8::EpiStore, pg8::StaticOrder, PG8_ALIGN, PG8_SP2>(ldsl + RING_OFF, g, S, E);
    } SEAM(7);
#if defined(PROBE_DUP) && PROBE_DUP == 7
    if (IN(7)) {
        pg8::Gemm g{MERGED, WO, T, D, D}; pg8::StaticOrder S; S.init(T, D, F.G, (int)blockIdx.x);
        pg8::EpiStore E{(bf16*)Y, D, 0xffff, nullptr};
        pg8::gemm_phase<pg8::EpiStore, pg8::StaticOrder, PG8_ALIGN, PG8_SP2>(ldsl + RING_OFF, g, S, E);
    } SEAM(7);
#endif
    }
    {
    if (IN(8)) { p6_post1(F); } SEAM(8);
#if defined(PROBE_DUP) && PROBE_DUP == 8
    if (IN(8)) { p6_post1(F); } SEAM(8);
#endif
    }
    {
    if (IN(9)) { p7_topk_gather(F); } SEAM(9);
#if defined(PROBE_DUP) && PROBE_DUP == 9
    if (IN(9)) { p7_topk_gather(F); } SEAM(9);
#endif
    }
    {
    if (IN(10)) {
        pg8::Gemm g{(const bf16*)(ws + WS_H2), WGU, 16 * 1024, 16 * 2048, D / 2, (const int*)(ws + WS_GIDX)}; pg8::GroupedOrder S{F.G, vcu};
        pg8::EpiSwiglu8 E{(unsigned char*)ACT, 1.f / W8S_GU};
        pg8::gemm_phase<pg8::EpiSwiglu8, pg8::GroupedOrder, PG8_ALIGN, PG8_SP2, true, true>(ldsl + RING_OFF, g, S, E);
    } SEAM(10);
    }
    {
    if (IN(11)) {
        pg8::Gemm g{ACT, WD, 16 * 1024, 16 * 2048, 1024 / 2}; pg8::GroupedOrder S{F.G, vcu};
        pg8::EpiStore E{SLAB, D, 7, SELAFF, 1.f / W8S_D};
        pg8::gemm_phase<pg8::EpiStore, pg8::GroupedOrder, PG8_ALIGN, PG8_SP2, false, true>(ldsl + RING_OFF, g, S, E);
    } SEAM(11);
    }
    {
    if (IN(12)) { p10_final(F); }
    }
#undef IN
#undef SEAM
}

extern "C" void kernel_launch(void* const* d_in, const int* in_sizes, int n_in, void* d_out, int out_size, void* d_ws, size_t ws_size, hipStream_t stream) {
    static int grid = 0;
    if (grid == 0) {
        if (n_in != 20 || ws_size < WS_END) { fprintf(stderr, "kernel_launch: unexpected n_in %d or ws_size %zu\n", n_in, ws_size); grid = -1; return; }
        int dev = 0, cus = 0;
        if (hipGetDevice(&dev) != hipSuccess || hipDeviceGetAttribute(&cus, hipDeviceAttributeMultiprocessorCount, dev) != hipSuccess) { grid = -1; return; }
        if (hipFuncSetAttribute((const void*)mega, hipFuncAttributeMaxDynamicSharedMemorySize, LDS_BYTES) != hipSuccess) { fprintf(stderr, "kernel_launch: hipFuncSetAttribute failed\n"); grid = -1; return; }
        grid = cus;
    }
    if (grid < 0) return;
    char* ws = (char*)d_ws;
    (void)hipMemsetAsync(ws + WS_CTL, 0, CTL_ZERO_BYTES, stream);
    Args a{};
    for (int i = 0; i < 20; ++i) a.in[i] = d_in[i];
    a.out = (float*)d_out; a.ws = (unsigned char*)d_ws;
#ifndef TESTMODE
    a.ph_lo = 0; a.ph_hi = 13; a.li = 0; a.mask = 3;
#ifdef PROBE_REPEAT
    a.rep = PROBE_REPEAT;
#else
    a.rep = -1;
#endif
    hipLaunchKernelGGL(mega, dim3(grid), dim3(NWAVES * 64), LDS_BYTES, stream, a);
#ifdef PROBE_LO
    a.ph_lo = PROBE_LO; a.ph_hi = PROBE_HI; a.li = 1; a.mask = PROBE_MASK;
    hipLaunchKernelGGL(mega, dim3(grid), dim3(NWAVES * 64), LDS_BYTES, stream, a);
#endif
#else
    const float* LB = (const float*)(ws + WS_LB); const float* ROPE = (const float*)(ws + WS_ROPE);
    bf16* PROJ = (bf16*)(ws + WS_PROJ); bf16* QR = (bf16*)(ws + WS_QR); bf16* KR = (bf16*)(ws + WS_KR); bf16* YAIN = (bf16*)(ws + WS_YAIN); bf16* ATT = (bf16*)(ws + WS_ATT);
    float* OF = (float*)(ws + WS_CS); float* OB = (float*)(ws + WS_CS + 32 * MiB);
    a.ph_lo = 0; a.ph_hi = 3; a.li = 0; a.mask = 3;
    hipLaunchKernelGGL(mega, dim3(grid), dim3(NWAVES * 64), LDS_BYTES, stream, a);
#if TESTMODE == 1
    k_hgrn_naive<<<32, 256, 0, stream>>>(PROJ, LB, OF, OB);
    k_hgrn_post<<<T * 8 / 4, 256, 0, stream>>>(OF, OB, PROJ, (const float*)d_in[11], YAIN);
    a.ph_lo = 3; a.ph_hi = 6; a.li = 1; a.mask = 1;
    hipLaunchKernelGGL(mega, dim3(grid), dim3(NWAVES * 64), LDS_BYTES, stream, a);
#else
    k_rope<<<T * 640 / 256, 256, 0, stream>>>(PROJ, ROPE, QR, KR);
    k_attn_naive<<<BATCH * 8 * SEQ / 4, 256, 0, stream>>>(QR, KR, PROJ, (const float*)d_in[12], ATT);
    a.ph_lo = 3; a.ph_hi = 6; a.li = 1; a.mask = 2;
    hipLaunchKernelGGL(mega, dim3(grid), dim3(NWAVES * 64), LDS_BYTES, stream, a);
#endif
    a.ph_lo = 6; a.ph_hi = 13; a.li = 2; a.mask = 3;
    hipLaunchKernelGGL(mega, dim3(grid), dim3(NWAVES * 64), LDS_BYTES, stream, a);
#endif
}
```

```cpp
#include <hip/hip_runtime.h>
#include <cstdint>
#include <cstdio>

constexpr int D = 2048, BATCH = 2, SEQ = 4096, T = BATCH * SEQ;
constexpr int INW = 10752;
constexpr int C_HQ = 0, C_FF = 1024, C_FB = 2048, C_HI = 3072, C_HG = 4096, C_AQ = 5120, C_AK = 6144, C_AV = 6400, C_GA = 6656, C_GB = 8704;
constexpr int NE = 16, EFF = 1024, CAP = 512;
constexpr float EPS = 1e-6f;

typedef unsigned short bf16;
__device__ __forceinline__ float bf2f(bf16 v) { return __uint_as_float(((unsigned)v) << 16); }
typedef float f32x2h_t __attribute__((ext_vector_type(2))); typedef __bf16 bf16x2h_t __attribute__((ext_vector_type(2)));
__device__ __forceinline__ unsigned cvtpk2(float lo, float hi) { const f32x2h_t v = {lo, hi}; const bf16x2h_t b = __builtin_convertvector(v, bf16x2h_t); return __builtin_bit_cast(unsigned, b); }
__device__ __forceinline__ bf16 f2bf(float f) { return (bf16)(cvtpk2(f, 0.f) & 0xffffu); }
__device__ __forceinline__ float sigmoidf_(float x) { return __builtin_amdgcn_rcpf(1.f + __expf(-x)); }
__device__ __forceinline__ float siluf_(float x) { return x * __builtin_amdgcn_rcpf(1.f + __expf(-x)); }

constexpr size_t MiB = 1u << 20;
constexpr size_t WS_CTL = 0, CTL_ZERO_BYTES = 64 * 1024;
constexpr size_t WS_MOD = 1 * MiB;
constexpr size_t WS_LB = WS_MOD + 128 * 1024;
constexpr size_t WS_AFF = 2 * MiB;
constexpr size_t WS_GIDX = 3 * MiB;
constexpr size_t WS_SELAFF = WS_GIDX + 128 * 1024;
constexpr size_t WS_TOKSLOT = 4 * MiB;
constexpr size_t WS_DEC = 5 * MiB;
constexpr size_t WS_ROPE = 8 * MiB;
constexpr size_t WS_WIN = 16 * MiB;
constexpr size_t WS_WA = 60 * MiB, WS_WB = 64 * MiB, WS_WO = 68 * MiB;
constexpr size_t WS_WGU = 76 * MiB;
constexpr size_t WS_WD = 204 * MiB;
constexpr size_t WS_H = 268 * MiB;
constexpr size_t WS_PROJ = 300 * MiB;
constexpr size_t WS_Y = 520 * MiB;
constexpr size_t WS_XE = 300 * MiB;
constexpr size_t WS_ACT = 364 * MiB;
constexpr size_t WS_SLAB = 396 * MiB;
constexpr size_t WS_QR = 468 * MiB, WS_KR = 484 * MiB;
constexpr size_t WS_YAIN = 488 * MiB, WS_ATT = 504 * MiB;
constexpr size_t WS_CS = 520 * MiB;
constexpr size_t WS_STATE = 584 * MiB;
constexpr size_t WS_H2 = 584 * MiB;
constexpr size_t WS_MERGED = 268 * MiB;
constexpr size_t WS_END = 648 * MiB;
constexpr int CW_BAR = 4096;

namespace pg8 {
#define PG8_LAS __attribute__((address_space(3)))
typedef unsigned short bf16_t;
typedef short bf16x8 __attribute__((ext_vector_type(8)));
typedef float f32x4 __attribute__((ext_vector_type(4)));
typedef unsigned u32x4 __attribute__((ext_vector_type(4)));
constexpr int BM = 256, BK = 64, HALF = 128, HTB = HALF * BK * 2  , STAGE_BYTES = 8 * HTB, NXCD = 8, WGM = 8;

__host__ __device__ __forceinline__ int lds_byte(int r, int c) { const int st = (r >> 4) * 2 + (c >> 5), rr = r & 15, cc = c & 31, ob = rr * 64 + cc * 2; return st * 1024 + (ob ^ (((ob >> 9) & 1) << 5)); }
__host__ __device__ __forceinline__ void stage_rc(int b, int& R, int& C) { const int st = b / 1024, sb = b % 1024, swz = sb ^ (((sb >> 9) & 1) << 5); R = (st >> 1) * 16 + swz / 64; C = (st & 1) * 32 + (swz % 64) / 2; }
__host__ __device__ __forceinline__ int perm32(int rho) { const int n = rho >> 4, i = rho & 15; return 8 * (i >> 2) + 4 * n + (i & 3); }

struct Unit { int pm, pn; };
struct Gemm { const bf16_t* A; const bf16_t* Bt; int M, N, K; const int* gidx = nullptr; };

struct StaticOrder {
    int nM, nN, nwg, G, c;
    __host__ __device__ void init(int M, int N, int G_, int c_) { nM = M / BM; nN = N / BM; nwg = nM * nN; G = G_; c = c_; }
    __host__ __device__ bool next(int i, Unit& u) const {
        const long L = (long)i * G + c; if (L >= nwg) return false;
        int wgid = (int)L; { const int q = nwg / NXCD, r = nwg % NXCD, xcd = wgid % NXCD, off = wgid / NXCD; wgid = (xcd < r ? xcd * (q + 1) : r * (q + 1) + (xcd - r) * q) + off; }
        const int nig = WGM * nN, gid = wgid / nig, fm = gid * WGM, gsz = (nM - fm) < WGM ? (nM - fm) : WGM;
        u.pm = fm + ((wgid % nig) % gsz); u.pn = (wgid % nig) / gsz; return true;
    }
    __device__ __forceinline__ void a_ready(const Unit&) const {}
    __device__ __forceinline__ void done(const Unit&) const {}
};

typedef float f32x2c_t __attribute__((ext_vector_type(2))); typedef __bf16 bf16x2c_t __attribute__((ext_vector_type(2)));
__device__ __forceinline__ unsigned cvt_pk_bf16(float lo, float hi) { const f32x2c_t v = {lo, hi}; const bf16x2c_t b = __builtin_convertvector(v, bf16x2c_t); return __builtin_bit_cast(unsigned, b); }
typedef float f32x2 __attribute__((ext_vector_type(2)));

typedef unsigned u32x2 __attribute__((ext_vector_type(2)));
struct EpiStore {
    static constexpr bool PERM = true, AFTER_DRAIN = false;
    bf16_t* O; int ldc; int cmask; const float* rowscale; float osc = 1.f;
    __device__ __forceinline__ void operator()(const f32x4 (&acc)[2][2][4][2], const Unit& u, int wr, int wc, int fr, int fq) const {
        const int row0 = u.pm * BM + wr * 64 + fr, col0 = (u.pn & cmask) * BM + wc * 32 + 8 * fq;
        float scv[8];
#pragma unroll
        for (int q = 0; q < 8; ++q) scv[q] = (rowscale ? rowscale[row0 + (q >> 2) * HALF + (q & 3) * 16] : 1.f) * osc;
#pragma unroll
        for (int ai = 0; ai < 2; ++ai)
#pragma unroll
            for (int m = 0; m < 4; ++m) { const int row = row0 + ai * HALF + m * 16; const float sc = scv[ai * 4 + m]; bf16_t* rowp = O + (size_t)row * ldc + col0;
#pragma unroll
                for (int bj = 0; bj < 2; ++bj) { const f32x4 v0 = acc[ai][bj][m][0] * sc, v1 = acc[ai][bj][m][1] * sc;
                    u32x4 w; w.x = cvt_pk_bf16(v0[0], v0[1]); w.y = cvt_pk_bf16(v0[2], v0[3]); w.z = cvt_pk_bf16(v1[0], v1[1]); w.w = cvt_pk_bf16(v1[2], v1[3]);
                    *(u32x4*)(rowp + bj * HALF) = w; } }
    }
};
__device__ __forceinline__ float sigm(float x) { return __builtin_amdgcn_rcpf(1.f + __expf(-x)); }
struct EpiGate2 {
    static constexpr bool PERM = true, AFTER_DRAIN = false;
    bf16_t* O; int ldc; const bf16_t* Ga; const bf16_t* Gb; int ldg;
    __device__ __forceinline__ void operator()(const f32x4 (&acc)[2][2][4][2], const Unit& u, int wr, int wc, int fr, int fq) const {
        const bool second = u.pm >= 32; const bf16_t* G = second ? Gb : Ga;
        const int row0 = (u.pm & 31) * BM + wr * 64 + fr, col0 = (u.pn & 7) * BM + wc * 32 + 8 * fq;
        u32x4 gcur[2], tcur[2], gnxt[2], tnxt[2];
#define EG2_LOAD(gd, td, q) do { const int row_ = row0 + ((q) >> 2) * HALF + ((q) & 3) * 16; _Pragma("unroll") for (int bj = 0; bj < 2; ++bj) { \
            gd[bj] = *(const u32x4*)(G + (size_t)row_ * ldg + col0 + bj * HALF); td[bj] = second ? *(const u32x4*)(O + (size_t)row_ * ldc + col0 + bj * HALF) : (u32x4){0u, 0u, 0u, 0u}; } } while (0)
        EG2_LOAD(gcur, tcur, 0);
#pragma unroll
        for (int q = 0; q < 8; ++q) { const int ai = q >> 2, m = q & 3, row = row0 + ai * HALF + m * 16;
            if (q < 7) EG2_LOAD(gnxt, tnxt, q + 1);
#pragma unroll
            for (int bj = 0; bj < 2; ++bj) { const int col = col0 + bj * HALF; const u32x4 g = gcur[bj], tq = tcur[bj];
                const float gg[8] = {__uint_as_float(g.x << 16), __uint_as_float(g.x & 0xffff0000u), __uint_as_float(g.y << 16), __uint_as_float(g.y & 0xffff0000u),
                                     __uint_as_float(g.z << 16), __uint_as_float(g.z & 0xffff0000u), __uint_as_float(g.w << 16), __uint_as_float(g.w & 0xffff0000u)};
                const float t[8] = {__uint_as_float(tq.x << 16), __uint_as_float(tq.x & 0xffff0000u), __uint_as_float(tq.y << 16), __uint_as_float(tq.y & 0xffff0000u),
                                    __uint_as_float(tq.z << 16), __uint_as_float(tq.z & 0xffff0000u), __uint_as_float(tq.w << 16), __uint_as_float(tq.w & 0xffff0000u)};
                const f32x4 a0 = acc[ai][bj][m][0], a1 = acc[ai][bj][m][1];
                float o[8];
#pragma unroll
                for (int i = 0; i < 4; ++i) { o[i] = t[i] + sigm(gg[i]) * a0[i]; o[4 + i] = t[4 + i] + sigm(gg[4 + i]) * a1[i]; }
                u32x4 w; w.x = cvt_pk_bf16(o[0], o[1]); w.y = cvt_pk_bf16(o[2], o[3]); w.z = cvt_pk_bf16(o[4], o[5]); w.w = cvt_pk_bf16(o[6], o[7]);
                *(u32x4*)(O + (size_t)row * ldc + col) = w; }
#pragma unroll
            for (int bj = 0; bj < 2; ++bj) { gcur[bj] = gnxt[bj]; tcur[bj] = tnxt[bj]; } }
#undef EG2_LOAD
    }
};
struct BranchOrder {
    StaticOrder S;
    __device__ __forceinline__ bool next(int i, Unit& u) const { Unit t; if (!S.next(i >> 1, t)) return false; u.pm = t.pm + 32 * (i & 1); u.pn = t.pn + 8 * (i & 1); return true; }
    __device__ __forceinline__ void a_ready(const Unit&) const {}
    __device__ __forceinline__ void done(const Unit&) const {}
};
struct EpiF32 {
    static constexpr bool PERM = true, AFTER_DRAIN = false;
    float* O; int ldc;
    __device__ __forceinline__ void operator()(const f32x4 (&acc)[2][2][4][2], const Unit& u, int wr, int wc, int fr, int fq) const {
        const int row0 = u.pm * BM + wr * 64 + fr, col0 = u.pn * BM + wc * 32 + 8 * fq;
#pragma unroll
        for (int ai = 0; ai < 2; ++ai)
#pragma unroll
            for (int m = 0; m < 4; ++m) { float* rowp = O + (size_t)(row0 + ai * HALF + m * 16) * ldc + col0;
#pragma unroll
                for (int bj = 0; bj < 2; ++bj) { *(f32x4*)(rowp + bj * HALF) = acc[ai][bj][m][0]; *(f32x4*)(rowp + bj * HALF + 4) = acc[ai][bj][m][1]; } }
    }
};
__device__ __forceinline__ unsigned pk4_fp8(float a, float b, float c, float d) { int w = __builtin_amdgcn_cvt_pk_fp8_f32(a, b, 0, false); w = __builtin_amdgcn_cvt_pk_fp8_f32(c, d, w, true); return (unsigned)w; }
struct EpiSwiglu8 {
    static constexpr bool PERM = true, AFTER_DRAIN = false;
    unsigned char* O; float isc;
    __device__ __forceinline__ void operator()(const f32x4 (&acc)[2][2][4][2], const Unit& u, int wr, int wc, int fr, int fq) const {
        const int row0 = u.pm * BM + wr * 64 + fr, col0 = (u.pn & 7) * HALF + wc * 32 + 8 * fq;
#pragma unroll
        for (int ai = 0; ai < 2; ++ai)
#pragma unroll
            for (int m = 0; m < 4; ++m) { unsigned char* rowp = O + (size_t)(row0 + ai * HALF + m * 16) * 1024 + col0;
                float o[8];
#pragma unroll
                for (int n = 0; n < 2; ++n)
#pragma unroll
                    for (int i = 0; i < 4; ++i) { const float g = acc[ai][0][m][n][i] * isc, up = acc[ai][1][m][n][i] * isc; o[4 * n + i] = g * sigm(g) * up; }
                u32x2 w; w.x = pk4_fp8(o[0], o[1], o[2], o[3]); w.y = pk4_fp8(o[4], o[5], o[6], o[7]);
                *(u32x2*)rowp = w; }
    }
};
struct EpiSwiglu {
    static constexpr bool PERM = true, AFTER_DRAIN = false;
    bf16_t* O;
    __device__ __forceinline__ void operator()(const f32x4 (&acc)[2][2][4][2], const Unit& u, int wr, int wc, int fr, int fq) const {
        const int row0 = u.pm * BM + wr * 64 + fr, col0 = (u.pn & 7) * HALF + wc * 32 + 8 * fq;
#pragma unroll
        for (int ai = 0; ai < 2; ++ai)
#pragma unroll
            for (int m = 0; m < 4; ++m) { bf16_t* rowp = O + (size_t)(row0 + ai * HALF + m * 16) * 1024 + col0;
                float o[8];
#pragma unroll
                for (int n = 0; n < 2; ++n)
#pragma unroll
                    for (int i = 0; i < 4; ++i) { const float g = acc[ai][0][m][n][i], up = acc[ai][1][m][n][i]; o[4 * n + i] = g * sigm(g) * up; }
                u32x4 w; w.x = cvt_pk_bf16(o[0], o[1]); w.y = cvt_pk_bf16(o[2], o[3]); w.z = cvt_pk_bf16(o[4], o[5]); w.w = cvt_pk_bf16(o[6], o[7]);
                *(u32x4*)rowp = w; }
    }
};
struct GroupedOrder {
    int G, c;
    __device__ __forceinline__ bool next(int i, Unit& u) const { const int L = i * G + c; if (L >= 512) return false; const int e = L >> 5, r = L & 31; u.pm = e * 4 + (r & 3); u.pn = e * 8 + (r >> 2); return true; }
    __device__ __forceinline__ void a_ready(const Unit&) const {}
    __device__ __forceinline__ void done(const Unit&) const {}
};

typedef int v8i32 __attribute__((ext_vector_type(8)));
typedef int v4i32 __attribute__((ext_vector_type(4)));
__device__ __forceinline__ void mfma_f8(f32x4& acc, const v8i32& a, const v8i32& b, int sc) {
    asm volatile("v_mfma_scale_f32_16x16x128_f8f6f4 %0, %1, %2, %0, %3, %3 op_sel_hi:[0,0,0]" : "+v"(acc) : "v"(a), "v"(b), "v"(sc));
}
template <class Epi, class Sched, bool ALIGN_EPI = false, bool SP2 = false, bool GATHER = false, bool FP8 = false>
__device__ __forceinline__ void gemm_phase(PG8_LAS unsigned char* lds, const Gemm g, const Sched& S, const Epi& E) {
    const int tid = threadIdx.x, wid = __builtin_amdgcn_readfirstlane(tid >> 6), lane = tid & 63, wr = wid >> 2, wc = wid & 3, fr = lane & 15, fq = lane >> 4;
    const int K = g.K, nt = K / BK;
    unsigned voffA[2], voffB[2]; int Rr[2], Cc[2];
#pragma unroll
    for (int i = 0; i < 2; ++i) { int R, C; stage_rc(tid * 16 + i * 8192, R, C); const int Rb = Epi::PERM ? ((R & ~31) + perm32(R & 31)) : R; Rr[i] = R; Cc[i] = C;
        voffA[i] = (unsigned)(R * K + C) * 2u; voffB[i] = (unsigned)(Rb * K + C) * 2u; }
    unsigned cv0[2], cv1[2], nv0[2], nv1[2], sv0[2], sv1[2];
#define PG8_GOFF(o0, o1, pm_) do { _Pragma("unroll") for (int _i = 0; _i < 2; ++_i) { \
        o0[_i] = (unsigned)(g.gidx[(pm_) * BM + Rr[_i]] * K + Cc[_i]) * 2u; o1[_i] = (unsigned)(g.gidx[(pm_) * BM + HALF + Rr[_i]] * K + Cc[_i]) * 2u; } } while (0)
    const size_t kstep = (size_t)(BK * 2);
    const size_t hstep = (size_t)HALF * K * 2;
    const size_t tstep = 2 * hstep;
    const unsigned ldsw = (unsigned)wid * 1024u;
    const int aoff = FP8 ? lds_byte(wr * 64 + fr, fq * 16) : lds_byte(wr * 64 + fr, fq * 8), boff = FP8 ? lds_byte(wc * 32 + fr, fq * 16) : lds_byte(wc * 32 + fr, fq * 8);
#define PG8_SA(b, h) (((b) * 2 + (h)) * HTB)
#define PG8_SB(b, h) ((4 + (b) * 2 + (h)) * HTB)
#define PG8_STAGE(bufoff, gbase, voff) do { _Pragma("unroll") for (int _i = 0; _i < 2; ++_i) \
        __builtin_amdgcn_global_load_lds((const unsigned*)((const char*)(gbase) + (voff)[_i]), (PG8_LAS unsigned*)(lds + (bufoff) + ldsw + _i * 8192), 16, 0, 0); } while (0)
#define PG8_LDA(dst, b, h) do { if constexpr (FP8) { _Pragma("unroll") for (int m = 0; m < 4; ++m) { const PG8_LAS unsigned char* p_ = lds + PG8_SA(b, h) + aoff + m * 2048; \
            const v4i32 lo_ = *(const PG8_LAS v4i32*)p_, hi_ = *(const PG8_LAS v4i32*)(p_ + 16); dst##8[m] = __builtin_shufflevector(lo_, hi_, 0, 1, 2, 3, 4, 5, 6, 7); } } \
        else { _Pragma("unroll") for (int m = 0; m < 4; ++m) _Pragma("unroll") for (int k = 0; k < 2; ++k) dst[m][k] = *(const PG8_LAS bf16x8*)(lds + PG8_SA(b, h) + aoff + m * 2048 + k * 1024); } } while (0)
#define PG8_LDB(dst, b, h) do { if constexpr (FP8) { _Pragma("unroll") for (int n = 0; n < 2; ++n) { const PG8_LAS unsigned char* p_ = lds + PG8_SB(b, h) + boff + n * 2048; \
            const v4i32 lo_ = *(const PG8_LAS v4i32*)p_, hi_ = *(const PG8_LAS v4i32*)(p_ + 16); dst##8[n] = __builtin_shufflevector(lo_, hi_, 0, 1, 2, 3, 4, 5, 6, 7); } } \
        else { _Pragma("unroll") for (int n = 0; n < 2; ++n) _Pragma("unroll") for (int k = 0; k < 2; ++k) dst[n][k] = *(const PG8_LAS bf16x8*)(lds + PG8_SB(b, h) + boff + n * 2048 + k * 1024); } } while (0)
#define PG8_MMA(ai, bj, At, Bt) do { __builtin_amdgcn_s_setprio(1); \
        if constexpr (FP8) { _Pragma("unroll") for (int m = 0; m < 4; ++m) _Pragma("unroll") for (int n = 0; n < 2; ++n) \
            mfma_f8(acc[ai][bj][m][n], Bt##8[n], At##8[m], f8one); } \
        else { _Pragma("unroll") for (int m = 0; m < 4; ++m) _Pragma("unroll") for (int n = 0; n < 2; ++n) _Pragma("unroll") for (int k = 0; k < 2; ++k) \
            acc[ai][bj][m][n] = __builtin_amdgcn_mfma_f32_16x16x32_bf16(Bt[n][k], At[m][k], acc[ai][bj][m][n], 0, 0, 0); } \
        __builtin_amdgcn_s_setprio(0); } while (0)
#define PG8_WAIT_V(n) asm volatile("s_waitcnt vmcnt(" #n ")" ::: "memory")
#define PG8_WAIT_L(n) asm volatile("s_waitcnt lgkmcnt(" #n ")" ::: "memory")
#define PG8_BAR __builtin_amdgcn_s_barrier()
#define PG8_SCHED __builtin_amdgcn_sched_barrier(0)
    Unit cur, nxt; int ui = 0;
    if (!S.next(0, cur)) return;
    if constexpr (GATHER) { PG8_GOFF(cv0, cv1, cur.pm); }
    else {
#pragma unroll
        for (int i = 0; i < 2; ++i) { cv0[i] = voffA[i]; cv1[i] = voffA[i] + (unsigned)(HALF * K * 2); } }
    f32x4 acc[2][2][4][2];
#pragma unroll
    for (int a = 0; a < 2; ++a)
#pragma unroll
        for (int b = 0; b < 2; ++b)
#pragma unroll
            for (int m = 0; m < 4; ++m)
#pragma unroll
                for (int n = 0; n < 2; ++n) acc[a][b][m][n] = (f32x4){0.f, 0.f, 0.f, 0.f};
    bf16x8 At[4][2], B0[2][2], B1[2][2]; v8i32 At8[4], B08[2], B18[2]; int f8one = 0x7f7f7f7f; asm volatile("" : "+v"(f8one));
    const char* cA = (const char*)g.A + (GATHER ? (size_t)0 : (size_t)cur.pm * tstep); const char* cB = (const char*)g.Bt + (size_t)cur.pn * tstep;
    S.a_ready(cur);
    if constexpr (SP2) {
        PG8_STAGE(PG8_SB(0, 0), cB, voffB); PG8_STAGE(PG8_SB(0, 1), cB + hstep, voffB); PG8_STAGE(PG8_SA(0, 0), cA, cv0); PG8_STAGE(PG8_SA(0, 1), cA, cv1);
        if (wr == 1) PG8_BAR;
        PG8_WAIT_V(2); PG8_BAR;
        PG8_STAGE(PG8_SB(1, 0), cB + kstep, voffB); PG8_STAGE(PG8_SA(1, 0), cA + kstep, cv0); PG8_STAGE(PG8_SB(1, 1), cB + hstep + kstep, voffB);
        PG8_WAIT_V(6); PG8_BAR;
    } else {
        PG8_STAGE(PG8_SB(0, 0), cB, voffB); PG8_STAGE(PG8_SA(0, 0), cA, cv0); PG8_STAGE(PG8_SB(0, 1), cB + hstep, voffB); PG8_STAGE(PG8_SA(0, 1), cA, cv1);
        if (wr == 1) PG8_BAR;
        PG8_WAIT_V(4); PG8_BAR;
        PG8_STAGE(PG8_SB(1, 0), cB + kstep, voffB); PG8_STAGE(PG8_SA(1, 0), cA + kstep, cv0); PG8_STAGE(PG8_SB(1, 1), cB + hstep + kstep, voffB);
        PG8_WAIT_V(6); PG8_BAR;
    }
    for (;;) {
        const bool has_next = S.next(ui + 1, nxt);
        if (GATHER && has_next) { PG8_GOFF(nv0, nv1, nxt.pm); }
        else {
#pragma unroll
            for (int i = 0; i < 2; ++i) { nv0[i] = cv0[i]; nv1[i] = cv1[i]; } }
        const char* nA = (has_next && !GATHER) ? (const char*)g.A + (size_t)nxt.pm * tstep : cA; const char* nB = has_next ? (const char*)g.Bt + (size_t)nxt.pn * tstep : cB;
#pragma unroll 1
        for (int t = 0; t < nt; t += 2) {
            const bool last = (t == nt - 2);
            const char* a1 = cA + (size_t)(t + 1) * kstep;
            const char* a2 = last ? nA : cA + (size_t)(t + 2) * kstep; const char* b2 = last ? nB : cB + (size_t)(t + 2) * kstep;
            const char* a3 = a2 + kstep; const char* b3 = b2 + kstep;
#pragma unroll
            for (int i = 0; i < 2; ++i) { sv0[i] = last ? nv0[i] : cv0[i]; sv1[i] = last ? nv1[i] : cv1[i]; }
            if (last && has_next) S.a_ready(nxt);
            if constexpr (SP2) {
            PG8_LDB(B0, 0, 0); PG8_LDB(B1, 0, 1); PG8_SCHED; PG8_LDA(At, 0, 0); PG8_STAGE(PG8_SA(1, 1), a1, cv1);
            PG8_WAIT_V(8); PG8_WAIT_L(0); PG8_BAR; PG8_MMA(0, 0, At, B0); PG8_MMA(0, 1, At, B1); PG8_BAR; PG8_SCHED;
            PG8_LDA(At, 0, 1); PG8_STAGE(PG8_SB(0, 0), b2, voffB); PG8_STAGE(PG8_SB(0, 1), b2 + hstep, voffB); PG8_STAGE(PG8_SA(0, 0), a2, sv0);
            PG8_WAIT_V(8); PG8_WAIT_L(0); PG8_BAR; PG8_MMA(1, 0, At, B0); PG8_MMA(1, 1, At, B1); PG8_BAR; PG8_SCHED;
            PG8_LDB(B0, 1, 0); PG8_LDB(B1, 1, 1); PG8_SCHED; PG8_LDA(At, 1, 0); PG8_STAGE(PG8_SA(0, 1), a2, sv1);
            PG8_WAIT_V(8); PG8_WAIT_L(0); PG8_BAR; PG8_MMA(0, 0, At, B0); PG8_MMA(0, 1, At, B1); PG8_BAR; PG8_SCHED;
            PG8_LDA(At, 1, 1); PG8_STAGE(PG8_SB(1, 0), b3, voffB); PG8_STAGE(PG8_SB(1, 1), b3 + hstep, voffB); PG8_STAGE(PG8_SA(1, 0), a3, sv0);
            PG8_WAIT_V(8); PG8_WAIT_L(0); PG8_BAR; PG8_MMA(1, 0, At, B0); PG8_MMA(1, 1, At, B1); PG8_BAR; PG8_SCHED;
            } else {
            PG8_LDB(B0, 0, 0); PG8_SCHED; PG8_LDA(At, 0, 0); PG8_STAGE(PG8_SA(1, 1), a1, cv1);
            PG8_WAIT_L(8); PG8_BAR; PG8_WAIT_L(0); PG8_MMA(0, 0, At, B0); PG8_BAR; PG8_SCHED;
            PG8_LDB(B1, 0, 1); PG8_STAGE(PG8_SB(0, 0), b2, voffB);
            PG8_BAR; PG8_WAIT_L(0); PG8_MMA(0, 1, At, B1); PG8_BAR;
            PG8_LDA(At, 0, 1); PG8_STAGE(PG8_SA(0, 0), a2, sv0);
            PG8_BAR; PG8_WAIT_L(0); PG8_MMA(1, 0, At, B0); PG8_BAR; PG8_SCHED;
            PG8_STAGE(PG8_SB(0, 1), b2 + hstep, voffB);
            PG8_WAIT_V(6); PG8_BAR; PG8_MMA(1, 1, At, B1); PG8_BAR;
            PG8_LDB(B0, 1, 0); PG8_SCHED; PG8_LDA(At, 1, 0); PG8_STAGE(PG8_SA(0, 1), a2, sv1);
            PG8_WAIT_L(8); PG8_BAR; PG8_WAIT_L(0); PG8_MMA(0, 0, At, B0); PG8_BAR; PG8_SCHED;
            PG8_LDB(B1, 1, 1); PG8_STAGE(PG8_SB(1, 0), b3, voffB);
            PG8_BAR; PG8_WAIT_L(0); PG8_MMA(0, 1, At, B1); PG8_BAR;
            PG8_LDA(At, 1, 1); PG8_STAGE(PG8_SA(1, 0), a3, sv0);
            PG8_BAR; PG8_WAIT_L(0); PG8_MMA(1, 0, At, B0); PG8_BAR; PG8_SCHED;
            PG8_STAGE(PG8_SB(1, 1), b3 + hstep, voffB);
            PG8_WAIT_V(6); PG8_BAR; PG8_MMA(1, 1, At, B1); PG8_BAR;
            }
        }
        if constexpr (FP8) { asm volatile("s_nop 15\n\ts_nop 15\n\ts_nop 7" ::: "memory"); }
        if constexpr (ALIGN_EPI) { if (wr == 0) PG8_BAR; }
        if constexpr (!Epi::AFTER_DRAIN) { E(acc, cur, wr, wc, fr, fq); S.done(cur); }
        if (!has_next) break;
#pragma unroll
        for (int a = 0; a < 2; ++a)
#pragma unroll
            for (int b = 0; b < 2; ++b)
#pragma unroll
                for (int m = 0; m < 4; ++m)
#pragma unroll
                    for (int n = 0; n < 2; ++n) acc[a][b][m][n] = (f32x4){0.f, 0.f, 0.f, 0.f};
        cur = nxt; cA = nA; cB = nB; ++ui;
#pragma unroll
        for (int i = 0; i < 2; ++i) { cv0[i] = nv0[i]; cv1[i] = nv1[i]; }
        if constexpr (ALIGN_EPI) { if (wr == 1) PG8_BAR; }
    }
    PG8_WAIT_V(0);
    if constexpr (!ALIGN_EPI) { if (wr == 0) PG8_BAR; }
    PG8_BAR;
    if constexpr (Epi::AFTER_DRAIN) { E.fused(acc, cur, wr, wc, fr, fq, lds, wid, lane); S.done(cur); }
#undef PG8_GOFF
#undef PG8_SA
#undef PG8_SB
#undef PG8_STAGE
#undef PG8_LDA
#undef PG8_LDB
#undef PG8_MMA
#undef PG8_WAIT_V
#undef PG8_WAIT_L
#undef PG8_BAR
#undef PG8_SCHED
}
}

#ifndef PG8_SP2
#define PG8_SP2 true
#endif
#ifndef PG8_ALIGN
#define PG8_ALIGN true
#endif
constexpr int RING_OFF = 0, RING_BYTES = 131072;
constexpr int LDSCTL_OFF = RING_BYTES, MISC_OFF = LDSCTL_OFF + 320;
constexpr int LDS_BYTES = 163840;
constexpr int PARAM_OFF = 135168;
constexpr int NWAVES = 8;
#define GAS __attribute__((address_space(1)))
#define LAS __attribute__((address_space(3)))
typedef unsigned v4u __attribute__((ext_vector_type(4)));
typedef unsigned u2v_t __attribute__((ext_vector_type(2)));
typedef float f32x4 __attribute__((ext_vector_type(4)));
typedef GAS unsigned gu32;
#define RLX_AGENT __ATOMIC_RELAXED, __HIP_MEMORY_SCOPE_AGENT
#define LDS_WAIT() asm volatile("s_waitcnt lgkmcnt(0)" ::: "memory")
__device__ __forceinline__ unsigned pk2(float lo, float hi) { return cvtpk2(lo, hi); }

#define XB_TMO      128
#define XB_XCNT(j)  (256  + 64 * (j))
#define XB_XSUB(j)  (1280 + 64 * (j))
#define XB_XGEN(j)  (2304 + 64 * (j))
#define XB_TOP      3328
#define XB_TOPGEN   3392
#define XCD_BAR_WORDS 3456
#define XB_SPIN_CAP (1u << 18)

__device__ __forceinline__ unsigned xb_ld(unsigned* p)              { return __hip_atomic_load(p, __ATOMIC_RELAXED, __HIP_MEMORY_SCOPE_AGENT); }
__device__ __forceinline__ unsigned xb_add(unsigned* p, unsigned v) { return __hip_atomic_fetch_add(p, v, __ATOMIC_RELAXED, __HIP_MEMORY_SCOPE_AGENT); }
__device__ __forceinline__ unsigned xb_xcc_id() { return (unsigned)__builtin_amdgcn_s_getreg((3 << 11) | 20) & 0xFu; }
#define XB_SPIN(cond, bar) do { unsigned _sp = 0; while (cond) { __builtin_amdgcn_s_sleep(1); \
    if ((++_sp & 255u) == 0u) { if (xb_ld(&(bar)[XB_TMO])) break; if (_sp > XB_SPIN_CAP) { atomicAdd(&(bar)[XB_TMO], 1u); break; } } } } while (0)

struct XcdBarrier {
    unsigned* bar; unsigned x;
    volatile LAS unsigned* st;
};

__device__ __forceinline__ XcdBarrier xcd_barrier_post(unsigned* bar, volatile LAS unsigned* st) {
    XcdBarrier b; b.bar = bar; b.x = xb_xcc_id(); b.st = st;
    if (threadIdx.x == 0) (void)xb_add(&bar[XB_XCNT(b.x)], 1u);
    return b;
}
__device__ __forceinline__ void xcd_barrier_complete(unsigned* bar, unsigned x, unsigned& nloc, unsigned& nx) {
    const unsigned G = gridDim.x * gridDim.y * gridDim.z;
    unsigned sum, cnt, mine, sp = 0u;
    for (;;) {
        sum = 0u; cnt = 0u; mine = 0u;
#pragma unroll
        for (unsigned j = 0; j < 16; ++j) { const unsigned c = xb_ld(&bar[XB_XCNT(j)]); sum += c; cnt += (c > 0u) ? 1u : 0u; mine = (j == x) ? c : mine; }
        if (sum == G) break;
        __builtin_amdgcn_s_sleep(1);
        if ((++sp & 255u) == 0u) { if (xb_ld(&bar[XB_TMO])) break; if (sp > XB_SPIN_CAP) { atomicAdd(&bar[XB_TMO], 1u); break; } }
    }
    nloc = mine > 0u ? mine : 1u; nx = cnt > 0u ? cnt : 1u;
}

__device__ __forceinline__ void xcd_barrier(const XcdBarrier& b) {
    asm volatile("s_waitcnt vmcnt(0)" ::: "memory");
    __syncthreads();
    if (threadIdx.x == 0) {
        unsigned* bar = b.bar;
        __builtin_amdgcn_s_waitcnt(0);
        unsigned nloc = b.st[0], nx = b.st[1];
        if (nloc == 0u) { xcd_barrier_complete(bar, b.x, nloc, nx); b.st[0] = nloc; b.st[1] = nx; }
        const unsigned old = xb_add(&bar[XB_XSUB(b.x)], 1u);
        const unsigned gen = old / nloc;
        if (old + 1u == (gen + 1u) * nloc) {
            __builtin_amdgcn_fence(__ATOMIC_RELEASE, "agent");
            asm volatile("s_waitcnt vmcnt(0)" ::: "memory");
            const unsigned og = xb_add(&bar[XB_TOP], 1u);
            const unsigned tg = og / nx;
            if (og + 1u == (tg + 1u) * nx) xb_add(&bar[XB_TOPGEN], 1u);
            else XB_SPIN(xb_ld(&bar[XB_TOPGEN]) == tg, bar);
            __builtin_amdgcn_fence(__ATOMIC_ACQUIRE, "agent");
            xb_add(&bar[XB_XGEN(b.x)], 1u);
            asm volatile("s_waitcnt vmcnt(0)" ::: "memory");
        } else {
            XB_SPIN(xb_ld(&bar[XB_XGEN(b.x)]) == gen, bar);
            __builtin_amdgcn_fence(__ATOMIC_ACQUIRE, "agent");
            asm volatile("s_waitcnt vmcnt(0)" ::: "memory");
        }
    }
    __syncthreads();
}

struct Args { const void* in[20]; float* out; unsigned char* ws; int ph_lo, ph_hi, li, mask, rep, pad; };
struct Ctx {
    unsigned char* lds; int tid, lane, wave, G, gw, NGW;
    const float *x, *c, *w_ada, *b_ada, *g_pre_mix, *g_post_mix, *g_pre_ffn, *g_post_ffn, *w_in, *lbl, *onorm, *sink, *w_a, *w_b, *w_o, *w_router, *w_eg, *w_eu, *w_ed;
    const int* pos; float* out; unsigned char* ws;
};
__device__ __forceinline__ float wave_sum(float v) {
#pragma unroll
    for (int o = 1; o < 64; o <<= 1) v += __shfl_xor(v, o);
    return v;
}
struct TDesc { const float* src; bf16* dst; int N, K; float f8s; };
__device__ __forceinline__ void t_load(const TDesc& d, f32x4 (&r)[16], int lane) {
    const float* p = d.src + (size_t)(16 * (lane >> 4)) * d.N + 4 * (lane & 15);
#pragma unroll
    for (int i = 0; i < 16; ++i) r[i] = __builtin_nontemporal_load((const f32x4*)(p + (size_t)i * d.N));
}
__device__ __forceinline__ void t_process(const TDesc& d, const f32x4 (&r)[16], float* scr, int lane) {
    unsigned char* s8 = (unsigned char*)scr; const int kq = lane >> 4, nl = lane & 15;
    if (d.f8s != 0.f) {
        const float f = d.f8s; unsigned char* dst8 = (unsigned char*)d.dst;
#pragma unroll
        for (int c = 0; c < 4; ++c) { v4u o;
            o.x = pg8::pk4_fp8(r[0][c] * f, r[1][c] * f, r[2][c] * f, r[3][c] * f); o.y = pg8::pk4_fp8(r[4][c] * f, r[5][c] * f, r[6][c] * f, r[7][c] * f);
            o.z = pg8::pk4_fp8(r[8][c] * f, r[9][c] * f, r[10][c] * f, r[11][c] * f); o.w = pg8::pk4_fp8(r[12][c] * f, r[13][c] * f, r[14][c] * f, r[15][c] * f);
            *(v4u*)(s8 + (4 * nl + c) * 80 + 16 * kq) = o; }
        LDS_WAIT(); asm volatile("" ::: "memory");
#pragma unroll
        for (int j = 0; j < 4; ++j) { const int row = 16 * j + (lane >> 2), pc = lane & 3; const v4u o = *(const v4u*)(s8 + row * 80 + 16 * pc);
            __builtin_nontemporal_store(o, (v4u*)(dst8 + (size_t)row * d.K + 16 * pc)); }
    } else {
#pragma unroll
        for (int c = 0; c < 4; ++c) { v4u o0, o1;
            o0.x = pk2(r[0][c], r[1][c]); o0.y = pk2(r[2][c], r[3][c]); o0.z = pk2(r[4][c], r[5][c]); o0.w = pk2(r[6][c], r[7][c]);
            o1.x = pk2(r[8][c], r[9][c]); o1.y = pk2(r[10][c], r[11][c]); o1.z = pk2(r[12][c], r[13][c]); o1.w = pk2(r[14][c], r[15][c]);
            *(v4u*)(s8 + (4 * nl + c) * 144 + 32 * kq) = o0; *(v4u*)(s8 + (4 * nl + c) * 144 + 32 * kq + 16) = o1; }
        LDS_WAIT(); asm volatile("" ::: "memory");
#pragma unroll
        for (int j = 0; j < 8; ++j) { const int row = 8 * j + (lane >> 3), pc = lane & 7; const v4u o = *(const v4u*)(s8 + row * 144 + 16 * pc);
            *(v4u*)(d.dst + (size_t)row * d.K + 8 * pc) = o; }
    }
    LDS_WAIT(); asm volatile("" ::: "memory");
}
__device__ __forceinline__ void rope_entry(const int* pos, float* rope, int gid) {
    const int t = gid >> 6, i = gid & 63;
    double inv = 1.0, rr = 0.8659643233600653523531691834202299819398;
    for (int bit = 0; bit < 6; ++bit) { if ((i >> bit) & 1) inv *= rr; rr *= rr; }
    const double ang = (double)pos[t] * inv;
    const double kq = rint(ang * 0.3183098861837906715377675267450287);
    const double r = ang - kq * 3.141592653589793238462643383279502884;
    const double u = -(r * r);
    double s = 1.0 / 121645100408832000.0;
    s = s * u + 1.0 / 355687428096000.0; s = s * u + 1.0 / 1307674368000.0; s = s * u + 1.0 / 6227020800.0; s = s * u + 1.0 / 39916800.0; s = s * u + 1.0 / 362880.0;
    s = s * u + 1.0 / 5040.0; s = s * u + 1.0 / 120.0; s = s * u + 1.0 / 6.0; s = s * u + 1.0; s = s * r;
    double cz = 1.0 / 6402373705728000.0;
    cz = cz * u + 1.0 / 20922789888000.0; cz = cz * u + 1.0 / 87178291200.0; cz = cz * u + 1.0 / 479001600.0; cz = cz * u + 1.0 / 3628800.0; cz = cz * u + 1.0 / 40320.0;
    cz = cz * u + 1.0 / 720.0; cz = cz * u + 1.0 / 24.0; cz = cz * u + 0.5; cz = cz * u + 1.0;
    const double sg = (((long long)kq) & 1) ? -1.0 : 1.0;
    rope[(size_t)gid * 2] = (float)(sg * cz); rope[(size_t)gid * 2 + 1] = (float)(sg * s);
}
constexpr float W8S_GU = 64.f, W8S_D = 32.f, W8S_IN = 64.f, X8S_IN = 16.f;
constexpr int I_IN = 32 * 168, I_A = 16 * 32, I_O = 32 * 32, I_E = 512, I_MIX = I_IN + 2 * I_A + I_O, I_EXP = 48 * I_E;
constexpr int CONV_BLOCKS = 64;
constexpr int CONV_ITEMS_PER_WAVE = 34;
constexpr int P0_EXPERT_ITEMS = I_EXP - CONV_BLOCKS * NWAVES * CONV_ITEMS_PER_WAVE;
constexpr int P0_GEMV_ROUNDS = 4;
constexpr int GEMV_BLOCKS = 96;
__device__ __forceinline__ TDesc transpose_desc(Ctx& F, int it) {
    bf16* WIN = (bf16*)(F.ws + WS_WIN); bf16* WA = (bf16*)(F.ws + WS_WA); bf16* WB = (bf16*)(F.ws + WS_WB); bf16* WO = (bf16*)(F.ws + WS_WO); bf16* WGU = (bf16*)(F.ws + WS_WGU); bf16* WD = (bf16*)(F.ws + WS_WD);
    int r = it; const float* W; bf16* WT; int K, N, kb, nb; size_t drow; float f8s = 0.f;
    if (r < I_IN) { W = F.w_in; WT = WIN; K = 2048; N = INW; kb = r / 168; nb = r % 168; drow = (size_t)64 * nb; f8s = W8S_IN; }
    else if ((r -= I_IN) < I_A) { W = F.w_a; WT = WA; K = 1024; N = 2048; kb = r / 32; nb = r % 32; drow = (size_t)64 * nb; }
    else if ((r -= I_A) < I_A) { W = F.w_b; WT = WB; K = 1024; N = 2048; kb = r / 32; nb = r % 32; drow = (size_t)64 * nb; }
    else if ((r -= I_A) < I_O) { W = F.w_o; WT = WO; K = 2048; N = 2048; kb = r / 32; nb = r % 32; drow = (size_t)64 * nb; }
    else { r -= I_O; const int e = r / (3 * I_E), q = r % (3 * I_E), which = q / I_E, ii = q % I_E;
        if (which < 2) { kb = ii / 16; nb = ii % 16; const int n0 = 64 * nb; W = (which ? F.w_eu : F.w_eg) + (size_t)e * 2048 * 1024; WT = WGU; K = 2048; N = 1024; f8s = W8S_GU; drow = (size_t)e * 2048 + (n0 >> 7) * 256 + which * 128 + (n0 & 127); }
        else { kb = ii / 32; nb = ii % 32; W = F.w_ed + (size_t)e * 1024 * 2048; WT = WD; K = 1024; N = 2048; f8s = W8S_D; drow = (size_t)e * 2048 + 64 * nb; } }
    TDesc d; d.src = W + (size_t)(64 * kb) * N + 64 * nb; d.N = N; d.K = K; d.f8s = f8s;
    if (f8s != 0.f) d.dst = (bf16*)((unsigned char*)WT + drow * K + 64 * kb); else d.dst = WT + drow * K + 64 * kb;
    return d;
}
template <class Seq> __device__ __forceinline__ void transpose_stream(Ctx& F, const Seq& seq, float* scr) {
    f32x4 ra[16], rb[16]; TDesc da, db; int j = 0; int it = seq(j);
    if (it < 0) return;
    da = transpose_desc(F, it); t_load(da, ra, F.lane);
    for (;;) {
        const int itn = seq(++j);
        if (itn >= 0) { db = transpose_desc(F, itn); t_load(db, rb, F.lane); }
        t_process(da, ra, scr, F.lane);
        if (itn < 0) break;
        const int itnn = seq(++j);
        if (itnn >= 0) { da = transpose_desc(F, itnn); t_load(da, ra, F.lane); }
        t_process(db, rb, scr, F.lane);
        if (itnn < 0) break;
    }
}
struct P0Seq { int gw, NGW, ngv; bool gemv;
    __device__ __forceinline__ int operator()(int r) const { int it; if (r < P0_GEMV_ROUNDS) it = r * NGW + gw; else { if (gemv) return -1; it = P0_GEMV_ROUNDS * NGW + (r - P0_GEMV_ROUNDS) * (NGW - ngv) + (gw - ngv); }
        return it < I_MIX + P0_EXPERT_ITEMS ? it : -1; } };
struct TailSeq { int first, stride;
    __device__ __forceinline__ int operator()(int j) const { const int it = first + j * stride; return it < I_MIX + I_EXP ? it : -1; } };
__device__ __forceinline__ void p1_modnorm(Ctx& F, int first, int stride) {
    const float* MOD = (const float*)(F.ws + WS_MOD); bf16* H = (bf16*)(F.ws + WS_H);
    for (int row0 = first; row0 < T; row0 += 2 * stride) {
        f32x4 v[2][8];
#pragma unroll
        for (int k = 0; k < 2; ++k) { const int row = row0 + k * stride; if (row < T) { const f32x4* xr = (const f32x4*)(F.x + (size_t)row * D) + F.lane;
#pragma unroll
            for (int j = 0; j < 8; ++j) v[k][j] = __builtin_nontemporal_load(xr + 64 * j); } }
#pragma unroll
        for (int k = 0; k < 2; ++k) { const int row = row0 + k * stride; if (row < T) {
            const int b = row / SEQ; float ss = 0.f;
#pragma unroll
            for (int j = 0; j < 8; ++j) ss += (v[k][j].x * v[k][j].x + v[k][j].y * v[k][j].y) + (v[k][j].z * v[k][j].z + v[k][j].w * v[k][j].w);
            const float r = rsqrtf(wave_sum(ss) * (1.f / D) + EPS);
            const f32x4* gp = (const f32x4*)F.g_pre_mix + F.lane; const f32x4* shp = (const f32x4*)(MOD + b * 12288) + F.lane; const f32x4* scp = (const f32x4*)(MOD + b * 12288 + 2048) + F.lane;
            unsigned* o8 = (unsigned*)((unsigned char*)H + (size_t)row * D) + F.lane;
            f32x4 g[8], sh[8], sc[8];
#pragma unroll
            for (int j = 0; j < 8; ++j) { g[j] = gp[64 * j]; sh[j] = shp[64 * j]; sc[j] = scp[64 * j]; }
#pragma unroll
            for (int j = 0; j < 8; ++j) { const f32x4 h = (v[k][j] * r * g[j] * (sc[j] + 1.f) + sh[j]) * X8S_IN;
                o8[64 * j] = pg8::pk4_fp8(h.x, h.y, h.z, h.w); } } }
    }
}
__device__ __forceinline__ void p0_prep(Ctx& F) {
    float* MOD = (float*)(F.ws + WS_MOD); float* LB = (float*)(F.ws + WS_LB); float* ROPE = (float*)(F.ws + WS_ROPE);
    if (blockIdx.x < GEMV_BLOCKS) {
        float* sc = (float*)F.lds; float* red = (float*)(F.lds + 16384);
        for (int i = F.tid; i < 4096; i += 512) sc[i] = siluf_(F.c[i]);
        __syncthreads();
        const int j0 = blockIdx.x * 128, k0 = F.wave * 256, half = F.lane >> 5, l32 = F.lane & 31;
        f32x4 a0 = {0.f, 0.f, 0.f, 0.f}, a1 = {0.f, 0.f, 0.f, 0.f};
        const float* wp = F.w_ada + (size_t)(k0 + half) * 12288 + j0 + 4 * l32;
#pragma unroll 16
        for (int k = 0; k < 128; ++k) { const f32x4 w = __builtin_nontemporal_load((const f32x4*)(wp + (size_t)(2 * k) * 12288)); const float s0 = sc[k0 + 2 * k + half], s1 = sc[2048 + k0 + 2 * k + half]; a0 += w * s0; a1 += w * s1; }
        *(f32x4*)(red + ((F.wave * 2 + half) * 2 + 0) * 128 + 4 * l32) = a0; *(f32x4*)(red + ((F.wave * 2 + half) * 2 + 1) * 128 + 4 * l32) = a1;
        __syncthreads();
        if (F.tid < 256) { const int b = F.tid >> 7, jj = F.tid & 127; float s = 0.f;
#pragma unroll
          for (int p = 0; p < 16; ++p) s += red[(p * 2 + b) * 128 + jj];
          MOD[b * 12288 + j0 + jj] = s + F.b_ada[j0 + jj]; }
        __syncthreads();
    }
    { const int gt = blockIdx.x * 512 + F.tid, NT = F.G * 512;
      if (gt < 2048) { const int dir = gt >> 10, ch = gt & 1023; const float l0 = F.lbl[dir * 2048 + ch], l1 = F.lbl[dir * 2048 + 1024 + ch]; LB[gt] = 1.f / (1.f + expf(l1 - l0)); }
      for (int g = gt; g < T * 64; g += NT) rope_entry(F.pos, ROPE, g); }
    unsigned* cnt = (unsigned*)(F.ws + WS_CTL) + 1024;
    if (blockIdx.x < GEMV_BLOCKS) {
        asm volatile("s_waitcnt vmcnt(0)" ::: "memory"); __syncthreads();
        if (F.tid == 0) { __builtin_amdgcn_fence(__ATOMIC_RELEASE, "agent"); asm volatile("s_waitcnt vmcnt(0)" ::: "memory"); __hip_atomic_fetch_add(cnt, 1u, __ATOMIC_RELAXED, __HIP_MEMORY_SCOPE_AGENT); }
    }
    float* scr = (float*)(F.lds + F.wave * 16384);
    P0Seq seq{F.gw, F.NGW, GEMV_BLOCKS * NWAVES, blockIdx.x < GEMV_BLOCKS};
    transpose_stream(F, seq, scr);
    __syncthreads();
    if (F.tid == 0) { unsigned sp = 0; while (__hip_atomic_load(cnt, __ATOMIC_RELAXED, __HIP_MEMORY_SCOPE_AGENT) < (unsigned)GEMV_BLOCKS && ++sp < (1u << 22)) __builtin_amdgcn_s_sleep(2);
        __builtin_amdgcn_fence(__ATOMIC_ACQUIRE, "agent"); asm volatile("s_waitcnt vmcnt(0)" ::: "memory"); }
    __syncthreads();
    p1_modnorm(F, F.gw, F.NGW);
}
__device__ __forceinline__ void p6_post1(Ctx& F) {
    const float* MOD = (const float*)(F.ws + WS_MOD); const float* Y = (const float*)(F.ws + WS_Y); bf16* H2 = (bf16*)(F.ws + WS_H2); float* AFF = (float*)(F.ws + WS_AFF);
    float* wT = (float*)F.lds;
    float* PA = (float*)(F.lds + PARAM_OFF); float* PB = PA + 2048; float* PC = PB + 2048;
    for (int f = F.tid; f < 8192; f += 512) { const int d = f >> 2, q = f & 3; const f32x4 wv = *((const f32x4*)F.w_router + f);
        wT[(4 * q + 0) * 2048 + d] = wv.x; wT[(4 * q + 1) * 2048 + d] = wv.y; wT[(4 * q + 2) * 2048 + d] = wv.z; wT[(4 * q + 3) * 2048 + d] = wv.w; }
    uint2 ywn[8]; f32x4 xvn[8];
#define P6_LOAD(rr) do { const uint2* yr_ = (const uint2*)((const bf16*)Y + (size_t)(rr) * D) + F.lane; const f32x4* xr_ = (const f32x4*)(F.x + (size_t)(rr) * D) + F.lane; \
        _Pragma("unroll") for (int j = 0; j < 8; ++j) { { const u2v_t t2_ = __builtin_nontemporal_load((const u2v_t*)(yr_ + 64 * j)); ywn[j].x = t2_.x; ywn[j].y = t2_.y; } xvn[j] = __builtin_nontemporal_load(xr_ + 64 * j); } } while (0)
    for (int b = 0; b < BATCH; ++b) {
        const float* mb = MOD + b * 12288;
        __syncthreads();
        if (F.tid < 512) { const int d4 = F.tid;
            const f32x4 gt = *((const f32x4*)(mb + 4096) + d4), gp = *((const f32x4*)F.g_post_mix + d4), g2 = *((const f32x4*)F.g_pre_ffn + d4), sc = *((const f32x4*)(mb + 8192) + d4), sh = *((const f32x4*)(mb + 6144) + d4);
            *((f32x4*)PA + d4) = gt * gp; *((f32x4*)PB + d4) = g2 * (sc + 1.f); *((f32x4*)PC + d4) = sh; }
        const int rfirst = b * SEQ + F.gw;
        if (F.gw < SEQ) P6_LOAD(rfirst);
        __syncthreads();
        for (int rl = F.gw; rl < SEQ; rl += F.NGW) {
            const int row = b * SEQ + rl, s = rl;
            f32x4 xv[8]; float ss = 0.f;
            {   uint2 yc[8];
#pragma unroll
                for (int j = 0; j < 8; ++j) { yc[j] = ywn[j]; const float y0 = __uint_as_float(yc[j].x << 16), y1 = __uint_as_float(yc[j].x & 0xffff0000u), y2 = __uint_as_float(yc[j].y << 16), y3 = __uint_as_float(yc[j].y & 0xffff0000u);
                    xv[j] = xvn[j]; ss += (y0 * y0 + y1 * y1) + (y2 * y2 + y3 * y3); }
                if (rl + F.NGW < SEQ) P6_LOAD(row + F.NGW);
                const float r = rsqrtf(wave_sum(ss) * (1.f / D) + EPS);
                f32x4* op = (f32x4*)(F.out + (size_t)row * D) + F.lane;
                ss = 0.f;
#pragma unroll
                for (int j = 0; j < 8; ++j) { const f32x4 y = {__uint_as_float(yc[j].x << 16), __uint_as_float(yc[j].x & 0xffff0000u), __uint_as_float(yc[j].y << 16), __uint_as_float(yc[j].y & 0xffff0000u)};
                    const f32x4 pa = *((const f32x4*)PA + F.lane + 64 * j);
                    xv[j] = xv[j] + pa * (y * r); ss += (xv[j].x * xv[j].x + xv[j].y * xv[j].y) + (xv[j].z * xv[j].z + xv[j].w * xv[j].w); }
#pragma unroll
                for (int j = 0; j < 8; ++j) op[64 * j] = xv[j];
            }
            const float r2 = rsqrtf(wave_sum(ss) * (1.f / D) + EPS);
            unsigned* o4 = (unsigned*)((unsigned char*)H2 + (size_t)row * D) + F.lane;
            float lg[16];
#pragma unroll
            for (int j = 0; j < 8; ++j) { const f32x4 pb = *((const f32x4*)PB + F.lane + 64 * j), pc = *((const f32x4*)PC + F.lane + 64 * j); xv[j] = xv[j] * r2 * pb + pc; }
#pragma unroll
            for (int j = 0; j < 8; ++j) o4[64 * j] = pg8::pk4_fp8(xv[j].x, xv[j].y, xv[j].z, xv[j].w);
#pragma unroll
            for (int e = 0; e < 16; ++e) { float a = 0.f;
#pragma unroll
                for (int j = 0; j < 8; ++j) { const f32x4 wv = *((const f32x4*)(wT + e * 2048) + F.lane + 64 * j); a += (xv[j].x * wv.x + xv[j].y * wv.y) + (xv[j].z * wv.z + xv[j].w * wv.w); }
                lg[e] = a; asm volatile("" ::: "memory"); }
            float mx = -1e30f;
#pragma unroll
            for (int e = 0; e < 16; ++e) { lg[e] = wave_sum(lg[e]); mx = fmaxf(mx, lg[e]); }
            float sm = 0.f;
#pragma unroll
            for (int e = 0; e < 16; ++e) { lg[e] = expf(lg[e] - mx); sm += lg[e]; }
            float mine = 0.f;
#pragma unroll
            for (int e = 0; e < 16; ++e) mine = (F.lane == e) ? lg[e] : mine;
            if (F.lane < 16) AFF[((size_t)b * 16 + F.lane) * SEQ + s] = mine / sm;
        }
    }
#undef P6_LOAD
    __syncthreads();
}
__device__ __forceinline__ void p7_topk_gather(Ctx& F) {
    const float* AFF = (const float*)(F.ws + WS_AFF); int* GIDX = (int*)(F.ws + WS_GIDX); float* SELAFF = (float*)(F.ws + WS_SELAFF); int* TOKSLOT = (int*)(F.ws + WS_TOKSLOT);
        int* sh = (int*)F.lds; int* wsum = (int*)(F.lds + 64);
    for (int unit = blockIdx.x; unit < 256; unit += F.G) {
        const int be = unit >> 3, part = unit & 7, b = be >> 4, e = be & 15, tid = F.tid, lane = F.lane;
        if (F.wave == 0) {
            unsigned v[64];
#pragma unroll
            for (int i = 0; i < 64; ++i) v[i] = __float_as_uint(AFF[(size_t)be * SEQ + i * 64 + lane]);
            unsigned tau = 0u;
            for (int bit = 30; bit >= 0; --bit) { const unsigned cand = tau | (1u << bit); int cl = 0;
#pragma unroll
                for (int i = 0; i < 64; ++i) cl += (v[i] >= cand) ? 1 : 0;
                int c = 0;
#pragma unroll
                for (int q = 0; q < 7; ++q) c += __popcll(__ballot((cl >> q) & 1)) << q;
                if (c >= CAP) tau = cand; }
            int cgt = 0;
            { int cl = 0;
#pragma unroll
              for (int i = 0; i < 64; ++i) cl += (v[i] > tau) ? 1 : 0;
#pragma unroll
              for (int q = 0; q < 7; ++q) cgt += __popcll(__ballot((cl >> q) & 1)) << q; }
            if (lane == 0) { sh[0] = (int)tau; sh[1] = cgt; }
        }
        __syncthreads();
        const unsigned tau = (unsigned)sh[0]; const int need = CAP - sh[1];
        const f32x4* a = (const f32x4*)(AFF + (size_t)be * SEQ + tid * 8);
        const f32x4 a0 = a[0], a1 = a[1];
        const unsigned v[8] = {__float_as_uint(a0.x), __float_as_uint(a0.y), __float_as_uint(a0.z), __float_as_uint(a0.w), __float_as_uint(a1.x), __float_as_uint(a1.y), __float_as_uint(a1.z), __float_as_uint(a1.w)};
        int cg = 0, ce = 0;
#pragma unroll
        for (int i = 0; i < 8; ++i) { cg += (v[i] > tau) ? 1 : 0; ce += (v[i] == tau) ? 1 : 0; }
        const int pk = cg | (ce << 16); int inc = pk;
#pragma unroll
        for (int o = 1; o < 64; o <<= 1) { const int t = __shfl_up(inc, o); if (lane >= o) inc += t; }
        if (lane == 63) wsum[F.wave] = inc;
        __syncthreads();
        int base = 0;
#pragma unroll
        for (int w = 0; w < 8; ++w) base += (w < F.wave) ? wsum[w] : 0;
        const int excl = base + inc - pk, pg = excl & 0xffff, pe = excl >> 16;
        int tie_before = pe, sel_before = pg + (pe < need ? pe : need);
#pragma unroll
        for (int i = 0; i < 8; ++i) {
            const int tok = tid * 8 + i; bool sel = false;
            if (v[i] > tau) sel = true; else if (v[i] == tau) { sel = tie_before < need; ++tie_before; }
            int slot = -1;
            if (sel) { const int sl = sel_before; ++sel_before; slot = b * CAP + sl;
                if ((sl >> 6) == part) { GIDX[e * 1024 + slot] = b * SEQ + tok; SELAFF[e * 1024 + slot] = __uint_as_float(v[i]); } }
            if (F.wave == part) TOKSLOT[((size_t)b * 16 + e) * SEQ + tok] = slot;
        }
        __syncthreads();
    }
}
__device__ __forceinline__ void p10_final(Ctx& F) {
    const float* MOD = (const float*)(F.ws + WS_MOD); const bf16* SLAB = (const bf16*)(F.ws + WS_SLAB); const int* TOKSLOT = (const int*)(F.ws + WS_TOKSLOT);
    for (int row0 = F.gw; row0 < T; row0 += 4 * F.NGW) {
        int slotw[4];
#pragma unroll
        for (int k = 0; k < 4; ++k) { const int row = row0 + k * F.NGW; slotw[k] = (row < T && F.lane < 16) ? TOKSLOT[((size_t)(row / SEQ) * 16 + F.lane) * SEQ + (row % SEQ)] : -1; }
#pragma unroll
        for (int k = 0; k < 4; ++k) { const int row = row0 + k * F.NGW; if (row < T) {
            const int b = row / SEQ; const float* mb = MOD + b * 12288;
            f32x4 x1v[8], gtv[8], gpv[8];
#pragma unroll
            for (int j = 0; j < 4; ++j) { const int col = 8 * F.lane + 512 * j; const float* op = F.out + (size_t)row * D + col;
#pragma unroll
                for (int hh = 0; hh < 2; ++hh) { x1v[2 * j + hh] = *(const f32x4*)(op + 4 * hh); gtv[2 * j + hh] = *(const f32x4*)(mb + 10240 + col + 4 * hh); gpv[2 * j + hh] = *(const f32x4*)(F.g_post_ffn + col + 4 * hh); } }
            float y[32];
#pragma unroll
            for (int i = 0; i < 32; ++i) y[i] = 0.f;
            for (int e = 0; e < 16; ++e) { const int sl = __shfl(slotw[k], e); if (sl >= 0) { const v4u* r = (const v4u*)(SLAB + ((size_t)e * 1024 + sl) * D) + F.lane;
#pragma unroll
                    for (int j = 0; j < 4; ++j) { const v4u q = r[64 * j];
                        y[8 * j + 0] += __uint_as_float(q.x << 16); y[8 * j + 1] += __uint_as_float(q.x & 0xffff0000u); y[8 * j + 2] += __uint_as_float(q.y << 16); y[8 * j + 3] += __uint_as_float(q.y & 0xffff0000u);
                        y[8 * j + 4] += __uint_as_float(q.z << 16); y[8 * j + 5] += __uint_as_float(q.z & 0xffff0000u); y[8 * j + 6] += __uint_as_float(q.w << 16); y[8 * j + 7] += __uint_as_float(q.w & 0xffff0000u); } } }
            float ss = 0.f;
#pragma unroll
            for (int i = 0; i < 32; ++i) ss += y[i] * y[i];
            const float r = rsqrtf(wave_sum(ss) * (1.f / D) + EPS);
#pragma unroll
            for (int j = 0; j < 4; ++j) { const int col = 8 * F.lane + 512 * j; float* op = F.out + (size_t)row * D + col;
#pragma unroll
                for (int hh = 0; hh < 2; ++hh) { f32x4 yy = {y[8 * j + 4 * hh], y[8 * j + 4 * hh + 1], y[8 * j + 4 * hh + 2], y[8 * j + 4 * hh + 3]};
                    *(f32x4*)(op + 4 * hh) = x1v[2 * j + hh] + gtv[2 * j + hh] * (yy * r * gpv[2 * j + hh]); } } } }
    }
}
typedef short bf16x8 __attribute__((ext_vector_type(8)));
typedef short s16x4 __attribute__((ext_vector_type(4)));
typedef short v4i16_t __attribute__((ext_vector_type(4)));
typedef float f32x16 __attribute__((ext_vector_type(16)));
typedef float f32x2m __attribute__((ext_vector_type(2)));
constexpr int RS = 272;
constexpr int RSA = 144;
constexpr float LOG2E = 1.4426950408889634f;
__device__ __forceinline__ s16x4 tr4(const LAS unsigned char* p) { return __builtin_bit_cast(s16x4, __builtin_amdgcn_ds_read_tr16_b64_v4i16((LAS v4i16_t*)p)); }
__device__ __forceinline__ bf16x8 tr8(const LAS unsigned char* p, int second) { const s16x4 a = tr4(p), b = tr4(p + second); return (bf16x8){a[0], a[1], a[2], a[3], b[0], b[1], b[2], b[3]}; }
__device__ __forceinline__ bf16x8 ld8(const LAS unsigned char* p) { return *(const LAS bf16x8*)p; }
__device__ __forceinline__ unsigned cvtpk(float lo, float hi) { return pg8::cvt_pk_bf16(lo, hi); }
__device__ __forceinline__ int crow(int r, int hi) { return (r & 3) + 8 * (r >> 2) + 4 * hi; }
#define MFMA16(a, b, c) __builtin_amdgcn_mfma_f32_16x16x32_bf16((a), (b), (c), 0, 0, 0)
#define MFMA32(a, b, c) __builtin_amdgcn_mfma_f32_32x32x16_bf16((a), (b), (c), 0, 0, 0)

__device__ __forceinline__ void rope_pass(Ctx& F) {
    const bf16* PROJ = (const bf16*)(F.ws + WS_PROJ); const float* ROPE = (const float*)(F.ws + WS_ROPE); bf16* QR = (bf16*)(F.ws + WS_QR); bf16* KR = (bf16*)(F.ws + WS_KR);
    const int NT = F.G * 512;
    for (int it0 = blockIdx.x * 512 + F.tid; it0 < T * 80; it0 += 2 * NT) {
        v4u a[2], bq[2]; f32x4 cs[2][4]; bool ok[2];
#pragma unroll
        for (int u = 0; u < 2; ++u) { const int it = it0 + u * NT; ok[u] = it < T * 80; if (ok[u]) { const int i8 = it & 7, hh = (it >> 3) % 10, t = it / 80;
            const bf16* src = PROJ + (size_t)t * INW + (hh < 8 ? C_AQ + hh * 128 : C_AK + (hh - 8) * 128) + i8 * 8;
            a[u] = *(const v4u*)src; bq[u] = *(const v4u*)(src + 64);
            const f32x4* rp = (const f32x4*)(ROPE + ((size_t)t * 64 + i8 * 8) * 2);
#pragma unroll
            for (int k = 0; k < 4; ++k) cs[u][k] = rp[k]; } }
#pragma unroll
        for (int u = 0; u < 2; ++u) { if (ok[u]) { const int it = it0 + u * NT; const int i8 = it & 7, hh = (it >> 3) % 10, t = it / 80;
            const unsigned aw[4] = {a[u].x, a[u].y, a[u].z, a[u].w}, bw[4] = {bq[u].x, bq[u].y, bq[u].z, bq[u].w};
            unsigned o1[4], o2[4];
#pragma unroll
            for (int k = 0; k < 4; ++k) { const f32x4 c4 = cs[u][k];
                const float x1a = __uint_as_float(aw[k] << 16), x1b = __uint_as_float(aw[k] & 0xffff0000u), x2a = __uint_as_float(bw[k] << 16), x2b = __uint_as_float(bw[k] & 0xffff0000u);
                o1[k] = pk2(x1a * c4.x - x2a * c4.y, x1b * c4.z - x2b * c4.w); o2[k] = pk2(x1a * c4.y + x2a * c4.x, x1b * c4.w + x2b * c4.z); }
            bf16* dst = (hh < 8 ? QR + (size_t)t * 1024 + hh * 128 : KR + (size_t)t * 256 + (hh - 8) * 128) + i8 * 8;
            *(v4u*)dst = (v4u){o1[0], o1[1], o1[2], o1[3]}; *(v4u*)(dst + 64) = (v4u){o2[0], o2[1], o2[2], o2[3]}; } }
    }
}
__device__ __forceinline__ void hgrn_a_phase(Ctx& F, LAS unsigned char* L) {
    const bf16* PROJ = (const bf16*)(F.ws + WS_PROJ); const float* LB = (const float*)(F.ws + WS_LB); bf16* CS = (bf16*)(F.ws + WS_CS); float* DEC = (float*)(F.ws + WS_DEC);
    LAS unsigned char* KD = L; LAS unsigned char* VV = L + 17408; LAS float* TOT = (LAS float*)(L + 34816);
    const int tid = F.tid, lane = F.lane, w = F.wave, dk0 = 2 * lane;
    const int tro16 = (8 * (lane >> 4) + ((lane & 15) >> 2)) * RS + (lane & 3) * 8;
    unsigned zraw[8]; v4u vr[2]; float lbA = 0.f, lbB = 0.f;
#define HA_LOAD(un) do { const int c_ = (un) & 63, dir_ = ((un) >> 6) & 1, h_ = ((un) >> 7) & 7, b_ = (un) >> 10; const size_t rb_ = (size_t)b_ * SEQ + c_ * 64; \
        { const float2 l2_ = *(const float2*)(LB + dir_ * 1024 + h_ * 128 + dk0); lbA = l2_.x; lbB = l2_.y; } \
        const bf16* zp_ = PROJ + (rb_ + 8 * w) * INW + (dir_ ? C_FB : C_FF) + h_ * 128; \
        _Pragma("unroll") for (int i = 0; i < 8; ++i) zraw[i] = *(const unsigned*)(zp_ + (size_t)i * INW + dk0); \
        _Pragma("unroll") for (int i = 0; i < 2; ++i) { const int idx = tid + 512 * i, row = idx >> 4, ch = idx & 15; vr[i] = *(const v4u*)(PROJ + (rb_ + row) * INW + C_HI + h_ * 128 + ch * 8); } } while (0)
    if ((int)blockIdx.x < 2048) HA_LOAD((int)blockIdx.x);
    for (int unit = blockIdx.x; unit < 2048; unit += F.G) {
        const int dir = (unit >> 6) & 1;
        float lfa[8], lfb[8], ka[8], kb[8];
#pragma unroll
        for (int i = 0; i < 8; ++i) { const float za = __uint_as_float(zraw[i] << 16), zb = __uint_as_float(zraw[i] & 0xffff0000u);
            const float fa = lbA + (1.f - lbA) * sigmoidf_(za), fb = lbB + (1.f - lbB) * sigmoidf_(zb); lfa[i] = __logf(fa); lfb[i] = __logf(fb); ka[i] = 1.f - fa; kb[i] = 1.f - fb; }
#pragma unroll
        for (int i = 0; i < 2; ++i) { const int idx = tid + 512 * i, row = idx >> 4, ch = idx & 15; *(LAS v4u*)(VV + row * RS + ch * 16) = vr[i]; }
        if (unit + F.G < 2048) HA_LOAD(unit + F.G);
        float runa = 0.f, runb = 0.f;
        if (dir == 0) {
#pragma unroll
            for (int i = 0; i < 8; ++i) { runa += lfa[i]; lfa[i] = runa; runb += lfb[i]; lfb[i] = runb; } }
        else {
#pragma unroll
            for (int i = 7; i >= 0; --i) { runa += lfa[i]; lfa[i] = runa; runb += lfb[i]; lfb[i] = runb; } }
        *(LAS f32x2m*)(TOT + w * 128 + dk0) = (f32x2m){runa, runb};
        __syncthreads();
        float totA = 0.f, totB = 0.f, offA = 0.f, offB = 0.f;
#pragma unroll
        for (int p = 0; p < 8; ++p) { const f32x2m t = *(const LAS f32x2m*)(TOT + p * 128 + dk0); totA += t.x; totB += t.y;
            const bool inoff = dir == 0 ? (p < w) : (p > w); offA += inoff ? t.x : 0.f; offB += inoff ? t.y : 0.f; }
#pragma unroll
        for (int i = 0; i < 8; ++i) { const float va = ka[i] * __expf(totA - (lfa[i] + offA)), vb = kb[i] * __expf(totB - (lfb[i] + offB));
            *(LAS unsigned*)(KD + (8 * w + i) * RS + dk0 * 2) = pk2(va, vb); }
        if (w == 0) *(float2*)(DEC + (size_t)unit * 128 + dk0) = make_float2(__expf(totA), __expf(totB));
        __syncthreads();
        f32x4 acc[2][4];
#pragma unroll
        for (int a = 0; a < 2; ++a)
#pragma unroll
            for (int t = 0; t < 4; ++t) acc[a][t] = (f32x4){0.f, 0.f, 0.f, 0.f};
        const int dvb = 32 * (w & 3), dkb = 64 * (w >> 2);
#pragma unroll
        for (int s = 0; s < 2; ++s) {
            bf16x8 af[2], bfr[4];
#pragma unroll
            for (int a = 0; a < 2; ++a) af[a] = tr8(VV + (32 * s) * RS + (dvb + 16 * a) * 2 + tro16, 4 * RS);
#pragma unroll
            for (int t = 0; t < 4; ++t) bfr[t] = tr8(KD + (32 * s) * RS + (dkb + 16 * t) * 2 + tro16, 4 * RS);
#pragma unroll
            for (int a = 0; a < 2; ++a)
#pragma unroll
                for (int t = 0; t < 4; ++t) acc[a][t] = MFMA16(af[a], bfr[t], acc[a][t]);
        }
        bf16* cso = CS + (size_t)unit * 16384;
        const int cc = lane & 15, rg = lane >> 4;
#pragma unroll
        for (int a = 0; a < 2; ++a)
#pragma unroll
            for (int t = 0; t < 4; ++t) { const int dkk = dkb + 16 * t + cc, dv0 = dvb + 16 * a + 4 * rg;
                uint2 o; o.x = cvtpk(acc[a][t][0], acc[a][t][1]); o.y = cvtpk(acc[a][t][2], acc[a][t][3]); *(uint2*)(cso + dkk * 128 + dv0) = o; }
        __syncthreads();
    }
#undef HA_LOAD
}
__device__ __forceinline__ void hgrn_scan_phase(Ctx& F) {
    const bf16* CS = (const bf16*)(F.ws + WS_CS); bf16* ST = (bf16*)(F.ws + WS_STATE); const float* DEC = (const float*)(F.ws + WS_DEC);
    const int NT = F.G * 512;
    for (int gt = blockIdx.x * 512 + F.tid; gt < 32 * 4096; gt += NT) {
        const int g = gt >> 12, e4 = (gt & 4095) * 4, dk = e4 >> 7, dir = g & 1;
        float s0 = 0.f, s1 = 0.f, s2 = 0.f, s3 = 0.f;
        uint2 tn[8]; float dn[8];
#define SC_LOAD(st_) do { _Pragma("unroll") for (int k = 0; k < 8; ++k) { const int c_ = dir ? 63 - ((st_) + k) : (st_) + k; const size_t u_ = (size_t)g * 64 + c_; { const u2v_t t2_ = __builtin_nontemporal_load((const u2v_t*)(CS + u_ * 16384 + e4)); tn[k].x = t2_.x; tn[k].y = t2_.y; } dn[k] = DEC[u_ * 128 + dk]; } } while (0)
        SC_LOAD(0);
        for (int st = 0; st < 64; st += 8) {
            uint2 tmp[8]; float dc[8];
#pragma unroll
            for (int k = 0; k < 8; ++k) { tmp[k] = tn[k]; dc[k] = dn[k]; }
            if (st + 8 < 64) SC_LOAD(st + 8);
#pragma unroll
            for (int k = 0; k < 8; ++k) { const int c = dir ? 63 - (st + k) : st + k; const size_t unit = (size_t)g * 64 + c;
                uint2 o; o.x = pk2(s0, s1); o.y = pk2(s2, s3); *(uint2*)(ST + unit * 16384 + e4) = o;
                s0 = dc[k] * s0 + __uint_as_float(tmp[k].x << 16); s1 = dc[k] * s1 + __uint_as_float(tmp[k].x & 0xffff0000u);
                s2 = dc[k] * s2 + __uint_as_float(tmp[k].y << 16); s3 = dc[k] * s3 + __uint_as_float(tmp[k].y & 0xffff0000u); }
        }
#undef SC_LOAD
    }
}
__device__ __forceinline__ void hgrn_c_phase(Ctx& F, LAS unsigned char* L) {
    const bf16* PROJ = (const bf16*)(F.ws + WS_PROJ); const float* LB = (const float*)(F.ws + WS_LB); const bf16* ST = (const bf16*)(F.ws + WS_STATE); bf16* YAIN = (bf16*)(F.ws + WS_YAIN);
    LAS unsigned char* QI = L; LAS unsigned char* KI = L + 17408; LAS unsigned char* QE = L + 34816; LAS unsigned char* VV = L + 52224; LAS unsigned char* SP = L + 69632; LAS unsigned char* AM = L + 104448;
    LAS float* TOT = (LAS float*)(L + 113664); LAS float* SSQ = (LAS float*)(L + 117760);
    const int tid = F.tid, lane = F.lane, w = F.wave, dk0 = 2 * lane, cc = lane & 15, rg = lane >> 4;
    const int tro16 = (8 * (lane >> 4) + ((lane & 15) >> 2)) * RS + (lane & 3) * 8;
    unsigned zraw[8], qraw[8]; v4u vr[2], sr[4]; float lbA = 0.f, lbB = 0.f;
#define HC_LOAD(un, dr) do { const int c_ = (un) & 63, h_ = ((un) >> 6) & 7, b_ = (un) >> 9; const size_t rb_ = (size_t)b_ * SEQ + c_ * 64; \
        { const float2 l2_ = *(const float2*)(LB + (dr) * 1024 + h_ * 128 + dk0); lbA = l2_.x; lbB = l2_.y; } \
        const bf16* zp_ = PROJ + (rb_ + 8 * w) * INW + h_ * 128; \
        _Pragma("unroll") for (int i = 0; i < 8; ++i) { const bf16* rp_ = zp_ + (size_t)i * INW; zraw[i] = *(const unsigned*)(rp_ + ((dr) ? C_FB : C_FF) + dk0); qraw[i] = *(const unsigned*)(rp_ + C_HQ + dk0); } \
        if ((dr) == 0) { _Pragma("unroll") for (int i = 0; i < 2; ++i) { const int idx = tid + 512 * i, row = idx >> 4, ch = idx & 15; vr[i] = *(const v4u*)(PROJ + (rb_ + row) * INW + C_HI + h_ * 128 + ch * 8); } } \
        { const bf16* sp_ = ST + ((size_t)((b_ * 8 + h_) * 2 + (dr)) * 64 + c_) * 16384; \
          _Pragma("unroll") for (int i = 0; i < 4; ++i) { const int idx = tid + 512 * i; sr[i] = __builtin_nontemporal_load((const v4u*)(sp_ + idx * 8)); } } } while (0)
    if ((int)blockIdx.x < 1024) HC_LOAD((int)blockIdx.x, 0);
    for (int unit = blockIdx.x; unit < 1024; unit += F.G) {
        const int c = unit & 63, h = (unit >> 6) & 7, b = unit >> 9;
        const size_t rb = (size_t)b * SEQ + c * 64;
        f32x4 o[4];
#pragma unroll
        for (int t = 0; t < 4; ++t) o[t] = (f32x4){0.f, 0.f, 0.f, 0.f};
        for (int dir = 0; dir < 2; ++dir) {
            float lfa[8], lfb[8], ka[8], kb[8], qa[8], qb[8];
#pragma unroll
            for (int i = 0; i < 8; ++i) { const float za = __uint_as_float(zraw[i] << 16), zb = __uint_as_float(zraw[i] & 0xffff0000u);
                const float fa = lbA + (1.f - lbA) * sigmoidf_(za), fb = lbB + (1.f - lbB) * sigmoidf_(zb); lfa[i] = __logf(fa); lfb[i] = __logf(fb); ka[i] = 1.f - fa; kb[i] = 1.f - fb;
                qa[i] = siluf_(__uint_as_float(qraw[i] << 16)); qb[i] = siluf_(__uint_as_float(qraw[i] & 0xffff0000u)); }
            if (dir == 0) {
#pragma unroll
                for (int i = 0; i < 2; ++i) { const int idx = tid + 512 * i, row = idx >> 4, ch = idx & 15; *(LAS v4u*)(VV + row * RS + ch * 16) = vr[i]; } }
#pragma unroll
            for (int i = 0; i < 4; ++i) { const int idx = tid + 512 * i, row = idx >> 4, ch = idx & 15; *(LAS v4u*)(SP + row * RS + ch * 16) = sr[i]; }
            if (dir == 0) HC_LOAD(unit, 1); else if (unit + F.G < 1024) HC_LOAD(unit + F.G, 0);
            float runa = 0.f, runb = 0.f;
            if (dir == 0) {
#pragma unroll
                for (int i = 0; i < 8; ++i) { runa += lfa[i]; lfa[i] = runa; runb += lfb[i]; lfb[i] = runb; } }
            else {
#pragma unroll
                for (int i = 7; i >= 0; --i) { runa += lfa[i]; lfa[i] = runa; runb += lfb[i]; lfb[i] = runb; } }
            *(LAS f32x2m*)(TOT + w * 128 + dk0) = (f32x2m){runa, runb};
            __syncthreads();
            {   float offA = 0.f, offB = 0.f, brA = 0.f, brB = 0.f;
#pragma unroll
                for (int p = 0; p < 8; ++p) { const f32x2m t = *(const LAS f32x2m*)(TOT + p * 128 + dk0);
                    const bool inoff = dir == 0 ? (p < w) : (p > w), inref = dir == 0 ? (p < 4) : (p >= 4);
                    offA += inoff ? t.x : 0.f; offB += inoff ? t.y : 0.f; brA += inref ? t.x : 0.f; brB += inref ? t.y : 0.f; }
#pragma unroll
                for (int i = 0; i < 8; ++i) { const float ba = lfa[i] + offA, bb = lfb[i] + offB; const int ro = (8 * w + i) * RS + dk0 * 2;
                    *(LAS unsigned*)(QI + ro) = pk2(qa[i] * __expf(ba - brA), qb[i] * __expf(bb - brB));
                    *(LAS unsigned*)(KI + ro) = pk2(ka[i] * __expf(brA - ba), kb[i] * __expf(brB - bb));
                    *(LAS unsigned*)(QE + ro) = pk2(qa[i] * __expf(ba), qb[i] * __expf(bb)); }
            }
            __syncthreads();
            {
                const int rt = w >> 1, ct0 = 2 * (w & 1);
                f32x4 am[2] = {(f32x4){0.f, 0.f, 0.f, 0.f}, (f32x4){0.f, 0.f, 0.f, 0.f}};
#pragma unroll
                for (int s = 0; s < 4; ++s) { const bf16x8 af = ld8(QI + (16 * rt + cc) * RS + (32 * s + 8 * rg) * 2);
#pragma unroll
                    for (int t = 0; t < 2; ++t) { const bf16x8 bfr = ld8(KI + (16 * (ct0 + t) + cc) * RS + (32 * s + 8 * rg) * 2); am[t] = MFMA16(af, bfr, am[t]); } }
#pragma unroll
                for (int t = 0; t < 2; ++t)
#pragma unroll
                    for (int i = 0; i < 4; ++i) { const int l = 16 * rt + 4 * rg + i, m = 16 * (ct0 + t) + cc; const bool keep = dir == 0 ? (m <= l) : (m >= l);
                        *(LAS bf16*)(AM + l * RSA + m * 2) = f2bf(keep ? am[t][i] : 0.f); }
            }
            __syncthreads();
            {
                const int rt = w & 3, cb = 64 * (w >> 2);
#pragma unroll
                for (int s = 0; s < 2; ++s) { const bf16x8 af = ld8(AM + (16 * rt + cc) * RSA + (32 * s + 8 * rg) * 2);
#pragma unroll
                    for (int t = 0; t < 4; ++t) { const bf16x8 bfr = tr8(VV + (32 * s) * RS + (cb + 16 * t) * 2 + tro16, 4 * RS); o[t] = MFMA16(af, bfr, o[t]); } }
#pragma unroll
                for (int s = 0; s < 4; ++s) { const bf16x8 af = ld8(QE + (16 * rt + cc) * RS + (32 * s + 8 * rg) * 2);
#pragma unroll
                    for (int t = 0; t < 4; ++t) { const bf16x8 bfr = tr8(SP + (32 * s) * RS + (cb + 16 * t) * 2 + tro16, 4 * RS); o[t] = MFMA16(af, bfr, o[t]); } }
            }
            __syncthreads();
        }
        const int rt = w & 3, chh = w >> 2, cb = 64 * chh;
        bf16 hgv[4][4]; float onv[4];
#pragma unroll
        for (int t = 0; t < 4; ++t) { const int dv = cb + 16 * t + cc; onv[t] = F.onorm[h * 128 + dv];
#pragma unroll
            for (int i = 0; i < 4; ++i) hgv[i][t] = PROJ[(rb + 16 * rt + 4 * rg + i) * INW + C_HG + h * 128 + dv]; }
        float ssv[4];
#pragma unroll
        for (int i = 0; i < 4; ++i) { float sq = 0.f;
#pragma unroll
            for (int t = 0; t < 4; ++t) sq += o[t][i] * o[t][i];
            sq += __shfl_xor(sq, 1); sq += __shfl_xor(sq, 2); sq += __shfl_xor(sq, 4); sq += __shfl_xor(sq, 8); ssv[i] = sq; }
        if (cc == 0) {
#pragma unroll
            for (int i = 0; i < 4; ++i) SSQ[chh * 64 + 16 * rt + 4 * rg + i] = ssv[i]; }
        __syncthreads();
        float rr[4];
#pragma unroll
        for (int i = 0; i < 4; ++i) { const int l = 16 * rt + 4 * rg + i; rr[i] = rsqrtf((SSQ[l] + SSQ[64 + l]) * (1.f / 128.f) + EPS); }
#pragma unroll
        for (int i = 0; i < 4; ++i) { const int l = 16 * rt + 4 * rg + i;
#pragma unroll
            for (int t = 0; t < 4; ++t) { const int dv = cb + 16 * t + cc;
                YAIN[(rb + l) * 1024 + h * 128 + dv] = f2bf(o[t][i] * rr[i] * onv[t] * siluf_(bf2f(hgv[i][t]))); } }
        __syncthreads();
    }
#undef HC_LOAD
}
__device__ __forceinline__ void rope8(v4u& a, v4u& bq, const f32x4 (&cs)[4]) {
    const unsigned aw[4] = {a.x, a.y, a.z, a.w}, bw[4] = {bq.x, bq.y, bq.z, bq.w}; unsigned o1[4], o2[4];
#pragma unroll
    for (int k = 0; k < 4; ++k) { const f32x4 c4 = cs[k];
        const float x1a = __uint_as_float(aw[k] << 16), x1b = __uint_as_float(aw[k] & 0xffff0000u), x2a = __uint_as_float(bw[k] << 16), x2b = __uint_as_float(bw[k] & 0xffff0000u);
        o1[k] = pk2(x1a * c4.x - x2a * c4.y, x1b * c4.z - x2b * c4.w); o2[k] = pk2(x1a * c4.y + x2a * c4.x, x1b * c4.w + x2b * c4.z); }
    a = (v4u){o1[0], o1[1], o1[2], o1[3]}; bq = (v4u){o2[0], o2[1], o2[2], o2[3]};
}
__device__ __forceinline__ void attn_phase(Ctx& F, LAS unsigned char* L) {
    const bf16* PROJ = (const bf16*)(F.ws + WS_PROJ); const float* ROPE = (const float*)(F.ws + WS_ROPE); bf16* ATT = (bf16*)(F.ws + WS_ATT);
    LAS unsigned char* KT = L; LAS unsigned char* VT = L + 17408; LAS float* AL = (LAS float*)(L + 34816) + F.wave * 32;
    const int tid = F.tid, lane = F.lane, w = F.wave, q32 = lane & 31, hh = lane >> 5;
    const int tro32 = (4 * hh + ((lane & 15) >> 2)) * RS + (16 * ((lane >> 4) & 1) + 4 * (lane & 3)) * 2;
    const int krow = tid >> 3, kc8 = tid & 7;
    constexpr float C2 = 0.08838834764831845f * LOG2E;
    for (int unit = blockIdx.x; unit < 256; unit += F.G) {
        const int qb = unit & 63, kvh = (unit >> 6) & 1, b = unit >> 7, q0 = qb * 64, h = kvh * 4 + (w >> 1);
        const int qp = q0 + 32 * (w & 1) + q32;
        bf16x8 qf[8];
        {
            const bf16* qptr = PROJ + ((size_t)b * SEQ + qp) * INW + C_AQ + h * 128 + 8 * hh;
            const f32x4* rp = (const f32x4*)(ROPE + (((size_t)b * SEQ + qp) * 64 + 8 * hh) * 2);
#pragma unroll
            for (int s = 0; s < 4; ++s) { v4u x1 = *(const v4u*)(qptr + 16 * s), x2 = *(const v4u*)(qptr + 16 * s + 64);
                f32x4 cs[4];
#pragma unroll
                for (int k = 0; k < 4; ++k) cs[k] = rp[8 * s + k];
                rope8(x1, x2, cs); qf[s] = __builtin_bit_cast(bf16x8, x1); qf[s + 4] = __builtin_bit_cast(bf16x8, x2); }
        }
        float m = F.sink[h] * LOG2E, l = 1.f;
        f32x16 o[4];
#pragma unroll
        for (int d = 0; d < 4; ++d)
#pragma unroll
            for (int r = 0; r < 16; ++r) o[d][r] = 0.f;
        int j = 0; while (j < 5 && (q0 - 128 + 64 * j < 0 || q0 - 128 + 64 * j >= SEQ)) ++j;
        v4u kr[2], vr[2]; f32x4 kcs[4];
#define ATT_LOAD(jj) do { const int kb_ = q0 - 128 + 64 * (jj); \
            { const size_t t_ = (size_t)b * SEQ + kb_ + krow; const bf16* kp_ = PROJ + t_ * INW + C_AK + kvh * 128 + kc8 * 8; kr[0] = *(const v4u*)kp_; kr[1] = *(const v4u*)(kp_ + 64); \
              const f32x4* rp_ = (const f32x4*)(ROPE + (t_ * 64 + kc8 * 8) * 2); _Pragma("unroll") for (int k = 0; k < 4; ++k) kcs[k] = rp_[k]; } \
            _Pragma("unroll") for (int i = 0; i < 2; ++i) { const int idx = tid + 512 * i, row = idx >> 4, ch = idx & 15; \
                vr[i] = *(const v4u*)(PROJ + ((size_t)b * SEQ + kb_ + row) * INW + C_AV + kvh * 128 + ch * 8); } } while (0)
        if (j < 5) ATT_LOAD(j);
        while (j < 5) {
            const int kb = q0 - 128 + 64 * j;
            __syncthreads();
            rope8(kr[0], kr[1], kcs);
            *(LAS v4u*)(KT + krow * RS + kc8 * 16) = kr[0]; *(LAS v4u*)(KT + krow * RS + (kc8 + 8) * 16) = kr[1];
#pragma unroll
            for (int i = 0; i < 2; ++i) { const int idx = tid + 512 * i, row = idx >> 4, ch = idx & 15; *(LAS v4u*)(VT + row * RS + ch * 16) = vr[i]; }
            __syncthreads();
            int jn = j + 1; while (jn < 5 && (q0 - 128 + 64 * jn < 0 || q0 - 128 + 64 * jn >= SEQ)) ++jn;
            if (jn < 5) ATT_LOAD(jn);
            f32x16 p0, p1;
#pragma unroll
            for (int r = 0; r < 16; ++r) { p0[r] = 0.f; p1[r] = 0.f; }
#pragma unroll
            for (int s = 0; s < 8; ++s) { const bf16x8 k0 = ld8(KT + q32 * RS + (16 * s + 8 * hh) * 2), k1 = ld8(KT + (32 + q32) * RS + (16 * s + 8 * hh) * 2);
                p0 = MFMA32(k0, qf[s], p0); p1 = MFMA32(k1, qf[s], p1); }
            float tmax = -INFINITY;
#pragma unroll
            for (int r = 0; r < 16; ++r) { const int d0 = kb + crow(r, hh) - qp;
                p0[r] = ((unsigned)(d0 + 128) <= 256u) ? p0[r] * C2 : -INFINITY; p1[r] = ((unsigned)(d0 + 32 + 128) <= 256u) ? p1[r] * C2 : -INFINITY;
                tmax = fmaxf(tmax, fmaxf(p0[r], p1[r])); }
            tmax = fmaxf(tmax, __shfl_xor(tmax, 32));
            const float mn = fmaxf(m, tmax), alpha = __builtin_amdgcn_exp2f(m - mn); m = mn;
            float rs = 0.f;
#pragma unroll
            for (int r = 0; r < 16; ++r) { p0[r] = __builtin_amdgcn_exp2f(p0[r] - mn); p1[r] = __builtin_amdgcn_exp2f(p1[r] - mn); rs += p0[r] + p1[r]; }
            rs += __shfl_xor(rs, 32);
            l = l * alpha + rs;
            if (hh == 0) AL[q32] = alpha;
            LDS_WAIT();
#pragma unroll
            for (int g4 = 0; g4 < 4; ++g4) { const f32x4 a4 = *(const LAS f32x4*)(AL + 8 * g4 + 4 * hh);
#pragma unroll
                for (int d = 0; d < 4; ++d) { o[d][4 * g4 + 0] *= a4.x; o[d][4 * g4 + 1] *= a4.y; o[d][4 * g4 + 2] *= a4.z; o[d][4 * g4 + 3] *= a4.w; } }
#pragma unroll
            for (int kb2 = 0; kb2 < 2; ++kb2)
#pragma unroll
                for (int s = 0; s < 2; ++s) {
                    unsigned pw[4];
#pragma unroll
                    for (int k = 0; k < 4; ++k) pw[k] = kb2 ? cvtpk(p1[8 * s + 2 * k], p1[8 * s + 2 * k + 1]) : cvtpk(p0[8 * s + 2 * k], p0[8 * s + 2 * k + 1]);
                    const bf16x8 pa = __builtin_bit_cast(bf16x8, (v4u){pw[0], pw[1], pw[2], pw[3]});
#pragma unroll
                    for (int d = 0; d < 4; ++d) { const bf16x8 vf = tr8(VT + (32 * kb2 + 16 * s) * RS + 64 * d + tro32, 8 * RS); o[d] = MFMA32(pa, vf, o[d]); }
                }
            j = jn;
        }
#undef ATT_LOAD
        if (hh == 0) AL[q32] = 1.f / l;
        LDS_WAIT();
#pragma unroll
        for (int g4 = 0; g4 < 4; ++g4) { const f32x4 a4 = *(const LAS f32x4*)(AL + 8 * g4 + 4 * hh); const float av[4] = {a4.x, a4.y, a4.z, a4.w};
#pragma unroll
            for (int i = 0; i < 4; ++i) { const int r = 4 * g4 + i; const int qrow = q0 + 32 * (w & 1) + crow(r, hh);
                bf16* op = ATT + ((size_t)b * SEQ + qrow) * 1024 + h * 128 + q32;
#pragma unroll
                for (int d = 0; d < 4; ++d) op[32 * d] = f2bf(o[d][r] * av[i]); } }
        __syncthreads();
    }
}

#ifdef TESTMODE
__global__ void __launch_bounds__(256) k_rope(const bf16* __restrict__ PROJ, const float* __restrict__ rope, bf16* __restrict__ QR, bf16* __restrict__ KR) {
    const int gid = blockIdx.x * 256 + threadIdx.x;
    const int i = gid & 63, hh = (gid >> 6) % 10, t = gid / 640;
    const float cs = rope[((size_t)t * 64 + i) * 2], sn = rope[((size_t)t * 64 + i) * 2 + 1];
    const bf16* src = PROJ + (size_t)t * INW + (hh < 8 ? C_AQ + hh * 128 : C_AK + (hh - 8) * 128);
    const float x1 = bf2f(src[i]), x2 = bf2f(src[i + 64]);
    bf16* dst = hh < 8 ? QR + (size_t)t * 1024 + hh * 128 : KR + (size_t)t * 256 + (hh - 8) * 128;
    dst[i] = f2bf(x1 * cs - x2 * sn); dst[i + 64] = f2bf(x1 * sn + x2 * cs);
}
__global__ void __launch_bounds__(256) k_hgrn_naive(const bf16* __restrict__ PROJ, const float* __restrict__ lb, float* __restrict__ OF, float* __restrict__ OB) {
    __shared__ float qs[128], fs[128], ks[128], part[128];
    const int dir = blockIdx.x & 1, h = (blockIdx.x >> 1) & 7, b = blockIdx.x >> 4, tid = threadIdx.x, dv = tid & 127, half = tid >> 7;
    float S[64];
#pragma unroll
    for (int i = 0; i < 64; ++i) S[i] = 0.f;
    float* O = dir ? OB : OF;
    const float lbv = tid < 128 ? lb[dir * 1024 + h * 128 + tid] : 0.f;
    bf16 nzq = 0, nzf = 0, nv = 0;
    { const int t = dir ? SEQ - 1 : 0; const bf16* pr = PROJ + ((size_t)b * SEQ + t) * INW;
      if (tid < 128) { nzq = pr[C_HQ + h * 128 + tid]; nzf = pr[(dir ? C_FB : C_FF) + h * 128 + tid]; } nv = pr[C_HI + h * 128 + dv]; }
    for (int tp = 0; tp < SEQ; ++tp) {
        const int t = dir ? SEQ - 1 - tp : tp; const size_t row = (size_t)b * SEQ + t;
        const bf16 czq = nzq, czf = nzf, cv = nv;
        if (tp + 1 < SEQ) { const int t2 = dir ? SEQ - 2 - tp : tp + 1; const bf16* pr = PROJ + ((size_t)b * SEQ + t2) * INW;
            if (tid < 128) { nzq = pr[C_HQ + h * 128 + tid]; nzf = pr[(dir ? C_FB : C_FF) + h * 128 + tid]; } nv = pr[C_HI + h * 128 + dv]; }
        if (tid < 128) { const float zq = bf2f(czq), zf = bf2f(czf);
            const float f = lbv + (1.f - lbv) * sigmoidf_(zf); qs[tid] = siluf_(zq); fs[tid] = f; ks[tid] = 1.f - f; }
        const float v = bf2f(cv);
        __syncthreads();
        float acc = 0.f;
#pragma unroll
        for (int i = 0; i < 64; ++i) { const int dk = half * 64 + i; S[i] = fs[dk] * S[i] + ks[dk] * v; acc += S[i] * qs[dk]; }
        if (half == 1) part[dv] = acc;
        __syncthreads();
        if (half == 0) O[row * 1024 + h * 128 + dv] = acc + part[dv];
    }
}
__global__ void __launch_bounds__(256) k_hgrn_post(const float* __restrict__ OF, const float* __restrict__ OB, const bf16* __restrict__ PROJ, const float* __restrict__ onorm, bf16* __restrict__ YAIN) {
    const int w = blockIdx.x * 4 + (threadIdx.x >> 6), lane = threadIdx.x & 63, row = w >> 3, h = w & 7;
    const size_t o = (size_t)row * 1024 + h * 128;
    const float a0 = OF[o + lane] + OB[o + lane], a1 = OF[o + 64 + lane] + OB[o + 64 + lane];
    float ss = a0 * a0 + a1 * a1;
    for (int s = 32; s > 0; s >>= 1) ss += __shfl_xor(ss, s);
    const float r = rsqrtf(ss * (1.f / 128.f) + EPS);
    const bf16* pg = PROJ + (size_t)row * INW + C_HG + h * 128;
    YAIN[o + lane] = f2bf(a0 * r * onorm[h * 128 + lane] * siluf_(bf2f(pg[lane])));
    YAIN[o + 64 + lane] = f2bf(a1 * r * onorm[h * 128 + 64 + lane] * siluf_(bf2f(pg[64 + lane])));
}
__global__ void __launch_bounds__(256) k_attn_naive(const bf16* __restrict__ QR, const bf16* __restrict__ KR, const bf16* __restrict__ PROJ, const float* __restrict__ sink, bf16* __restrict__ ATT) {
    __shared__ float sl[4][264];
    const int wv = threadIdx.x >> 6, lane = threadIdx.x & 63;
    const int w = blockIdx.x * 4 + wv;
    const int i = w & 4095, h = (w >> 12) & 7, b = w >> 15, kvh = h >> 2;
    const size_t qrow = (size_t)b * SEQ + i;
    const float q0 = bf2f(QR[qrow * 1024 + h * 128 + 2 * lane]), q1 = bf2f(QR[qrow * 1024 + h * 128 + 2 * lane + 1]);
    const int jlo = i - 128 < 0 ? 0 : i - 128, jhi = i + 128 > SEQ - 1 ? SEQ - 1 : i + 128;
    const float sk = sink[h];
    float m = sk;
    for (int j = jlo; j <= jhi; ++j) {
        const bf16* kr = KR + ((size_t)b * SEQ + j) * 256 + kvh * 128;
        float p = q0 * bf2f(kr[2 * lane]) + q1 * bf2f(kr[2 * lane + 1]);
        for (int s = 32; s > 0; s >>= 1) p += __shfl_xor(p, s);
        p *= 0.08838834764831845f;
        if (lane == 0) sl[wv][j - jlo] = p;
        m = fmaxf(m, p);
    }
    __syncthreads();
    float den = expf(sk - m), o0 = 0.f, o1 = 0.f;
    for (int j = jlo; j <= jhi; ++j) {
        const float p = expf(sl[wv][j - jlo] - m); den += p;
        const bf16* vr = PROJ + ((size_t)b * SEQ + j) * INW + C_AV + kvh * 128;
        o0 += p * bf2f(vr[2 * lane]); o1 += p * bf2f(vr[2 * lane + 1]);
    }
    ATT[qrow * 1024 + h * 128 + 2 * lane] = f2bf(o0 / den); ATT[qrow * 1024 + h * 128 + 2 * lane + 1] = f2bf(o1 / den);
}
#endif
__global__ void __launch_bounds__(NWAVES * 64, 2) mega(Args args) {
    extern __shared__ __attribute__((aligned(16))) unsigned char lds[];
    Ctx F;
    F.lds = lds; F.tid = threadIdx.x; F.lane = F.tid & 63; F.wave = __builtin_amdgcn_readfirstlane(F.tid >> 6); F.G = gridDim.x;
    F.gw = blockIdx.x * NWAVES + F.wave; F.NGW = F.G * NWAVES;
    F.x = (const float*)args.in[0]; F.c = (const float*)args.in[1]; F.pos = (const int*)args.in[2]; F.w_ada = (const float*)args.in[3]; F.b_ada = (const float*)args.in[4];
    F.g_pre_mix = (const float*)args.in[5]; F.g_post_mix = (const float*)args.in[6]; F.g_pre_ffn = (const float*)args.in[7]; F.g_post_ffn = (const float*)args.in[8];
    F.w_in = (const float*)args.in[9]; F.lbl = (const float*)args.in[10]; F.onorm = (const float*)args.in[11]; F.sink = (const float*)args.in[12];
    F.w_a = (const float*)args.in[13]; F.w_b = (const float*)args.in[14]; F.w_o = (const float*)args.in[15]; F.w_router = (const float*)args.in[16];
    F.w_eg = (const float*)args.in[17]; F.w_eu = (const float*)args.in[18]; F.w_ed = (const float*)args.in[19];
    F.out = args.out; F.ws = args.ws;
    LAS unsigned char* ldsl = (LAS unsigned char*)lds;
    for (int u = F.tid; u < (LDS_BYTES - LDSCTL_OFF) / 4; u += NWAVES * 64) ((LAS unsigned*)(ldsl + LDSCTL_OFF))[u] = 0u;
    __syncthreads();
    volatile LAS unsigned* MISC = (volatile LAS unsigned*)(ldsl + MISC_OFF);
    XcdBarrier bar = xcd_barrier_post((unsigned*)(args.ws + WS_CTL) + CW_BAR + args.li * XCD_BAR_WORDS, MISC + 8);
    const int lo = args.ph_lo, hi = args.ph_hi;
#ifdef PROBE_REP
#define REP(k) ((((PROBE_REP) >> (k)) & 1) ? 2 : 1)
#else
#define REP(k) 1
#endif
#define IN(k) (lo <= (k) && (k) < hi)
#define SEAM(k) do { if (IN(k) && IN((k) + 1)) xcd_barrier(bar); } while (0)
    unsigned char* ws = args.ws;
    bf16* H = (bf16*)(ws + WS_H); bf16* PROJ = (bf16*)(ws + WS_PROJ); bf16* WIN = (bf16*)(ws + WS_WIN); bf16* WA = (bf16*)(ws + WS_WA); bf16* WB = (bf16*)(ws + WS_WB); bf16* WO = (bf16*)(ws + WS_WO);
    bf16* WGU = (bf16*)(ws + WS_WGU); bf16* WD = (bf16*)(ws + WS_WD); bf16* YAIN = (bf16*)(ws + WS_YAIN); bf16* ATT = (bf16*)(ws + WS_ATT); bf16* MERGED = (bf16*)(ws + WS_MERGED);
    float* Y = (float*)(ws + WS_Y); bf16* XE = (bf16*)(ws + WS_XE); bf16* ACT = (bf16*)(ws + WS_ACT); bf16* SLAB = (bf16*)(ws + WS_SLAB); const float* SELAFF = (const float*)(ws + WS_SELAFF);
    const int vcu = (F.G % 8 == 0) ? ((int)blockIdx.x % 8) * (F.G / 8) + (int)blockIdx.x / 8 : (int)blockIdx.x;

    {
    if (IN(0)) { p0_prep(F); __syncthreads(); } SEAM(0);
#if defined(PROBE_DUP) && PROBE_DUP == 0
    if (IN(0)) { p0_prep(F); __syncthreads(); } SEAM(0);
#endif
    }
    {
    if (IN(2)) {
        if (F.G == 256 && blockIdx.x >= 256 - CONV_BLOCKS) { float* scr = (float*)(F.lds + F.wave * 16384); TailSeq seq{I_MIX + P0_EXPERT_ITEMS + ((int)blockIdx.x - (256 - CONV_BLOCKS)) * NWAVES + F.wave, CONV_BLOCKS * NWAVES}; transpose_stream(F, seq, scr); }
        else {
            const int gg = F.G == 256 ? 256 - CONV_BLOCKS : F.G;
            pg8::Gemm g{H, WIN, T, INW, D / 2}; pg8::StaticOrder S; S.init(T, INW, gg, (int)blockIdx.x);
            pg8::EpiStore E{PROJ, INW, 0xffff, nullptr, 1.f / (W8S_IN * X8S_IN)};
            pg8::gemm_phase<pg8::EpiStore, pg8::StaticOrder, PG8_ALIGN, PG8_SP2, false, true>(ldsl + RING_OFF, g, S, E);
            if (F.G != 256 && blockIdx.x == 0) { float* scr = (float*)(F.lds + F.wave * 16384); TailSeq seq{I_MIX + P0_EXPERT_ITEMS + F.wave, NWAVES}; transpose_stream(F, seq, scr); }
        }
    } SEAM(2);
    }
    {
    if (IN(3)) { if (args.mask & 2) hgrn_a_phase(F, ldsl); } SEAM(3);
#if defined(PROBE_DUP) && PROBE_DUP == 3
    if (IN(3)) { if (args.mask & 2) hgrn_a_phase(F, ldsl); } SEAM(3);
#endif
    }
    {
    if (IN(4)) { if (args.mask & 2) hgrn_scan_phase(F); if (args.mask & 1) attn_phase(F, ldsl); } SEAM(4);
#if defined(PROBE_DUP) && PROBE_DUP == 4
    if (IN(4)) { if (args.mask & 2) hgrn_scan_phase(F); if (args.mask & 1) attn_phase(F, ldsl); } SEAM(4);
#endif
    }
    {
    if (IN(5)) { if (args.mask & 2) hgrn_c_phase(F, ldsl); } SEAM(5);
#if defined(PROBE_DUP) && PROBE_DUP == 5
    if (IN(5)) { if (args.mask & 2) hgrn_c_phase(F, ldsl); } SEAM(5);
#endif
    }
    {
    if (IN(6)) {
        static_assert(WS_ATT == WS_YAIN + 16 * MiB && WS_WB == WS_WA + 4 * MiB, "branch operands must be contiguous");
        pg8::Gemm g{YAIN, WA, 2 * T, 2 * D, 1024}; pg8::BranchOrder S; S.S.init(T, D, F.G, (int)blockIdx.x);
        pg8::EpiGate2 E{MERGED, D, PROJ + C_GA, PROJ + C_GB, INW};
        pg8::gemm_phase<pg8::EpiGate2, pg8::BranchOrder, PG8_ALIGN, PG8_SP2>(ldsl + RING_OFF, g, S, E);
    } SEAM(6);
    }
    {
    if (IN(7)) {
        pg8::Gemm g{MERGED, WO, T, D, D}; pg8::StaticOrder S; S.init(T, D, F.G, (int)blockIdx.x);
        pg8::EpiStore E{(bf16*)Y, D, 0xffff, nullptr};
        pg8::gemm_phase<pg8::EpiStore, pg8::StaticOrder, PG8_ALIGN, PG8_SP2>(ldsl + RING_OFF, g, S, E);
    } SEAM(7);
#if defined(PROBE_DUP) && PROBE_DUP == 7
    if (IN(7)) {
        pg8::Gemm g{MERGED, WO, T, D, D}; pg8::StaticOrder S; S.init(T, D, F.G, (int)blockIdx.x);
        pg8::EpiStore E{(bf16*)Y, D, 0xffff, nullptr};
        pg8::gemm_phase<pg8::EpiStore, pg8::StaticOrder, PG8_ALIGN, PG8_SP2>(ldsl + RING_OFF, g, S, E);
    } SEAM(7);
#endif
    }
    {
    if (IN(8)) { p6_post1(F); } SEAM(8);
#if defined(PROBE_DUP) && PROBE_DUP == 8
    if (IN(8)) { p6_post1(F); } SEAM(8);
#endif
    }
    {
    if (IN(9)) { p7_topk_gather(F); } SEAM(9);
#if defined(PROBE_DUP) && PROBE_DUP == 9
    if (IN(9)) { p7_topk_gather(F); } SEAM(9);
#endif
    }
    {
    if (IN(10)) {
        pg8::Gemm g{(const bf16*)(ws + WS_H2), WGU, 16 * 1024, 16 * 2048, D / 2, (const int*)(ws + WS_GIDX)}; pg8::GroupedOrder S{F.G, vcu};
        pg8::EpiSwiglu8 E{(unsigned char*)ACT, 1.f / W8S_GU};
        pg8::gemm_phase<pg8::EpiSwiglu8, pg8::GroupedOrder, PG8_ALIGN, PG8_SP2, true, true>(ldsl + RING_OFF, g, S, E);
    } SEAM(10);
    }
    {
    if (IN(11)) {
        pg8::Gemm g{ACT, WD, 16 * 1024, 16 * 2048, 1024 / 2}; pg8::GroupedOrder S{F.G, vcu};
        pg8::EpiStore E{SLAB, D, 7, SELAFF, 1.f / W8S_D};
        pg8::gemm_phase<pg8::EpiStore, pg8::GroupedOrder, PG8_ALIGN, PG8_SP2, false, true>(ldsl + RING_OFF, g, S, E);
    } SEAM(11);
    }
    {
    if (IN(12)) { p10_final(F); }
    }
#undef IN
#undef SEAM
}

extern "C" void kernel_launch(void* const* d_in, const int* in_sizes, int n_in, void* d_out, int out_size, void* d_ws, size_t ws_size, hipStream_t stream) {
    static int grid = 0;
    if (grid == 0) {
        if (n_in != 20 || ws_size < WS_END) { fprintf(stderr, "kernel_launch: unexpected n_in %d or ws_size %zu\n", n_in, ws_size); grid = -1; return; }
        int dev = 0, cus = 0;
        if (hipGetDevice(&dev) != hipSuccess || hipDeviceGetAttribute(&cus, hipDeviceAttributeMultiprocessorCount, dev) != hipSuccess) { grid = -1; return; }
        if (hipFuncSetAttribute((const void*)mega, hipFuncAttributeMaxDynamicSharedMemorySize, LDS_BYTES) != hipSuccess) { fprintf(stderr, "kernel_launch: hipFuncSetAttribute failed\n"); grid = -1; return; }
        grid = cus;
    }
    if (grid < 0) return;
    char* ws = (char*)d_ws;
    (void)hipMemsetAsync(ws + WS_CTL, 0, CTL_ZERO_BYTES, stream);
    Args a{};
    for (int i = 0; i < 20; ++i) a.in[i] = d_in[i];
    a.out = (float*)d_out; a.ws = (unsigned char*)d_ws;
#ifndef TESTMODE
    a.ph_lo = 0; a.ph_hi = 13; a.li = 0; a.mask = 3;
#ifdef PROBE_REPEAT
    a.rep = PROBE_REPEAT;
#else
    a.rep = -1;
#endif
    hipLaunchKernelGGL(mega, dim3(grid), dim3(NWAVES * 64), LDS_BYTES, stream, a);
#ifdef PROBE_LO
    a.ph_lo = PROBE_LO; a.ph_hi = PROBE_HI; a.li = 1; a.mask = PROBE_MASK;
    hipLaunchKernelGGL(mega, dim3(grid), dim3(NWAVES * 64), LDS_BYTES, stream, a);
#endif
#else
    const float* LB = (const float*)(ws + WS_LB); const float* ROPE = (const float*)(ws + WS_ROPE);
    bf16* PROJ = (bf16*)(ws + WS_PROJ); bf16* QR = (bf16*)(ws + WS_QR); bf16* KR = (bf16*)(ws + WS_KR); bf16* YAIN = (bf16*)(ws + WS_YAIN); bf16* ATT = (bf16*)(ws + WS_ATT);
    float* OF = (float*)(ws + WS_CS); float* OB = (float*)(ws + WS_CS + 32 * MiB);
    a.ph_lo = 0; a.ph_hi = 3; a.li = 0; a.mask = 3;
    hipLaunchKernelGGL(mega, dim3(grid), dim3(NWAVES * 64), LDS_BYTES, stream, a);
#if TESTMODE == 1
    k_hgrn_naive<<<32, 256, 0, stream>>>(PROJ, LB, OF, OB);
    k_hgrn_post<<<T * 8 / 4, 256, 0, stream>>>(OF, OB, PROJ, (const float*)d_in[11], YAIN);
    a.ph_lo = 3; a.ph_hi = 6; a.li = 1; a.mask = 1;
    hipLaunchKernelGGL(mega, dim3(grid), dim3(NWAVES * 64), LDS_BYTES, stream, a);
#else
    k_rope<<<T * 640 / 256, 256, 0, stream>>>(PROJ, ROPE, QR, KR);
    k_attn_naive<<<BATCH * 8 * SEQ / 4, 256, 0, stream>>>(QR, KR, PROJ, (const float*)d_in[12], ATT);
    a.ph_lo = 3; a.ph_hi = 6; a.li = 1; a.mask = 2;
    hipLaunchKernelGGL(mega, dim3(grid), dim3(NWAVES * 64), LDS_BYTES, stream, a);
#endif
    a.ph_lo = 6; a.ph_hi = 13; a.li = 2; a.mask = 3;
    hipLaunchKernelGGL(mega, dim3(grid), dim3(NWAVES * 64), LDS_BYTES, stream, a);
#endif
}
```

```cpp
#include <hip/hip_runtime.h>
#include <cstdint>
#include <cstdio>

constexpr int D = 2048, BATCH = 2, SEQ = 4096, T = BATCH * SEQ;
constexpr int INW = 10752;
constexpr int C_HQ = 0, C_FF = 1024, C_FB = 2048, C_HI = 3072, C_HG = 4096, C_AQ = 5120, C_AK = 6144, C_AV = 6400, C_GA = 6656, C_GB = 8704;
constexpr int NE = 16, EFF = 1024, CAP = 512;
constexpr float EPS = 1e-6f;

typedef unsigned short bf16;
__device__ __forceinline__ float bf2f(bf16 v) { return __uint_as_float(((unsigned)v) << 16); }
typedef float f32x2h_t __attribute__((ext_vector_type(2))); typedef __bf16 bf16x2h_t __attribute__((ext_vector_type(2)));
__device__ __forceinline__ unsigned cvtpk2(float lo, float hi) { const f32x2h_t v = {lo, hi}; const bf16x2h_t b = __builtin_convertvector(v, bf16x2h_t); return __builtin_bit_cast(unsigned, b); }
__device__ __forceinline__ bf16 f2bf(float f) { return (bf16)(cvtpk2(f, 0.f) & 0xffffu); }
__device__ __forceinline__ float sigmoidf_(float x) { return __builtin_amdgcn_rcpf(1.f + __expf(-x)); }
__device__ __forceinline__ float siluf_(float x) { return x * __builtin_amdgcn_rcpf(1.f + __expf(-x)); }

constexpr size_t MiB = 1u << 20;
constexpr size_t WS_CTL = 0, CTL_ZERO_BYTES = 64 * 1024;
constexpr size_t WS_MOD = 1 * MiB;
constexpr size_t WS_LB = WS_MOD + 128 * 1024;
constexpr size_t WS_AFF = 2 * MiB;
constexpr size_t WS_GIDX = 3 * MiB;
constexpr size_t WS_SELAFF = WS_GIDX + 128 * 1024;
constexpr size_t WS_TOKSLOT = 4 * MiB;
constexpr size_t WS_DEC = 5 * MiB;
constexpr size_t WS_ROPE = 8 * MiB;
constexpr size_t WS_WIN = 16 * MiB;
constexpr size_t WS_WA = 60 * MiB, WS_WB = 64 * MiB, WS_WO = 68 * MiB;
constexpr size_t WS_WGU = 76 * MiB;
constexpr size_t WS_WD = 204 * MiB;
constexpr size_t WS_H = 268 * MiB;
constexpr size_t WS_PROJ = 300 * MiB;
constexpr size_t WS_Y = 520 * MiB;
constexpr size_t WS_XE = 300 * MiB;
constexpr size_t WS_ACT = 364 * MiB;
constexpr size_t WS_SLAB = 396 * MiB;
constexpr size_t WS_QR = 468 * MiB, WS_KR = 484 * MiB;
constexpr size_t WS_YAIN = 488 * MiB, WS_ATT = 504 * MiB;
constexpr size_t WS_CS = 520 * MiB;
constexpr size_t WS_STATE = 584 * MiB;
constexpr size_t WS_H2 = 584 * MiB;
constexpr size_t WS_MERGED = 268 * MiB;
constexpr size_t WS_END = 648 * MiB;
constexpr int CW_BAR = 4096;

namespace pg8 {
#define PG8_LAS __attribute__((address_space(3)))
typedef unsigned short bf16_t;
typedef short bf16x8 __attribute__((ext_vector_type(8)));
typedef float f32x4 __attribute__((ext_vector_type(4)));
typedef unsigned u32x4 __attribute__((ext_vector_type(4)));
constexpr int BM = 256, BK = 64, HALF = 128, HTB = HALF * BK * 2  , STAGE_BYTES = 8 * HTB, NXCD = 8, WGM = 8;

__host__ __device__ __forceinline__ int lds_byte(int r, int c) { const int st = (r >> 4) * 2 + (c >> 5), rr = r & 15, cc = c & 31, ob = rr * 64 + cc * 2; return st * 1024 + (ob ^ (((ob >> 9) & 1) << 5)); }
__host__ __device__ __forceinline__ void stage_rc(int b, int& R, int& C) { const int st = b / 1024, sb = b % 1024, swz = sb ^ (((sb >> 9) & 1) << 5); R = (st >> 1) * 16 + swz / 64; C = (st & 1) * 32 + (swz % 64) / 2; }
__host__ __device__ __forceinline__ int perm32(int rho) { const int n = rho >> 4, i = rho & 15; return 8 * (i >> 2) + 4 * n + (i & 3); }

struct Unit { int pm, pn; };
struct Gemm { const bf16_t* A; const bf16_t* Bt; int M, N, K; const int* gidx = nullptr; };

struct StaticOrder {
    int nM, nN, nwg, G, c;
    __host__ __device__ void init(int M, int N, int G_, int c_) { nM = M / BM; nN = N / BM; nwg = nM * nN; G = G_; c = c_; }
    __host__ __device__ bool next(int i, Unit& u) const {
        const long L = (long)i * G + c; if (L >= nwg) return false;
        int wgid = (int)L; { const int q = nwg / NXCD, r = nwg % NXCD, xcd = wgid % NXCD, off = wgid / NXCD; wgid = (xcd < r ? xcd * (q + 1) : r * (q + 1) + (xcd - r) * q) + off; }
        const int nig = WGM * nN, gid = wgid / nig, fm = gid * WGM, gsz = (nM - fm) < WGM ? (nM - fm) : WGM;
        u.pm = fm + ((wgid % nig) % gsz); u.pn = (wgid % nig) / gsz; return true;
    }
    __device__ __forceinline__ void a_ready(const Unit&) const {}
    __device__ __forceinline__ void done(const Unit&) const {}
};

typedef float f32x2c_t __attribute__((ext_vector_type(2))); typedef __bf16 bf16x2c_t __attribute__((ext_vector_type(2)));
__device__ __forceinline__ unsigned cvt_pk_bf16(float lo, float hi) { const f32x2c_t v = {lo, hi}; const bf16x2c_t b = __builtin_convertvector(v, bf16x2c_t); return __builtin_bit_cast(unsigned, b); }
typedef float f32x2 __attribute__((ext_vector_type(2)));

typedef unsigned u32x2 __attribute__((ext_vector_type(2)));
struct EpiStore {
    static constexpr bool PERM = true, AFTER_DRAIN = false;
    bf16_t* O; int ldc; int cmask; const float* rowscale; float osc = 1.f;
    __device__ __forceinline__ void operator()(const f32x4 (&acc)[2][2][4][2], const Unit& u, int wr, int wc, int fr, int fq) const {
        const int row0 = u.pm * BM + wr * 64 + fr, col0 = (u.pn & cmask) * BM + wc * 32 + 8 * fq;
        float scv[8];
#pragma unroll
        for (int q = 0; q < 8; ++q) scv[q] = (rowscale ? rowscale[row0 + (q >> 2) * HALF + (q & 3) * 16] : 1.f) * osc;
#pragma unroll
        for (int ai = 0; ai < 2; ++ai)
#pragma unroll
            for (int m = 0; m < 4; ++m) { const int row = row0 + ai * HALF + m * 16; const float sc = scv[ai * 4 + m]; bf16_t* rowp = O + (size_t)row * ldc + col0;
#pragma unroll
                for (int bj = 0; bj < 2; ++bj) { const f32x4 v0 = acc[ai][bj][m][0] * sc, v1 = acc[ai][bj][m][1] * sc;
                    u32x4 w; w.x = cvt_pk_bf16(v0[0], v0[1]); w.y = cvt_pk_bf16(v0[2], v0[3]); w.z = cvt_pk_bf16(v1[0], v1[1]); w.w = cvt_pk_bf16(v1[2], v1[3]);
                    *(u32x4*)(rowp + bj * HALF) = w; } }
    }
};
__device__ __forceinline__ float sigm(float x) { return __builtin_amdgcn_rcpf(1.f + __expf(-x)); }
struct EpiGate2 {
    static constexpr bool PERM = true, AFTER_DRAIN = false;
    bf16_t* O; int ldc; const bf16_t* Ga; const bf16_t* Gb; int ldg;
    __device__ __forceinline__ void operator()(const f32x4 (&acc)[2][2][4][2], const Unit& u, int wr, int wc, int fr, int fq) const {
        const bool second = u.pm >= 32; const bf16_t* G = second ? Gb : Ga;
        const int row0 = (u.pm & 31) * BM + wr * 64 + fr, col0 = (u.pn & 7) * BM + wc * 32 + 8 * fq;
        u32x4 gcur[2], tcur[2], gnxt[2], tnxt[2];
#define EG2_LOAD(gd, td, q) do { const int row_ = row0 + ((q) >> 2) * HALF + ((q) & 3) * 16; _Pragma("unroll") for (int bj = 0; bj < 2; ++bj) { \
            gd[bj] = *(const u32x4*)(G + (size_t)row_ * ldg + col0 + bj * HALF); td[bj] = second ? *(const u32x4*)(O + (size_t)row_ * ldc + col0 + bj * HALF) : (u32x4){0u, 0u, 0u, 0u}; } } while (0)
        EG2_LOAD(gcur, tcur, 0);
#pragma unroll
        for (int q = 0; q < 8; ++q) { const int ai = q >> 2, m = q & 3, row = row0 + ai * HALF + m * 16;
            if (q < 7) EG2_LOAD(gnxt, tnxt, q + 1);
#pragma unroll
            for (int bj = 0; bj < 2; ++bj) { const int col = col0 + bj * HALF; const u32x4 g = gcur[bj], tq = tcur[bj];
                const float gg[8] = {__uint_as_float(g.x << 16), __uint_as_float(g.x & 0xffff0000u), __uint_as_float(g.y << 16), __uint_as_float(g.y & 0xffff0000u),
                                     __uint_as_float(g.z << 16), __uint_as_float(g.z & 0xffff0000u), __uint_as_float(g.w << 16), __uint_as_float(g.w & 0xffff0000u)};
                const float t[8] = {__uint_as_float(tq.x << 16), __uint_as_float(tq.x & 0xffff0000u), __uint_as_float(tq.y << 16), __uint_as_float(tq.y & 0xffff0000u),
                                    __uint_as_float(tq.z << 16), __uint_as_float(tq.z & 0xffff0000u), __uint_as_float(tq.w << 16), __uint_as_float(tq.w & 0xffff0000u)};
                const f32x4 a0 = acc[ai][bj][m][0], a1 = acc[ai][bj][m][1];
                float o[8];
#pragma unroll
                for (int i = 0; i < 4; ++i) { o[i] = t[i] + sigm(gg[i]) * a0[i]; o[4 + i] = t[4 + i] + sigm(gg[4 + i]) * a1[i]; }
                u32x4 w; w.x = cvt_pk_bf16(o[0], o[1]); w.y = cvt_pk_bf16(o[2], o[3]); w.z = cvt_pk_bf16(o[4], o[5]); w.w = cvt_pk_bf16(o[6], o[7]);
                *(u32x4*)(O + (size_t)row * ldc + col) = w; }
#pragma unroll
            for (int bj = 0; bj < 2; ++bj) { gcur[bj] = gnxt[bj]; tcur[bj] = tnxt[bj]; } }
#undef EG2_LOAD
    }
};
struct BranchOrder {
    StaticOrder S;
    __device__ __forceinline__ bool next(int i, Unit& u) const { Unit t; if (!S.next(i >> 1, t)) return false; u.pm = t.pm + 32 * (i & 1); u.pn = t.pn + 8 * (i & 1); return true; }
    __device__ __forceinline__ void a_ready(const Unit&) const {}
    __device__ __forceinline__ void done(const Unit&) const {}
};
struct EpiF32 {
    static constexpr bool PERM = true, AFTER_DRAIN = false;
    float* O; int ldc;
    __device__ __forceinline__ void operator()(const f32x4 (&acc)[2][2][4][2], const Unit& u, int wr, int wc, int fr, int fq) const {
        const int row0 = u.pm * BM + wr * 64 + fr, col0 = u.pn * BM + wc * 32 + 8 * fq;
#pragma unroll
        for (int ai = 0; ai < 2; ++ai)
#pragma unroll
            for (int m = 0; m < 4; ++m) { float* rowp = O + (size_t)(row0 + ai * HALF + m * 16) * ldc + col0;
#pragma unroll
                for (int bj = 0; bj < 2; ++bj) { *(f32x4*)(rowp + bj * HALF) = acc[ai][bj][m][0]; *(f32x4*)(rowp + bj * HALF + 4) = acc[ai][bj][m][1]; } }
    }
};
__device__ __forceinline__ unsigned pk4_fp8(float a, float b, float c, float d) { int w = __builtin_amdgcn_cvt_pk_fp8_f32(a, b, 0, false); w = __builtin_amdgcn_cvt_pk_fp8_f32(c, d, w, true); return (unsigned)w; }
struct EpiSwiglu8 {
    static constexpr bool PERM = true, AFTER_DRAIN = false;
    unsigned char* O; float isc;
    __device__ __forceinline__ void operator()(const f32x4 (&acc)[2][2][4][2], const Unit& u, int wr, int wc, int fr, int fq) const {
        const int row0 = u.pm * BM + wr * 64 + fr, col0 = (u.pn & 7) * HALF + wc * 32 + 8 * fq;
#pragma unroll
        for (int ai = 0; ai < 2; ++ai)
#pragma unroll
            for (int m = 0; m < 4; ++m) { unsigned char* rowp = O + (size_t)(row0 + ai * HALF + m * 16) * 1024 + col0;
                float o[8];
#pragma unroll
                for (int n = 0; n < 2; ++n)
#pragma unroll
                    for (int i = 0; i < 4; ++i) { const float g = acc[ai][0][m][n][i] * isc, up = acc[ai][1][m][n][i] * isc; o[4 * n + i] = g * sigm(g) * up; }
                u32x2 w; w.x = pk4_fp8(o[0], o[1], o[2], o[3]); w.y = pk4_fp8(o[4], o[5], o[6], o[7]);
                *(u32x2*)rowp = w; }
    }
};
struct EpiSwiglu {
    static constexpr bool PERM = true, AFTER_DRAIN = false;
    bf16_t* O;
    __device__ __forceinline__ void operator()(const f32x4 (&acc)[2][2][4][2], const Unit& u, int wr, int wc, int fr, int fq) const {
        const int row0 = u.pm * BM + wr * 64 + fr, col0 = (u.pn & 7) * HALF + wc * 32 + 8 * fq;
#pragma unroll
        for (int ai = 0; ai < 2; ++ai)
#pragma unroll
            for (int m = 0; m < 4; ++m) { bf16_t* rowp = O + (size_t)(row0 + ai * HALF + m * 16) * 1024 + col0;
                float o[8];
#pragma unroll
                for (int n = 0; n < 2; ++n)
#pragma unroll
                    for (int i = 0; i < 4; ++i) { const float g = acc[ai][0][m][n][i], up = acc[ai][1][m][n][i]; o[4 * n + i] = g * sigm(g) * up; }
                u32x4 w; w.x = cvt_pk_bf16(o[0], o[1]); w.y = cvt_pk_bf16(o[2], o[3]); w.z = cvt_pk_bf16(o[4], o[5]); w.w = cvt_pk_bf16(o[6], o[7]);
                *(u32x4*)rowp = w; }
    }
};
struct GroupedOrder {
    int G, c;
    __device__ __forceinline__ bool next(int i, Unit& u) const { const int L = i * G + c; if (L >= 512) return false; const int e = L >> 5, r = L & 31; u.pm = e * 4 + (r & 3); u.pn = e * 8 + (r >> 2); return true; }
    __device__ __forceinline__ void a_ready(const Unit&) const {}
    __device__ __forceinline__ void done(const Unit&) const {}
};

typedef int v8i32 __attribute__((ext_vector_type(8)));
typedef int v4i32 __attribute__((ext_vector_type(4)));
__device__ __forceinline__ void mfma_f8(f32x4& acc, const v8i32& a, const v8i32& b, int sc) {
    asm volatile("v_mfma_scale_f32_16x16x128_f8f6f4 %0, %1, %2, %0, %3, %3 op_sel_hi:[0,0,0]" : "+v"(acc) : "v"(a), "v"(b), "v"(sc));
}
template <class Epi, class Sched, bool ALIGN_EPI = false, bool SP2 = false, bool GATHER = false, bool FP8 = false>
__device__ __forceinline__ void gemm_phase(PG8_LAS unsigned char* lds, const Gemm g, const Sched& S, const Epi& E) {
    const int tid = threadIdx.x, wid = __builtin_amdgcn_readfirstlane(tid >> 6), lane = tid & 63, wr = wid >> 2, wc = wid & 3, fr = lane & 15, fq = lane >> 4;
    const int K = g.K, nt = K / BK;
    unsigned voffA[2], voffB[2]; int Rr[2], Cc[2];
#pragma unroll
    for (int i = 0; i < 2; ++i) { int R, C; stage_rc(tid * 16 + i * 8192, R, C); const int Rb = Epi::PERM ? ((R & ~31) + perm32(R & 31)) : R; Rr[i] = R; Cc[i] = C;
        voffA[i] = (unsigned)(R * K + C) * 2u; voffB[i] = (unsigned)(Rb * K + C) * 2u; }
    unsigned cv0[2], cv1[2], nv0[2], nv1[2], sv0[2], sv1[2];
#define PG8_GOFF(o0, o1, pm_) do { _Pragma("unroll") for (int _i = 0; _i < 2; ++_i) { \
        o0[_i] = (unsigned)(g.gidx[(pm_) * BM + Rr[_i]] * K + Cc[_i]) * 2u; o1[_i] = (unsigned)(g.gidx[(pm_) * BM + HALF + Rr[_i]] * K + Cc[_i]) * 2u; } } while (0)
    const size_t kstep = (size_t)(BK * 2);
    const size_t hstep = (size_t)HALF * K * 2;
    const size_t tstep = 2 * hstep;
    const unsigned ldsw = (unsigned)wid * 1024u;
    const int aoff = FP8 ? lds_byte(wr * 64 + fr, fq * 16) : lds_byte(wr * 64 + fr, fq * 8), boff = FP8 ? lds_byte(wc * 32 + fr, fq * 16) : lds_byte(wc * 32 + fr, fq * 8);
#define PG8_SA(b, h) (((b) * 2 + (h)) * HTB)
#define PG8_SB(b, h) ((4 + (b) * 2 + (h)) * HTB)
#define PG8_STAGE(bufoff, gbase, voff) do { _Pragma("unroll") for (int _i = 0; _i < 2; ++_i) \
        __builtin_amdgcn_global_load_lds((const unsigned*)((const char*)(gbase) + (voff)[_i]), (PG8_LAS unsigned*)(lds + (bufoff) + ldsw + _i * 8192), 16, 0, 0); } while (0)
#define PG8_LDA(dst, b, h) do { if constexpr (FP8) { _Pragma("unroll") for (int m = 0; m < 4; ++m) { const PG8_LAS unsigned char* p_ = lds + PG8_SA(b, h) + aoff + m * 2048; \
            const v4i32 lo_ = *(const PG8_LAS v4i32*)p_, hi_ = *(const PG8_LAS v4i32*)(p_ + 16); dst##8[m] = __builtin_shufflevector(lo_, hi_, 0, 1, 2, 3, 4, 5, 6, 7); } } \
        else { _Pragma("unroll") for (int m = 0; m < 4; ++m) _Pragma("unroll") for (int k = 0; k < 2; ++k) dst[m][k] = *(const PG8_LAS bf16x8*)(lds + PG8_SA(b, h) + aoff + m * 2048 + k * 1024); } } while (0)
#define PG8_LDB(dst, b, h) do { if constexpr (FP8) { _Pragma("unroll") for (int n = 0; n < 2; ++n) { const PG8_LAS unsigned char* p_ = lds + PG8_SB(b, h) + boff + n * 2048; \
            const v4i32 lo_ = *(const PG8_LAS v4i32*)p_, hi_ = *(const PG8_LAS v4i32*)(p_ + 16); dst##8[n] = __builtin_shufflevector(lo_, hi_, 0, 1, 2, 3, 4, 5, 6, 7); } } \
        else { _Pragma("unroll") for (int n = 0; n < 2; ++n) _Pragma("unroll") for (int k = 0; k < 2; ++k) dst[n][k] = *(const PG8_LAS bf16x8*)(lds + PG8_SB(b, h) + boff + n * 2048 + k * 1024); } } while (0)
#define PG8_MMA(ai, bj, At, Bt) do { __builtin_amdgcn_s_setprio(1); \
        if constexpr (FP8) { _Pragma("unroll") for (int m = 0; m < 4; ++m) _Pragma("unroll") for (int n = 0; n < 2; ++n) \
            mfma_f8(acc[ai][bj][m][n], Bt##8[n], At##8[m], f8one); } \
        else { _Pragma("unroll") for (int m = 0; m < 4; ++m) _Pragma("unroll") for (int n = 0; n < 2; ++n) _Pragma("unroll") for (int k = 0; k < 2; ++k) \
            acc[ai][bj][m][n] = __builtin_amdgcn_mfma_f32_16x16x32_bf16(Bt[n][k], At[m][k], acc[ai][bj][m][n], 0, 0, 0); } \
        __builtin_amdgcn_s_setprio(0); } while (0)
#define PG8_WAIT_V(n) asm volatile("s_waitcnt vmcnt(" #n ")" ::: "memory")
#define PG8_WAIT_L(n) asm volatile("s_waitcnt lgkmcnt(" #n ")" ::: "memory")
#define PG8_BAR __builtin_amdgcn_s_barrier()
#define PG8_SCHED __builtin_amdgcn_sched_barrier(0)
    Unit cur, nxt; int ui = 0;
    if (!S.next(0, cur)) return;
    if constexpr (GATHER) { PG8_GOFF(cv0, cv1, cur.pm); }
    else {
#pragma unroll
        for (int i = 0; i < 2; ++i) { cv0[i] = voffA[i]; cv1[i] = voffA[i] + (unsigned)(HALF * K * 2); } }
    f32x4 acc[2][2][4][2];
#pragma unroll
    for (int a = 0; a < 2; ++a)
#pragma unroll
        for (int b = 0; b < 2; ++b)
#pragma unroll
            for (int m = 0; m < 4; ++m)
#pragma unroll
                for (int n = 0; n < 2; ++n) acc[a][b][m][n] = (f32x4){0.f, 0.f, 0.f, 0.f};
    bf16x8 At[4][2], B0[2][2], B1[2][2]; v8i32 At8[4], B08[2], B18[2]; int f8one = 0x7f7f7f7f; asm volatile("" : "+v"(f8one));
    const char* cA = (const char*)g.A + (GATHER ? (size_t)0 : (size_t)cur.pm * tstep); const char* cB = (const char*)g.Bt + (size_t)cur.pn * tstep;
    S.a_ready(cur);
    if constexpr (SP2) {
        PG8_STAGE(PG8_SB(0, 0), cB, voffB); PG8_STAGE(PG8_SB(0, 1), cB + hstep, voffB); PG8_STAGE(PG8_SA(0, 0), cA, cv0); PG8_STAGE(PG8_SA(0, 1), cA, cv1);
        if (wr == 1) PG8_BAR;
        PG8_WAIT_V(2); PG8_BAR;
        PG8_STAGE(PG8_SB(1, 0), cB + kstep, voffB); PG8_STAGE(PG8_SA(1, 0), cA + kstep, cv0); PG8_STAGE(PG8_SB(1, 1), cB + hstep + kstep, voffB);
        PG8_WAIT_V(6); PG8_BAR;
    } else {
        PG8_STAGE(PG8_SB(0, 0), cB, voffB); PG8_STAGE(PG8_SA(0, 0), cA, cv0); PG8_STAGE(PG8_SB(0, 1), cB + hstep, voffB); PG8_STAGE(PG8_SA(0, 1), cA, cv1);
        if (wr == 1) PG8_BAR;
        PG8_WAIT_V(4); PG8_BAR;
        PG8_STAGE(PG8_SB(1, 0), cB + kstep, voffB); PG8_STAGE(PG8_SA(1, 0), cA + kstep, cv0); PG8_STAGE(PG8_SB(1, 1), cB + hstep + kstep, voffB);
        PG8_WAIT_V(6); PG8_BAR;
    }
    for (;;) {
        const bool has_next = S.next(ui + 1, nxt);
        if (GATHER && has_next) { PG8_GOFF(nv0, nv1, nxt.pm); }
        else {
#pragma unroll
            for (int i = 0; i < 2; ++i) { nv0[i] = cv0[i]; nv1[i] = cv1[i]; } }
        const char* nA = (has_next && !GATHER) ? (const char*)g.A + (size_t)nxt.pm * tstep : cA; const char* nB = has_next ? (const char*)g.Bt + (size_t)nxt.pn * tstep : cB;
#pragma unroll 1
        for (int t = 0; t < nt; t += 2) {
            const bool last = (t == nt - 2);
            const char* a1 = cA + (size_t)(t + 1) * kstep;
            const char* a2 = last ? nA : cA + (size_t)(t + 2) * kstep; const char* b2 = last ? nB : cB + (size_t)(t + 2) * kstep;
            const char* a3 = a2 + kstep; const char* b3 = b2 + kstep;
#pragma unroll
            for (int i = 0; i < 2; ++i) { sv0[i] = last ? nv0[i] : cv0[i]; sv1[i] = last ? nv1[i] : cv1[i]; }
            if (last && has_next) S.a_ready(nxt);
            if constexpr (SP2) {
            PG8_LDB(B0, 0, 0); PG8_LDB(B1, 0, 1); PG8_SCHED; PG8_LDA(At, 0, 0); PG8_STAGE(PG8_SA(1, 1), a1, cv1);
            PG8_WAIT_V(8); PG8_WAIT_L(0); PG8_BAR; PG8_MMA(0, 0, At, B0); PG8_MMA(0, 1, At, B1); PG8_BAR; PG8_SCHED;
            PG8_LDA(At, 0, 1); PG8_STAGE(PG8_SB(0, 0), b2, voffB); PG8_STAGE(PG8_SB(0, 1), b2 + hstep, voffB); PG8_STAGE(PG8_SA(0, 0), a2, sv0);
            PG8_WAIT_V(8); PG8_WAIT_L(0); PG8_BAR; PG8_MMA(1, 0, At, B0); PG8_MMA(1, 1, At, B1); PG8_BAR; PG8_SCHED;
            PG8_LDB(B0, 1, 0); PG8_LDB(B1, 1, 1); PG8_SCHED; PG8_LDA(At, 1, 0); PG8_STAGE(PG8_SA(0, 1), a2, sv1);
            PG8_WAIT_V(8); PG8_WAIT_L(0); PG8_BAR; PG8_MMA(0, 0, At, B0); PG8_MMA(0, 1, At, B1); PG8_BAR; PG8_SCHED;
            PG8_LDA(At, 1, 1); PG8_STAGE(PG8_SB(1, 0), b3, voffB); PG8_STAGE(PG8_SB(1, 1), b3 + hstep, voffB); PG8_STAGE(PG8_SA(1, 0), a3, sv0);
            PG8_WAIT_V(8); PG8_WAIT_L(0); PG8_BAR; PG8_MMA(1, 0, At, B0); PG8_MMA(1, 1, At, B1); PG8_BAR; PG8_SCHED;
            } else {
            PG8_LDB(B0, 0, 0); PG8_SCHED; PG8_LDA(At, 0, 0); PG8_STAGE(PG8_SA(1, 1), a1, cv1);
            PG8_WAIT_L(8); PG8_BAR; PG8_WAIT_L(0); PG8_MMA(0, 0, At, B0); PG8_BAR; PG8_SCHED;
            PG8_LDB(B1, 0, 1); PG8_STAGE(PG8_SB(0, 0), b2, voffB);
            PG8_BAR; PG8_WAIT_L(0); PG8_MMA(0, 1, At, B1); PG8_BAR;
            PG8_LDA(At, 0, 1); PG8_STAGE(PG8_SA(0, 0), a2, sv0);
            PG8_BAR; PG8_WAIT_L(0); PG8_MMA(1, 0, At, B0); PG8_BAR; PG8_SCHED;
            PG8_STAGE(PG8_SB(0, 1), b2 + hstep, voffB);
            PG8_WAIT_V(6); PG8_BAR; PG8_MMA(1, 1, At, B1); PG8_BAR;
            PG8_LDB(B0, 1, 0); PG8_SCHED; PG8_LDA(At, 1, 0); PG8_STAGE(PG8_SA(0, 1), a2, sv1);
            PG8_WAIT_L(8); PG8_BAR; PG8_WAIT_L(0); PG8_MMA(0, 0, At, B0); PG8_BAR; PG8_SCHED;
            PG8_LDB(B1, 1, 1); PG8_STAGE(PG8_SB(1, 0), b3, voffB);
            PG8_BAR; PG8_WAIT_L(0); PG8_MMA(0, 1, At, B1); PG8_BAR;
            PG8_LDA(At, 1, 1); PG8_STAGE(PG8_SA(1, 0), a3, sv0);
            PG8_BAR; PG8_WAIT_L(0); PG8_MMA(1, 0, At, B0); PG8_BAR; PG8_SCHED;
            PG8_STAGE(PG8_SB(1, 1), b3 + hstep, voffB);
            PG8_WAIT_V(6); PG8_BAR; PG8_MMA(1, 1, At, B1); PG8_BAR;
            }
        }
        if constexpr (FP8) { asm volatile("s_nop 15\n\ts_nop 15\n\ts_nop 7" ::: "memory"); }
        if constexpr (ALIGN_EPI) { if (wr == 0) PG8_BAR; }
        if constexpr (!Epi::AFTER_DRAIN) { E(acc, cur, wr, wc, fr, fq); S.done(cur); }
        if (!has_next) break;
#pragma unroll
        for (int a = 0; a < 2; ++a)
#pragma unroll
            for (int b = 0; b < 2; ++b)
#pragma unroll
                for (int m = 0; m < 4; ++m)
#pragma unroll
                    for (int n = 0; n < 2; ++n) acc[a][b][m][n] = (f32x4){0.f, 0.f, 0.f, 0.f};
        cur = nxt; cA = nA; cB = nB; ++ui;
#pragma unroll
        for (int i = 0; i < 2; ++i) { cv0[i] = nv0[i]; cv1[i] = nv1[i]; }
        if constexpr (ALIGN_EPI) { if (wr == 1) PG8_BAR; }
    }
    PG8_WAIT_V(0);
    if constexpr (!ALIGN_EPI) { if (wr == 0) PG8_BAR; }
    PG8_BAR;
    if constexpr (Epi::AFTER_DRAIN) { E.fused(acc, cur, wr, wc, fr, fq, lds, wid, lane); S.done(cur); }
#undef PG8_GOFF
#undef PG8_SA
#undef PG8_SB
#undef PG8_STAGE
#undef PG8_LDA
#undef PG8_LDB
#undef PG8_MMA
#undef PG8_WAIT_V
#undef PG8_WAIT_L
#undef PG8_BAR
#undef PG8_SCHED
}
}

#ifndef PG8_SP2
#define PG8_SP2 true
#endif
#ifndef PG8_ALIGN
#define PG8_ALIGN true
#endif
constexpr int RING_OFF = 0, RING_BYTES = 131072;
constexpr int LDSCTL_OFF = RING_BYTES, MISC_OFF = LDSCTL_OFF + 320;
constexpr int LDS_BYTES = 163840;
constexpr int PARAM_OFF = 135168;
constexpr int NWAVES = 8;
#define GAS __attribute__((address_space(1)))
#define LAS __attribute__((address_space(3)))
typedef unsigned v4u __attribute__((ext_vector_type(4)));
typedef unsigned u2v_t __attribute__((ext_vector_type(2)));
typedef float f32x4 __attribute__((ext_vector_type(4)));
typedef GAS unsigned gu32;
#define RLX_AGENT __ATOMIC_RELAXED, __HIP_MEMORY_SCOPE_AGENT
#define LDS_WAIT() asm volatile("s_waitcnt lgkmcnt(0)" ::: "memory")
__device__ __forceinline__ unsigned pk2(float lo, float hi) { return cvtpk2(lo, hi); }

#define XB_TMO      128
#define XB_XCNT(j)  (256  + 64 * (j))
#define XB_XSUB(j)  (1280 + 64 * (j))
#define XB_XGEN(j)  (2304 + 64 * (j))
#define XB_TOP      3328
#define XB_TOPGEN   3392
#define XCD_BAR_WORDS 3456
#define XB_SPIN_CAP (1u << 18)

__device__ __forceinline__ unsigned xb_ld(unsigned* p)              { return __hip_atomic_load(p, __ATOMIC_RELAXED, __HIP_MEMORY_SCOPE_AGENT); }
__device__ __forceinline__ unsigned xb_add(unsigned* p, unsigned v) { return __hip_atomic_fetch_add(p, v, __ATOMIC_RELAXED, __HIP_MEMORY_SCOPE_AGENT); }
__device__ __forceinline__ unsigned xb_xcc_id() { return (unsigned)__builtin_amdgcn_s_getreg((3 << 11) | 20) & 0xFu; }
#define XB_SPIN(cond, bar) do { unsigned _sp = 0; while (cond) { __builtin_amdgcn_s_sleep(1); \
    if ((++_sp & 255u) == 0u) { if (xb_ld(&(bar)[XB_TMO])) break; if (_sp > XB_SPIN_CAP) { atomicAdd(&(bar)[XB_TMO], 1u); break; } } } } while (0)

struct XcdBarrier {
    unsigned* bar; unsigned x;
    volatile LAS unsigned* st;
};

__device__ __forceinline__ XcdBarrier xcd_barrier_post(unsigned* bar, volatile LAS unsigned* st) {
    XcdBarrier b; b.bar = bar; b.x = xb_xcc_id(); b.st = st;
    if (threadIdx.x == 0) (void)xb_add(&bar[XB_XCNT(b.x)], 1u);
    return b;
}
__device__ __forceinline__ void xcd_barrier_complete(unsigned* bar, unsigned x, unsigned& nloc, unsigned& nx) {
    const unsigned G = gridDim.x * gridDim.y * gridDim.z;
    unsigned sum, cnt, mine, sp = 0u;
    for (;;) {
        sum = 0u; cnt = 0u; mine = 0u;
#pragma unroll
        for (unsigned j = 0; j < 16; ++j) { const unsigned c = xb_ld(&bar[XB_XCNT(j)]); sum += c; cnt += (c > 0u) ? 1u : 0u; mine = (j == x) ? c : mine; }
        if (sum == G) break;
        __builtin_amdgcn_s_sleep(1);
        if ((++sp & 255u) == 0u) { if (xb_ld(&bar[XB_TMO])) break; if (sp > XB_SPIN_CAP) { atomicAdd(&bar[XB_TMO], 1u); break; } }
    }
    nloc = mine > 0u ? mine : 1u; nx = cnt > 0u ? cnt : 1u;
}

__device__ __forceinline__ void xcd_barrier(const XcdBarrier& b) {
    asm volatile("s_waitcnt vmcnt(0)" ::: "memory");
    __syncthreads();
    if (threadIdx.x == 0) {
        unsigned* bar = b.bar;
        __builtin_amdgcn_s_waitcnt(0);
        unsigned nloc = b.st[0], nx = b.st[1];
        if (nloc == 0u) { xcd_barrier_complete(bar, b.x, nloc, nx); b.st[0] = nloc; b.st[1] = nx; }
        const unsigned old = xb_add(&bar[XB_XSUB(b.x)], 1u);
        const unsigned gen = old / nloc;
        if (old + 1u == (gen + 1u) * nloc) {
            __builtin_amdgcn_fence(__ATOMIC_RELEASE, "agent");
            asm volatile("s_waitcnt vmcnt(0)" ::: "memory");
            const unsigned og = xb_add(&bar[XB_TOP], 1u);
            const unsigned tg = og / nx;
            if (og + 1u == (tg + 1u) * nx) xb_add(&bar[XB_TOPGEN], 1u);
            else XB_SPIN(xb_ld(&bar[XB_TOPGEN]) == tg, bar);
            __builtin_amdgcn_fence(__ATOMIC_ACQUIRE, "agent");
            xb_add(&bar[XB_XGEN(b.x)], 1u);
            asm volatile("s_waitcnt vmcnt(0)" ::: "memory");
        } else {
            XB_SPIN(xb_ld(&bar[XB_XGEN(b.x)]) == gen, bar);
            __builtin_amdgcn_fence(__ATOMIC_ACQUIRE, "agent");
            asm volatile("s_waitcnt vmcnt(0)" ::: "memory");
        }
    }
    __syncthreads();
}

struct Args { const void* in[20]; float* out; unsigned char* ws; int ph_lo, ph_hi, li, mask, rep, pad; };
struct Ctx {
    unsigned char* lds; int tid, lane, wave, G, gw, NGW;
    const float *x, *c, *w_ada, *b_ada, *g_pre_mix, *g_post_mix, *g_pre_ffn, *g_post_ffn, *w_in, *lbl, *onorm, *sink, *w_a, *w_b, *w_o, *w_router, *w_eg, *w_eu, *w_ed;
    const int* pos; float* out; unsigned char* ws;
};
__device__ __forceinline__ float wave_sum(float v) {
#pragma unroll
    for (int o = 1; o < 64; o <<= 1) v += __shfl_xor(v, o);
    return v;
}
struct TDesc { const float* src; bf16* dst; int N, K; float f8s; };
__device__ __forceinline__ void t_load(const TDesc& d, int h, f32x4 (&r)[16], int lane) {
    const float* p = d.src + (size_t)(64 * h + 16 * (lane >> 4)) * d.N + 4 * (lane & 15);
#pragma unroll
    for (int i = 0; i < 16; ++i) r[i] = __builtin_nontemporal_load((const f32x4*)(p + (size_t)i * d.N));
}
template <int HALF_> __device__ __forceinline__ void t_process(const TDesc& d, const f32x4 (&r)[16], float* scr, int lane) {
    unsigned char* s8 = (unsigned char*)scr; const int kq = lane >> 4, nl = lane & 15;
    if (d.f8s != 0.f) {
        const float f = d.f8s; unsigned char* dst8 = (unsigned char*)d.dst;
#pragma unroll
        for (int c = 0; c < 4; ++c) { v4u o;
            o.x = pg8::pk4_fp8(r[0][c] * f, r[1][c] * f, r[2][c] * f, r[3][c] * f); o.y = pg8::pk4_fp8(r[4][c] * f, r[5][c] * f, r[6][c] * f, r[7][c] * f);
            o.z = pg8::pk4_fp8(r[8][c] * f, r[9][c] * f, r[10][c] * f, r[11][c] * f); o.w = pg8::pk4_fp8(r[12][c] * f, r[13][c] * f, r[14][c] * f, r[15][c] * f);
            *(v4u*)(s8 + (4 * nl + c) * 144 + 64 * HALF_ + 16 * kq) = o; }
        if (HALF_ == 1) {
            LDS_WAIT(); asm volatile("" ::: "memory");
#pragma unroll
            for (int j = 0; j < 8; ++j) { const int row = 8 * j + (lane >> 3), pc = lane & 7; const v4u o = *(const v4u*)(s8 + row * 144 + 16 * pc);
                __builtin_nontemporal_store(o, (v4u*)(dst8 + (size_t)row * d.K + 16 * pc)); }
        }
    } else {
#pragma unroll
        for (int c = 0; c < 4; ++c) { v4u o0, o1;
            o0.x = pk2(r[0][c], r[1][c]); o0.y = pk2(r[2][c], r[3][c]); o0.z = pk2(r[4][c], r[5][c]); o0.w = pk2(r[6][c], r[7][c]);
            o1.x = pk2(r[8][c], r[9][c]); o1.y = pk2(r[10][c], r[11][c]); o1.z = pk2(r[12][c], r[13][c]); o1.w = pk2(r[14][c], r[15][c]);
            *(v4u*)(s8 + (4 * nl + c) * 144 + 32 * kq) = o0; *(v4u*)(s8 + (4 * nl + c) * 144 + 32 * kq + 16) = o1; }
        LDS_WAIT(); asm volatile("" ::: "memory");
#pragma unroll
        for (int j = 0; j < 8; ++j) { const int row = 8 * j + (lane >> 3), pc = lane & 7; const v4u o = *(const v4u*)(s8 + row * 144 + 16 * pc);
            *(v4u*)(d.dst + (size_t)row * d.K + 64 * HALF_ + 8 * pc) = o; }
    }
    LDS_WAIT(); asm volatile("" ::: "memory");
}
__device__ __forceinline__ void rope_entry(const int* pos, float* rope, int gid) {
    const int t = gid >> 6, i = gid & 63;
    double inv = 1.0, rr = 0.8659643233600653523531691834202299819398;
    for (int bit = 0; bit < 6; ++bit) { if ((i >> bit) & 1) inv *= rr; rr *= rr; }
    const double ang = (double)pos[t] * inv;
    const double kq = rint(ang * 0.3183098861837906715377675267450287);
    const double r = ang - kq * 3.141592653589793238462643383279502884;
    const double u = -(r * r);
    double s = 1.0 / 121645100408832000.0;
    s = s * u + 1.0 / 355687428096000.0; s = s * u + 1.0 / 1307674368000.0; s = s * u + 1.0 / 6227020800.0; s = s * u + 1.0 / 39916800.0; s = s * u + 1.0 / 362880.0;
    s = s * u + 1.0 / 5040.0; s = s * u + 1.0 / 120.0; s = s * u + 1.0 / 6.0; s = s * u + 1.0; s = s * r;
    double cz = 1.0 / 6402373705728000.0;
    cz = cz * u + 1.0 / 20922789888000.0; cz = cz * u + 1.0 / 87178291200.0; cz = cz * u + 1.0 / 479001600.0; cz = cz * u + 1.0 / 3628800.0; cz = cz * u + 1.0 / 40320.0;
    cz = cz * u + 1.0 / 720.0; cz = cz * u + 1.0 / 24.0; cz = cz * u + 0.5; cz = cz * u + 1.0;
    const double sg = (((long long)kq) & 1) ? -1.0 : 1.0;
    rope[(size_t)gid * 2] = (float)(sg * cz); rope[(size_t)gid * 2 + 1] = (float)(sg * s);
}
constexpr float W8S_GU = 64.f, W8S_D = 32.f, W8S_IN = 64.f, X8S_IN = 16.f;
constexpr int I_IN = 16 * 168, I_A = 8 * 32, I_O = 16 * 32, I_E = 256, I_MIX = I_IN + 2 * I_A + I_O, I_EXP = 48 * I_E;
constexpr int CONV_BLOCKS = 64;
constexpr int CONV_ITEMS_PER_WAVE = 24;
constexpr int P0_EXPERT_ITEMS = I_EXP - CONV_BLOCKS * NWAVES * CONV_ITEMS_PER_WAVE;
constexpr int P0_GEMV_ROUNDS = 2;
constexpr int GEMV_BLOCKS = 96;
__device__ __forceinline__ TDesc transpose_desc(Ctx& F, int it) {
    bf16* WIN = (bf16*)(F.ws + WS_WIN); bf16* WA = (bf16*)(F.ws + WS_WA); bf16* WB = (bf16*)(F.ws + WS_WB); bf16* WO = (bf16*)(F.ws + WS_WO); bf16* WGU = (bf16*)(F.ws + WS_WGU); bf16* WD = (bf16*)(F.ws + WS_WD);
    int r = it; const float* W; bf16* WT; int K, N, kb, nb; size_t drow; float f8s = 0.f;
    if (r < I_IN) { W = F.w_in; WT = WIN; K = 2048; N = INW; kb = r / 168; nb = r % 168; drow = (size_t)64 * nb; f8s = W8S_IN; }
    else if ((r -= I_IN) < I_A) { W = F.w_a; WT = WA; K = 1024; N = 2048; kb = r / 32; nb = r % 32; drow = (size_t)64 * nb; }
    else if ((r -= I_A) < I_A) { W = F.w_b; WT = WB; K = 1024; N = 2048; kb = r / 32; nb = r % 32; drow = (size_t)64 * nb; }
    else if ((r -= I_A) < I_O) { W = F.w_o; WT = WO; K = 2048; N = 2048; kb = r / 32; nb = r % 32; drow = (size_t)64 * nb; }
    else { r -= I_O; const int e = r / (3 * I_E), q = r % (3 * I_E), which = q / I_E, ii = q % I_E;
        if (which < 2) { kb = ii / 16; nb = ii % 16; const int n0 = 64 * nb; W = (which ? F.w_eu : F.w_eg) + (size_t)e * 2048 * 1024; WT = WGU; K = 2048; N = 1024; f8s = W8S_GU; drow = (size_t)e * 2048 + (n0 >> 7) * 256 + which * 128 + (n0 & 127); }
        else { kb = ii / 32; nb = ii % 32; W = F.w_ed + (size_t)e * 1024 * 2048; WT = WD; K = 1024; N = 2048; f8s = W8S_D; drow = (size_t)e * 2048 + 64 * nb; } }
    TDesc d; d.src = W + (size_t)(128 * kb) * N + 64 * nb; d.N = N; d.K = K; d.f8s = f8s;
    if (f8s != 0.f) d.dst = (bf16*)((unsigned char*)WT + drow * K + 128 * kb); else d.dst = WT + drow * K + 128 * kb;
    return d;
}
template <class Seq> __device__ __forceinline__ void transpose_stream(Ctx& F, const Seq& seq, float* scr) {
    f32x4 ra[16], rb[16]; TDesc d, dn; int j = 0; int it = seq(j);
    if (it < 0) return;
    d = transpose_desc(F, it); t_load(d, 0, ra, F.lane); t_load(d, 1, rb, F.lane);
    for (;;) {
        const int itn = seq(++j);
        t_process<0>(d, ra, scr, F.lane);
        if (itn >= 0) { dn = transpose_desc(F, itn); t_load(dn, 0, ra, F.lane); }
        t_process<1>(d, rb, scr, F.lane);
        if (itn < 0) break;
        t_load(dn, 1, rb, F.lane); d = dn;
    }
}
struct P0Seq { int gw, NGW, ngv; bool gemv;
    __device__ __forceinline__ int operator()(int r) const { int it; if (r < P0_GEMV_ROUNDS) it = r * NGW + gw; else { if (gemv) return -1; it = P0_GEMV_ROUNDS * NGW + (r - P0_GEMV_ROUNDS) * (NGW - ngv) + (gw - ngv); }
        return it < I_MIX + P0_EXPERT_ITEMS ? it : -1; } };
struct TailSeq { int first, stride;
    __device__ __forceinline__ int operator()(int j) const { const int it = first + j * stride; return it < I_MIX + I_EXP ? it : -1; } };
__device__ __forceinline__ void p1_modnorm(Ctx& F, int first, int stride) {
    const float* MOD = (const float*)(F.ws + WS_MOD); bf16* H = (bf16*)(F.ws + WS_H);
    for (int row0 = first; row0 < T; row0 += 2 * stride) {
        f32x4 v[2][8];
#pragma unroll
        for (int k = 0; k < 2; ++k) { const int row = row0 + k * stride; if (row < T) { const f32x4* xr = (const f32x4*)(F.x + (size_t)row * D) + F.lane;
#pragma unroll
            for (int j = 0; j < 8; ++j) v[k][j] = __builtin_nontemporal_load(xr + 64 * j); } }
#pragma unroll
        for (int k = 0; k < 2; ++k) { const int row = row0 + k * stride; if (row < T) {
            const int b = row / SEQ; float ss = 0.f;
#pragma unroll
            for (int j = 0; j < 8; ++j) ss += (v[k][j].x * v[k][j].x + v[k][j].y * v[k][j].y) + (v[k][j].z * v[k][j].z + v[k][j].w * v[k][j].w);
            const float r = rsqrtf(wave_sum(ss) * (1.f / D) + EPS);
            const f32x4* gp = (const f32x4*)F.g_pre_mix + F.lane; const f32x4* shp = (const f32x4*)(MOD + b * 12288) + F.lane; const f32x4* scp = (const f32x4*)(MOD + b * 12288 + 2048) + F.lane;
            unsigned* o8 = (unsigned*)((unsigned char*)H + (size_t)row * D) + F.lane;
            f32x4 g[8], sh[8], sc[8];
#pragma unroll
            for (int j = 0; j < 8; ++j) { g[j] = gp[64 * j]; sh[j] = shp[64 * j]; sc[j] = scp[64 * j]; }
#pragma unroll
            for (int j = 0; j < 8; ++j) { const f32x4 h = (v[k][j] * r * g[j] * (sc[j] + 1.f) + sh[j]) * X8S_IN;
                o8[64 * j] = pg8::pk4_fp8(h.x, h.y, h.z, h.w); } } }
    }
}
__device__ __forceinline__ void p0_prep(Ctx& F) {
    float* MOD = (float*)(F.ws + WS_MOD); float* LB = (float*)(F.ws + WS_LB); float* ROPE = (float*)(F.ws + WS_ROPE);
    if (blockIdx.x < GEMV_BLOCKS) {
        float* sc = (float*)F.lds; float* red = (float*)(F.lds + 16384);
        for (int i = F.tid; i < 4096; i += 512) sc[i] = siluf_(F.c[i]);
        __syncthreads();
        const int j0 = blockIdx.x * 128, k0 = F.wave * 256, half = F.lane >> 5, l32 = F.lane & 31;
        f32x4 a0 = {0.f, 0.f, 0.f, 0.f}, a1 = {0.f, 0.f, 0.f, 0.f};
        const float* wp = F.w_ada + (size_t)(k0 + half) * 12288 + j0 + 4 * l32;
#pragma unroll 16
        for (int k = 0; k < 128; ++k) { const f32x4 w = __builtin_nontemporal_load((const f32x4*)(wp + (size_t)(2 * k) * 12288)); const float s0 = sc[k0 + 2 * k + half], s1 = sc[2048 + k0 + 2 * k + half]; a0 += w * s0; a1 += w * s1; }
        *(f32x4*)(red + ((F.wave * 2 + half) * 2 + 0) * 128 + 4 * l32) = a0; *(f32x4*)(red + ((F.wave * 2 + half) * 2 + 1) * 128 + 4 * l32) = a1;
        __syncthreads();
        if (F.tid < 256) { const int b = F.tid >> 7, jj = F.tid & 127; float s = 0.f;
#pragma unroll
          for (int p = 0; p < 16; ++p) s += red[(p * 2 + b) * 128 + jj];
          MOD[b * 12288 + j0 + jj] = s + F.b_ada[j0 + jj]; }
        __syncthreads();
    }
    { const int gt = blockIdx.x * 512 + F.tid, NT = F.G * 512;
      if (gt < 2048) { const int dir = gt >> 10, ch = gt & 1023; const float l0 = F.lbl[dir * 2048 + ch], l1 = F.lbl[dir * 2048 + 1024 + ch]; LB[gt] = 1.f / (1.f + expf(l1 - l0)); }
      for (int g = gt; g < T * 64; g += NT) rope_entry(F.pos, ROPE, g); }
    unsigned* cnt = (unsigned*)(F.ws + WS_CTL) + 1024;
    if (blockIdx.x < GEMV_BLOCKS) {
        asm volatile("s_waitcnt vmcnt(0)" ::: "memory"); __syncthreads();
        if (F.tid == 0) { __builtin_amdgcn_fence(__ATOMIC_RELEASE, "agent"); asm volatile("s_waitcnt vmcnt(0)" ::: "memory"); __hip_atomic_fetch_add(cnt, 1u, __ATOMIC_RELAXED, __HIP_MEMORY_SCOPE_AGENT); }
    }
    float* scr = (float*)(F.lds + F.wave * 16384);
    P0Seq seq{F.gw, F.NGW, GEMV_BLOCKS * NWAVES, blockIdx.x < GEMV_BLOCKS};
    transpose_stream(F, seq, scr);
    __syncthreads();
    if (F.tid == 0) { unsigned sp = 0; while (__hip_atomic_load(cnt, __ATOMIC_RELAXED, __HIP_MEMORY_SCOPE_AGENT) < (unsigned)GEMV_BLOCKS && ++sp < (1u << 22)) __builtin_amdgcn_s_sleep(2);
        __builtin_amdgcn_fence(__ATOMIC_ACQUIRE, "agent"); asm volatile("s_waitcnt vmcnt(0)" ::: "memory"); }
    __syncthreads();
    p1_modnorm(F, F.gw, F.NGW);
}
__device__ __forceinline__ void p6_post1(Ctx& F) {
    const float* MOD = (const float*)(F.ws + WS_MOD); const float* Y = (const float*)(F.ws + WS_Y); bf16* H2 = (bf16*)(F.ws + WS_H2); float* AFF = (float*)(F.ws + WS_AFF);
    float* wT = (float*)F.lds;
    float* PA = (float*)(F.lds + PARAM_OFF); float* PB = PA + 2048; float* PC = PB + 2048;
    for (int f = F.tid; f < 8192; f += 512) { const int d = f >> 2, q = f & 3; const f32x4 wv = *((const f32x4*)F.w_router + f);
        wT[(4 * q + 0) * 2048 + d] = wv.x; wT[(4 * q + 1) * 2048 + d] = wv.y; wT[(4 * q + 2) * 2048 + d] = wv.z; wT[(4 * q + 3) * 2048 + d] = wv.w; }
    uint2 ywn[8]; f32x4 xvn[8];
#define P6_LOAD(rr) do { const uint2* yr_ = (const uint2*)((const bf16*)Y + (size_t)(rr) * D) + F.lane; const f32x4* xr_ = (const f32x4*)(F.x + (size_t)(rr) * D) + F.lane; \
        _Pragma("unroll") for (int j = 0; j < 8; ++j) { { const u2v_t t2_ = __builtin_nontemporal_load((const u2v_t*)(yr_ + 64 * j)); ywn[j].x = t2_.x; ywn[j].y = t2_.y; } xvn[j] = __builtin_nontemporal_load(xr_ + 64 * j); } } while (0)
    for (int b = 0; b < BATCH; ++b) {
        const float* mb = MOD + b * 12288;
        __syncthreads();
        if (F.tid < 512) { const int d4 = F.tid;
            const f32x4 gt = *((const f32x4*)(mb + 4096) + d4), gp = *((const f32x4*)F.g_post_mix + d4), g2 = *((const f32x4*)F.g_pre_ffn + d4), sc = *((const f32x4*)(mb + 8192) + d4), sh = *((const f32x4*)(mb + 6144) + d4);
            *((f32x4*)PA + d4) = gt * gp; *((f32x4*)PB + d4) = g2 * (sc + 1.f); *((f32x4*)PC + d4) = sh; }
        const int rfirst = b * SEQ + F.gw;
        if (F.gw < SEQ) P6_LOAD(rfirst);
        __syncthreads();
        for (int rl = F.gw; rl < SEQ; rl += F.NGW) {
            const int row = b * SEQ + rl, s = rl;
            f32x4 xv[8]; float ss = 0.f;
            {   uint2 yc[8];
#pragma unroll
                for (int j = 0; j < 8; ++j) { yc[j] = ywn[j]; const float y0 = __uint_as_float(yc[j].x << 16), y1 = __uint_as_float(yc[j].x & 0xffff0000u), y2 = __uint_as_float(yc[j].y << 16), y3 = __uint_as_float(yc[j].y & 0xffff0000u);
                    xv[j] = xvn[j]; ss += (y0 * y0 + y1 * y1) + (y2 * y2 + y3 * y3); }
                if (rl + F.NGW < SEQ) P6_LOAD(row + F.NGW);
                const float r = rsqrtf(wave_sum(ss) * (1.f / D) + EPS);
                f32x4* op = (f32x4*)(F.out + (size_t)row * D) + F.lane;
                ss = 0.f;
#pragma unroll
                for (int j = 0; j < 8; ++j) { const f32x4 y = {__uint_as_float(yc[j].x << 16), __uint_as_float(yc[j].x & 0xffff0000u), __uint_as_float(yc[j].y << 16), __uint_as_float(yc[j].y & 0xffff0000u)};
                    const f32x4 pa = *((const f32x4*)PA + F.lane + 64 * j);
                    xv[j] = xv[j] + pa * (y * r); ss += (xv[j].x * xv[j].x + xv[j].y * xv[j].y) + (xv[j].z * xv[j].z + xv[j].w * xv[j].w); }
#pragma unroll
                for (int j = 0; j < 8; ++j) op[64 * j] = xv[j];
            }
            const float r2 = rsqrtf(wave_sum(ss) * (1.f / D) + EPS);
            unsigned* o4 = (unsigned*)((unsigned char*)H2 + (size_t)row * D) + F.lane;
            float lg[16];
#pragma unroll
            for (int j = 0; j < 8; ++j) { const f32x4 pb = *((const f32x4*)PB + F.lane + 64 * j), pc = *((const f32x4*)PC + F.lane + 64 * j); xv[j] = xv[j] * r2 * pb + pc; }
#pragma unroll
            for (int j = 0; j < 8; ++j) o4[64 * j] = pg8::pk4_fp8(xv[j].x, xv[j].y, xv[j].z, xv[j].w);
#pragma unroll
            for (int e = 0; e < 16; ++e) { float a = 0.f;
#pragma unroll
                for (int j = 0; j < 8; ++j) { const f32x4 wv = *((const f32x4*)(wT + e * 2048) + F.lane + 64 * j); a += (xv[j].x * wv.x + xv[j].y * wv.y) + (xv[j].z * wv.z + xv[j].w * wv.w); }
                lg[e] = a; asm volatile("" ::: "memory"); }
            float mx = -1e30f;
#pragma unroll
            for (int e = 0; e < 16; ++e) { lg[e] = wave_sum(lg[e]); mx = fmaxf(mx, lg[e]); }
            float sm = 0.f;
#pragma unroll
            for (int e = 0; e < 16; ++e) { lg[e] = expf(lg[e] - mx); sm += lg[e]; }
            float mine = 0.f;
#pragma unroll
            for (int e = 0; e < 16; ++e) mine = (F.lane == e) ? lg[e] : mine;
            if (F.lane < 16) AFF[((size_t)b * 16 + F.lane) * SEQ + s] = mine / sm;
        }
    }
#undef P6_LOAD
    __syncthreads();
}
__device__ __forceinline__ void p7_topk_gather(Ctx& F) {
    const float* AFF = (const float*)(F.ws + WS_AFF); int* GIDX = (int*)(F.ws + WS_GIDX); float* SELAFF = (float*)(F.ws + WS_SELAFF); int* TOKSLOT = (int*)(F.ws + WS_TOKSLOT);
        int* sh = (int*)F.lds; int* wsum = (int*)(F.lds + 64);
    for (int unit = blockIdx.x; unit < 256; unit += F.G) {
        const int be = unit >> 3, part = unit & 7, b = be >> 4, e = be & 15, tid = F.tid, lane = F.lane;
        if (F.wave == 0) {
            unsigned v[64];
#pragma unroll
            for (int i = 0; i < 64; ++i) v[i] = __float_as_uint(AFF[(size_t)be * SEQ + i * 64 + lane]);
            unsigned tau = 0u;
            for (int bit = 30; bit >= 0; --bit) { const unsigned cand = tau | (1u << bit); int cl = 0;
#pragma unroll
                for (int i = 0; i < 64; ++i) cl += (v[i] >= cand) ? 1 : 0;
                int c = 0;
#pragma unroll
                for (int q = 0; q < 7; ++q) c += __popcll(__ballot((cl >> q) & 1)) << q;
                if (c >= CAP) tau = cand; }
            int cgt = 0;
            { int cl = 0;
#pragma unroll
              for (int i = 0; i < 64; ++i) cl += (v[i] > tau) ? 1 : 0;
#pragma unroll
              for (int q = 0; q < 7; ++q) cgt += __popcll(__ballot((cl >> q) & 1)) << q; }
            if (lane == 0) { sh[0] = (int)tau; sh[1] = cgt; }
        }
        __syncthreads();
        const unsigned tau = (unsigned)sh[0]; const int need = CAP - sh[1];
        const f32x4* a = (const f32x4*)(AFF + (size_t)be * SEQ + tid * 8);
        const f32x4 a0 = a[0], a1 = a[1];
        const unsigned v[8] = {__float_as_uint(a0.x), __float_as_uint(a0.y), __float_as_uint(a0.z), __float_as_uint(a0.w), __float_as_uint(a1.x), __float_as_uint(a1.y), __float_as_uint(a1.z), __float_as_uint(a1.w)};
        int cg = 0, ce = 0;
#pragma unroll
        for (int i = 0; i < 8; ++i) { cg += (v[i] > tau) ? 1 : 0; ce += (v[i] == tau) ? 1 : 0; }
        const int pk = cg | (ce << 16); int inc = pk;
#pragma unroll
        for (int o = 1; o < 64; o <<= 1) { const int t = __shfl_up(inc, o); if (lane >= o) inc += t; }
        if (lane == 63) wsum[F.wave] = inc;
        __syncthreads();
        int base = 0;
#pragma unroll
        for (int w = 0; w < 8; ++w) base += (w < F.wave) ? wsum[w] : 0;
        const int excl = base + inc - pk, pg = excl & 0xffff, pe = excl >> 16;
        int tie_before = pe, sel_before = pg + (pe < need ? pe : need);
#pragma unroll
        for (int i = 0; i < 8; ++i) {
            const int tok = tid * 8 + i; bool sel = false;
            if (v[i] > tau) sel = true; else if (v[i] == tau) { sel = tie_before < need; ++tie_before; }
            int slot = -1;
            if (sel) { const int sl = sel_before; ++sel_before; slot = b * CAP + sl;
                if ((sl >> 6) == part) { GIDX[e * 1024 + slot] = b * SEQ + tok; SELAFF[e * 1024 + slot] = __uint_as_float(v[i]); } }
            if (F.wave == part) TOKSLOT[((size_t)b * 16 + e) * SEQ + tok] = slot;
        }
        __syncthreads();
    }
}
__device__ __forceinline__ void p10_final(Ctx& F) {
    const float* MOD = (const float*)(F.ws + WS_MOD); const bf16* SLAB = (const bf16*)(F.ws + WS_SLAB); const int* TOKSLOT = (const int*)(F.ws + WS_TOKSLOT);
    for (int row0 = F.gw; row0 < T; row0 += 4 * F.NGW) {
        int slotw[4];
#pragma unroll
        for (int k = 0; k < 4; ++k) { const int row = row0 + k * F.NGW; slotw[k] = (row < T && F.lane < 16) ? TOKSLOT[((size_t)(row / SEQ) * 16 + F.lane) * SEQ + (row % SEQ)] : -1; }
#pragma unroll
        for (int k = 0; k < 4; ++k) { const int row = row0 + k * F.NGW; if (row < T) {
            const int b = row / SEQ; const float* mb = MOD + b * 12288;
            f32x4 x1v[8], gtv[8], gpv[8];
#pragma unroll
            for (int j = 0; j < 4; ++j) { const int col = 8 * F.lane + 512 * j; const float* op = F.out + (size_t)row * D + col;
#pragma unroll
                for (int hh = 0; hh < 2; ++hh) { x1v[2 * j + hh] = *(const f32x4*)(op + 4 * hh); gtv[2 * j + hh] = *(const f32x4*)(mb + 10240 + col + 4 * hh); gpv[2 * j + hh] = *(const f32x4*)(F.g_post_ffn + col + 4 * hh); } }
            float y[32];
#pragma unroll
            for (int i = 0; i < 32; ++i) y[i] = 0.f;
            for (int e = 0; e < 16; ++e) { const int sl = __shfl(slotw[k], e); if (sl >= 0) { const v4u* r = (const v4u*)(SLAB + ((size_t)e * 1024 + sl) * D) + F.lane;
#pragma unroll
                    for (int j = 0; j < 4; ++j) { const v4u q = r[64 * j];
                        y[8 * j + 0] += __uint_as_float(q.x << 16); y[8 * j + 1] += __uint_as_float(q.x & 0xffff0000u); y[8 * j + 2] += __uint_as_float(q.y << 16); y[8 * j + 3] += __uint_as_float(q.y & 0xffff0000u);
                        y[8 * j + 4] += __uint_as_float(q.z << 16); y[8 * j + 5] += __uint_as_float(q.z & 0xffff0000u); y[8 * j + 6] += __uint_as_float(q.w << 16); y[8 * j + 7] += __uint_as_float(q.w & 0xffff0000u); } } }
            float ss = 0.f;
#pragma unroll
            for (int i = 0; i < 32; ++i) ss += y[i] * y[i];
            const float r = rsqrtf(wave_sum(ss) * (1.f / D) + EPS);
#pragma unroll
            for (int j = 0; j < 4; ++j) { const int col = 8 * F.lane + 512 * j; float* op = F.out + (size_t)row * D + col;
#pragma unroll
                for (int hh = 0; hh < 2; ++hh) { f32x4 yy = {y[8 * j + 4 * hh], y[8 * j + 4 * hh + 1], y[8 * j + 4 * hh + 2], y[8 * j + 4 * hh + 3]};
                    *(f32x4*)(op + 4 * hh) = x1v[2 * j + hh] + gtv[2 * j + hh] * (yy * r * gpv[2 * j + hh]); } } } }
    }
}
typedef short bf16x8 __attribute__((ext_vector_type(8)));
typedef short s16x4 __attribute__((ext_vector_type(4)));
typedef short v4i16_t __attribute__((ext_vector_type(4)));
typedef float f32x16 __attribute__((ext_vector_type(16)));
typedef float f32x2m __attribute__((ext_vector_type(2)));
constexpr int RS = 272;
constexpr int RSA = 144;
constexpr float LOG2E = 1.4426950408889634f;
__device__ __forceinline__ s16x4 tr4(const LAS unsigned char* p) { return __builtin_bit_cast(s16x4, __builtin_amdgcn_ds_read_tr16_b64_v4i16((LAS v4i16_t*)p)); }
__device__ __forceinline__ bf16x8 tr8(const LAS unsigned char* p, int second) { const s16x4 a = tr4(p), b = tr4(p + second); return (bf16x8){a[0], a[1], a[2], a[3], b[0], b[1], b[2], b[3]}; }
__device__ __forceinline__ bf16x8 ld8(const LAS unsigned char* p) { return *(const LAS bf16x8*)p; }
__device__ __forceinline__ unsigned cvtpk(float lo, float hi) { return pg8::cvt_pk_bf16(lo, hi); }
__device__ __forceinline__ int crow(int r, int hi) { return (r & 3) + 8 * (r >> 2) + 4 * hi; }
#define MFMA16(a, b, c) __builtin_amdgcn_mfma_f32_16x16x32_bf16((a), (b), (c), 0, 0, 0)
#define MFMA32(a, b, c) __builtin_amdgcn_mfma_f32_32x32x16_bf16((a), (b), (c), 0, 0, 0)

__device__ __forceinline__ void rope_pass(Ctx& F) {
    const bf16* PROJ = (const bf16*)(F.ws + WS_PROJ); const float* ROPE = (const float*)(F.ws + WS_ROPE); bf16* QR = (bf16*)(F.ws + WS_QR); bf16* KR = (bf16*)(F.ws + WS_KR);
    const int NT = F.G * 512;
    for (int it0 = blockIdx.x * 512 + F.tid; it0 < T * 80; it0 += 2 * NT) {
        v4u a[2], bq[2]; f32x4 cs[2][4]; bool ok[2];
#pragma unroll
        for (int u = 0; u < 2; ++u) { const int it = it0 + u * NT; ok[u] = it < T * 80; if (ok[u]) { const int i8 = it & 7, hh = (it >> 3) % 10, t = it / 80;
            const bf16* src = PROJ + (size_t)t * INW + (hh < 8 ? C_AQ + hh * 128 : C_AK + (hh - 8) * 128) + i8 * 8;
            a[u] = *(const v4u*)src; bq[u] = *(const v4u*)(src + 64);
            const f32x4* rp = (const f32x4*)(ROPE + ((size_t)t * 64 + i8 * 8) * 2);
#pragma unroll
            for (int k = 0; k < 4; ++k) cs[u][k] = rp[k]; } }
#pragma unroll
        for (int u = 0; u < 2; ++u) { if (ok[u]) { const int it = it0 + u * NT; const int i8 = it & 7, hh = (it >> 3) % 10, t = it / 80;
            const unsigned aw[4] = {a[u].x, a[u].y, a[u].z, a[u].w}, bw[4] = {bq[u].x, bq[u].y, bq[u].z, bq[u].w};
            unsigned o1[4], o2[4];
#pragma unroll
            for (int k = 0; k < 4; ++k) { const f32x4 c4 = cs[u][k];
                const float x1a = __uint_as_float(aw[k] << 16), x1b = __uint_as_float(aw[k] & 0xffff0000u), x2a = __uint_as_float(bw[k] << 16), x2b = __uint_as_float(bw[k] & 0xffff0000u);
                o1[k] = pk2(x1a * c4.x - x2a * c4.y, x1b * c4.z - x2b * c4.w); o2[k] = pk2(x1a * c4.y + x2a * c4.x, x1b * c4.w + x2b * c4.z); }
            bf16* dst = (hh < 8 ? QR + (size_t)t * 1024 + hh * 128 : KR + (size_t)t * 256 + (hh - 8) * 128) + i8 * 8;
            *(v4u*)dst = (v4u){o1[0], o1[1], o1[2], o1[3]}; *(v4u*)(dst + 64) = (v4u){o2[0], o2[1], o2[2], o2[3]}; } }
    }
}
__device__ __forceinline__ void hgrn_a_phase(Ctx& F, LAS unsigned char* L) {
    const bf16* PROJ = (const bf16*)(F.ws + WS_PROJ); const float* LB = (const float*)(F.ws + WS_LB); bf16* CS = (bf16*)(F.ws + WS_CS); float* DEC = (float*)(F.ws + WS_DEC);
    LAS unsigned char* KD = L; LAS unsigned char* VV = L + 17408; LAS float* TOT = (LAS float*)(L + 34816);
    const int tid = F.tid, lane = F.lane, w = F.wave, dk0 = 2 * lane;
    const int tro16 = (8 * (lane >> 4) + ((lane & 15) >> 2)) * RS + (lane & 3) * 8;
    unsigned zraw[8]; v4u vr[2]; float lbA = 0.f, lbB = 0.f;
#define HA_LOAD(un) do { const int c_ = (un) & 63, dir_ = ((un) >> 6) & 1, h_ = ((un) >> 7) & 7, b_ = (un) >> 10; const size_t rb_ = (size_t)b_ * SEQ + c_ * 64; \
        { const float2 l2_ = *(const float2*)(LB + dir_ * 1024 + h_ * 128 + dk0); lbA = l2_.x; lbB = l2_.y; } \
        const bf16* zp_ = PROJ + (rb_ + 8 * w) * INW + (dir_ ? C_FB : C_FF) + h_ * 128; \
        _Pragma("unroll") for (int i = 0; i < 8; ++i) zraw[i] = *(const unsigned*)(zp_ + (size_t)i * INW + dk0); \
        _Pragma("unroll") for (int i = 0; i < 2; ++i) { const int idx = tid + 512 * i, row = idx >> 4, ch = idx & 15; vr[i] = *(const v4u*)(PROJ + (rb_ + row) * INW + C_HI + h_ * 128 + ch * 8); } } while (0)
    if ((int)blockIdx.x < 2048) HA_LOAD((int)blockIdx.x);
    for (int unit = blockIdx.x; unit < 2048; unit += F.G) {
        const int dir = (unit >> 6) & 1;
        float lfa[8], lfb[8], ka[8], kb[8];
#pragma unroll
        for (int i = 0; i < 8; ++i) { const float za = __uint_as_float(zraw[i] << 16), zb = __uint_as_float(zraw[i] & 0xffff0000u);
            const float fa = lbA + (1.f - lbA) * sigmoidf_(za), fb = lbB + (1.f - lbB) * sigmoidf_(zb); lfa[i] = __logf(fa); lfb[i] = __logf(fb); ka[i] = 1.f - fa; kb[i] = 1.f - fb; }
#pragma unroll
        for (int i = 0; i < 2; ++i) { const int idx = tid + 512 * i, row = idx >> 4, ch = idx & 15; *(LAS v4u*)(VV + row * RS + ch * 16) = vr[i]; }
        if (unit + F.G < 2048) HA_LOAD(unit + F.G);
        float runa = 0.f, runb = 0.f;
        if (dir == 0) {
#pragma unroll
            for (int i = 0; i < 8; ++i) { runa += lfa[i]; lfa[i] = runa; runb += lfb[i]; lfb[i] = runb; } }
        else {
#pragma unroll
            for (int i = 7; i >= 0; --i) { runa += lfa[i]; lfa[i] = runa; runb += lfb[i]; lfb[i] = runb; } }
        *(LAS f32x2m*)(TOT + w * 128 + dk0) = (f32x2m){runa, runb};
        __syncthreads();
        float totA = 0.f, totB = 0.f, offA = 0.f, offB = 0.f;
#pragma unroll
        for (int p = 0; p < 8; ++p) { const f32x2m t = *(const LAS f32x2m*)(TOT + p * 128 + dk0); totA += t.x; totB += t.y;
            const bool inoff = dir == 0 ? (p < w) : (p > w); offA += inoff ? t.x : 0.f; offB += inoff ? t.y : 0.f; }
#pragma unroll
        for (int i = 0; i < 8; ++i) { const float va = ka[i] * __expf(totA - (lfa[i] + offA)), vb = kb[i] * __expf(totB - (lfb[i] + offB));
            *(LAS unsigned*)(KD + (8 * w + i) * RS + dk0 * 2) = pk2(va, vb); }
        if (w == 0) *(float2*)(DEC + (size_t)unit * 128 + dk0) = make_float2(__expf(totA), __expf(totB));
        __syncthreads();
        f32x4 acc[2][4];
#pragma unroll
        for (int a = 0; a < 2; ++a)
#pragma unroll
            for (int t = 0; t < 4; ++t) acc[a][t] = (f32x4){0.f, 0.f, 0.f, 0.f};
        const int dvb = 32 * (w & 3), dkb = 64 * (w >> 2);
#pragma unroll
        for (int s = 0; s < 2; ++s) {
            bf16x8 af[2], bfr[4];
#pragma unroll
            for (int a = 0; a < 2; ++a) af[a] = tr8(VV + (32 * s) * RS + (dvb + 16 * a) * 2 + tro16, 4 * RS);
#pragma unroll
            for (int t = 0; t < 4; ++t) bfr[t] = tr8(KD + (32 * s) * RS + (dkb + 16 * t) * 2 + tro16, 4 * RS);
#pragma unroll
            for (int a = 0; a < 2; ++a)
#pragma unroll
                for (int t = 0; t < 4; ++t) acc[a][t] = MFMA16(af[a], bfr[t], acc[a][t]);
        }
        bf16* cso = CS + (size_t)unit * 16384;
        const int cc = lane & 15, rg = lane >> 4;
#pragma unroll
        for (int a = 0; a < 2; ++a)
#pragma unroll
            for (int t = 0; t < 4; ++t) { const int dkk = dkb + 16 * t + cc, dv0 = dvb + 16 * a + 4 * rg;
                uint2 o; o.x = cvtpk(acc[a][t][0], acc[a][t][1]); o.y = cvtpk(acc[a][t][2], acc[a][t][3]); *(uint2*)(cso + dkk * 128 + dv0) = o; }
        __syncthreads();
    }
#undef HA_LOAD
}
__device__ __forceinline__ void hgrn_scan_phase(Ctx& F) {
    const bf16* CS = (const bf16*)(F.ws + WS_CS); bf16* ST = (bf16*)(F.ws + WS_STATE); const float* DEC = (const float*)(F.ws + WS_DEC);
    const int NT = F.G * 512;
    for (int gt = blockIdx.x * 512 + F.tid; gt < 32 * 4096; gt += NT) {
        const int g = gt >> 12, e4 = (gt & 4095) * 4, dk = e4 >> 7, dir = g & 1;
        float s0 = 0.f, s1 = 0.f, s2 = 0.f, s3 = 0.f;
        uint2 tn[8]; float dn[8];
#define SC_LOAD(st_) do { _Pragma("unroll") for (int k = 0; k < 8; ++k) { const int c_ = dir ? 63 - ((st_) + k) : (st_) + k; const size_t u_ = (size_t)g * 64 + c_; { const u2v_t t2_ = __builtin_nontemporal_load((const u2v_t*)(CS + u_ * 16384 + e4)); tn[k].x = t2_.x; tn[k].y = t2_.y; } dn[k] = DEC[u_ * 128 + dk]; } } while (0)
        SC_LOAD(0);
        for (int st = 0; st < 64; st += 8) {
            uint2 tmp[8]; float dc[8];
#pragma unroll
            for (int k = 0; k < 8; ++k) { tmp[k] = tn[k]; dc[k] = dn[k]; }
            if (st + 8 < 64) SC_LOAD(st + 8);
#pragma unroll
            for (int k = 0; k < 8; ++k) { const int c = dir ? 63 - (st + k) : st + k; const size_t unit = (size_t)g * 64 + c;
                uint2 o; o.x = pk2(s0, s1); o.y = pk2(s2, s3); *(uint2*)(ST + unit * 16384 + e4) = o;
                s0 = dc[k] * s0 + __uint_as_float(tmp[k].x << 16); s1 = dc[k] * s1 + __uint_as_float(tmp[k].x & 0xffff0000u);
                s2 = dc[k] * s2 + __uint_as_float(tmp[k].y << 16); s3 = dc[k] * s3 + __uint_as_float(tmp[k].y & 0xffff0000u); }
        }
#undef SC_LOAD
    }
}
__device__ __forceinline__ void hgrn_c_phase(Ctx& F, LAS unsigned char* L) {
    const bf16* PROJ = (const bf16*)(F.ws + WS_PROJ); const float* LB = (const float*)(F.ws + WS_LB); const bf16* ST = (const bf16*)(F.ws + WS_STATE); bf16* YAIN = (bf16*)(F.ws + WS_YAIN);
    LAS unsigned char* QI = L; LAS unsigned char* KI = L + 17408; LAS unsigned char* QE = L + 34816; LAS unsigned char* VV = L + 52224; LAS unsigned char* SP = L + 69632; LAS unsigned char* AM = L + 104448;
    LAS float* TOT = (LAS float*)(L + 113664); LAS float* SSQ = (LAS float*)(L + 117760);
    const int tid = F.tid, lane = F.lane, w = F.wave, dk0 = 2 * lane, cc = lane & 15, rg = lane >> 4;
    const int tro16 = (8 * (lane >> 4) + ((lane & 15) >> 2)) * RS + (lane & 3) * 8;
    unsigned zraw[8], qraw[8]; v4u vr[2], sr[4]; float lbA = 0.f, lbB = 0.f;
#define HC_LOAD(un, dr) do { const int c_ = (un) & 63, h_ = ((un) >> 6) & 7, b_ = (un) >> 9; const size_t rb_ = (size_t)b_ * SEQ + c_ * 64; \
        { const float2 l2_ = *(const float2*)(LB + (dr) * 1024 + h_ * 128 + dk0); lbA = l2_.x; lbB = l2_.y; } \
        const bf16* zp_ = PROJ + (rb_ + 8 * w) * INW + h_ * 128; \
        _Pragma("unroll") for (int i = 0; i < 8; ++i) { const bf16* rp_ = zp_ + (size_t)i * INW; zraw[i] = *(const unsigned*)(rp_ + ((dr) ? C_FB : C_FF) + dk0); qraw[i] = *(const unsigned*)(rp_ + C_HQ + dk0); } \
        if ((dr) == 0) { _Pragma("unroll") for (int i = 0; i < 2; ++i) { const int idx = tid + 512 * i, row = idx >> 4, ch = idx & 15; vr[i] = *(const v4u*)(PROJ + (rb_ + row) * INW + C_HI + h_ * 128 + ch * 8); } } \
        { const bf16* sp_ = ST + ((size_t)((b_ * 8 + h_) * 2 + (dr)) * 64 + c_) * 16384; \
          _Pragma("unroll") for (int i = 0; i < 4; ++i) { const int idx = tid + 512 * i; sr[i] = __builtin_nontemporal_load((const v4u*)(sp_ + idx * 8)); } } } while (0)
    if ((int)blockIdx.x < 1024) HC_LOAD((int)blockIdx.x, 0);
    for (int unit = blockIdx.x; unit < 1024; unit += F.G) {
        const int c = unit & 63, h = (unit >> 6) & 7, b = unit >> 9;
        const size_t rb = (size_t)b * SEQ + c * 64;
        f32x4 o[4];
#pragma unroll
        for (int t = 0; t < 4; ++t) o[t] = (f32x4){0.f, 0.f, 0.f, 0.f};
        for (int dir = 0; dir < 2; ++dir) {
            float lfa[8], lfb[8], ka[8], kb[8], qa[8], qb[8];
#pragma unroll
            for (int i = 0; i < 8; ++i) { const float za = __uint_as_float(zraw[i] << 16), zb = __uint_as_float(zraw[i] & 0xffff0000u);
                const float fa = lbA + (1.f - lbA) * sigmoidf_(za), fb = lbB + (1.f - lbB) * sigmoidf_(zb); lfa[i] = __logf(fa); lfb[i] = __logf(fb); ka[i] = 1.f - fa; kb[i] = 1.f - fb;
                qa[i] = siluf_(__uint_as_float(qraw[i] << 16)); qb[i] = siluf_(__uint_as_float(qraw[i] & 0xffff0000u)); }
            if (dir == 0) {
#pragma unroll
                for (int i = 0; i < 2; ++i) { const int idx = tid + 512 * i, row = idx >> 4, ch = idx & 15; *(LAS v4u*)(VV + row * RS + ch * 16) = vr[i]; } }
#pragma unroll
            for (int i = 0; i < 4; ++i) { const int idx = tid + 512 * i, row = idx >> 4, ch = idx & 15; *(LAS v4u*)(SP + row * RS + ch * 16) = sr[i]; }
            if (dir == 0) HC_LOAD(unit, 1); else if (unit + F.G < 1024) HC_LOAD(unit + F.G, 0);
            float runa = 0.f, runb = 0.f;
            if (dir == 0) {
#pragma unroll
                for (int i = 0; i < 8; ++i) { runa += lfa[i]; lfa[i] = runa; runb += lfb[i]; lfb[i] = runb; } }
            else {
#pragma unroll
                for (int i = 7; i >= 0; --i) { runa += lfa[i]; lfa[i] = runa; runb += lfb[i]; lfb[i] = runb; } }
            *(LAS f32x2m*)(TOT + w * 128 + dk0) = (f32x2m){runa, runb};
            __syncthreads();
            {   float offA = 0.f, offB = 0.f, brA = 0.f, brB = 0.f;
#pragma unroll
                for (int p = 0; p < 8; ++p) { const f32x2m t = *(const LAS f32x2m*)(TOT + p * 128 + dk0);
                    const bool inoff = dir == 0 ? (p < w) : (p > w), inref = dir == 0 ? (p < 4) : (p >= 4);
                    offA += inoff ? t.x : 0.f; offB += inoff ? t.y : 0.f; brA += inref ? t.x : 0.f; brB += inref ? t.y : 0.f; }
#pragma unroll
                for (int i = 0; i < 8; ++i) { const float ba = lfa[i] + offA, bb = lfb[i] + offB; const int ro = (8 * w + i) * RS + dk0 * 2;
                    *(LAS unsigned*)(QI + ro) = pk2(qa[i] * __expf(ba - brA), qb[i] * __expf(bb - brB));
                    *(LAS unsigned*)(KI + ro) = pk2(ka[i] * __expf(brA - ba), kb[i] * __expf(brB - bb));
                    *(LAS unsigned*)(QE + ro) = pk2(qa[i] * __expf(ba), qb[i] * __expf(bb)); }
            }
            __syncthreads();
            {
                const int rt = w >> 1, ct0 = 2 * (w & 1);
                f32x4 am[2] = {(f32x4){0.f, 0.f, 0.f, 0.f}, (f32x4){0.f, 0.f, 0.f, 0.f}};
#pragma unroll
                for (int s = 0; s < 4; ++s) { const bf16x8 af = ld8(QI + (16 * rt + cc) * RS + (32 * s + 8 * rg) * 2);
#pragma unroll
                    for (int t = 0; t < 2; ++t) { const bf16x8 bfr = ld8(KI + (16 * (ct0 + t) + cc) * RS + (32 * s + 8 * rg) * 2); am[t] = MFMA16(af, bfr, am[t]); } }
#pragma unroll
                for (int t = 0; t < 2; ++t)
#pragma unroll
                    for (int i = 0; i < 4; ++i) { const int l = 16 * rt + 4 * rg + i, m = 16 * (ct0 + t) + cc; const bool keep = dir == 0 ? (m <= l) : (m >= l);
                        *(LAS bf16*)(AM + l * RSA + m * 2) = f2bf(keep ? am[t][i] : 0.f); }
            }
            __syncthreads();
            {
                const int rt = w & 3, cb = 64 * (w >> 2);
#pragma unroll
                for (int s = 0; s < 2; ++s) { const bf16x8 af = ld8(AM + (16 * rt + cc) * RSA + (32 * s + 8 * rg) * 2);
#pragma unroll
                    for (int t = 0; t < 4; ++t) { const bf16x8 bfr = tr8(VV + (32 * s) * RS + (cb + 16 * t) * 2 + tro16, 4 * RS); o[t] = MFMA16(af, bfr, o[t]); } }
#pragma unroll
                for (int s = 0; s < 4; ++s) { const bf16x8 af = ld8(QE + (16 * rt + cc) * RS + (32 * s + 8 * rg) * 2);
#pragma unroll
                    for (int t = 0; t < 4; ++t) { const bf16x8 bfr = tr8(SP + (32 * s) * RS + (cb + 16 * t) * 2 + tro16, 4 * RS); o[t] = MFMA16(af, bfr, o[t]); } }
            }
            __syncthreads();
        }
        const int rt = w & 3, chh = w >> 2, cb = 64 * chh;
        bf16 hgv[4][4]; float onv[4];
#pragma unroll
        for (int t = 0; t < 4; ++t) { const int dv = cb + 16 * t + cc; onv[t] = F.onorm[h * 128 + dv];
#pragma unroll
            for (int i = 0; i < 4; ++i) hgv[i][t] = PROJ[(rb + 16 * rt + 4 * rg + i) * INW + C_HG + h * 128 + dv]; }
        float ssv[4];
#pragma unroll
        for (int i = 0; i < 4; ++i) { float sq = 0.f;
#pragma unroll
            for (int t = 0; t < 4; ++t) sq += o[t][i] * o[t][i];
            sq += __shfl_xor(sq, 1); sq += __shfl_xor(sq, 2); sq += __shfl_xor(sq, 4); sq += __shfl_xor(sq, 8); ssv[i] = sq; }
        if (cc == 0) {
#pragma unroll
            for (int i = 0; i < 4; ++i) SSQ[chh * 64 + 16 * rt + 4 * rg + i] = ssv[i]; }
        __syncthreads();
        float rr[4];
#pragma unroll
        for (int i = 0; i < 4; ++i) { const int l = 16 * rt + 4 * rg + i; rr[i] = rsqrtf((SSQ[l] + SSQ[64 + l]) * (1.f / 128.f) + EPS); }
#pragma unroll
        for (int i = 0; i < 4; ++i) { const int l = 16 * rt + 4 * rg + i;
#pragma unroll
            for (int t = 0; t < 4; ++t) { const int dv = cb + 16 * t + cc;
                YAIN[(rb + l) * 1024 + h * 128 + dv] = f2bf(o[t][i] * rr[i] * onv[t] * siluf_(bf2f(hgv[i][t]))); } }
        __syncthreads();
    }
#undef HC_LOAD
}
__device__ __forceinline__ void rope8(v4u& a, v4u& bq, const f32x4 (&cs)[4]) {
    const unsigned aw[4] = {a.x, a.y, a.z, a.w}, bw[4] = {bq.x, bq.y, bq.z, bq.w}; unsigned o1[4], o2[4];
#pragma unroll
    for (int k = 0; k < 4; ++k) { const f32x4 c4 = cs[k];
        const float x1a = __uint_as_float(aw[k] << 16), x1b = __uint_as_float(aw[k] & 0xffff0000u), x2a = __uint_as_float(bw[k] << 16), x2b = __uint_as_float(bw[k] & 0xffff0000u);
        o1[k] = pk2(x1a * c4.x - x2a * c4.y, x1b * c4.z - x2b * c4.w); o2[k] = pk2(x1a * c4.y + x2a * c4.x, x1b * c4.w + x2b * c4.z); }
    a = (v4u){o1[0], o1[1], o1[2], o1[3]}; bq = (v4u){o2[0], o2[1], o2[2], o2[3]};
}
__device__ __forceinline__ void attn_phase(Ctx& F, LAS unsigned char* L) {
    const bf16* PROJ = (const bf16*)(F.ws + WS_PROJ); const float* ROPE = (const float*)(F.ws + WS_ROPE); bf16* ATT = (bf16*)(F.ws + WS_ATT);
    LAS unsigned char* KT = L; LAS unsigned char* VT = L + 17408; LAS float* AL = (LAS float*)(L + 34816) + F.wave * 32;
    const int tid = F.tid, lane = F.lane, w = F.wave, q32 = lane & 31, hh = lane >> 5;
    const int tro32 = (4 * hh + ((lane & 15) >> 2)) * RS + (16 * ((lane >> 4) & 1) + 4 * (lane & 3)) * 2;
    const int krow = tid >> 3, kc8 = tid & 7;
    constexpr float C2 = 0.08838834764831845f * LOG2E;
    for (int unit = blockIdx.x; unit < 256; unit += F.G) {
        const int qb = unit & 63, kvh = (unit >> 6) & 1, b = unit >> 7, q0 = qb * 64, h = kvh * 4 + (w >> 1);
        const int qp = q0 + 32 * (w & 1) + q32;
        bf16x8 qf[8];
        {
            const bf16* qptr = PROJ + ((size_t)b * SEQ + qp) * INW + C_AQ + h * 128 + 8 * hh;
            const f32x4* rp = (const f32x4*)(ROPE + (((size_t)b * SEQ + qp) * 64 + 8 * hh) * 2);
#pragma unroll
            for (int s = 0; s < 4; ++s) { v4u x1 = *(const v4u*)(qptr + 16 * s), x2 = *(const v4u*)(qptr + 16 * s + 64);
                f32x4 cs[4];
#pragma unroll
                for (int k = 0; k < 4; ++k) cs[k] = rp[8 * s + k];
                rope8(x1, x2, cs); qf[s] = __builtin_bit_cast(bf16x8, x1); qf[s + 4] = __builtin_bit_cast(bf16x8, x2); }
        }
        float m = F.sink[h] * LOG2E, l = 1.f;
        f32x16 o[4];
#pragma unroll
        for (int d = 0; d < 4; ++d)
#pragma unroll
            for (int r = 0; r < 16; ++r) o[d][r] = 0.f;
        int j = 0; while (j < 5 && (q0 - 128 + 64 * j < 0 || q0 - 128 + 64 * j >= SEQ)) ++j;
        v4u kr[2], vr[2]; f32x4 kcs[4];
#define ATT_LOAD(jj) do { const int kb_ = q0 - 128 + 64 * (jj); \
            { const size_t t_ = (size_t)b * SEQ + kb_ + krow; const bf16* kp_ = PROJ + t_ * INW + C_AK + kvh * 128 + kc8 * 8; kr[0] = *(const v4u*)kp_; kr[1] = *(const v4u*)(kp_ + 64); \
              const f32x4* rp_ = (const f32x4*)(ROPE + (t_ * 64 + kc8 * 8) * 2); _Pragma("unroll") for (int k = 0; k < 4; ++k) kcs[k] = rp_[k]; } \
            _Pragma("unroll") for (int i = 0; i < 2; ++i) { const int idx = tid + 512 * i, row = idx >> 4, ch = idx & 15; \
                vr[i] = *(const v4u*)(PROJ + ((size_t)b * SEQ + kb_ + row) * INW + C_AV + kvh * 128 + ch * 8); } } while (0)
        if (j < 5) ATT_LOAD(j);
        while (j < 5) {
            const int kb = q0 - 128 + 64 * j;
            __syncthreads();
            rope8(kr[0], kr[1], kcs);
            *(LAS v4u*)(KT + krow * RS + kc8 * 16) = kr[0]; *(LAS v4u*)(KT + krow * RS + (kc8 + 8) * 16) = kr[1];
#pragma unroll
            for (int i = 0; i < 2; ++i) { const int idx = tid + 512 * i, row = idx >> 4, ch = idx & 15; *(LAS v4u*)(VT + row * RS + ch * 16) = vr[i]; }
            __syncthreads();
            int jn = j + 1; while (jn < 5 && (q0 - 128 + 64 * jn < 0 || q0 - 128 + 64 * jn >= SEQ)) ++jn;
            if (jn < 5) ATT_LOAD(jn);
            f32x16 p0, p1;
#pragma unroll
            for (int r = 0; r < 16; ++r) { p0[r] = 0.f; p1[r] = 0.f; }
#pragma unroll
            for (int s = 0; s < 8; ++s) { const bf16x8 k0 = ld8(KT + q32 * RS + (16 * s + 8 * hh) * 2), k1 = ld8(KT + (32 + q32) * RS + (16 * s + 8 * hh) * 2);
                p0 = MFMA32(k0, qf[s], p0); p1 = MFMA32(k1, qf[s], p1); }
            float tmax = -INFINITY;
#pragma unroll
            for (int r = 0; r < 16; ++r) { const int d0 = kb + crow(r, hh) - qp;
                p0[r] = ((unsigned)(d0 + 128) <= 256u) ? p0[r] * C2 : -INFINITY; p1[r] = ((unsigned)(d0 + 32 + 128) <= 256u) ? p1[r] * C2 : -INFINITY;
                tmax = fmaxf(tmax, fmaxf(p0[r], p1[r])); }
            tmax = fmaxf(tmax, __shfl_xor(tmax, 32));
            const float mn = fmaxf(m, tmax), alpha = __builtin_amdgcn_exp2f(m - mn); m = mn;
            float rs = 0.f;
#pragma unroll
            for (int r = 0; r < 16; ++r) { p0[r] = __builtin_amdgcn_exp2f(p0[r] - mn); p1[r] = __builtin_amdgcn_exp2f(p1[r] - mn); rs += p0[r] + p1[r]; }
            rs += __shfl_xor(rs, 32);
            l = l * alpha + rs;
            if (hh == 0) AL[q32] = alpha;
            LDS_WAIT();
#pragma unroll
            for (int g4 = 0; g4 < 4; ++g4) { const f32x4 a4 = *(const LAS f32x4*)(AL + 8 * g4 + 4 * hh);
#pragma unroll
                for (int d = 0; d < 4; ++d) { o[d][4 * g4 + 0] *= a4.x; o[d][4 * g4 + 1] *= a4.y; o[d][4 * g4 + 2] *= a4.z; o[d][4 * g4 + 3] *= a4.w; } }
#pragma unroll
            for (int kb2 = 0; kb2 < 2; ++kb2)
#pragma unroll
                for (int s = 0; s < 2; ++s) {
                    unsigned pw[4];
#pragma unroll
                    for (int k = 0; k < 4; ++k) pw[k] = kb2 ? cvtpk(p1[8 * s + 2 * k], p1[8 * s + 2 * k + 1]) : cvtpk(p0[8 * s + 2 * k], p0[8 * s + 2 * k + 1]);
                    const bf16x8 pa = __builtin_bit_cast(bf16x8, (v4u){pw[0], pw[1], pw[2], pw[3]});
#pragma unroll
                    for (int d = 0; d < 4; ++d) { const bf16x8 vf = tr8(VT + (32 * kb2 + 16 * s) * RS + 64 * d + tro32, 8 * RS); o[d] = MFMA32(pa, vf, o[d]); }
                }
            j = jn;
        }
#undef ATT_LOAD
        if (hh == 0) AL[q32] = 1.f / l;
        LDS_WAIT();
#pragma unroll
        for (int g4 = 0; g4 < 4; ++g4) { const f32x4 a4 = *(const LAS f32x4*)(AL + 8 * g4 + 4 * hh); const float av[4] = {a4.x, a4.y, a4.z, a4.w};
#pragma unroll
            for (int i = 0; i < 4; ++i) { const int r = 4 * g4 + i; const int qrow = q0 + 32 * (w & 1) + crow(r, hh);
                bf16* op = ATT + ((size_t)b * SEQ + qrow) * 1024 + h * 128 + q32;
#pragma unroll
                for (int d = 0; d < 4; ++d) op[32 * d] = f2bf(o[d][r] * av[i]); } }
        __syncthreads();
    }
}

#ifdef TESTMODE
__global__ void __launch_bounds__(256) k_rope(const bf16* __restrict__ PROJ, const float* __restrict__ rope, bf16* __restrict__ QR, bf16* __restrict__ KR) {
    const int gid = blockIdx.x * 256 + threadIdx.x;
    const int i = gid & 63, hh = (gid >> 6) % 10, t = gid / 640;
    const float cs = rope[((size_t)t * 64 + i) * 2], sn = rope[((size_t)t * 64 + i) * 2 + 1];
    const bf16* src = PROJ + (size_t)t * INW + (hh < 8 ? C_AQ + hh * 128 : C_AK + (hh - 8) * 128);
    const float x1 = bf2f(src[i]), x2 = bf2f(src[i + 64]);
    bf16* dst = hh < 8 ? QR + (size_t)t * 1024 + hh * 128 : KR + (size_t)t * 256 + (hh - 8) * 128;
    dst[i] = f2bf(x1 * cs - x2 * sn); dst[i + 64] = f2bf(x1 * sn + x2 * cs);
}
__global__ void __launch_bounds__(256) k_hgrn_naive(const bf16* __restrict__ PROJ, const float* __restrict__ lb, float* __restrict__ OF, float* __restrict__ OB) {
    __shared__ float qs[128], fs[128], ks[128], part[128];
    const int dir = blockIdx.x & 1, h = (blockIdx.x >> 1) & 7, b = blockIdx.x >> 4, tid = threadIdx.x, dv = tid & 127, half = tid >> 7;
    float S[64];
#pragma unroll
    for (int i = 0; i < 64; ++i) S[i] = 0.f;
    float* O = dir ? OB : OF;
    const float lbv = tid < 128 ? lb[dir * 1024 + h * 128 + tid] : 0.f;
    bf16 nzq = 0, nzf = 0, nv = 0;
    { const int t = dir ? SEQ - 1 : 0; const bf16* pr = PROJ + ((size_t)b * SEQ + t) * INW;
      if (tid < 128) { nzq = pr[C_HQ + h * 128 + tid]; nzf = pr[(dir ? C_FB : C_FF) + h * 128 + tid]; } nv = pr[C_HI + h * 128 + dv]; }
    for (int tp = 0; tp < SEQ; ++tp) {
        const int t = dir ? SEQ - 1 - tp : tp; const size_t row = (size_t)b * SEQ + t;
        const bf16 czq = nzq, czf = nzf, cv = nv;
        if (tp + 1 < SEQ) { const int t2 = dir ? SEQ - 2 - tp : tp + 1; const bf16* pr = PROJ + ((size_t)b * SEQ + t2) * INW;
            if (tid < 128) { nzq = pr[C_HQ + h * 128 + tid]; nzf = pr[(dir ? C_FB : C_FF) + h * 128 + tid]; } nv = pr[C_HI + h * 128 + dv]; }
        if (tid < 128) { const float zq = bf2f(czq), zf = bf2f(czf);
            const float f = lbv + (1.f - lbv) * sigmoidf_(zf); qs[tid] = siluf_(zq); fs[tid] = f; ks[tid] = 1.f - f; }
        const float v = bf2f(cv);
        __syncthreads();
        float acc = 0.f;
#pragma unroll
        for (int i = 0; i < 64; ++i) { const int dk = half * 64 + i; S[i] = fs[dk] * S[i] + ks[dk] * v; acc += S[i] * qs[dk]; }
        if (half == 1) part[dv] = acc;
        __syncthreads();
        if (half == 0) O[row * 1024 + h * 128 + dv] = acc + part[dv];
    }
}
__global__ void __launch_bounds__(256) k_hgrn_post(const float* __restrict__ OF, const float* __restrict__ OB, const bf16* __restrict__ PROJ, const float* __restrict__ onorm, bf16* __restrict__ YAIN) {
    const int w = blockIdx.x * 4 + (threadIdx.x >> 6), lane = threadIdx.x & 63, row = w >> 3, h = w & 7;
    const size_t o = (size_t)row * 1024 + h * 128;
    const float a0 = OF[o + lane] + OB[o + lane], a1 = OF[o + 64 + lane] + OB[o + 64 + lane];
    float ss = a0 * a0 + a1 * a1;
    for (int s = 32; s > 0; s >>= 1) ss += __shfl_xor(ss, s);
    const float r = rsqrtf(ss * (1.f / 128.f) + EPS);
    const bf16* pg = PROJ + (size_t)row * INW + C_HG + h * 128;
    YAIN[o + lane] = f2bf(a0 * r * onorm[h * 128 + lane] * siluf_(bf2f(pg[lane])));
    YAIN[o + 64 + lane] = f2bf(a1 * r * onorm[h * 128 + 64 + lane] * siluf_(bf2f(pg[64 + lane])));
}
__global__ void __launch_bounds__(256) k_attn_naive(const bf16* __restrict__ QR, const bf16* __restrict__ KR, const bf16* __restrict__ PROJ, const float* __restrict__ sink, bf16* __restrict__ ATT) {
    __shared__ float sl[4][264];
    const int wv = threadIdx.x >> 6, lane = threadIdx.x & 63;
    const int w = blockIdx.x * 4 + wv;
    const int i = w & 4095, h = (w >> 12) & 7, b = w >> 15, kvh = h >> 2;
    const size_t qrow = (size_t)b * SEQ + i;
    const float q0 = bf2f(QR[qrow * 1024 + h * 128 + 2 * lane]), q1 = bf2f(QR[qrow * 1024 + h * 128 + 2 * lane + 1]);
    const int jlo = i - 128 < 0 ? 0 : i - 128, jhi = i + 128 > SEQ - 1 ? SEQ - 1 : i + 128;
    const float sk = sink[h];
    float m = sk;
    for (int j = jlo; j <= jhi; ++j) {
        const bf16* kr = KR + ((size_t)b * SEQ + j) * 256 + kvh * 128;
        float p = q0 * bf2f(kr[2 * lane]) + q1 * bf2f(kr[2 * lane + 1]);
        for (int s = 32; s > 0; s >>= 1) p += __shfl_xor(p, s);
        p *= 0.08838834764831845f;
        if (lane == 0) sl[wv][j - jlo] = p;
        m = fmaxf(m, p);
    }
    __syncthreads();
    float den = expf(sk - m), o0 = 0.f, o1 = 0.f;
    for (int j = jlo; j <= jhi; ++j) {
        const float p = expf(sl[wv][j - jlo] - m); den += p;
        const bf16* vr = PROJ + ((size_t)b * SEQ + j) * INW + C_AV + kvh * 128;
        o0 += p * bf2f(vr[2 * lane]); o1 += p * bf2f(vr[2 * lane + 1]);
    }
    ATT[qrow * 1024 + h * 128 + 2 * lane] = f2bf(o0 / den); ATT[qrow * 1024 + h * 128 + 2 * lane + 1] = f2bf(o1 / den);
}
#endif
__global__ void __launch_bounds__(NWAVES * 64, 2) mega(Args args) {
    extern __shared__ __attribute__((aligned(16))) unsigned char lds[];
    Ctx F;
    F.lds = lds; F.tid = threadIdx.x; F.lane = F.tid & 63; F.wave = __builtin_amdgcn_readfirstlane(F.tid >> 6); F.G = gridDim.x;
    F.gw = blockIdx.x * NWAVES + F.wave; F.NGW = F.G * NWAVES;
    F.x = (const float*)args.in[0]; F.c = (const float*)args.in[1]; F.pos = (const int*)args.in[2]; F.w_ada = (const float*)args.in[3]; F.b_ada = (const float*)args.in[4];
    F.g_pre_mix = (const float*)args.in[5]; F.g_post_mix = (const float*)args.in[6]; F.g_pre_ffn = (const float*)args.in[7]; F.g_post_ffn = (const float*)args.in[8];
    F.w_in = (const float*)args.in[9]; F.lbl = (const float*)args.in[10]; F.onorm = (const float*)args.in[11]; F.sink = (const float*)args.in[12];
    F.w_a = (const float*)args.in[13]; F.w_b = (const float*)args.in[14]; F.w_o = (const float*)args.in[15]; F.w_router = (const float*)args.in[16];
    F.w_eg = (const float*)args.in[17]; F.w_eu = (const float*)args.in[18]; F.w_ed = (const float*)args.in[19];
    F.out = args.out; F.ws = args.ws;
    LAS unsigned char* ldsl = (LAS unsigned char*)lds;
    for (int u = F.tid; u < (LDS_BYTES - LDSCTL_OFF) / 4; u += NWAVES * 64) ((LAS unsigned*)(ldsl + LDSCTL_OFF))[u] = 0u;
    __syncthreads();
    volatile LAS unsigned* MISC = (volatile LAS unsigned*)(ldsl + MISC_OFF);
    XcdBarrier bar = xcd_barrier_post((unsigned*)(args.ws + WS_CTL) + CW_BAR + args.li * XCD_BAR_WORDS, MISC + 8);
    const int lo = args.ph_lo, hi = args.ph_hi;
#ifdef PROBE_REP
#define REP(k) ((((PROBE_REP) >> (k)) & 1) ? 2 : 1)
#else
#define REP(k) 1
#endif
#define IN(k) (lo <= (k) && (k) < hi)
#define SEAM(k) do { if (IN(k) && IN((k) + 1)) xcd_barrier(bar); } while (0)
    unsigned char* ws = args.ws;
    bf16* H = (bf16*)(ws + WS_H); bf16* PROJ = (bf16*)(ws + WS_PROJ); bf16* WIN = (bf16*)(ws + WS_WIN); bf16* WA = (bf16*)(ws + WS_WA); bf16* WB = (bf16*)(ws + WS_WB); bf16* WO = (bf16*)(ws + WS_WO);
    bf16* WGU = (bf16*)(ws + WS_WGU); bf16* WD = (bf16*)(ws + WS_WD); bf16* YAIN = (bf16*)(ws + WS_YAIN); bf16* ATT = (bf16*)(ws + WS_ATT); bf16* MERGED = (bf16*)(ws + WS_MERGED);
    float* Y = (float*)(ws + WS_Y); bf16* XE = (bf16*)(ws + WS_XE); bf16* ACT = (bf16*)(ws + WS_ACT); bf16* SLAB = (bf16*)(ws + WS_SLAB); const float* SELAFF = (const float*)(ws + WS_SELAFF);
    const int vcu = (F.G % 8 == 0) ? ((int)blockIdx.x % 8) * (F.G / 8) + (int)blockIdx.x / 8 : (int)blockIdx.x;

    {
    if (IN(0)) { p0_prep(F); __syncthreads(); } SEAM(0);
#if defined(PROBE_DUP) && PROBE_DUP == 0
    if (IN(0)) { p0_prep(F); __syncthreads(); } SEAM(0);
#endif
    }
    {
    if (IN(2)) {
        if (F.G == 256 && blockIdx.x >= 256 - CONV_BLOCKS) { float* scr = (float*)(F.lds + F.wave * 16384); TailSeq seq{I_MIX + P0_EXPERT_ITEMS + ((int)blockIdx.x - (256 - CONV_BLOCKS)) * NWAVES + F.wave, CONV_BLOCKS * NWAVES}; transpose_stream(F, seq, scr); }
        else {
            const int gg = F.G == 256 ? 256 - CONV_BLOCKS : F.G;
            pg8::Gemm g{H, WIN, T, INW, D / 2}; pg8::StaticOrder S; S.init(T, INW, gg, (int)blockIdx.x);
            pg8::EpiStore E{PROJ, INW, 0xffff, nullptr, 1.f / (W8S_IN * X8S_IN)};
            pg8::gemm_phase<pg8::EpiStore, pg8::StaticOrder, PG8_ALIGN, PG8_SP2, false, true>(ldsl + RING_OFF, g, S, E);
            if (F.G != 256 && blockIdx.x == 0) { float* scr = (float*)(F.lds + F.wave * 16384); TailSeq seq{I_MIX + P0_EXPERT_ITEMS + F.wave, NWAVES}; transpose_stream(F, seq, scr); }
        }
    } SEAM(2);
    }
    {
    if (IN(3)) { if (args.mask & 2) hgrn_a_phase(F, ldsl); } SEAM(3);
#if defined(PROBE_DUP) && PROBE_DUP == 3
    if (IN(3)) { if (args.mask & 2) hgrn_a_phase(F, ldsl); } SEAM(3);
#endif
    }
    {
    if (IN(4)) { if (args.mask & 2) hgrn_scan_phase(F); if (args.mask & 1) attn_phase(F, ldsl); } SEAM(4);
#if defined(PROBE_DUP) && PROBE_DUP == 4
    if (IN(4)) { if (args.mask & 2) hgrn_scan_phase(F); if (args.mask & 1) attn_phase(F, ldsl); } SEAM(4);
#endif
    }
    {
    if (IN(5)) { if (args.mask & 2) hgrn_c_phase(F, ldsl); } SEAM(5);
#if defined(PROBE_DUP) && PROBE_DUP == 5
    if (IN(5)) { if (args.mask & 2) hgrn_c_phase(F, ldsl); } SEAM(5);
#endif
    }
    {
    if (IN(6)) {
        static_assert(WS_ATT == WS_YAIN + 16 * MiB && WS_WB == WS_WA + 4 * MiB, "branch operands must be contiguous");
        pg8::Gemm g{YAIN, WA, 2 * T, 2 * D, 1024}; pg8::BranchOrder S; S.S.init(T, D, F.G, (int)blockIdx.x);
        pg8::EpiGate2 E{MERGED, D, PROJ + C_GA, PROJ + C_GB, INW};
        pg8::gemm_phase<pg8::EpiGate2, pg8::BranchOrder, PG8_ALIGN, PG8_SP2>(ldsl + RING_OFF, g, S, E);
    } SEAM(6);
    }
    {
    if (IN(7)) {
        pg8::Gemm g{MERGED, WO, T, D, D}; pg8::StaticOrder S; S.init(T, D, F.G, (int)blockIdx.x);
        pg8::EpiStore E{(bf16*)Y, D, 0xffff, nullptr};
        pg8::gemm_phase<pg8::EpiStore, pg8::StaticOrder, PG8_ALIGN, PG8_SP2>(ldsl + RING_OFF, g, S, E);
    } SEAM(7);
#if defined(PROBE_DUP) && PROBE_DUP == 7
    if (IN(7)) {
        pg8::Gemm g{MERGED, WO, T, D, D}; pg8::StaticOrder S; S.init(T, D, F.G, (int)blockIdx.x);
        pg8::EpiStore E{(bf16*)Y, D, 0xffff, nullptr};
        pg8::gemm_phase<pg8::EpiStore, pg8::StaticOrder, PG8_ALIGN, PG8_SP2>(ldsl + RING_OFF, g, S, E);
    } SEAM(7);
#endif
    }
    {
    if (IN(8)) { p6_post1(F); } SEAM(8);
#if defined(PROBE_DUP) && PROBE_DUP == 8
    if (IN(8)) { p6_post1(F); } SEAM(8);
#endif
    }
    {
    if (IN(9)) { p7_topk_gather(F); } SEAM(9);
#if defined(PROBE_DUP) && PROBE_DUP == 9
    if (IN(9)) { p7_topk_gather(F); } SEAM(9);
#endif
    }
    {
    if (IN(10)) {
        pg8::Gemm g{(const bf16*)(ws + WS_H2), WGU, 16 * 1024, 16 * 2048, D / 2, (const int*)(ws + WS_GIDX)}; pg8::GroupedOrder S{F.G, vcu};
        pg8::EpiSwiglu8 E{(unsigned char*)ACT, 1.f / W8S_GU};
        pg8::gemm_phase<pg8::EpiSwiglu8, pg8::GroupedOrder, PG8_ALIGN, PG8_SP2, true, true>(ldsl + RING_OFF, g, S, E);
    } SEAM(10);
    }
    {
    if (IN(11)) {
        pg8::Gemm g{ACT, WD, 16 * 1024, 16 * 2048, 1024 / 2}; pg8::GroupedOrder S{F.G, vcu};
        pg8::EpiStore E{SLAB, D, 7, SELAFF, 1.f / W8S_D};
        pg8::gemm_phase<pg8::EpiStore, pg8::GroupedOrder, PG8_ALIGN, PG8_SP2, false, true>(ldsl + RING_OFF, g, S, E);
    } SEAM(11);
    }
    {
    if (IN(12)) { p10_final(F); }
    }
#undef IN
#undef SEAM
}

extern "C" void kernel_launch(void* const* d_in, const int* in_sizes, int n_in, void* d_out, int out_size, void* d_ws, size_t ws_size, hipStream_t stream) {
    static int grid = 0;
    if (grid == 0) {
        if (n_in != 20 || ws_size < WS_END) { fprintf(stderr, "kernel_launch: unexpected n_in %d or ws_size %zu\n", n_in, ws_size); grid = -1; return; }
        int dev = 0, cus = 0;
        if (hipGetDevice(&dev) != hipSuccess || hipDeviceGetAttribute(&cus, hipDeviceAttributeMultiprocessorCount, dev) != hipSuccess) { grid = -1; return; }
        if (hipFuncSetAttribute((const void*)mega, hipFuncAttributeMaxDynamicSharedMemorySize, LDS_BYTES) != hipSuccess) { fprintf(stderr, "kernel_launch: hipFuncSetAttribute failed\n"); grid = -1; return; }
        grid = cus;
    }
    if (grid < 0) return;
    char* ws = (char*)d_ws;
    (void)hipMemsetAsync(ws + WS_CTL, 0, CTL_ZERO_BYTES, stream);
    Args a{};
    for (int i = 0; i < 20; ++i) a.in[i] = d_in[i];
    a.out = (float*)d_out; a.ws = (unsigned char*)d_ws;
#ifndef TESTMODE
    a.ph_lo = 0; a.ph_hi = 13; a.li = 0; a.mask = 3;
#ifdef PROBE_REPEAT
    a.rep = PROBE_REPEAT;
#else
    a.rep = -1;
#endif
    hipLaunchKernelGGL(mega, dim3(grid), dim3(NWAVES * 64), LDS_BYTES, stream, a);
#ifdef PROBE_LO
    a.ph_lo = PROBE_LO; a.ph_hi = PROBE_HI; a.li = 1; a.mask = PROBE_MASK;
    hipLaunchKernelGGL(mega, dim3(grid), dim3(NWAVES * 64), LDS_BYTES, stream, a);
#endif
#else
    const float* LB = (const float*)(ws + WS_LB); const float* ROPE = (const float*)(ws + WS_ROPE);
    bf16* PROJ = (bf16*)(ws + WS_PROJ); bf16* QR = (bf16*)(ws + WS_QR); bf16* KR = (bf16*)(ws + WS_KR); bf16* YAIN = (bf16*)(ws + WS_YAIN); bf16* ATT = (bf16*)(ws + WS_ATT);
    float* OF = (float*)(ws + WS_CS); float* OB = (float*)(ws + WS_CS + 32 * MiB);
    a.ph_lo = 0; a.ph_hi = 3; a.li = 0; a.mask = 3;
    hipLaunchKernelGGL(mega, dim3(grid), dim3(NWAVES * 64), LDS_BYTES, stream, a);
#if TESTMODE == 1
    k_hgrn_naive<<<32, 256, 0, stream>>>(PROJ, LB, OF, OB);
    k_hgrn_post<<<T * 8 / 4, 256, 0, stream>>>(OF, OB, PROJ, (const float*)d_in[11], YAIN);
    a.ph_lo = 3; a.ph_hi = 6; a.li = 1; a.mask = 1;
    hipLaunchKernelGGL(mega, dim3(grid), dim3(NWAVES * 64), LDS_BYTES, stream, a);
#else
    k_rope<<<T * 640 / 256, 256, 0, stream>>>(PROJ, ROPE, QR, KR);
    k_attn_naive<<<BATCH * 8 * SEQ / 4, 256, 0, stream>>>(QR, KR, PROJ, (const float*)d_in[12], ATT);
    a.ph_lo = 3; a.ph_hi = 6; a.li = 1; a.mask = 2;
    hipLaunchKernelGGL(mega, dim3(grid), dim3(NWAVES * 64), LDS_BYTES, stream, a);
#endif
    a.ph_lo = 6; a.ph_hi = 13; a.li = 2; a.mask = 3;
    hipLaunchKernelGGL(mega, dim3(grid), dim3(NWAVES * 64), LDS_BYTES, stream, a);
#endif
}
```

```cpp
#include <hip/hip_runtime.h>
#include <cstdint>
#include <cstdio>

constexpr int D = 2048, BATCH = 2, SEQ = 4096, T = BATCH * SEQ;
constexpr int INW = 10752;
constexpr int C_HQ = 0, C_FF = 1024, C_FB = 2048, C_HI = 3072, C_HG = 4096, C_AQ = 5120, C_AK = 6144, C_AV = 6400, C_GA = 6656, C_GB = 8704;
constexpr int NE = 16, EFF = 1024, CAP = 512;
constexpr float EPS = 1e-6f;

typedef unsigned short bf16;
__device__ __forceinline__ float bf2f(bf16 v) { return __uint_as_float(((unsigned)v) << 16); }
typedef float f32x2h_t __attribute__((ext_vector_type(2))); typedef __bf16 bf16x2h_t __attribute__((ext_vector_type(2)));
__device__ __forceinline__ unsigned cvtpk2(float lo, float hi) { const f32x2h_t v = {lo, hi}; const bf16x2h_t b = __builtin_convertvector(v, bf16x2h_t); return __builtin_bit_cast(unsigned, b); }
__device__ __forceinline__ bf16 f2bf(float f) { return (bf16)(cvtpk2(f, 0.f) & 0xffffu); }
__device__ __forceinline__ float sigmoidf_(float x) { return __builtin_amdgcn_rcpf(1.f + __expf(-x)); }
__device__ __forceinline__ float siluf_(float x) { return x * __builtin_amdgcn_rcpf(1.f + __expf(-x)); }

constexpr size_t MiB = 1u << 20;
constexpr size_t WS_CTL = 0, CTL_ZERO_BYTES = 64 * 1024;
constexpr size_t WS_MOD = 1 * MiB;
constexpr size_t WS_LB = WS_MOD + 128 * 1024;
constexpr size_t WS_MODP = WS_MOD + 256 * 1024;
constexpr size_t WS_AFF = 2 * MiB;
constexpr size_t WS_GIDX = 3 * MiB;
constexpr size_t WS_SELAFF = WS_GIDX + 128 * 1024;
constexpr size_t WS_TOKSLOT = 4 * MiB;
constexpr size_t WS_DEC = 5 * MiB;
constexpr size_t WS_ROPE = 8 * MiB;
constexpr size_t WS_WIN = 16 * MiB;
constexpr size_t WS_WA = 60 * MiB, WS_WB = 64 * MiB, WS_WO = 68 * MiB;
constexpr size_t WS_WGU = 76 * MiB;
constexpr size_t WS_WD = 204 * MiB;
constexpr size_t WS_H = 268 * MiB;
constexpr size_t WS_PROJ = 300 * MiB;
constexpr size_t WS_Y = 520 * MiB;
constexpr size_t WS_XE = 300 * MiB;
constexpr size_t WS_ACT = 364 * MiB;
constexpr size_t WS_SLAB = 396 * MiB;
constexpr size_t WS_QR = 468 * MiB, WS_KR = 484 * MiB;
constexpr size_t WS_YAIN = 488 * MiB, WS_ATT = 504 * MiB;
constexpr size_t WS_CS = 520 * MiB;
constexpr size_t WS_STATE = 584 * MiB;
constexpr size_t WS_H2 = 584 * MiB;
constexpr size_t WS_MERGED = 268 * MiB;
constexpr size_t WS_END = 648 * MiB;
constexpr int CW_BAR = 4096;

namespace pg8 {
#define PG8_LAS __attribute__((address_space(3)))
typedef unsigned short bf16_t;
typedef short bf16x8 __attribute__((ext_vector_type(8)));
typedef float f32x4 __attribute__((ext_vector_type(4)));
typedef unsigned u32x4 __attribute__((ext_vector_type(4)));
constexpr int BM = 256, BK = 64, HALF = 128, HTB = HALF * BK * 2  , STAGE_BYTES = 8 * HTB, NXCD = 8, WGM = 8;

__host__ __device__ __forceinline__ int lds_byte(int r, int c) { const int st = (r >> 4) * 2 + (c >> 5), rr = r & 15, cc = c & 31, ob = rr * 64 + cc * 2; return st * 1024 + (ob ^ (((ob >> 9) & 1) << 5)); }
__host__ __device__ __forceinline__ void stage_rc(int b, int& R, int& C) { const int st = b / 1024, sb = b % 1024, swz = sb ^ (((sb >> 9) & 1) << 5); R = (st >> 1) * 16 + swz / 64; C = (st & 1) * 32 + (swz % 64) / 2; }
__host__ __device__ __forceinline__ int perm32(int rho) { const int n = rho >> 4, i = rho & 15; return 8 * (i >> 2) + 4 * n + (i & 3); }

struct Unit { int pm, pn; };
struct Gemm { const bf16_t* A; const bf16_t* Bt; int M, N, K; const int* gidx = nullptr; };

struct StaticOrder {
    int nM, nN, nwg, G, c;
    __host__ __device__ void init(int M, int N, int G_, int c_) { nM = M / BM; nN = N / BM; nwg = nM * nN; G = G_; c = c_; }
    __host__ __device__ bool next(int i, Unit& u) const {
        const long L = (long)i * G + c; if (L >= nwg) return false;
        int wgid = (int)L; { const int q = nwg / NXCD, r = nwg % NXCD, xcd = wgid % NXCD, off = wgid / NXCD; wgid = (xcd < r ? xcd * (q + 1) : r * (q + 1) + (xcd - r) * q) + off; }
        const int nig = WGM * nN, gid = wgid / nig, fm = gid * WGM, gsz = (nM - fm) < WGM ? (nM - fm) : WGM;
        u.pm = fm + ((wgid % nig) % gsz); u.pn = (wgid % nig) / gsz; return true;
    }
    __device__ __forceinline__ void a_ready(const Unit&) const {}
    __device__ __forceinline__ void done(const Unit&) const {}
};

typedef float f32x2c_t __attribute__((ext_vector_type(2))); typedef __bf16 bf16x2c_t __attribute__((ext_vector_type(2)));
__device__ __forceinline__ unsigned cvt_pk_bf16(float lo, float hi) { const f32x2c_t v = {lo, hi}; const bf16x2c_t b = __builtin_convertvector(v, bf16x2c_t); return __builtin_bit_cast(unsigned, b); }
typedef float f32x2 __attribute__((ext_vector_type(2)));

typedef unsigned u32x2 __attribute__((ext_vector_type(2)));
__device__ __forceinline__ unsigned pk4_fp8(float a, float b, float c, float d) { int w = __builtin_amdgcn_cvt_pk_fp8_f32(a, b, 0, false); w = __builtin_amdgcn_cvt_pk_fp8_f32(c, d, w, true); return (unsigned)w; }
__device__ __forceinline__ float sigm(float x) { return __builtin_amdgcn_rcpf(1.f + __expf(-x)); }
struct EpiStore {
    static constexpr bool PERM = true, AFTER_DRAIN = false, KEEPS = false;
    bf16_t* O; int ldc; int cmask; const float* rowscale; float osc = 1.f; bool f8 = false;
    int xq = -1000, xf = -1000;
    __device__ __forceinline__ void operator()(const f32x4 (&acc)[2][2][4][2], const Unit& u, int wr, int wc, int fr, int fq) const {
        const int row0 = u.pm * BM + wr * 64 + fr, col0 = (u.pn & cmask) * BM + wc * 32 + 8 * fq;
        const int mode = (u.pn >= xq && u.pn < xq + 4) ? 1 : (u.pn >= xf && u.pn < xf + 8) ? 2 : 0;
        float scv[8];
#pragma unroll
        for (int q = 0; q < 8; ++q) scv[q] = (rowscale ? rowscale[row0 + (q >> 2) * HALF + (q & 3) * 16] : 1.f) * osc;
#pragma unroll
        for (int ai = 0; ai < 2; ++ai)
#pragma unroll
            for (int m = 0; m < 4; ++m) { const int row = row0 + ai * HALF + m * 16; const float sc = scv[ai * 4 + m]; bf16_t* rowp = O + (size_t)row * ldc + col0;
#pragma unroll
                for (int bj = 0; bj < 2; ++bj) { f32x4 v0 = acc[ai][bj][m][0] * sc, v1 = acc[ai][bj][m][1] * sc;
                    if (mode == 1) {
#pragma unroll
                        for (int i = 0; i < 4; ++i) { v0[i] *= sigm(v0[i]); v1[i] *= sigm(v1[i]); } }
                    else if (mode == 2) {
#pragma unroll
                        for (int i = 0; i < 4; ++i) { v0[i] = __expf(fminf(-v0[i], 80.f)); v1[i] = __expf(fminf(-v1[i], 80.f)); } }
                    if (f8) { u32x2 w8; w8.x = pk4_fp8(v0[0], v0[1], v0[2], v0[3]); w8.y = pk4_fp8(v1[0], v1[1], v1[2], v1[3]); *(u32x2*)((unsigned char*)O + (size_t)row * ldc + col0 + bj * HALF) = w8; }
                    else { u32x4 w; w.x = cvt_pk_bf16(v0[0], v0[1]); w.y = cvt_pk_bf16(v0[2], v0[3]); w.z = cvt_pk_bf16(v1[0], v1[1]); w.w = cvt_pk_bf16(v1[2], v1[3]);
                    *(u32x4*)(rowp + bj * HALF) = w; } } }
    }
};
struct EpiGate2 {
    static constexpr bool PERM = true, AFTER_DRAIN = false, KEEPS = true;
    bf16_t* O; int ldc; const bf16_t* Ga; const bf16_t* Gb; int ldg;
    __device__ __forceinline__ bool first(const Unit& u) const { return u.pm < 32; }
    __device__ __forceinline__ void scale(f32x4 (&acc)[2][2][4][2], const Unit& u, int wr, int wc, int fr, int fq) const {
        const int row0 = (u.pm & 31) * BM + wr * 64 + fr, col0 = (u.pn & 7) * BM + wc * 32 + 8 * fq;
        u32x4 acur[2], bcur[2], anxt[2], bnxt[2];
#define EG2_LOADS(ad, bd, q) do { const int row_ = row0 + ((q) >> 2) * HALF + ((q) & 3) * 16; _Pragma("unroll") for (int bj = 0; bj < 2; ++bj) { \
            ad[bj] = *(const u32x4*)(Ga + (size_t)row_ * ldg + col0 + bj * HALF); bd[bj] = *(const u32x4*)(Gb + (size_t)row_ * ldg + col0 + bj * HALF); } } while (0)
        EG2_LOADS(acur, bcur, 0);
#pragma unroll
        for (int q = 0; q < 8; ++q) { const int ai = q >> 2, m = q & 3;
            if (q < 7) EG2_LOADS(anxt, bnxt, q + 1);
#pragma unroll
            for (int bj = 0; bj < 2; ++bj) { const u32x4 ga = acur[bj], gb = bcur[bj];
                const float xa[8] = {__uint_as_float(ga.x << 16), __uint_as_float(ga.x & 0xffff0000u), __uint_as_float(ga.y << 16), __uint_as_float(ga.y & 0xffff0000u),
                                     __uint_as_float(ga.z << 16), __uint_as_float(ga.z & 0xffff0000u), __uint_as_float(ga.w << 16), __uint_as_float(ga.w & 0xffff0000u)};
                const float xb[8] = {__uint_as_float(gb.x << 16), __uint_as_float(gb.x & 0xffff0000u), __uint_as_float(gb.y << 16), __uint_as_float(gb.y & 0xffff0000u),
                                     __uint_as_float(gb.z << 16), __uint_as_float(gb.z & 0xffff0000u), __uint_as_float(gb.w << 16), __uint_as_float(gb.w & 0xffff0000u)};
#pragma unroll
                for (int i = 0; i < 4; ++i) { acc[ai][bj][m][0][i] *= sigm(xa[i]) * (1.f + __expf(fminf(-xb[i], 80.f))); acc[ai][bj][m][1][i] *= sigm(xa[4 + i]) * (1.f + __expf(fminf(-xb[4 + i], 80.f))); } }
            asm volatile("" ::: "memory");
#pragma unroll
            for (int bj = 0; bj < 2; ++bj) { acur[bj] = anxt[bj]; bcur[bj] = bnxt[bj]; } }
#undef EG2_LOADS
    }
    __device__ __forceinline__ void operator()(const f32x4 (&acc)[2][2][4][2], const Unit& u, int wr, int wc, int fr, int fq) const {
        const int row0 = (u.pm & 31) * BM + wr * 64 + fr, col0 = (u.pn & 7) * BM + wc * 32 + 8 * fq;
        u32x4 gcur[2], gnxt[2];
#define EG2_LOAD(gd, q) do { const int row_ = row0 + ((q) >> 2) * HALF + ((q) & 3) * 16; _Pragma("unroll") for (int bj = 0; bj < 2; ++bj) gd[bj] = *(const u32x4*)(Gb + (size_t)row_ * ldg + col0 + bj * HALF); } while (0)
        EG2_LOAD(gcur, 0);
#pragma unroll
        for (int q = 0; q < 8; ++q) { const int ai = q >> 2, m = q & 3, row = row0 + ai * HALF + m * 16;
            if (q < 7) EG2_LOAD(gnxt, q + 1);
#pragma unroll
            for (int bj = 0; bj < 2; ++bj) { const int col = col0 + bj * HALF; const u32x4 g = gcur[bj];
                const float gg[8] = {__uint_as_float(g.x << 16), __uint_as_float(g.x & 0xffff0000u), __uint_as_float(g.y << 16), __uint_as_float(g.y & 0xffff0000u),
                                     __uint_as_float(g.z << 16), __uint_as_float(g.z & 0xffff0000u), __uint_as_float(g.w << 16), __uint_as_float(g.w & 0xffff0000u)};
                const f32x4 a0 = acc[ai][bj][m][0], a1 = acc[ai][bj][m][1];
                float o[8];
#pragma unroll
                for (int i = 0; i < 4; ++i) { o[i] = sigm(gg[i]) * a0[i]; o[4 + i] = sigm(gg[4 + i]) * a1[i]; }
                u32x4 w; w.x = cvt_pk_bf16(o[0], o[1]); w.y = cvt_pk_bf16(o[2], o[3]); w.z = cvt_pk_bf16(o[4], o[5]); w.w = cvt_pk_bf16(o[6], o[7]);
                *(u32x4*)(O + (size_t)row * ldc + col) = w; }
#pragma unroll
            for (int bj = 0; bj < 2; ++bj) gcur[bj] = gnxt[bj]; }
#undef EG2_LOAD
    }
};
struct BranchOrder {
    StaticOrder S;
    __device__ __forceinline__ bool next(int i, Unit& u) const { Unit t; if (!S.next(i >> 1, t)) return false; u.pm = t.pm + 32 * (i & 1); u.pn = t.pn + 8 * (i & 1); return true; }
    __device__ __forceinline__ void a_ready(const Unit&) const {}
    __device__ __forceinline__ void done(const Unit&) const {}
};
struct EpiF32 {
    static constexpr bool PERM = true, AFTER_DRAIN = false, KEEPS = false;
    float* O; int ldc;
    __device__ __forceinline__ void operator()(const f32x4 (&acc)[2][2][4][2], const Unit& u, int wr, int wc, int fr, int fq) const {
        const int row0 = u.pm * BM + wr * 64 + fr, col0 = u.pn * BM + wc * 32 + 8 * fq;
#pragma unroll
        for (int ai = 0; ai < 2; ++ai)
#pragma unroll
            for (int m = 0; m < 4; ++m) { float* rowp = O + (size_t)(row0 + ai * HALF + m * 16) * ldc + col0;
#pragma unroll
                for (int bj = 0; bj < 2; ++bj) { *(f32x4*)(rowp + bj * HALF) = acc[ai][bj][m][0]; *(f32x4*)(rowp + bj * HALF + 4) = acc[ai][bj][m][1]; } }
    }
};
struct EpiSwiglu8 {
    static constexpr bool PERM = true, AFTER_DRAIN = false, KEEPS = false;
    unsigned char* O; float isc;
    __device__ __forceinline__ void operator()(const f32x4 (&acc)[2][2][4][2], const Unit& u, int wr, int wc, int fr, int fq) const {
        const int row0 = u.pm * BM + wr * 64 + fr, col0 = (u.pn & 7) * HALF + wc * 32 + 8 * fq;
#pragma unroll
        for (int ai = 0; ai < 2; ++ai)
#pragma unroll
            for (int m = 0; m < 4; ++m) { unsigned char* rowp = O + (size_t)(row0 + ai * HALF + m * 16) * 1024 + col0;
                float o[8];
#pragma unroll
                for (int n = 0; n < 2; ++n)
#pragma unroll
                    for (int i = 0; i < 4; ++i) { const float g = acc[ai][0][m][n][i] * isc, up = acc[ai][1][m][n][i] * isc; o[4 * n + i] = g * sigm(g) * up; }
                u32x2 w; w.x = pk4_fp8(o[0], o[1], o[2], o[3]); w.y = pk4_fp8(o[4], o[5], o[6], o[7]);
                *(u32x2*)rowp = w; }
    }
};
struct EpiSwiglu {
    static constexpr bool PERM = true, AFTER_DRAIN = false, KEEPS = false;
    bf16_t* O;
    __device__ __forceinline__ void operator()(const f32x4 (&acc)[2][2][4][2], const Unit& u, int wr, int wc, int fr, int fq) const {
        const int row0 = u.pm * BM + wr * 64 + fr, col0 = (u.pn & 7) * HALF + wc * 32 + 8 * fq;
#pragma unroll
        for (int ai = 0; ai < 2; ++ai)
#pragma unroll
            for (int m = 0; m < 4; ++m) { bf16_t* rowp = O + (size_t)(row0 + ai * HALF + m * 16) * 1024 + col0;
                float o[8];
#pragma unroll
                for (int n = 0; n < 2; ++n)
#pragma unroll
                    for (int i = 0; i < 4; ++i) { const float g = acc[ai][0][m][n][i], up = acc[ai][1][m][n][i]; o[4 * n + i] = g * sigm(g) * up; }
                u32x4 w; w.x = cvt_pk_bf16(o[0], o[1]); w.y = cvt_pk_bf16(o[2], o[3]); w.z = cvt_pk_bf16(o[4], o[5]); w.w = cvt_pk_bf16(o[6], o[7]);
                *(u32x4*)rowp = w; }
    }
};
struct GroupedOrder {
    int G, c;
    __device__ __forceinline__ bool next(int i, Unit& u) const { const int L = i * G + c; if (L >= 512) return false; const int e = L >> 5, r = L & 31; u.pm = e * 4 + (r & 3); u.pn = e * 8 + (r >> 2); return true; }
    __device__ __forceinline__ void a_ready(const Unit&) const {}
    __device__ __forceinline__ void done(const Unit&) const {}
};

typedef int v8i32 __attribute__((ext_vector_type(8)));
typedef int v4i32 __attribute__((ext_vector_type(4)));
__device__ __forceinline__ void mfma_f8(f32x4& acc, const v8i32& a, const v8i32& b, int sc) {
    asm volatile("v_mfma_scale_f32_16x16x128_f8f6f4 %0, %1, %2, %0, %3, %3 op_sel_hi:[0,0,0]" : "+v"(acc) : "v"(a), "v"(b), "v"(sc));
}
template <class Epi, class Sched, bool ALIGN_EPI = false, bool SP2 = false, bool GATHER = false, bool FP8 = false>
__device__ __forceinline__ void gemm_phase(PG8_LAS unsigned char* lds, const Gemm g, const Sched& S, const Epi& E) {
    const int tid = threadIdx.x, wid = __builtin_amdgcn_readfirstlane(tid >> 6), lane = tid & 63, wr = wid >> 2, wc = wid & 3, fr = lane & 15, fq = lane >> 4;
    const int K = g.K, nt = K / BK;
    unsigned voffA[2], voffB[2]; int Rr[2], Cc[2];
#pragma unroll
    for (int i = 0; i < 2; ++i) { int R, C; stage_rc(tid * 16 + i * 8192, R, C); const int Rb = Epi::PERM ? ((R & ~31) + perm32(R & 31)) : R; Rr[i] = R; Cc[i] = C;
        voffA[i] = (unsigned)(R * K + C) * 2u; voffB[i] = (unsigned)(Rb * K + C) * 2u; }
    unsigned cv0[2], cv1[2], nv0[2], nv1[2], sv0[2], sv1[2];
#define PG8_GOFF(o0, o1, pm_) do { _Pragma("unroll") for (int _i = 0; _i < 2; ++_i) { \
        o0[_i] = (unsigned)(g.gidx[(pm_) * BM + Rr[_i]] * K + Cc[_i]) * 2u; o1[_i] = (unsigned)(g.gidx[(pm_) * BM + HALF + Rr[_i]] * K + Cc[_i]) * 2u; } } while (0)
    const size_t kstep = (size_t)(BK * 2);
    const size_t hstep = (size_t)HALF * K * 2;
    const size_t tstep = 2 * hstep;
    const unsigned ldsw = (unsigned)wid * 1024u;
    const int aoff = FP8 ? lds_byte(wr * 64 + fr, fq * 16) : lds_byte(wr * 64 + fr, fq * 8), boff = FP8 ? lds_byte(wc * 32 + fr, fq * 16) : lds_byte(wc * 32 + fr, fq * 8);
#define PG8_SA(b, h) (((b) * 2 + (h)) * HTB)
#define PG8_SB(b, h) ((4 + (b) * 2 + (h)) * HTB)
#define PG8_STAGE(bufoff, gbase, voff) do { _Pragma("unroll") for (int _i = 0; _i < 2; ++_i) \
        __builtin_amdgcn_global_load_lds((const unsigned*)((const char*)(gbase) + (voff)[_i]), (PG8_LAS unsigned*)(lds + (bufoff) + ldsw + _i * 8192), 16, 0, 0); } while (0)
#define PG8_LDA(dst, b, h) do { if constexpr (FP8) { _Pragma("unroll") for (int m = 0; m < 4; ++m) { const PG8_LAS unsigned char* p_ = lds + PG8_SA(b, h) + aoff + m * 2048; \
            const v4i32 lo_ = *(const PG8_LAS v4i32*)p_, hi_ = *(const PG8_LAS v4i32*)(p_ + 16); dst##8[m] = __builtin_shufflevector(lo_, hi_, 0, 1, 2, 3, 4, 5, 6, 7); } } \
        else { _Pragma("unroll") for (int m = 0; m < 4; ++m) _Pragma("unroll") for (int k = 0; k < 2; ++k) dst[m][k] = *(const PG8_LAS bf16x8*)(lds + PG8_SA(b, h) + aoff + m * 2048 + k * 1024); } } while (0)
#define PG8_LDB(dst, b, h) do { if constexpr (FP8) { _Pragma("unroll") for (int n = 0; n < 2; ++n) { const PG8_LAS unsigned char* p_ = lds + PG8_SB(b, h) + boff + n * 2048; \
            const v4i32 lo_ = *(const PG8_LAS v4i32*)p_, hi_ = *(const PG8_LAS v4i32*)(p_ + 16); dst##8[n] = __builtin_shufflevector(lo_, hi_, 0, 1, 2, 3, 4, 5, 6, 7); } } \
        else { _Pragma("unroll") for (int n = 0; n < 2; ++n) _Pragma("unroll") for (int k = 0; k < 2; ++k) dst[n][k] = *(const PG8_LAS bf16x8*)(lds + PG8_SB(b, h) + boff + n * 2048 + k * 1024); } } while (0)
#define PG8_MMA(ai, bj, At, Bt) do { __builtin_amdgcn_s_setprio(1); \
        if constexpr (FP8) { _Pragma("unroll") for (int m = 0; m < 4; ++m) _Pragma("unroll") for (int n = 0; n < 2; ++n) \
            mfma_f8(acc[ai][bj][m][n], Bt##8[n], At##8[m], f8one); } \
        else { _Pragma("unroll") for (int m = 0; m < 4; ++m) _Pragma("unroll") for (int n = 0; n < 2; ++n) _Pragma("unroll") for (int k = 0; k < 2; ++k) \
            acc[ai][bj][m][n] = __builtin_amdgcn_mfma_f32_16x16x32_bf16(Bt[n][k], At[m][k], acc[ai][bj][m][n], 0, 0, 0); } \
        __builtin_amdgcn_s_setprio(0); } while (0)
#define PG8_WAIT_V(n) asm volatile("s_waitcnt vmcnt(" #n ")" ::: "memory")
#define PG8_WAIT_L(n) asm volatile("s_waitcnt lgkmcnt(" #n ")" ::: "memory")
#define PG8_BAR __builtin_amdgcn_s_barrier()
#define PG8_SCHED __builtin_amdgcn_sched_barrier(0)
    Unit cur, nxt; int ui = 0;
    if (!S.next(0, cur)) return;
    if constexpr (GATHER) { PG8_GOFF(cv0, cv1, cur.pm); }
    else {
#pragma unroll
        for (int i = 0; i < 2; ++i) { cv0[i] = voffA[i]; cv1[i] = voffA[i] + (unsigned)(HALF * K * 2); } }
    f32x4 acc[2][2][4][2];
#pragma unroll
    for (int a = 0; a < 2; ++a)
#pragma unroll
        for (int b = 0; b < 2; ++b)
#pragma unroll
            for (int m = 0; m < 4; ++m)
#pragma unroll
                for (int n = 0; n < 2; ++n) acc[a][b][m][n] = (f32x4){0.f, 0.f, 0.f, 0.f};
    bf16x8 At[4][2], B0[2][2], B1[2][2]; v8i32 At8[4], B08[2], B18[2]; int f8one = 0x7f7f7f7f; asm volatile("" : "+v"(f8one));
    const char* cA = (const char*)g.A + (GATHER ? (size_t)0 : (size_t)cur.pm * tstep); const char* cB = (const char*)g.Bt + (size_t)cur.pn * tstep;
    S.a_ready(cur);
    if constexpr (SP2) {
        PG8_STAGE(PG8_SB(0, 0), cB, voffB); PG8_STAGE(PG8_SB(0, 1), cB + hstep, voffB); PG8_STAGE(PG8_SA(0, 0), cA, cv0); PG8_STAGE(PG8_SA(0, 1), cA, cv1);
        if (wr == 1) PG8_BAR;
        PG8_WAIT_V(2); PG8_BAR;
        PG8_STAGE(PG8_SB(1, 0), cB + kstep, voffB); PG8_STAGE(PG8_SA(1, 0), cA + kstep, cv0); PG8_STAGE(PG8_SB(1, 1), cB + hstep + kstep, voffB);
        PG8_WAIT_V(6); PG8_BAR;
    } else {
        PG8_STAGE(PG8_SB(0, 0), cB, voffB); PG8_STAGE(PG8_SA(0, 0), cA, cv0); PG8_STAGE(PG8_SB(0, 1), cB + hstep, voffB); PG8_STAGE(PG8_SA(0, 1), cA, cv1);
        if (wr == 1) PG8_BAR;
        PG8_WAIT_V(4); PG8_BAR;
        PG8_STAGE(PG8_SB(1, 0), cB + kstep, voffB); PG8_STAGE(PG8_SA(1, 0), cA + kstep, cv0); PG8_STAGE(PG8_SB(1, 1), cB + hstep + kstep, voffB);
        PG8_WAIT_V(6); PG8_BAR;
    }
    for (;;) {
        const bool has_next = S.next(ui + 1, nxt);
        if (GATHER && has_next) { PG8_GOFF(nv0, nv1, nxt.pm); }
        else {
#pragma unroll
            for (int i = 0; i < 2; ++i) { nv0[i] = cv0[i]; nv1[i] = cv1[i]; } }
        const char* nA = (has_next && !GATHER) ? (const char*)g.A + (size_t)nxt.pm * tstep : cA; const char* nB = has_next ? (const char*)g.Bt + (size_t)nxt.pn * tstep : cB;
#pragma unroll 1
        for (int t = 0; t < nt; t += 2) {
            const bool last = (t == nt - 2);
            const char* a1 = cA + (size_t)(t + 1) * kstep;
            const char* a2 = last ? nA : cA + (size_t)(t + 2) * kstep; const char* b2 = last ? nB : cB + (size_t)(t + 2) * kstep;
            const char* a3 = a2 + kstep; const char* b3 = b2 + kstep;
#pragma unroll
            for (int i = 0; i < 2; ++i) { sv0[i] = last ? nv0[i] : cv0[i]; sv1[i] = last ? nv1[i] : cv1[i]; }
            if (last && has_next) S.a_ready(nxt);
            if constexpr (SP2) {
            PG8_LDB(B0, 0, 0); PG8_LDB(B1, 0, 1); PG8_SCHED; PG8_LDA(At, 0, 0); PG8_STAGE(PG8_SA(1, 1), a1, cv1);
            PG8_WAIT_V(8); PG8_WAIT_L(0); PG8_BAR; PG8_MMA(0, 0, At, B0); PG8_MMA(0, 1, At, B1); PG8_BAR; PG8_SCHED;
            PG8_LDA(At, 0, 1); PG8_STAGE(PG8_SB(0, 0), b2, voffB); PG8_STAGE(PG8_SB(0, 1), b2 + hstep, voffB); PG8_STAGE(PG8_SA(0, 0), a2, sv0);
            PG8_WAIT_V(8); PG8_WAIT_L(0); PG8_BAR; PG8_MMA(1, 0, At, B0); PG8_MMA(1, 1, At, B1); PG8_BAR; PG8_SCHED;
            PG8_LDB(B0, 1, 0); PG8_LDB(B1, 1, 1); PG8_SCHED; PG8_LDA(At, 1, 0); PG8_STAGE(PG8_SA(0, 1), a2, sv1);
            PG8_WAIT_V(8); PG8_WAIT_L(0); PG8_BAR; PG8_MMA(0, 0, At, B0); PG8_MMA(0, 1, At, B1); PG8_BAR; PG8_SCHED;
            PG8_LDA(At, 1, 1); PG8_STAGE(PG8_SB(1, 0), b3, voffB); PG8_STAGE(PG8_SB(1, 1), b3 + hstep, voffB); PG8_STAGE(PG8_SA(1, 0), a3, sv0);
            PG8_WAIT_V(8); PG8_WAIT_L(0); PG8_BAR; PG8_MMA(1, 0, At, B0); PG8_MMA(1, 1, At, B1); PG8_BAR; PG8_SCHED;
            } else {
            PG8_LDB(B0, 0, 0); PG8_SCHED; PG8_LDA(At, 0, 0); PG8_STAGE(PG8_SA(1, 1), a1, cv1);
            PG8_WAIT_L(8); PG8_BAR; PG8_WAIT_L(0); PG8_MMA(0, 0, At, B0); PG8_BAR; PG8_SCHED;
            PG8_LDB(B1, 0, 1); PG8_STAGE(PG8_SB(0, 0), b2, voffB);
            PG8_BAR; PG8_WAIT_L(0); PG8_MMA(0, 1, At, B1); PG8_BAR;
            PG8_LDA(At, 0, 1); PG8_STAGE(PG8_SA(0, 0), a2, sv0);
            PG8_BAR; PG8_WAIT_L(0); PG8_MMA(1, 0, At, B0); PG8_BAR; PG8_SCHED;
            PG8_STAGE(PG8_SB(0, 1), b2 + hstep, voffB);
            PG8_WAIT_V(6); PG8_BAR; PG8_MMA(1, 1, At, B1); PG8_BAR;
            PG8_LDB(B0, 1, 0); PG8_SCHED; PG8_LDA(At, 1, 0); PG8_STAGE(PG8_SA(0, 1), a2, sv1);
            PG8_WAIT_L(8); PG8_BAR; PG8_WAIT_L(0); PG8_MMA(0, 0, At, B0); PG8_BAR; PG8_SCHED;
            PG8_LDB(B1, 1, 1); PG8_STAGE(PG8_SB(1, 0), b3, voffB);
            PG8_BAR; PG8_WAIT_L(0); PG8_MMA(0, 1, At, B1); PG8_BAR;
            PG8_LDA(At, 1, 1); PG8_STAGE(PG8_SA(1, 0), a3, sv0);
            PG8_BAR; PG8_WAIT_L(0); PG8_MMA(1, 0, At, B0); PG8_BAR; PG8_SCHED;
            PG8_STAGE(PG8_SB(1, 1), b3 + hstep, voffB);
            PG8_WAIT_V(6); PG8_BAR; PG8_MMA(1, 1, At, B1); PG8_BAR;
            }
        }
        if constexpr (FP8) { asm volatile("s_nop 15\n\ts_nop 15\n\ts_nop 7" ::: "memory"); }
        if constexpr (ALIGN_EPI) { if (wr == 0) PG8_BAR; }
        bool keep = false;
        if constexpr (Epi::KEEPS) { if (E.first(cur)) { E.scale(acc, cur, wr, wc, fr, fq); keep = true; } else E(acc, cur, wr, wc, fr, fq); S.done(cur); }
        else if constexpr (!Epi::AFTER_DRAIN) { E(acc, cur, wr, wc, fr, fq); S.done(cur); }
        if (!has_next) break;
        if (!keep) {
#pragma unroll
        for (int a = 0; a < 2; ++a)
#pragma unroll
            for (int b = 0; b < 2; ++b)
#pragma unroll
                for (int m = 0; m < 4; ++m)
#pragma unroll
                    for (int n = 0; n < 2; ++n) acc[a][b][m][n] = (f32x4){0.f, 0.f, 0.f, 0.f};
        }
        cur = nxt; cA = nA; cB = nB; ++ui;
#pragma unroll
        for (int i = 0; i < 2; ++i) { cv0[i] = nv0[i]; cv1[i] = nv1[i]; }
        if constexpr (ALIGN_EPI) { if (wr == 1) PG8_BAR; }
    }
    PG8_WAIT_V(0);
    if constexpr (!ALIGN_EPI) { if (wr == 0) PG8_BAR; }
    PG8_BAR;
    if constexpr (Epi::AFTER_DRAIN) { E.fused(acc, cur, wr, wc, fr, fq, lds, wid, lane); S.done(cur); }
#undef PG8_GOFF
#undef PG8_SA
#undef PG8_SB
#undef PG8_STAGE
#undef PG8_LDA
#undef PG8_LDB
#undef PG8_MMA
#undef PG8_WAIT_V
#undef PG8_WAIT_L
#undef PG8_BAR
#undef PG8_SCHED
}
}

#ifndef PG8_SP2
#define PG8_SP2 true
#endif
#ifndef PG8_ALIGN
#define PG8_ALIGN true
#endif
constexpr int RING_OFF = 0, RING_BYTES = 131072;
constexpr int LDSCTL_OFF = RING_BYTES, MISC_OFF = LDSCTL_OFF + 320;
constexpr int LDS_BYTES = 163840;
constexpr int PARAM_OFF = 135168;
constexpr int NWAVES = 8;
#define GAS __attribute__((address_space(1)))
#define LAS __attribute__((address_space(3)))
typedef unsigned v4u __attribute__((ext_vector_type(4)));
typedef unsigned u2v_t __attribute__((ext_vector_type(2)));
typedef float f32x2q_t __attribute__((ext_vector_type(2)));
typedef float f32x4 __attribute__((ext_vector_type(4)));
typedef GAS unsigned gu32;
#define RLX_AGENT __ATOMIC_RELAXED, __HIP_MEMORY_SCOPE_AGENT
#define LDS_WAIT() asm volatile("s_waitcnt lgkmcnt(0)" ::: "memory")
__device__ __forceinline__ unsigned pk2(float lo, float hi) { return cvtpk2(lo, hi); }

#define XB_TMO      128
#define XB_XCNT(j)  (256  + 64 * (j))
#define XB_XSUB(j)  (1280 + 64 * (j))
#define XB_XGEN(j)  (2304 + 64 * (j))
#define XB_TOP      3328
#define XB_TOPGEN   3392
#define XCD_BAR_WORDS 3456
#define XB_SPIN_CAP (1u << 18)

__device__ __forceinline__ unsigned xb_ld(unsigned* p)              { return __hip_atomic_load(p, __ATOMIC_RELAXED, __HIP_MEMORY_SCOPE_AGENT); }
__device__ __forceinline__ unsigned xb_add(unsigned* p, unsigned v) { return __hip_atomic_fetch_add(p, v, __ATOMIC_RELAXED, __HIP_MEMORY_SCOPE_AGENT); }
__device__ __forceinline__ unsigned xb_xcc_id() { return (unsigned)__builtin_amdgcn_s_getreg((3 << 11) | 20) & 0xFu; }
#define XB_SPIN(cond, bar) do { unsigned _sp = 0; while (cond) { __builtin_amdgcn_s_sleep(1); \
    if ((++_sp & 255u) == 0u) { if (xb_ld(&(bar)[XB_TMO])) break; if (_sp > XB_SPIN_CAP) { atomicAdd(&(bar)[XB_TMO], 1u); break; } } } } while (0)

struct XcdBarrier {
    unsigned* bar; unsigned x;
    volatile LAS unsigned* st;
};

__device__ __forceinline__ XcdBarrier xcd_barrier_post(unsigned* bar, volatile LAS unsigned* st) {
    XcdBarrier b; b.bar = bar; b.x = xb_xcc_id(); b.st = st;
    if (threadIdx.x == 0) (void)xb_add(&bar[XB_XCNT(b.x)], 1u);
    return b;
}
__device__ __forceinline__ void xcd_barrier_complete(unsigned* bar, unsigned x, unsigned& nloc, unsigned& nx) {
    const unsigned G = gridDim.x * gridDim.y * gridDim.z;
    unsigned sum, cnt, mine, sp = 0u;
    for (;;) {
        sum = 0u; cnt = 0u; mine = 0u;
#pragma unroll
        for (unsigned j = 0; j < 16; ++j) { const unsigned c = xb_ld(&bar[XB_XCNT(j)]); sum += c; cnt += (c > 0u) ? 1u : 0u; mine = (j == x) ? c : mine; }
        if (sum == G) break;
        __builtin_amdgcn_s_sleep(1);
        if ((++sp & 255u) == 0u) { if (xb_ld(&bar[XB_TMO])) break; if (sp > XB_SPIN_CAP) { atomicAdd(&bar[XB_TMO], 1u); break; } }
    }
    nloc = mine > 0u ? mine : 1u; nx = cnt > 0u ? cnt : 1u;
}

__device__ __forceinline__ void xcd_barrier(const XcdBarrier& b) {
    asm volatile("s_waitcnt vmcnt(0)" ::: "memory");
    __syncthreads();
    if (threadIdx.x == 0) {
        unsigned* bar = b.bar;
        __builtin_amdgcn_s_waitcnt(0);
        unsigned nloc = b.st[0], nx = b.st[1];
        if (nloc == 0u) { xcd_barrier_complete(bar, b.x, nloc, nx); b.st[0] = nloc; b.st[1] = nx; }
        const unsigned old = xb_add(&bar[XB_XSUB(b.x)], 1u);
        const unsigned gen = old / nloc;
        if (old + 1u == (gen + 1u) * nloc) {
            __builtin_amdgcn_fence(__ATOMIC_RELEASE, "agent");
            asm volatile("s_waitcnt vmcnt(0)" ::: "memory");
            const unsigned og = xb_add(&bar[XB_TOP], 1u);
            const unsigned tg = og / nx;
            if (og + 1u == (tg + 1u) * nx) xb_add(&bar[XB_TOPGEN], 1u);
            else XB_SPIN(xb_ld(&bar[XB_TOPGEN]) == tg, bar);
            __builtin_amdgcn_fence(__ATOMIC_ACQUIRE, "agent");
            xb_add(&bar[XB_XGEN(b.x)], 1u);
            asm volatile("s_waitcnt vmcnt(0)" ::: "memory");
        } else {
            XB_SPIN(xb_ld(&bar[XB_XGEN(b.x)]) == gen, bar);
            __builtin_amdgcn_fence(__ATOMIC_ACQUIRE, "agent");
            asm volatile("s_waitcnt vmcnt(0)" ::: "memory");
        }
    }
    __syncthreads();
}

struct Args { const void* in[20]; float* out; unsigned char* ws; int ph_lo, ph_hi, li, mask, rep, pad; };
struct Ctx {
    unsigned char* lds; int tid, lane, wave, G, gw, NGW;
    const float *x, *c, *w_ada, *b_ada, *g_pre_mix, *g_post_mix, *g_pre_ffn, *g_post_ffn, *w_in, *lbl, *onorm, *sink, *w_a, *w_b, *w_o, *w_router, *w_eg, *w_eu, *w_ed;
    const int* pos; float* out; unsigned char* ws;
};
__device__ __forceinline__ float wave_sum(float v) {
#pragma unroll
    for (int o = 1; o < 64; o <<= 1) v += __shfl_xor(v, o);
    return v;
}
struct TDesc { const float* src; bf16* dst; int N, K; float f8s; };
__device__ __forceinline__ void t_load(const TDesc& d, int h, f32x4 (&r)[16], int lane) {
    const float* p = d.src + (size_t)(64 * h + 16 * (lane >> 4)) * d.N + 4 * (lane & 15);
#pragma unroll
    for (int i = 0; i < 16; ++i) r[i] = __builtin_nontemporal_load((const f32x4*)(p + (size_t)i * d.N));
}
template <int HALF_> __device__ __forceinline__ void t_process(const TDesc& d, const f32x4 (&r)[16], float* scr, int lane) {
    unsigned char* s8 = (unsigned char*)scr; const int kq = lane >> 4, nl = lane & 15;
    if (d.f8s != 0.f) {
        const float f = d.f8s; unsigned char* dst8 = (unsigned char*)d.dst;
#pragma unroll
        for (int c = 0; c < 4; ++c) { v4u o;
            o.x = pg8::pk4_fp8(r[0][c] * f, r[1][c] * f, r[2][c] * f, r[3][c] * f); o.y = pg8::pk4_fp8(r[4][c] * f, r[5][c] * f, r[6][c] * f, r[7][c] * f);
            o.z = pg8::pk4_fp8(r[8][c] * f, r[9][c] * f, r[10][c] * f, r[11][c] * f); o.w = pg8::pk4_fp8(r[12][c] * f, r[13][c] * f, r[14][c] * f, r[15][c] * f);
            *(v4u*)(s8 + (4 * nl + c) * 144 + 64 * HALF_ + 16 * kq) = o; }
        if (HALF_ == 1) {
            LDS_WAIT(); asm volatile("" ::: "memory");
#pragma unroll
            for (int j = 0; j < 8; ++j) { const int row = 8 * j + (lane >> 3), pc = lane & 7; const v4u o = *(const v4u*)(s8 + row * 144 + 16 * pc);
                __builtin_nontemporal_store(o, (v4u*)(dst8 + (size_t)row * d.K + 16 * pc)); }
        }
    } else {
#pragma unroll
        for (int c = 0; c < 4; ++c) { v4u o0, o1;
            o0.x = pk2(r[0][c], r[1][c]); o0.y = pk2(r[2][c], r[3][c]); o0.z = pk2(r[4][c], r[5][c]); o0.w = pk2(r[6][c], r[7][c]);
            o1.x = pk2(r[8][c], r[9][c]); o1.y = pk2(r[10][c], r[11][c]); o1.z = pk2(r[12][c], r[13][c]); o1.w = pk2(r[14][c], r[15][c]);
            *(v4u*)(s8 + (4 * nl + c) * 144 + 32 * kq) = o0; *(v4u*)(s8 + (4 * nl + c) * 144 + 32 * kq + 16) = o1; }
        LDS_WAIT(); asm volatile("" ::: "memory");
#pragma unroll
        for (int j = 0; j < 8; ++j) { const int row = 8 * j + (lane >> 3), pc = lane & 7; const v4u o = *(const v4u*)(s8 + row * 144 + 16 * pc);
            *(v4u*)(d.dst + (size_t)row * d.K + 64 * HALF_ + 8 * pc) = o; }
    }
    LDS_WAIT(); asm volatile("" ::: "memory");
}
__device__ __forceinline__ void rope_entry(const int* pos, float* rope, int gid) {
    const int t = gid >> 6, i = gid & 63;
    double inv = 1.0, rr = 0.8659643233600653523531691834202299819398;
    for (int bit = 0; bit < 6; ++bit) { if ((i >> bit) & 1) inv *= rr; rr *= rr; }
    const double ang = (double)pos[t] * inv;
    const double kq = rint(ang * 0.3183098861837906715377675267450287);
    const double r = ang - kq * 3.141592653589793238462643383279502884;
    const double u = -(r * r);
    double s = 1.0 / 121645100408832000.0;
    s = s * u + 1.0 / 355687428096000.0; s = s * u + 1.0 / 1307674368000.0; s = s * u + 1.0 / 6227020800.0; s = s * u + 1.0 / 39916800.0; s = s * u + 1.0 / 362880.0;
    s = s * u + 1.0 / 5040.0; s = s * u + 1.0 / 120.0; s = s * u + 1.0 / 6.0; s = s * u + 1.0; s = s * r;
    double cz = 1.0 / 6402373705728000.0;
    cz = cz * u + 1.0 / 20922789888000.0; cz = cz * u + 1.0 / 87178291200.0; cz = cz * u + 1.0 / 479001600.0; cz = cz * u + 1.0 / 3628800.0; cz = cz * u + 1.0 / 40320.0;
    cz = cz * u + 1.0 / 720.0; cz = cz * u + 1.0 / 24.0; cz = cz * u + 0.5; cz = cz * u + 1.0;
    const double sg = (((long long)kq) & 1) ? -1.0 : 1.0;
    rope[(size_t)gid * 2] = (float)(sg * cz); rope[(size_t)gid * 2 + 1] = (float)(sg * s);
}
constexpr float W8S_GU = 64.f, W8S_D = 32.f, W8S_IN = 64.f, X8S_IN = 8.f, SLAB8S = 32.f;
constexpr int I_IN = 16 * 168, I_A = 8 * 32, I_O = 16 * 32, I_E = 256, I_MIX = I_IN + 2 * I_A + I_O, I_EXP = 48 * I_E;
constexpr int CONV_BLOCKS = 64;
constexpr int CONV_ITEMS_PER_WAVE = 24;
constexpr int P0_EXPERT_ITEMS = I_EXP - CONV_BLOCKS * NWAVES * CONV_ITEMS_PER_WAVE;
constexpr int P0_GEMV_ROUNDS = 1;
constexpr int GEMV_BLOCKS = 192;
__device__ __forceinline__ TDesc transpose_desc(Ctx& F, int it) {
    bf16* WIN = (bf16*)(F.ws + WS_WIN); bf16* WA = (bf16*)(F.ws + WS_WA); bf16* WB = (bf16*)(F.ws + WS_WB); bf16* WO = (bf16*)(F.ws + WS_WO); bf16* WGU = (bf16*)(F.ws + WS_WGU); bf16* WD = (bf16*)(F.ws + WS_WD);
    int r = it; const float* W; bf16* WT; int K, N, kb, nb; size_t drow; float f8s = 0.f;
    if (r < I_IN) { W = F.w_in; WT = WIN; K = 2048; N = INW; kb = r / 168; nb = r % 168; drow = (size_t)64 * nb; f8s = W8S_IN; }
    else if ((r -= I_IN) < I_A) { W = F.w_a; WT = WA; K = 1024; N = 2048; kb = r / 32; nb = r % 32; drow = (size_t)64 * nb; }
    else if ((r -= I_A) < I_A) { W = F.w_b; WT = WB; K = 1024; N = 2048; kb = r / 32; nb = r % 32; drow = (size_t)64 * nb; }
    else if ((r -= I_A) < I_O) { W = F.w_o; WT = WO; K = 2048; N = 2048; kb = r / 32; nb = r % 32; drow = (size_t)64 * nb; }
    else { r -= I_O; const int e = r / (3 * I_E), q = r % (3 * I_E), which = q / I_E, ii = q % I_E;
        if (which < 2) { kb = ii / 16; nb = ii % 16; const int n0 = 64 * nb; W = (which ? F.w_eu : F.w_eg) + (size_t)e * 2048 * 1024; WT = WGU; K = 2048; N = 1024; f8s = W8S_GU; drow = (size_t)e * 2048 + (n0 >> 7) * 256 + which * 128 + (n0 & 127); }
        else { kb = ii / 32; nb = ii % 32; W = F.w_ed + (size_t)e * 1024 * 2048; WT = WD; K = 1024; N = 2048; f8s = W8S_D; drow = (size_t)e * 2048 + 64 * nb; } }
    TDesc d; d.src = W + (size_t)(128 * kb) * N + 64 * nb; d.N = N; d.K = K; d.f8s = f8s;
    if (f8s != 0.f) d.dst = (bf16*)((unsigned char*)WT + drow * K + 128 * kb); else d.dst = WT + drow * K + 128 * kb;
    return d;
}
template <class Seq> __device__ __forceinline__ void transpose_stream(Ctx& F, const Seq& seq, float* scr) {
    f32x4 ra[16], rb[16]; TDesc d, dn; int j = 0; int it = seq(j);
    if (it < 0) return;
    d = transpose_desc(F, it); t_load(d, 0, ra, F.lane); t_load(d, 1, rb, F.lane);
    for (;;) {
        const int itn = seq(++j);
        t_process<0>(d, ra, scr, F.lane);
        if (itn >= 0) { dn = transpose_desc(F, itn); t_load(dn, 0, ra, F.lane); }
        t_process<1>(d, rb, scr, F.lane);
        if (itn < 0) break;
        t_load(dn, 1, rb, F.lane); d = dn;
    }
}
struct P0Seq { int gw, NGW, ngv; bool gemv;
    __device__ __forceinline__ int operator()(int r) const { int it; if (r < P0_GEMV_ROUNDS) it = r * NGW + gw; else { if (gemv) return -1; it = P0_GEMV_ROUNDS * NGW + (r - P0_GEMV_ROUNDS) * (NGW - ngv) + (gw - ngv); }
        return it < I_MIX + P0_EXPERT_ITEMS ? it : -1; } };
struct TailSeq { int first, stride;
    __device__ __forceinline__ int operator()(int j) const { const int it = first + j * stride; return it < I_MIX + I_EXP ? it : -1; } };
__device__ __forceinline__ void p1_modnorm(Ctx& F, int first, int stride, const float* AB) {
    bf16* H = (bf16*)(F.ws + WS_H);
    for (int row0 = first; row0 < T; row0 += 2 * stride) {
        f32x4 v[2][8];
#pragma unroll
        for (int k = 0; k < 2; ++k) { const int row = row0 + k * stride; if (row < T) { const f32x4* xr = (const f32x4*)(F.x + (size_t)row * D) + F.lane;
#pragma unroll
            for (int j = 0; j < 8; ++j) v[k][j] = __builtin_nontemporal_load(xr + 64 * j); } }
#pragma unroll
        for (int k = 0; k < 2; ++k) { const int row = row0 + k * stride; if (row < T) {
            const int b = row / SEQ; float ss = 0.f;
#pragma unroll
            for (int j = 0; j < 8; ++j) ss += (v[k][j].x * v[k][j].x + v[k][j].y * v[k][j].y) + (v[k][j].z * v[k][j].z + v[k][j].w * v[k][j].w);
            const float r = rsqrtf(wave_sum(ss) * (1.f / D) + EPS);
            const f32x4* ap = (const f32x4*)(AB + b * 4096) + F.lane; const f32x4* bp = (const f32x4*)(AB + b * 4096 + 2048) + F.lane;
            unsigned* o8 = (unsigned*)((unsigned char*)H + (size_t)row * D) + F.lane;
#pragma unroll
            for (int j = 0; j < 8; ++j) { const f32x4 h = v[k][j] * r * ap[64 * j] + bp[64 * j];
                o8[64 * j] = pg8::pk4_fp8(h.x, h.y, h.z, h.w); } } }
    }
}
__device__ __forceinline__ void p0_prep(Ctx& F) {
    float* MOD = (float*)(F.ws + WS_MOD); float* MODP = (float*)(F.ws + WS_MODP); float* LB = (float*)(F.ws + WS_LB); float* ROPE = (float*)(F.ws + WS_ROPE);
    if (blockIdx.x < GEMV_BLOCKS) {
        float* sc = (float*)F.lds; float* red = (float*)(F.lds + 16384);
        for (int i = F.tid; i < 4096; i += 512) sc[i] = siluf_(F.c[i]);
        __syncthreads();
        const int cb = (int)blockIdx.x % 96, kh = (int)blockIdx.x / 96;
        const int j0 = cb * 128, k0 = kh * 1024 + F.wave * 128, half = F.lane >> 5, l32 = F.lane & 31;
        f32x4 a0 = {0.f, 0.f, 0.f, 0.f}, a1 = {0.f, 0.f, 0.f, 0.f};
        const float* wp = F.w_ada + (size_t)(k0 + half) * 12288 + j0 + 4 * l32;
#pragma unroll 16
        for (int k = 0; k < 64; ++k) { const f32x4 w = __builtin_nontemporal_load((const f32x4*)(wp + (size_t)(2 * k) * 12288)); const float s0 = sc[k0 + 2 * k + half], s1 = sc[2048 + k0 + 2 * k + half]; a0 += w * s0; a1 += w * s1; }
        *(f32x4*)(red + ((F.wave * 2 + half) * 2 + 0) * 128 + 4 * l32) = a0; *(f32x4*)(red + ((F.wave * 2 + half) * 2 + 1) * 128 + 4 * l32) = a1;
        __syncthreads();
        if (F.tid < 256) { const int b = F.tid >> 7, jj = F.tid & 127; float s = 0.f;
#pragma unroll
          for (int p = 0; p < 16; ++p) s += red[(p * 2 + b) * 128 + jj];
          MODP[(kh * 2 + b) * 12288 + j0 + jj] = s; }
        __syncthreads();
    }
    { const int gt = blockIdx.x * 512 + F.tid, NT = F.G * 512;
      if (gt < 2048) { const int dir = gt >> 10, ch = gt & 1023; const float l0 = F.lbl[dir * 2048 + ch], l1 = F.lbl[dir * 2048 + 1024 + ch]; LB[gt] = 1.f / (1.f + expf(l1 - l0)); }
      for (int g = gt; g < T * 64; g += NT) rope_entry(F.pos, ROPE, g); }
    unsigned* cnt = (unsigned*)(F.ws + WS_CTL) + 1024;
    if (blockIdx.x < GEMV_BLOCKS) {
        asm volatile("s_waitcnt vmcnt(0)" ::: "memory"); __syncthreads();
        if (F.tid == 0) { __builtin_amdgcn_fence(__ATOMIC_RELEASE, "agent"); asm volatile("s_waitcnt vmcnt(0)" ::: "memory"); __hip_atomic_fetch_add(cnt, 1u, __ATOMIC_RELAXED, __HIP_MEMORY_SCOPE_AGENT); }
    }
    float* scr = (float*)(F.lds + F.wave * 16384);
    P0Seq seq{F.gw, F.NGW, GEMV_BLOCKS * NWAVES, blockIdx.x < GEMV_BLOCKS};
    transpose_stream(F, seq, scr);
    __syncthreads();
    if (F.tid == 0) { unsigned sp = 0; while (__hip_atomic_load(cnt, __ATOMIC_RELAXED, __HIP_MEMORY_SCOPE_AGENT) < (unsigned)GEMV_BLOCKS && ++sp < (1u << 22)) __builtin_amdgcn_s_sleep(2);
        __builtin_amdgcn_fence(__ATOMIC_ACQUIRE, "agent"); asm volatile("s_waitcnt vmcnt(0)" ::: "memory"); }
    __syncthreads();
    for (int idx = blockIdx.x * 512 + F.tid; idx < 2 * 12288; idx += F.G * 512) MOD[idx] = (MODP[idx] + MODP[2 * 12288 + idx]) + F.b_ada[idx % 12288];
    float* AB = (float*)F.lds;
    {   const int d4 = F.tid;
        const f32x4 g = *((const f32x4*)F.g_pre_mix + d4), bsh = *((const f32x4*)F.b_ada + d4), bsc = *((const f32x4*)(F.b_ada + 2048) + d4);
#pragma unroll
        for (int b = 0; b < BATCH; ++b) { const float* p0 = MODP + b * 12288; const float* p1 = MODP + (2 + b) * 12288;
            const f32x4 sh = (*((const f32x4*)p0 + d4) + *((const f32x4*)p1 + d4)) + bsh, sc1 = (*((const f32x4*)(p0 + 2048) + d4) + *((const f32x4*)(p1 + 2048) + d4)) + bsc;
            *((f32x4*)(AB + b * 4096) + d4) = g * (sc1 + 1.f) * X8S_IN; *((f32x4*)(AB + b * 4096 + 2048) + d4) = sh * X8S_IN; } }
    __syncthreads();
    p1_modnorm(F, F.gw, F.NGW, AB);
}
__device__ __forceinline__ void p6_post1(Ctx& F) {
    const float* MOD = (const float*)(F.ws + WS_MOD); const float* Y = (const float*)(F.ws + WS_Y); bf16* H2 = (bf16*)(F.ws + WS_H2); float* AFF = (float*)(F.ws + WS_AFF);
    float* wT = (float*)F.lds;
    float* PA = (float*)(F.lds + PARAM_OFF); float* PB = PA + 2048; float* PC = PB + 2048;
    const int gpb = F.G / BATCH, b = (int)blockIdx.x / gpb, NWB = gpb * NWAVES, gwb = ((int)blockIdx.x - b * gpb) * NWAVES + F.wave;
    if (b < BATCH) {
        uint2 yc[2][8]; f32x4 xv[2][8];
#define P6_LOADPAIR(rl_) do { const int r0_ = b * SEQ + (rl_), r1_ = ((rl_) + NWB < SEQ) ? r0_ + NWB : r0_; \
            _Pragma("unroll") for (int k = 0; k < 2; ++k) { const int rr = k ? r1_ : r0_; const uint2* yr_ = (const uint2*)((const bf16*)Y + (size_t)rr * D) + F.lane; const f32x4* xr_ = (const f32x4*)(F.x + (size_t)rr * D) + F.lane; \
                _Pragma("unroll") for (int j = 0; j < 8; ++j) { yc[k][j] = yr_[64 * j]; xv[k][j] = xr_[64 * j]; } } } while (0)
        if (gwb < SEQ) P6_LOADPAIR(gwb);
        {   const float* mb = MOD + b * 12288;
            const int d4 = F.tid;
            const f32x4 gt = *((const f32x4*)(mb + 4096) + d4), gp = *((const f32x4*)F.g_post_mix + d4), g2 = *((const f32x4*)F.g_pre_ffn + d4), sc = *((const f32x4*)(mb + 8192) + d4), sh = *((const f32x4*)(mb + 6144) + d4);
#pragma unroll
            for (int half = 0; half < 2; ++half) { f32x4 wv[8];
#pragma unroll
                for (int k = 0; k < 8; ++k) wv[k] = *((const f32x4*)F.w_router + F.tid + 512 * (8 * half + k));
#pragma unroll
                for (int k = 0; k < 8; ++k) { const int f = F.tid + 512 * (8 * half + k), d = f >> 2, q = f & 3;
                    wT[(4 * q + 0) * 2048 + d] = wv[k].x; wT[(4 * q + 1) * 2048 + d] = wv[k].y; wT[(4 * q + 2) * 2048 + d] = wv[k].z; wT[(4 * q + 3) * 2048 + d] = wv[k].w; } }
            *((f32x4*)PA + d4) = gt * gp; *((f32x4*)PB + d4) = g2 * (sc + 1.f); *((f32x4*)PC + d4) = sh; }
        __syncthreads();
        for (int rl = gwb; rl < SEQ; rl += 2 * NWB) {
            const bool two = rl + NWB < SEQ;
            const int row0 = b * SEQ + rl, row1 = two ? row0 + NWB : row0;
            if (rl != gwb) P6_LOADPAIR(rl);
            float ssa = 0.f, ssb = 0.f;
#pragma unroll
            for (int j = 0; j < 8; ++j) {
                { const float y0 = __uint_as_float(yc[0][j].x << 16), y1 = __uint_as_float(yc[0][j].x & 0xffff0000u), y2 = __uint_as_float(yc[0][j].y << 16), y3 = __uint_as_float(yc[0][j].y & 0xffff0000u); ssa += (y0 * y0 + y1 * y1) + (y2 * y2 + y3 * y3); }
                { const float y0 = __uint_as_float(yc[1][j].x << 16), y1 = __uint_as_float(yc[1][j].x & 0xffff0000u), y2 = __uint_as_float(yc[1][j].y << 16), y3 = __uint_as_float(yc[1][j].y & 0xffff0000u); ssb += (y0 * y0 + y1 * y1) + (y2 * y2 + y3 * y3); } }
            const float ra = rsqrtf(wave_sum(ssa) * (1.f / D) + EPS), rb = rsqrtf(wave_sum(ssb) * (1.f / D) + EPS);
            ssa = 0.f; ssb = 0.f;
#pragma unroll
            for (int j = 0; j < 8; ++j) { const f32x4 pa = *((const f32x4*)PA + F.lane + 64 * j);
                const f32x4 ya = {__uint_as_float(yc[0][j].x << 16), __uint_as_float(yc[0][j].x & 0xffff0000u), __uint_as_float(yc[0][j].y << 16), __uint_as_float(yc[0][j].y & 0xffff0000u)};
                const f32x4 yb = {__uint_as_float(yc[1][j].x << 16), __uint_as_float(yc[1][j].x & 0xffff0000u), __uint_as_float(yc[1][j].y << 16), __uint_as_float(yc[1][j].y & 0xffff0000u)};
                xv[0][j] = xv[0][j] + pa * (ya * ra); xv[1][j] = xv[1][j] + pa * (yb * rb);
                ssa += (xv[0][j].x * xv[0][j].x + xv[0][j].y * xv[0][j].y) + (xv[0][j].z * xv[0][j].z + xv[0][j].w * xv[0][j].w);
                ssb += (xv[1][j].x * xv[1][j].x + xv[1][j].y * xv[1][j].y) + (xv[1][j].z * xv[1][j].z + xv[1][j].w * xv[1][j].w); }
            { f32x4* op = (f32x4*)(F.out + (size_t)row0 * D) + F.lane;
#pragma unroll
              for (int j = 0; j < 8; ++j) op[64 * j] = xv[0][j]; }
            if (two) { f32x4* op = (f32x4*)(F.out + (size_t)row1 * D) + F.lane;
#pragma unroll
              for (int j = 0; j < 8; ++j) op[64 * j] = xv[1][j]; }
            const float r2a = rsqrtf(wave_sum(ssa) * (1.f / D) + EPS), r2b = rsqrtf(wave_sum(ssb) * (1.f / D) + EPS);
#pragma unroll
            for (int j = 0; j < 8; ++j) { const f32x4 pb = *((const f32x4*)PB + F.lane + 64 * j), pc = *((const f32x4*)PC + F.lane + 64 * j); xv[0][j] = xv[0][j] * r2a * pb + pc; xv[1][j] = xv[1][j] * r2b * pb + pc; }
            { unsigned* o4 = (unsigned*)((unsigned char*)H2 + (size_t)row0 * D) + F.lane;
#pragma unroll
              for (int j = 0; j < 8; ++j) o4[64 * j] = pg8::pk4_fp8(xv[0][j].x, xv[0][j].y, xv[0][j].z, xv[0][j].w); }
            if (two) { unsigned* o4 = (unsigned*)((unsigned char*)H2 + (size_t)row1 * D) + F.lane;
#pragma unroll
              for (int j = 0; j < 8; ++j) o4[64 * j] = pg8::pk4_fp8(xv[1][j].x, xv[1][j].y, xv[1][j].z, xv[1][j].w); }
            float la[16], lb[16];
#pragma unroll
            for (int e = 0; e < 16; ++e) { f32x4 a0 = {0.f, 0.f, 0.f, 0.f}, a1 = {0.f, 0.f, 0.f, 0.f};
#pragma unroll
                for (int j = 0; j < 8; ++j) { const f32x4 wv = *((const f32x4*)(wT + e * 2048) + F.lane + 64 * j); a0 += xv[0][j] * wv; a1 += xv[1][j] * wv; }
                la[e] = (a0.x + a0.y) + (a0.z + a0.w); lb[e] = (a1.x + a1.y) + (a1.z + a1.w); if (e & 1) asm volatile("" ::: "memory"); }
            const bool h5 = F.lane & 32, h4 = F.lane & 16, h3 = F.lane & 8, h2 = F.lane & 4, h1 = F.lane & 2;
            float t16[16], t8[8], t4[4], t2[2];
#pragma unroll
            for (int e = 0; e < 16; ++e) { const float keep = h5 ? lb[e] : la[e], send = h5 ? la[e] : lb[e]; t16[e] = keep + __shfl_xor(send, 32); }
#pragma unroll
            for (int i = 0; i < 8; ++i) { const float keep = h4 ? t16[8 + i] : t16[i], send = h4 ? t16[i] : t16[8 + i]; t8[i] = keep + __shfl_xor(send, 16); }
#pragma unroll
            for (int i = 0; i < 4; ++i) { const float keep = h3 ? t8[4 + i] : t8[i], send = h3 ? t8[i] : t8[4 + i]; t4[i] = keep + __shfl_xor(send, 8); }
#pragma unroll
            for (int i = 0; i < 2; ++i) { const float keep = h2 ? t4[2 + i] : t4[i], send = h2 ? t4[i] : t4[2 + i]; t2[i] = keep + __shfl_xor(send, 4); }
            float lg; { const float keep = h1 ? t2[1] : t2[0], send = h1 ? t2[0] : t2[1]; lg = keep + __shfl_xor(send, 2); }
            lg += __shfl_xor(lg, 1);
            float mx = lg;
#pragma unroll
            for (int o = 2; o < 32; o <<= 1) mx = fmaxf(mx, __shfl_xor(mx, o));
            const float ex = expf(lg - mx); float sm = ex;
#pragma unroll
            for (int o = 2; o < 32; o <<= 1) sm += __shfl_xor(sm, o);
            const int er = (F.lane >> 1) & 15, rw = F.lane >> 5;
            if ((F.lane & 1) == 0 && (rw == 0 || two)) AFF[((size_t)b * 16 + er) * SEQ + rl + rw * NWB] = ex / sm;
        }
    }
#undef P6_LOADPAIR
    __syncthreads();
}
__device__ __forceinline__ void p7_topk_gather(Ctx& F) {
    const float* AFF = (const float*)(F.ws + WS_AFF); int* GIDX = (int*)(F.ws + WS_GIDX); float* SELAFF = (float*)(F.ws + WS_SELAFF); int* TOKSLOT = (int*)(F.ws + WS_TOKSLOT);
        int* sh = (int*)F.lds; int* wsum = (int*)(F.lds + 64);
    for (int unit = blockIdx.x; unit < 256; unit += F.G) {
        const int be = unit >> 3, part = unit & 7, b = be >> 4, e = be & 15, tid = F.tid, lane = F.lane;
        const f32x4* a = (const f32x4*)(AFF + (size_t)be * SEQ + tid * 8);
        const f32x4 a0 = a[0], a1 = a[1];
        const unsigned v[8] = {__float_as_uint(a0.x), __float_as_uint(a0.y), __float_as_uint(a0.z), __float_as_uint(a0.w), __float_as_uint(a1.x), __float_as_uint(a1.y), __float_as_uint(a1.z), __float_as_uint(a1.w)};
        unsigned tau = 0u; int need;
        {   int* cnt = sh + 32;
            for (int bit = 30; bit >= -1; --bit) { const unsigned cand = bit >= 0 ? (tau | (1u << bit)) : tau + 1u; int cl = 0;
#pragma unroll
                for (int i = 0; i < 8; ++i) cl += (v[i] >= cand) ? 1 : 0;
                int c = 0;
#pragma unroll
                for (int q = 0; q < 4; ++q) c += __popcll(__ballot((cl >> q) & 1)) << q;
                int* row = cnt + ((bit & 1) ? 8 : 0);
                if (lane == 0) row[F.wave] = c;
                __syncthreads();
                int tot = 0;
#pragma unroll
                for (int w8 = 0; w8 < 8; ++w8) tot += row[w8];
                if (bit >= 0) { if (tot >= CAP) tau = cand; } else need = CAP - tot; }
        }
        int cg = 0, ce = 0;
#pragma unroll
        for (int i = 0; i < 8; ++i) { cg += (v[i] > tau) ? 1 : 0; ce += (v[i] == tau) ? 1 : 0; }
        const int pk = cg | (ce << 16); int inc = pk;
#pragma unroll
        for (int o = 1; o < 64; o <<= 1) { const int t = __shfl_up(inc, o); if (lane >= o) inc += t; }
        if (lane == 63) wsum[F.wave] = inc;
        __syncthreads();
        int base = 0;
#pragma unroll
        for (int w = 0; w < 8; ++w) base += (w < F.wave) ? wsum[w] : 0;
        const int excl = base + inc - pk, pg = excl & 0xffff, pe = excl >> 16;
        int tie_before = pe, sel_before = pg + (pe < need ? pe : need);
#pragma unroll
        for (int i = 0; i < 8; ++i) {
            const int tok = tid * 8 + i; bool sel = false;
            if (v[i] > tau) sel = true; else if (v[i] == tau) { sel = tie_before < need; ++tie_before; }
            int slot = -1;
            if (sel) { const int sl = sel_before; ++sel_before; slot = b * CAP + sl;
                if ((sl >> 6) == part) { GIDX[e * 1024 + slot] = b * SEQ + tok; SELAFF[e * 1024 + slot] = __uint_as_float(v[i]); } }
            if (F.wave == part) TOKSLOT[((size_t)b * 16 + e) * SEQ + tok] = slot;
        }
        __syncthreads();
    }
}
typedef float f32x2c2 __attribute__((ext_vector_type(2)));
__device__ __forceinline__ void p10_final(Ctx& F) {
    const float* MOD = (const float*)(F.ws + WS_MOD); const unsigned char* SLAB8 = (const unsigned char*)(F.ws + WS_SLAB); const int* TOKSLOT = (const int*)(F.ws + WS_TOKSLOT);
    float* GG = (float*)F.lds;
    for (int i = F.tid; i < BATCH * 512; i += 512) { const int b = i >> 9, c4 = i & 511;
        const f32x4 gt = *((const f32x4*)(MOD + b * 12288 + 10240) + c4), gp = *((const f32x4*)F.g_post_ffn + c4); *((f32x4*)(GG + b * 2048) + c4) = gt * gp; }
    __syncthreads();
#define SLAB_ACC(q) do { const f32x2c2 a0 = __builtin_amdgcn_cvt_pk_f32_fp8((int)(q).x, false), a1 = __builtin_amdgcn_cvt_pk_f32_fp8((int)(q).x, true), a2 = __builtin_amdgcn_cvt_pk_f32_fp8((int)(q).y, false), a3 = __builtin_amdgcn_cvt_pk_f32_fp8((int)(q).y, true); \
        y[8 * j + 0] += a0[0]; y[8 * j + 1] += a0[1]; y[8 * j + 2] += a1[0]; y[8 * j + 3] += a1[1]; y[8 * j + 4] += a2[0]; y[8 * j + 5] += a2[1]; y[8 * j + 6] += a3[0]; y[8 * j + 7] += a3[1]; } while (0)
    for (int row0 = F.gw; row0 < T; row0 += 4 * F.NGW) {
        int slotw[4];
#pragma unroll
        for (int k = 0; k < 4; ++k) { const int row = row0 + k * F.NGW; slotw[k] = (row < T && F.lane < 16) ? TOKSLOT[((size_t)(row / SEQ) * 16 + F.lane) * SEQ + (row % SEQ)] : -1; }
        f32x4 xn[8]; u2v_t sn[3][4]; unsigned restn = 0u; int cntn = 0;
#define FIN_LOAD(k) do { const int row_ = row0 + (k) * F.NGW; restn = 0u; cntn = 0; if (row_ < T) { \
            unsigned m_ = (unsigned)__ballot(slotw[k] >= 0) & 0xffffu; \
            const float* op_ = F.out + (size_t)row_ * D + 8 * F.lane; \
            _Pragma("unroll") for (int j = 0; j < 4; ++j) { xn[2 * j] = *(const f32x4*)(op_ + 512 * j); xn[2 * j + 1] = *(const f32x4*)(op_ + 512 * j + 4); } \
            _Pragma("unroll") for (int p = 0; p < 3; ++p) { if (m_) { const int e_ = __builtin_ctz(m_); m_ &= m_ - 1u; const int sl_ = __shfl(slotw[k], e_); \
                const u2v_t* r_ = (const u2v_t*)(SLAB8 + ((size_t)e_ * 1024 + sl_) * D) + F.lane; \
                _Pragma("unroll") for (int j = 0; j < 4; ++j) sn[p][j] = r_[64 * j]; cntn = p + 1; } } \
            restn = m_; } } while (0)
        FIN_LOAD(0);
#pragma unroll
        for (int k = 0; k < 4; ++k) { const int row = row0 + k * F.NGW;
            f32x4 xc[8]; u2v_t sc[3][4]; const unsigned rest = restn; const int cnt = cntn;
#pragma unroll
            for (int j = 0; j < 8; ++j) xc[j] = xn[j];
#pragma unroll
            for (int p = 0; p < 3; ++p)
#pragma unroll
                for (int j = 0; j < 4; ++j) sc[p][j] = sn[p][j];
            if (k + 1 < 4) FIN_LOAD(k + 1);
            if (row < T) {
                float y[32];
#pragma unroll
                for (int i = 0; i < 32; ++i) y[i] = 0.f;
#pragma unroll
                for (int p = 0; p < 3; ++p) { if (p < cnt) {
#pragma unroll
                    for (int j = 0; j < 4; ++j) SLAB_ACC(sc[p][j]); } }
                for (unsigned m = rest; m; m &= m - 1u) { const int e = __builtin_ctz(m); const int sl = __shfl(slotw[k], e);
                    const u2v_t* r = (const u2v_t*)(SLAB8 + ((size_t)e * 1024 + sl) * D) + F.lane;
#pragma unroll
                    for (int j = 0; j < 4; ++j) { const u2v_t q = r[64 * j]; SLAB_ACC(q); } }
                float ss = 0.f;
#pragma unroll
                for (int i = 0; i < 32; ++i) ss += y[i] * y[i];
                const float r = rsqrtf(wave_sum(ss) * (1.f / (D * SLAB8S * SLAB8S)) + EPS) * (1.f / SLAB8S);
                const float* gg = GG + (row / SEQ) * 2048 + 8 * F.lane; float* op = F.out + (size_t)row * D + 8 * F.lane;
#pragma unroll
                for (int j = 0; j < 4; ++j)
#pragma unroll
                    for (int hh = 0; hh < 2; ++hh) { const f32x4 yy = {y[8 * j + 4 * hh], y[8 * j + 4 * hh + 1], y[8 * j + 4 * hh + 2], y[8 * j + 4 * hh + 3]};
                        *(f32x4*)(op + 512 * j + 4 * hh) = xc[2 * j + hh] + *(const f32x4*)(gg + 512 * j + 4 * hh) * (yy * r); }
            } }
#undef FIN_LOAD
    }
#undef SLAB_ACC
}
typedef short bf16x8 __attribute__((ext_vector_type(8)));
typedef short s16x4 __attribute__((ext_vector_type(4)));
typedef short v4i16_t __attribute__((ext_vector_type(4)));
typedef float f32x16 __attribute__((ext_vector_type(16)));
typedef float f32x2m __attribute__((ext_vector_type(2)));
constexpr int RS = 272;
constexpr int RSA = 144;
constexpr float LOG2E = 1.4426950408889634f;
__device__ __forceinline__ s16x4 tr4(const LAS unsigned char* p) { return __builtin_bit_cast(s16x4, __builtin_amdgcn_ds_read_tr16_b64_v4i16((LAS v4i16_t*)p)); }
__device__ __forceinline__ bf16x8 tr8(const LAS unsigned char* p, int second) { const s16x4 a = tr4(p), b = tr4(p + second); return (bf16x8){a[0], a[1], a[2], a[3], b[0], b[1], b[2], b[3]}; }
__device__ __forceinline__ bf16x8 ld8(const LAS unsigned char* p) { return *(const LAS bf16x8*)p; }
__device__ __forceinline__ unsigned cvtpk(float lo, float hi) { return pg8::cvt_pk_bf16(lo, hi); }
__device__ __forceinline__ int crow(int r, int hi) { return (r & 3) + 8 * (r >> 2) + 4 * hi; }
#define MFMA16(a, b, c) __builtin_amdgcn_mfma_f32_16x16x32_bf16((a), (b), (c), 0, 0, 0)
#define MFMA32(a, b, c) __builtin_amdgcn_mfma_f32_32x32x16_bf16((a), (b), (c), 0, 0, 0)

__device__ __forceinline__ void rope_pass(Ctx& F) {
    const bf16* PROJ = (const bf16*)(F.ws + WS_PROJ); const float* ROPE = (const float*)(F.ws + WS_ROPE); bf16* QR = (bf16*)(F.ws + WS_QR); bf16* KR = (bf16*)(F.ws + WS_KR);
    const int NT = F.G * 512;
    for (int it0 = blockIdx.x * 512 + F.tid; it0 < T * 80; it0 += 2 * NT) {
        v4u a[2], bq[2]; f32x4 cs[2][4]; bool ok[2];
#pragma unroll
        for (int u = 0; u < 2; ++u) { const int it = it0 + u * NT; ok[u] = it < T * 80; if (ok[u]) { const int i8 = it & 7, hh = (it >> 3) % 10, t = it / 80;
            const bf16* src = PROJ + (size_t)t * INW + (hh < 8 ? C_AQ + hh * 128 : C_AK + (hh - 8) * 128) + i8 * 8;
            a[u] = *(const v4u*)src; bq[u] = *(const v4u*)(src + 64);
            const f32x4* rp = (const f32x4*)(ROPE + ((size_t)t * 64 + i8 * 8) * 2);
#pragma unroll
            for (int k = 0; k < 4; ++k) cs[u][k] = rp[k]; } }
#pragma unroll
        for (int u = 0; u < 2; ++u) { if (ok[u]) { const int it = it0 + u * NT; const int i8 = it & 7, hh = (it >> 3) % 10, t = it / 80;
            const unsigned aw[4] = {a[u].x, a[u].y, a[u].z, a[u].w}, bw[4] = {bq[u].x, bq[u].y, bq[u].z, bq[u].w};
            unsigned o1[4], o2[4];
#pragma unroll
            for (int k = 0; k < 4; ++k) { const f32x4 c4 = cs[u][k];
                const float x1a = __uint_as_float(aw[k] << 16), x1b = __uint_as_float(aw[k] & 0xffff0000u), x2a = __uint_as_float(bw[k] << 16), x2b = __uint_as_float(bw[k] & 0xffff0000u);
                o1[k] = pk2(x1a * c4.x - x2a * c4.y, x1b * c4.z - x2b * c4.w); o2[k] = pk2(x1a * c4.y + x2a * c4.x, x1b * c4.w + x2b * c4.z); }
            bf16* dst = (hh < 8 ? QR + (size_t)t * 1024 + hh * 128 : KR + (size_t)t * 256 + (hh - 8) * 128) + i8 * 8;
            *(v4u*)dst = (v4u){o1[0], o1[1], o1[2], o1[3]}; *(v4u*)(dst + 64) = (v4u){o2[0], o2[1], o2[2], o2[3]}; } }
    }
}
__device__ __forceinline__ void hgrn_a_phase(Ctx& F, LAS unsigned char* L) {
    const bf16* PROJ = (const bf16*)(F.ws + WS_PROJ); const float* LB = (const float*)(F.ws + WS_LB); bf16* CS = (bf16*)(F.ws + WS_CS); float* DEC = (float*)(F.ws + WS_DEC);
    LAS unsigned char* KD = L; LAS unsigned char* VV = L + 17408; LAS float* TOT = (LAS float*)(L + 34816);
    const int tid = F.tid, lane = F.lane, w = F.wave, dk0 = 2 * lane;
    const int tro16 = (8 * (lane >> 4) + ((lane & 15) >> 2)) * RS + (lane & 3) * 8;
    unsigned zraw[8]; v4u vr[2]; float lbA = 0.f, lbB = 0.f;
#define HA_LOAD(un) do { const int c_ = (un) & 63, dir_ = ((un) >> 6) & 1, h_ = ((un) >> 7) & 7, b_ = (un) >> 10; const size_t rb_ = (size_t)b_ * SEQ + c_ * 64; \
        { const float2 l2_ = *(const float2*)(LB + dir_ * 1024 + h_ * 128 + dk0); lbA = l2_.x; lbB = l2_.y; } \
        const bf16* zp_ = PROJ + (rb_ + 8 * w) * INW + (dir_ ? C_FB : C_FF) + h_ * 128; \
        _Pragma("unroll") for (int i = 0; i < 8; ++i) zraw[i] = *(const unsigned*)(zp_ + (size_t)i * INW + dk0); \
        _Pragma("unroll") for (int i = 0; i < 2; ++i) { const int idx = tid + 512 * i, row = idx >> 4, ch = idx & 15; vr[i] = *(const v4u*)(PROJ + (rb_ + row) * INW + C_HI + h_ * 128 + ch * 8); } } while (0)
    if ((int)blockIdx.x < 2048) HA_LOAD((int)blockIdx.x);
    for (int unit = blockIdx.x; unit < 2048; unit += F.G) {
        const int dir = (unit >> 6) & 1;
        float lfa[8], lfb[8], ka[8], kb[8];
#pragma unroll
        for (int i = 0; i < 8; ++i) { const float za = __uint_as_float(zraw[i] << 16), zb = __uint_as_float(zraw[i] & 0xffff0000u);
            const float fa = lbA + (1.f - lbA) * __builtin_amdgcn_rcpf(1.f + za), fb = lbB + (1.f - lbB) * __builtin_amdgcn_rcpf(1.f + zb); lfa[i] = __logf(fa); lfb[i] = __logf(fb); ka[i] = 1.f - fa; kb[i] = 1.f - fb; }
#pragma unroll
        for (int i = 0; i < 2; ++i) { const int idx = tid + 512 * i, row = idx >> 4, ch = idx & 15; *(LAS v4u*)(VV + row * RS + ch * 16) = vr[i]; }
        if (unit + F.G < 2048) HA_LOAD(unit + F.G);
        float runa = 0.f, runb = 0.f;
        if (dir == 0) {
#pragma unroll
            for (int i = 0; i < 8; ++i) { runa += lfa[i]; lfa[i] = runa; runb += lfb[i]; lfb[i] = runb; } }
        else {
#pragma unroll
            for (int i = 7; i >= 0; --i) { runa += lfa[i]; lfa[i] = runa; runb += lfb[i]; lfb[i] = runb; } }
        *(LAS f32x2m*)(TOT + w * 128 + dk0) = (f32x2m){runa, runb};
        __syncthreads();
        float totA = 0.f, totB = 0.f, offA = 0.f, offB = 0.f;
#pragma unroll
        for (int p = 0; p < 8; ++p) { const f32x2m t = *(const LAS f32x2m*)(TOT + p * 128 + dk0); totA += t.x; totB += t.y;
            const bool inoff = dir == 0 ? (p < w) : (p > w); offA += inoff ? t.x : 0.f; offB += inoff ? t.y : 0.f; }
#pragma unroll
        for (int i = 0; i < 8; ++i) { const float va = ka[i] * __expf(totA - (lfa[i] + offA)), vb = kb[i] * __expf(totB - (lfb[i] + offB));
            *(LAS unsigned*)(KD + (8 * w + i) * RS + dk0 * 2) = pk2(va, vb); }
        if (w == 0) *(float2*)(DEC + (size_t)unit * 128 + dk0) = make_float2(__expf(totA), __expf(totB));
        __syncthreads();
        f32x4 acc[2][4];
#pragma unroll
        for (int a = 0; a < 2; ++a)
#pragma unroll
            for (int t = 0; t < 4; ++t) acc[a][t] = (f32x4){0.f, 0.f, 0.f, 0.f};
        const int dvb = 32 * (w & 3), dkb = 64 * (w >> 2);
#pragma unroll
        for (int s = 0; s < 2; ++s) {
            bf16x8 af[2], bfr[4];
#pragma unroll
            for (int a = 0; a < 2; ++a) af[a] = tr8(VV + (32 * s) * RS + (dvb + 16 * a) * 2 + tro16, 4 * RS);
#pragma unroll
            for (int t = 0; t < 4; ++t) bfr[t] = tr8(KD + (32 * s) * RS + (dkb + 16 * t) * 2 + tro16, 4 * RS);
#pragma unroll
            for (int a = 0; a < 2; ++a)
#pragma unroll
                for (int t = 0; t < 4; ++t) acc[a][t] = MFMA16(af[a], bfr[t], acc[a][t]);
        }
        unsigned char* cso = (unsigned char*)CS + (size_t)unit * 16384;
        const int cc = lane & 15, rg = lane >> 4;
        LAS unsigned char* CST = L + 40960;
#pragma unroll
        for (int a = 0; a < 2; ++a)
#pragma unroll
            for (int t = 0; t < 4; ++t) { const int dkk = dkb + 16 * t + cc, dv0 = dvb + 16 * a + 4 * rg;
                *(LAS unsigned*)(CST + dkk * 144 + dv0) = pg8::pk4_fp8(acc[a][t][0], acc[a][t][1], acc[a][t][2], acc[a][t][3]); }
        __syncthreads();
#pragma unroll
        for (int i = 0; i < 2; ++i) { const int idx = tid + 512 * i, row = idx >> 3, pc = idx & 7; *(v4u*)(cso + row * 128 + pc * 16) = *(const LAS v4u*)(CST + row * 144 + pc * 16); }
        __syncthreads();
    }
#undef HA_LOAD
}
__device__ __forceinline__ void hgrn_scan_phase(Ctx& F) {
    const unsigned char* CS = (const unsigned char*)(F.ws + WS_CS); unsigned char* ST = (unsigned char*)(F.ws + WS_STATE); const float* DEC = (const float*)(F.ws + WS_DEC);
    const int NT = F.G * 512;
    for (int gt = blockIdx.x * 512 + F.tid; gt < 32 * 4096; gt += NT) {
        const int g = gt >> 12, e4 = (gt & 4095) * 4, dk = e4 >> 7, dir = g & 1;
        float s0 = 0.f, s1 = 0.f, s2 = 0.f, s3 = 0.f;
        unsigned tn[8]; float dn[8];
#define SC_LOAD(st_) do { _Pragma("unroll") for (int k = 0; k < 8; ++k) { const int c_ = dir ? 63 - ((st_) + k) : (st_) + k; const size_t u_ = (size_t)g * 64 + c_; \
            tn[k] = __builtin_nontemporal_load((const unsigned*)(CS + u_ * 16384 + e4)); dn[k] = DEC[u_ * 128 + dk]; } } while (0)
        SC_LOAD(0);
        for (int st = 0; st < 64; st += 8) {
            unsigned tmp[8]; float dc[8];
#pragma unroll
            for (int k = 0; k < 8; ++k) { tmp[k] = tn[k]; dc[k] = dn[k]; }
            if (st + 8 < 64) SC_LOAD(st + 8);
#pragma unroll
            for (int k = 0; k < 8; ++k) { const int c = dir ? 63 - (st + k) : st + k; const size_t unit = (size_t)g * 64 + c;
                *(unsigned*)(ST + unit * 16384 + e4) = pg8::pk4_fp8(s0, s1, s2, s3);
                const f32x2q_t a0 = __builtin_amdgcn_cvt_pk_f32_fp8((int)tmp[k], false), a1 = __builtin_amdgcn_cvt_pk_f32_fp8((int)tmp[k], true);
                s0 = dc[k] * s0 + a0[0]; s1 = dc[k] * s1 + a0[1]; s2 = dc[k] * s2 + a1[0]; s3 = dc[k] * s3 + a1[1]; }
        }
#undef SC_LOAD
    }
}
__device__ __forceinline__ void hgrn_c_phase(Ctx& F, LAS unsigned char* L) {
    const bf16* PROJ = (const bf16*)(F.ws + WS_PROJ); const float* LB = (const float*)(F.ws + WS_LB); const bf16* ST = (const bf16*)(F.ws + WS_STATE); bf16* YAIN = (bf16*)(F.ws + WS_YAIN);
    LAS unsigned char* QI = L; LAS unsigned char* KI = L + 17408; LAS unsigned char* QE = L + 34816; LAS unsigned char* VV = L + 52224; LAS unsigned char* SP = L + 69632; LAS unsigned char* AM = L + 104448;
    LAS float* TOT = (LAS float*)(L + 113664); LAS float* SSQ = (LAS float*)(L + 117760);
    const int tid = F.tid, lane = F.lane, w = F.wave, dk0 = 2 * lane, cc = lane & 15, rg = lane >> 4;
    const int tro16 = (8 * (lane >> 4) + ((lane & 15) >> 2)) * RS + (lane & 3) * 8;
    unsigned zraw[8], qraw[8]; v4u vr[2], sr[2]; float lbA = 0.f, lbB = 0.f;
#define HC_LOAD(un, dr) do { const int c_ = (un) & 63, h_ = ((un) >> 6) & 7, b_ = (un) >> 9; const size_t rb_ = (size_t)b_ * SEQ + c_ * 64; \
        { const float2 l2_ = *(const float2*)(LB + (dr) * 1024 + h_ * 128 + dk0); lbA = l2_.x; lbB = l2_.y; } \
        const bf16* zp_ = PROJ + (rb_ + 8 * w) * INW + h_ * 128; \
        _Pragma("unroll") for (int i = 0; i < 8; ++i) { const bf16* rp_ = zp_ + (size_t)i * INW; zraw[i] = *(const unsigned*)(rp_ + ((dr) ? C_FB : C_FF) + dk0); if ((dr) == 0) qraw[i] = *(const unsigned*)(rp_ + C_HQ + dk0); } \
        if ((dr) == 0) { _Pragma("unroll") for (int i = 0; i < 2; ++i) { const int idx = tid + 512 * i, row = idx >> 4, ch = idx & 15; vr[i] = *(const v4u*)(PROJ + (rb_ + row) * INW + C_HI + h_ * 128 + ch * 8); } } \
        { const unsigned char* sp_ = (const unsigned char*)ST + ((size_t)((b_ * 8 + h_) * 2 + (dr)) * 64 + c_) * 16384;        \
          _Pragma("unroll") for (int i = 0; i < 2; ++i) { const int idx = tid + 512 * i; sr[i] = __builtin_nontemporal_load((const v4u*)(sp_ + idx * 16)); } } } while (0)
    if ((int)blockIdx.x < 1024) HC_LOAD((int)blockIdx.x, 0);
    for (int unit = blockIdx.x; unit < 1024; unit += F.G) {
        const int c = unit & 63, h = (unit >> 6) & 7, b = unit >> 9;
        const size_t rb = (size_t)b * SEQ + c * 64;
        f32x4 o[4];
#pragma unroll
        for (int t = 0; t < 4; ++t) o[t] = (f32x4){0.f, 0.f, 0.f, 0.f};
        float qa[8], qb[8];
        for (int dir = 0; dir < 2; ++dir) {
            float lfa[8], lfb[8], ka[8], kb[8];
#pragma unroll
            for (int i = 0; i < 8; ++i) { const float za = __uint_as_float(zraw[i] << 16), zb = __uint_as_float(zraw[i] & 0xffff0000u);
                const float fa = lbA + (1.f - lbA) * __builtin_amdgcn_rcpf(1.f + za), fb = lbB + (1.f - lbB) * __builtin_amdgcn_rcpf(1.f + zb); lfa[i] = __logf(fa); lfb[i] = __logf(fb); ka[i] = 1.f - fa; kb[i] = 1.f - fb;
                if (dir == 0) { qa[i] = __uint_as_float(qraw[i] << 16); qb[i] = __uint_as_float(qraw[i] & 0xffff0000u); } }
            if (dir == 0) {
#pragma unroll
                for (int i = 0; i < 2; ++i) { const int idx = tid + 512 * i, row = idx >> 4, ch = idx & 15; *(LAS v4u*)(VV + row * RS + ch * 16) = vr[i]; } }
#pragma unroll
            for (int i = 0; i < 2; ++i) { const int idx = tid + 512 * i, row = idx >> 3, ch = idx & 7; const unsigned wq[4] = {sr[i].x, sr[i].y, sr[i].z, sr[i].w}; unsigned ob[8];
#pragma unroll
                for (int q = 0; q < 4; ++q) { const f32x2q_t a0 = __builtin_amdgcn_cvt_pk_f32_fp8((int)wq[q], false), a1 = __builtin_amdgcn_cvt_pk_f32_fp8((int)wq[q], true); ob[2 * q] = cvtpk(a0[0], a0[1]); ob[2 * q + 1] = cvtpk(a1[0], a1[1]); }
                *(LAS v4u*)(SP + row * RS + ch * 32) = (v4u){ob[0], ob[1], ob[2], ob[3]}; *(LAS v4u*)(SP + row * RS + ch * 32 + 16) = (v4u){ob[4], ob[5], ob[6], ob[7]}; }
            if ((w & 1) == 0) { if (dir == 0) HC_LOAD(unit, 1); else if (unit + F.G < 1024) HC_LOAD(unit + F.G, 0); }
            float runa = 0.f, runb = 0.f;
            if (dir == 0) {
#pragma unroll
                for (int i = 0; i < 8; ++i) { runa += lfa[i]; lfa[i] = runa; runb += lfb[i]; lfb[i] = runb; } }
            else {
#pragma unroll
                for (int i = 7; i >= 0; --i) { runa += lfa[i]; lfa[i] = runa; runb += lfb[i]; lfb[i] = runb; } }
            *(LAS f32x2m*)(TOT + w * 128 + dk0) = (f32x2m){runa, runb};
            __syncthreads();
            if ((w & 1) != 0) { if (dir == 0) HC_LOAD(unit, 1); else if (unit + F.G < 1024) HC_LOAD(unit + F.G, 0); }
            {   float offA = 0.f, offB = 0.f, brA = 0.f, brB = 0.f;
#pragma unroll
                for (int p = 0; p < 8; ++p) { const f32x2m t = *(const LAS f32x2m*)(TOT + p * 128 + dk0);
                    const bool inoff = dir == 0 ? (p < w) : (p > w), inref = dir == 0 ? (p < 4) : (p >= 4);
                    offA += inoff ? t.x : 0.f; offB += inoff ? t.y : 0.f; brA += inref ? t.x : 0.f; brB += inref ? t.y : 0.f; }
                const float cEa = __expf(brA), cEb = __expf(brB);
#pragma unroll
                for (int i = 0; i < 8; ++i) { const float ea = __expf(lfa[i] + offA - brA), eb = __expf(lfb[i] + offB - brB); const int ro = (8 * w + i) * RS + dk0 * 2;
                    const float qia = qa[i] * ea, qib = qb[i] * eb;
                    *(LAS unsigned*)(QI + ro) = pk2(qia, qib);
                    *(LAS unsigned*)(KI + ro) = pk2(ka[i] * __builtin_amdgcn_rcpf(ea), kb[i] * __builtin_amdgcn_rcpf(eb));
                    *(LAS unsigned*)(QE + ro) = pk2(qia * cEa, qib * cEb); }
            }
            __syncthreads();
            {
                const int rt = w >> 1, ct0 = 2 * (w & 1);
                f32x4 am[2] = {(f32x4){0.f, 0.f, 0.f, 0.f}, (f32x4){0.f, 0.f, 0.f, 0.f}};
#pragma unroll
                for (int s = 0; s < 4; ++s) { const bf16x8 af = ld8(QI + (16 * rt + cc) * RS + (32 * s + 8 * rg) * 2);
#pragma unroll
                    for (int t = 0; t < 2; ++t) { const bf16x8 bfr = ld8(KI + (16 * (ct0 + t) + cc) * RS + (32 * s + 8 * rg) * 2); am[t] = MFMA16(af, bfr, am[t]); } }
#pragma unroll
                for (int t = 0; t < 2; ++t)
#pragma unroll
                    for (int i = 0; i < 4; ++i) { const int l = 16 * rt + 4 * rg + i, m = 16 * (ct0 + t) + cc; const bool keep = dir == 0 ? (m <= l) : (m >= l);
                        *(LAS bf16*)(AM + l * RSA + m * 2) = f2bf(keep ? am[t][i] : 0.f); }
            }
            __syncthreads();
            {
                const int rt = w & 3, cb = 64 * (w >> 2);
#pragma unroll
                for (int s = 0; s < 2; ++s) { const bf16x8 af = ld8(AM + (16 * rt + cc) * RSA + (32 * s + 8 * rg) * 2);
#pragma unroll
                    for (int t = 0; t < 4; ++t) { const bf16x8 bfr = tr8(VV + (32 * s) * RS + (cb + 16 * t) * 2 + tro16, 4 * RS); o[t] = MFMA16(af, bfr, o[t]); } }
#pragma unroll
                for (int s = 0; s < 4; ++s) { const bf16x8 af = ld8(QE + (16 * rt + cc) * RS + (32 * s + 8 * rg) * 2);
#pragma unroll
                    for (int t = 0; t < 4; ++t) { const bf16x8 bfr = tr8(SP + (32 * s) * RS + (cb + 16 * t) * 2 + tro16, 4 * RS); o[t] = MFMA16(af, bfr, o[t]); } }
            }
            __syncthreads();
        }
        const int rt = w & 3, chh = w >> 2, cb = 64 * chh;
        bf16 hgv[4][4]; float onv[4];
#pragma unroll
        for (int t = 0; t < 4; ++t) { const int dv = cb + 16 * t + cc; onv[t] = F.onorm[h * 128 + dv];
#pragma unroll
            for (int i = 0; i < 4; ++i) hgv[i][t] = PROJ[(rb + 16 * rt + 4 * rg + i) * INW + C_HG + h * 128 + dv]; }
        float ssv[4];
#pragma unroll
        for (int i = 0; i < 4; ++i) { float sq = 0.f;
#pragma unroll
            for (int t = 0; t < 4; ++t) sq += o[t][i] * o[t][i];
            sq += __shfl_xor(sq, 1); sq += __shfl_xor(sq, 2); sq += __shfl_xor(sq, 4); sq += __shfl_xor(sq, 8); ssv[i] = sq; }
        if (cc == 0) {
#pragma unroll
            for (int i = 0; i < 4; ++i) SSQ[chh * 64 + 16 * rt + 4 * rg + i] = ssv[i]; }
        __syncthreads();
        float rr[4];
#pragma unroll
        for (int i = 0; i < 4; ++i) { const int l = 16 * rt + 4 * rg + i; rr[i] = rsqrtf((SSQ[l] + SSQ[64 + l]) * (1.f / 128.f) + EPS); }
#pragma unroll
        for (int i = 0; i < 4; ++i) { const int l = 16 * rt + 4 * rg + i;
#pragma unroll
            for (int t = 0; t < 4; ++t) { const int dv = cb + 16 * t + cc;
                YAIN[(rb + l) * 1024 + h * 128 + dv] = f2bf(o[t][i] * rr[i] * onv[t] * siluf_(bf2f(hgv[i][t]))); } }
        __syncthreads();
    }
#undef HC_LOAD
}
__device__ __forceinline__ void rope8(v4u& a, v4u& bq, const f32x4 (&cs)[4]) {
    const unsigned aw[4] = {a.x, a.y, a.z, a.w}, bw[4] = {bq.x, bq.y, bq.z, bq.w}; unsigned o1[4], o2[4];
#pragma unroll
    for (int k = 0; k < 4; ++k) { const f32x4 c4 = cs[k];
        const float x1a = __uint_as_float(aw[k] << 16), x1b = __uint_as_float(aw[k] & 0xffff0000u), x2a = __uint_as_float(bw[k] << 16), x2b = __uint_as_float(bw[k] & 0xffff0000u);
        o1[k] = pk2(x1a * c4.x - x2a * c4.y, x1b * c4.z - x2b * c4.w); o2[k] = pk2(x1a * c4.y + x2a * c4.x, x1b * c4.w + x2b * c4.z); }
    a = (v4u){o1[0], o1[1], o1[2], o1[3]}; bq = (v4u){o2[0], o2[1], o2[2], o2[3]};
}
template <bool WITH_SCAN> __device__ __forceinline__ void attn_phase(Ctx& F, LAS unsigned char* L) {
    constexpr int SNB = 16, SNBAT = 64 / SNB;
    const unsigned char* CSs = (const unsigned char*)(F.ws + WS_CS); unsigned char* STs = (unsigned char*)(F.ws + WS_STATE);
    const int swave = __builtin_amdgcn_readfirstlane(F.tid >> 6);
    LAS unsigned char* RING = L + 36864 + swave * (2 * SNB * 256); LAS float* DECL = (LAS float*)(L + 122880);
    static_assert(36864 + 8 * 2 * SNB * 256 <= 122880, "ring layout");
    const int sg = (int)blockIdx.x >> 3, sdir = sg & 1, e0w = (((int)blockIdx.x & 7) * 512 + swave * 64) * 4, sdkl = swave * 2 + (F.lane >> 5);
    float ss0 = 0.f, ss1 = 0.f, ss2 = 0.f, ss3 = 0.f; int sbt = 0;
#define SC_ISSUE(t_) do { if ((t_) < SNBAT) { LAS unsigned char* slot_ = RING + ((t_) & 1) * (SNB * 256); \
        _Pragma("unroll") for (int i_ = 0; i_ < SNB / 4; ++i_) { const int step_ = (t_) * SNB + 4 * i_ + (F.lane >> 4); const int c_ = sdir ? 63 - step_ : step_; \
            __builtin_amdgcn_global_load_lds((const unsigned*)(CSs + ((size_t)(sg * 64 + c_) * 16384 + e0w + 16 * (F.lane & 15))), (LAS unsigned*)(slot_ + i_ * 1024), 16, 0, 0); } } } while (0)
#define SC_CONSUME(t_) do { if ((t_) < SNBAT) { const LAS unsigned char* slot_ = RING + ((t_) & 1) * (SNB * 256) + F.lane * 4; \
        _Pragma("unroll") for (int k_ = 0; k_ < SNB; ++k_) { const int step_ = (t_) * SNB + k_; const int c_ = sdir ? 63 - step_ : step_; \
            const unsigned d_ = *(const LAS unsigned*)(slot_ + k_ * 256); const float dc_ = DECL[c_ * 16 + sdkl]; \
            *(unsigned*)(STs + (size_t)(sg * 64 + c_) * 16384 + e0w + 4 * F.lane) = pg8::pk4_fp8(ss0, ss1, ss2, ss3); \
            const f32x2q_t a0_ = __builtin_amdgcn_cvt_pk_f32_fp8((int)d_, false), a1_ = __builtin_amdgcn_cvt_pk_f32_fp8((int)d_, true); \
            ss0 = dc_ * ss0 + a0_[0]; ss1 = dc_ * ss1 + a0_[1]; ss2 = dc_ * ss2 + a1_[0]; ss3 = dc_ * ss3 + a1_[1]; } } } while (0)
    if (WITH_SCAN) {
        SC_ISSUE(0);
        const float* DECs = (const float*)(F.ws + WS_DEC);
        for (int idx = F.tid; idx < 1024; idx += 512) DECL[idx] = DECs[(size_t)(sg * 64 + (idx >> 4)) * 128 + ((int)blockIdx.x & 7) * 16 + (idx & 15)];
        __syncthreads();
    }
    const bf16* PROJ = (const bf16*)(F.ws + WS_PROJ); const float* ROPE = (const float*)(F.ws + WS_ROPE); bf16* ATT = (bf16*)(F.ws + WS_ATT);
    LAS unsigned char* KT = L; LAS unsigned char* VT = L + 17408; LAS float* AL = (LAS float*)(L + 34816) + F.wave * 32;
    const int tid = F.tid, lane = F.lane, w = F.wave, q32 = lane & 31, hh = lane >> 5;
    const int tro32 = (4 * hh + ((lane & 15) >> 2)) * RS + (16 * ((lane >> 4) & 1) + 4 * (lane & 3)) * 2;
    const int krow = tid >> 3, kc8 = tid & 7;
    constexpr float C2 = 0.08838834764831845f * LOG2E;
    for (int unit = blockIdx.x; unit < 256; unit += F.G) {
        const int qb = unit & 63, kvh = (unit >> 6) & 1, b = unit >> 7, q0 = qb * 64, h = kvh * 4 + (w >> 1);
        const int qp = q0 + 32 * (w & 1) + q32;
        bf16x8 qf[8];
        {
            const bf16* qptr = PROJ + ((size_t)b * SEQ + qp) * INW + C_AQ + h * 128 + 8 * hh;
            const f32x4* rp = (const f32x4*)(ROPE + (((size_t)b * SEQ + qp) * 64 + 8 * hh) * 2);
#pragma unroll
            for (int s = 0; s < 4; ++s) { v4u x1 = *(const v4u*)(qptr + 16 * s), x2 = *(const v4u*)(qptr + 16 * s + 64);
                f32x4 cs[4];
#pragma unroll
                for (int k = 0; k < 4; ++k) cs[k] = rp[8 * s + k];
                rope8(x1, x2, cs); qf[s] = __builtin_bit_cast(bf16x8, x1); qf[s + 4] = __builtin_bit_cast(bf16x8, x2); }
        }
        float m = F.sink[h] * LOG2E, l = 1.f;
        f32x16 o[4];
#pragma unroll
        for (int d = 0; d < 4; ++d)
#pragma unroll
            for (int r = 0; r < 16; ++r) o[d][r] = 0.f;
        int j = 0; while (j < 5 && (q0 - 128 + 64 * j < 0 || q0 - 128 + 64 * j >= SEQ)) ++j;
        v4u kr[2], vr[2]; f32x4 kcs[4];
#define ATT_LOAD(jj) do { const int kb_ = q0 - 128 + 64 * (jj); \
            { const size_t t_ = (size_t)b * SEQ + kb_ + krow; const bf16* kp_ = PROJ + t_ * INW + C_AK + kvh * 128 + kc8 * 8; kr[0] = *(const v4u*)kp_; kr[1] = *(const v4u*)(kp_ + 64); \
              const f32x4* rp_ = (const f32x4*)(ROPE + (t_ * 64 + kc8 * 8) * 2); _Pragma("unroll") for (int k = 0; k < 4; ++k) kcs[k] = rp_[k]; } \
            _Pragma("unroll") for (int i = 0; i < 2; ++i) { const int idx = tid + 512 * i, row = idx >> 4, ch = idx & 15; \
                vr[i] = *(const v4u*)(PROJ + ((size_t)b * SEQ + kb_ + row) * INW + C_AV + kvh * 128 + ch * 8); } } while (0)
        if (j < 5) ATT_LOAD(j);
        while (j < 5) {
            const int kb = q0 - 128 + 64 * j;
            if (WITH_SCAN) asm volatile("s_waitcnt vmcnt(0)" ::: "memory");
            __syncthreads();
            rope8(kr[0], kr[1], kcs);
            *(LAS v4u*)(KT + krow * RS + kc8 * 16) = kr[0]; *(LAS v4u*)(KT + krow * RS + (kc8 + 8) * 16) = kr[1];
#pragma unroll
            for (int i = 0; i < 2; ++i) { const int idx = tid + 512 * i, row = idx >> 4, ch = idx & 15; *(LAS v4u*)(VT + row * RS + ch * 16) = vr[i]; }
            __syncthreads();
            int jn = j + 1; while (jn < 5 && (q0 - 128 + 64 * jn < 0 || q0 - 128 + 64 * jn >= SEQ)) ++jn;
            if (jn < 5) ATT_LOAD(jn);
            if (WITH_SCAN) { SC_ISSUE(sbt + 1); SC_CONSUME(sbt); ++sbt; }
            f32x16 p0, p1;
#pragma unroll
            for (int r = 0; r < 16; ++r) { p0[r] = 0.f; p1[r] = 0.f; }
#pragma unroll
            for (int s = 0; s < 8; ++s) { const bf16x8 k0 = ld8(KT + q32 * RS + (16 * s + 8 * hh) * 2), k1 = ld8(KT + (32 + q32) * RS + (16 * s + 8 * hh) * 2);
                p0 = MFMA32(k0, qf[s], p0); p1 = MFMA32(k1, qf[s], p1); }
            float tmax = -INFINITY;
#pragma unroll
            for (int r = 0; r < 16; ++r) { const int d0 = kb + crow(r, hh) - qp;
                p0[r] = ((unsigned)(d0 + 128) <= 256u) ? p0[r] * C2 : -INFINITY; p1[r] = ((unsigned)(d0 + 32 + 128) <= 256u) ? p1[r] * C2 : -INFINITY;
                tmax = fmaxf(tmax, fmaxf(p0[r], p1[r])); }
            tmax = fmaxf(tmax, __shfl_xor(tmax, 32));
            const float mn = fmaxf(m, tmax), alpha = __builtin_amdgcn_exp2f(m - mn); m = mn;
            float rs = 0.f;
#pragma unroll
            for (int r = 0; r < 16; ++r) { p0[r] = __builtin_amdgcn_exp2f(p0[r] - mn); p1[r] = __builtin_amdgcn_exp2f(p1[r] - mn); rs += p0[r] + p1[r]; }
            rs += __shfl_xor(rs, 32);
            l = l * alpha + rs;
            if (hh == 0) AL[q32] = alpha;
            LDS_WAIT();
#pragma unroll
            for (int g4 = 0; g4 < 4; ++g4) { const f32x4 a4 = *(const LAS f32x4*)(AL + 8 * g4 + 4 * hh);
#pragma unroll
                for (int d = 0; d < 4; ++d) { o[d][4 * g4 + 0] *= a4.x; o[d][4 * g4 + 1] *= a4.y; o[d][4 * g4 + 2] *= a4.z; o[d][4 * g4 + 3] *= a4.w; } }
#pragma unroll
            for (int kb2 = 0; kb2 < 2; ++kb2)
#pragma unroll
                for (int s = 0; s < 2; ++s) {
                    unsigned pw[4];
#pragma unroll
                    for (int k = 0; k < 4; ++k) pw[k] = kb2 ? cvtpk(p1[8 * s + 2 * k], p1[8 * s + 2 * k + 1]) : cvtpk(p0[8 * s + 2 * k], p0[8 * s + 2 * k + 1]);
                    const bf16x8 pa = __builtin_bit_cast(bf16x8, (v4u){pw[0], pw[1], pw[2], pw[3]});
#pragma unroll
                    for (int d = 0; d < 4; ++d) { const bf16x8 vf = tr8(VT + (32 * kb2 + 16 * s) * RS + 64 * d + tro32, 8 * RS); o[d] = MFMA32(pa, vf, o[d]); }
                }
            j = jn;
        }
#undef ATT_LOAD
        if (hh == 0) AL[q32] = 1.f / l;
        LDS_WAIT();
#pragma unroll
        for (int g4 = 0; g4 < 4; ++g4) { const f32x4 a4 = *(const LAS f32x4*)(AL + 8 * g4 + 4 * hh); const float av[4] = {a4.x, a4.y, a4.z, a4.w};
#pragma unroll
            for (int i = 0; i < 4; ++i) { const int r = 4 * g4 + i; const int qrow = q0 + 32 * (w & 1) + crow(r, hh);
                bf16* op = ATT + ((size_t)b * SEQ + qrow) * 1024 + h * 128 + q32;
#pragma unroll
                for (int d = 0; d < 4; ++d) op[32 * d] = f2bf(o[d][r] * av[i]); } }
        __syncthreads();
    }
    if (WITH_SCAN) { while (sbt < SNBAT) { asm volatile("s_waitcnt vmcnt(0)" ::: "memory"); SC_ISSUE(sbt + 1); SC_CONSUME(sbt); ++sbt; } }
#undef SC_ISSUE
#undef SC_CONSUME
}

#ifdef TESTMODE
__global__ void __launch_bounds__(256) k_rope(const bf16* __restrict__ PROJ, const float* __restrict__ rope, bf16* __restrict__ QR, bf16* __restrict__ KR) {
    const int gid = blockIdx.x * 256 + threadIdx.x;
    const int i = gid & 63, hh = (gid >> 6) % 10, t = gid / 640;
    const float cs = rope[((size_t)t * 64 + i) * 2], sn = rope[((size_t)t * 64 + i) * 2 + 1];
    const bf16* src = PROJ + (size_t)t * INW + (hh < 8 ? C_AQ + hh * 128 : C_AK + (hh - 8) * 128);
    const float x1 = bf2f(src[i]), x2 = bf2f(src[i + 64]);
    bf16* dst = hh < 8 ? QR + (size_t)t * 1024 + hh * 128 : KR + (size_t)t * 256 + (hh - 8) * 128;
    dst[i] = f2bf(x1 * cs - x2 * sn); dst[i + 64] = f2bf(x1 * sn + x2 * cs);
}
__global__ void __launch_bounds__(256) k_hgrn_naive(const bf16* __restrict__ PROJ, const float* __restrict__ lb, float* __restrict__ OF, float* __restrict__ OB) {
    __shared__ float qs[128], fs[128], ks[128], part[128];
    const int dir = blockIdx.x & 1, h = (blockIdx.x >> 1) & 7, b = blockIdx.x >> 4, tid = threadIdx.x, dv = tid & 127, half = tid >> 7;
    float S[64];
#pragma unroll
    for (int i = 0; i < 64; ++i) S[i] = 0.f;
    float* O = dir ? OB : OF;
    const float lbv = tid < 128 ? lb[dir * 1024 + h * 128 + tid] : 0.f;
    bf16 nzq = 0, nzf = 0, nv = 0;
    { const int t = dir ? SEQ - 1 : 0; const bf16* pr = PROJ + ((size_t)b * SEQ + t) * INW;
      if (tid < 128) { nzq = pr[C_HQ + h * 128 + tid]; nzf = pr[(dir ? C_FB : C_FF) + h * 128 + tid]; } nv = pr[C_HI + h * 128 + dv]; }
    for (int tp = 0; tp < SEQ; ++tp) {
        const int t = dir ? SEQ - 1 - tp : tp; const size_t row = (size_t)b * SEQ + t;
        const bf16 czq = nzq, czf = nzf, cv = nv;
        if (tp + 1 < SEQ) { const int t2 = dir ? SEQ - 2 - tp : tp + 1; const bf16* pr = PROJ + ((size_t)b * SEQ + t2) * INW;
            if (tid < 128) { nzq = pr[C_HQ + h * 128 + tid]; nzf = pr[(dir ? C_FB : C_FF) + h * 128 + tid]; } nv = pr[C_HI + h * 128 + dv]; }
        if (tid < 128) { const float zq = bf2f(czq), zf = bf2f(czf);
            const float f = lbv + (1.f - lbv) * sigmoidf_(zf); qs[tid] = siluf_(zq); fs[tid] = f; ks[tid] = 1.f - f; }
        const float v = bf2f(cv);
        __syncthreads();
        float acc = 0.f;
#pragma unroll
        for (int i = 0; i < 64; ++i) { const int dk = half * 64 + i; S[i] = fs[dk] * S[i] + ks[dk] * v; acc += S[i] * qs[dk]; }
        if (half == 1) part[dv] = acc;
        __syncthreads();
        if (half == 0) O[row * 1024 + h * 128 + dv] = acc + part[dv];
    }
}
__global__ void __launch_bounds__(256) k_hgrn_post(const float* __restrict__ OF, const float* __restrict__ OB, const bf16* __restrict__ PROJ, const float* __restrict__ onorm, bf16* __restrict__ YAIN) {
    const int w = blockIdx.x * 4 + (threadIdx.x >> 6), lane = threadIdx.x & 63, row = w >> 3, h = w & 7;
    const size_t o = (size_t)row * 1024 + h * 128;
    const float a0 = OF[o + lane] + OB[o + lane], a1 = OF[o + 64 + lane] + OB[o + 64 + lane];
    float ss = a0 * a0 + a1 * a1;
    for (int s = 32; s > 0; s >>= 1) ss += __shfl_xor(ss, s);
    const float r = rsqrtf(ss * (1.f / 128.f) + EPS);
    const bf16* pg = PROJ + (size_t)row * INW + C_HG + h * 128;
    YAIN[o + lane] = f2bf(a0 * r * onorm[h * 128 + lane] * siluf_(bf2f(pg[lane])));
    YAIN[o + 64 + lane] = f2bf(a1 * r * onorm[h * 128 + 64 + lane] * siluf_(bf2f(pg[64 + lane])));
}
__global__ void __launch_bounds__(256) k_attn_naive(const bf16* __restrict__ QR, const bf16* __restrict__ KR, const bf16* __restrict__ PROJ, const float* __restrict__ sink, bf16* __restrict__ ATT) {
    __shared__ float sl[4][264];
    const int wv = threadIdx.x >> 6, lane = threadIdx.x & 63;
    const int w = blockIdx.x * 4 + wv;
    const int i = w & 4095, h = (w >> 12) & 7, b = w >> 15, kvh = h >> 2;
    const size_t qrow = (size_t)b * SEQ + i;
    const float q0 = bf2f(QR[qrow * 1024 + h * 128 + 2 * lane]), q1 = bf2f(QR[qrow * 1024 + h * 128 + 2 * lane + 1]);
    const int jlo = i - 128 < 0 ? 0 : i - 128, jhi = i + 128 > SEQ - 1 ? SEQ - 1 : i + 128;
    const float sk = sink[h];
    float m = sk;
    for (int j = jlo; j <= jhi; ++j) {
        const bf16* kr = KR + ((size_t)b * SEQ + j) * 256 + kvh * 128;
        float p = q0 * bf2f(kr[2 * lane]) + q1 * bf2f(kr[2 * lane + 1]);
        for (int s = 32; s > 0; s >>= 1) p += __shfl_xor(p, s);
        p *= 0.08838834764831845f;
        if (lane == 0) sl[wv][j - jlo] = p;
        m = fmaxf(m, p);
    }
    __syncthreads();
    float den = expf(sk - m), o0 = 0.f, o1 = 0.f;
    for (int j = jlo; j <= jhi; ++j) {
        const float p = expf(sl[wv][j - jlo] - m); den += p;
        const bf16* vr = PROJ + ((size_t)b * SEQ + j) * INW + C_AV + kvh * 128;
        o0 += p * bf2f(vr[2 * lane]); o1 += p * bf2f(vr[2 * lane + 1]);
    }
    ATT[qrow * 1024 + h * 128 + 2 * lane] = f2bf(o0 / den); ATT[qrow * 1024 + h * 128 + 2 * lane + 1] = f2bf(o1 / den);
}
#endif
__global__ void __launch_bounds__(NWAVES * 64, 2) mega(Args args) {
    extern __shared__ __attribute__((aligned(16))) unsigned char lds[];
    Ctx F;
    F.lds = lds; F.tid = threadIdx.x; F.lane = F.tid & 63; F.wave = __builtin_amdgcn_readfirstlane(F.tid >> 6); F.G = gridDim.x;
    F.gw = blockIdx.x * NWAVES + F.wave; F.NGW = F.G * NWAVES;
    F.x = (const float*)args.in[0]; F.c = (const float*)args.in[1]; F.pos = (const int*)args.in[2]; F.w_ada = (const float*)args.in[3]; F.b_ada = (const float*)args.in[4];
    F.g_pre_mix = (const float*)args.in[5]; F.g_post_mix = (const float*)args.in[6]; F.g_pre_ffn = (const float*)args.in[7]; F.g_post_ffn = (const float*)args.in[8];
    F.w_in = (const float*)args.in[9]; F.lbl = (const float*)args.in[10]; F.onorm = (const float*)args.in[11]; F.sink = (const float*)args.in[12];
    F.w_a = (const float*)args.in[13]; F.w_b = (const float*)args.in[14]; F.w_o = (const float*)args.in[15]; F.w_router = (const float*)args.in[16];
    F.w_eg = (const float*)args.in[17]; F.w_eu = (const float*)args.in[18]; F.w_ed = (const float*)args.in[19];
    F.out = args.out; F.ws = args.ws;
    LAS unsigned char* ldsl = (LAS unsigned char*)lds;
    for (int u = F.tid; u < (LDS_BYTES - LDSCTL_OFF) / 4; u += NWAVES * 64) ((LAS unsigned*)(ldsl + LDSCTL_OFF))[u] = 0u;
    __syncthreads();
    volatile LAS unsigned* MISC = (volatile LAS unsigned*)(ldsl + MISC_OFF);
    XcdBarrier bar = xcd_barrier_post((unsigned*)(args.ws + WS_CTL) + CW_BAR + args.li * XCD_BAR_WORDS, MISC + 8);
    const int lo = args.ph_lo, hi = args.ph_hi;
#ifdef PROBE_REP
#define REP(k) ((((PROBE_REP) >> (k)) & 1) ? 2 : 1)
#else
#define REP(k) 1
#endif
#define IN(k) (lo <= (k) && (k) < hi)
#define SEAM(k) do { if (IN(k) && IN((k) + 1)) xcd_barrier(bar); } while (0)
    unsigned char* ws = args.ws;
    bf16* H = (bf16*)(ws + WS_H); bf16* PROJ = (bf16*)(ws + WS_PROJ); bf16* WIN = (bf16*)(ws + WS_WIN); bf16* WA = (bf16*)(ws + WS_WA); bf16* WB = (bf16*)(ws + WS_WB); bf16* WO = (bf16*)(ws + WS_WO);
    bf16* WGU = (bf16*)(ws + WS_WGU); bf16* WD = (bf16*)(ws + WS_WD); bf16* YAIN = (bf16*)(ws + WS_YAIN); bf16* ATT = (bf16*)(ws + WS_ATT); bf16* MERGED = (bf16*)(ws + WS_MERGED);
    float* Y = (float*)(ws + WS_Y); bf16* XE = (bf16*)(ws + WS_XE); bf16* ACT = (bf16*)(ws + WS_ACT); bf16* SLAB = (bf16*)(ws + WS_SLAB); const float* SELAFF = (const float*)(ws + WS_SELAFF);
    const int vcu = (F.G % 8 == 0) ? ((int)blockIdx.x % 8) * (F.G / 8) + (int)blockIdx.x / 8 : (int)blockIdx.x;

    {
    if (IN(0)) { p0_prep(F); __syncthreads(); } SEAM(0);
#if defined(PROBE_DUP) && PROBE_DUP == 0
    if (IN(0)) { p0_prep(F); __syncthreads(); } SEAM(0);
#endif
    }
    {
    if (IN(2)) {
        if (F.G == 256 && blockIdx.x >= 256 - CONV_BLOCKS) { float* scr = (float*)(F.lds + F.wave * 16384); TailSeq seq{I_MIX + P0_EXPERT_ITEMS + ((int)blockIdx.x - (256 - CONV_BLOCKS)) * NWAVES + F.wave, CONV_BLOCKS * NWAVES}; transpose_stream(F, seq, scr); }
        else {
            const int gg = F.G == 256 ? 256 - CONV_BLOCKS : F.G;
            pg8::Gemm g{H, WIN, T, INW, D / 2}; pg8::StaticOrder S; S.init(T, INW, gg, (int)blockIdx.x);
            pg8::EpiStore E{PROJ, INW, 0xffff, nullptr, 1.f / (W8S_IN * X8S_IN), false, C_HQ / 256, C_FF / 256};
            pg8::gemm_phase<pg8::EpiStore, pg8::StaticOrder, PG8_ALIGN, PG8_SP2, false, true>(ldsl + RING_OFF, g, S, E);
            if (F.G != 256 && blockIdx.x == 0) { float* scr = (float*)(F.lds + F.wave * 16384); TailSeq seq{I_MIX + P0_EXPERT_ITEMS + F.wave, NWAVES}; transpose_stream(F, seq, scr); }
        }
    } SEAM(2);
    }
    {
    if (IN(3)) { if (args.mask & 2) hgrn_a_phase(F, ldsl); } SEAM(3);
#if defined(PROBE_DUP) && PROBE_DUP == 3
    if (IN(3)) { if (args.mask & 2) hgrn_a_phase(F, ldsl); } SEAM(3);
#endif
    }
    {
    if (IN(4)) { if ((args.mask & 3) == 3 && F.G == 256) attn_phase<true>(F, ldsl); else { if (args.mask & 2) hgrn_scan_phase(F); if (args.mask & 1) attn_phase<false>(F, ldsl); } } SEAM(4);
#if defined(PROBE_DUP) && PROBE_DUP == 4
    if (IN(4)) { if ((args.mask & 3) == 3 && F.G == 256) attn_phase<true>(F, ldsl); else { if (args.mask & 2) hgrn_scan_phase(F); if (args.mask & 1) attn_phase<false>(F, ldsl); } } SEAM(4);
#endif
    }
    {
    if (IN(5)) { if (args.mask & 2) hgrn_c_phase(F, ldsl); } SEAM(5);
#if defined(PROBE_DUP) && PROBE_DUP == 5
    if (IN(5)) { if (args.mask & 2) hgrn_c_phase(F, ldsl); } SEAM(5);
#endif
    }
    {
    if (IN(6)) {
        static_assert(WS_ATT == WS_YAIN + 16 * MiB && WS_WB == WS_WA + 4 * MiB, "branch operands must be contiguous");
        pg8::Gemm g{YAIN, WA, 2 * T, 2 * D, 1024}; pg8::BranchOrder S; S.S.init(T, D, F.G, (int)blockIdx.x);
        pg8::EpiGate2 E{MERGED, D, PROJ + C_GA, PROJ + C_GB, INW};
        pg8::gemm_phase<pg8::EpiGate2, pg8::BranchOrder, PG8_ALIGN, PG8_SP2>(ldsl + RING_OFF, g, S, E);
    } SEAM(6);
    }
    {
    if (IN(7)) {
        pg8::Gemm g{MERGED, WO, T, D, D}; pg8::StaticOrder S; S.init(T, D, F.G, (int)blockIdx.x);
        pg8::EpiStore E{(bf16*)Y, D, 0xffff, nullptr};
        pg8::gemm_phase<pg8::EpiStore, pg8::StaticOrder, PG8_ALIGN, PG8_SP2>(ldsl + RING_OFF, g, S, E);
    } SEAM(7);
#if defined(PROBE_DUP) && PROBE_DUP == 7
    if (IN(7)) {
        pg8::Gemm g{MERGED, WO, T, D, D}; pg8::StaticOrder S; S.init(T, D, F.G, (int)blockIdx.x);
        pg8::EpiStore E{(bf16*)Y, D, 0xffff, nullptr};
        pg8::gemm_phase<pg8::EpiStore, pg8::StaticOrder, PG8_ALIGN, PG8_SP2>(ldsl + RING_OFF, g, S, E);
    } SEAM(7);
#endif
    }
    {
    if (IN(8)) { p6_post1(F); } SEAM(8);
#if defined(PROBE_DUP) && PROBE_DUP == 8
    if (IN(8)) { p6_post1(F); } SEAM(8);
#endif
    }
    {
    if (IN(9)) { p7_topk_gather(F); } SEAM(9);
#if defined(PROBE_DUP) && PROBE_DUP == 9
    if (IN(9)) { p7_topk_gather(F); } SEAM(9);
#endif
    }
    {
    if (IN(10)) {
        pg8::Gemm g{(const bf16*)(ws + WS_H2), WGU, 16 * 1024, 16 * 2048, D / 2, (const int*)(ws + WS_GIDX)}; pg8::GroupedOrder S{F.G, vcu};
        pg8::EpiSwiglu8 E{(unsigned char*)ACT, 1.f / W8S_GU};
        pg8::gemm_phase<pg8::EpiSwiglu8, pg8::GroupedOrder, PG8_ALIGN, PG8_SP2, true, true>(ldsl + RING_OFF, g, S, E);
    } SEAM(10);
    }
    {
    if (IN(11)) {
        pg8::Gemm g{ACT, WD, 16 * 1024, 16 * 2048, 1024 / 2}; pg8::GroupedOrder S{F.G, vcu};
        pg8::EpiStore E{SLAB, D, 7, SELAFF, SLAB8S / W8S_D, true};
        pg8::gemm_phase<pg8::EpiStore, pg8::GroupedOrder, PG8_ALIGN, PG8_SP2, false, true>(ldsl + RING_OFF, g, S, E);
    } SEAM(11);
    }
    {
    if (IN(12)) { p10_final(F); }
    }
#undef IN
#undef SEAM
}

extern "C" void kernel_launch(void* const* d_in, const int* in_sizes, int n_in, void* d_out, int out_size, void* d_ws, size_t ws_size, hipStream_t stream) {
    static int grid = 0;
    if (grid == 0) {
        if (n_in != 20 || ws_size < WS_END) { fprintf(stderr, "kernel_launch: unexpected n_in %d or ws_size %zu\n", n_in, ws_size); grid = -1; return; }
        int dev = 0, cus = 0;
        if (hipGetDevice(&dev) != hipSuccess || hipDeviceGetAttribute(&cus, hipDeviceAttributeMultiprocessorCount, dev) != hipSuccess) { grid = -1; return; }
        if (hipFuncSetAttribute((const void*)mega, hipFuncAttributeMaxDynamicSharedMemorySize, LDS_BYTES) != hipSuccess) { fprintf(stderr, "kernel_launch: hipFuncSetAttribute failed\n"); grid = -1; return; }
        grid = cus;
    }
    if (grid < 0) return;
    char* ws = (char*)d_ws;
    (void)hipMemsetAsync(ws + WS_CTL, 0, CTL_ZERO_BYTES, stream);
    Args a{};
    for (int i = 0; i < 20; ++i) a.in[i] = d_in[i];
    a.out = (float*)d_out; a.ws = (unsigned char*)d_ws;
#ifndef TESTMODE
    a.ph_lo = 0; a.ph_hi = 13; a.li = 0; a.mask = 3;
#ifdef PROBE_REPEAT
    a.rep = PROBE_REPEAT;
#else
    a.rep = -1;
#endif
    hipLaunchKernelGGL(mega, dim3(grid), dim3(NWAVES * 64), LDS_BYTES, stream, a);
#ifdef PROBE_LO
    a.ph_lo = PROBE_LO; a.ph_hi = PROBE_HI; a.li = 1; a.mask = PROBE_MASK;
    hipLaunchKernelGGL(mega, dim3(grid), dim3(NWAVES * 64), LDS_BYTES, stream, a);
#endif
#else
    const float* LB = (const float*)(ws + WS_LB); const float* ROPE = (const float*)(ws + WS_ROPE);
    bf16* PROJ = (bf16*)(ws + WS_PROJ); bf16* QR = (bf16*)(ws + WS_QR); bf16* KR = (bf16*)(ws + WS_KR); bf16* YAIN = (bf16*)(ws + WS_YAIN); bf16* ATT = (bf16*)(ws + WS_ATT);
    float* OF = (float*)(ws + WS_CS); float* OB = (float*)(ws + WS_CS + 32 * MiB);
    a.ph_lo = 0; a.ph_hi = 3; a.li = 0; a.mask = 3;
    hipLaunchKernelGGL(mega, dim3(grid), dim3(NWAVES * 64), LDS_BYTES, stream, a);
#if TESTMODE == 1
    k_hgrn_naive<<<32, 256, 0, stream>>>(PROJ, LB, OF, OB);
    k_hgrn_post<<<T * 8 / 4, 256, 0, stream>>>(OF, OB, PROJ, (const float*)d_in[11], YAIN);
    a.ph_lo = 3; a.ph_hi = 6; a.li = 1; a.mask = 1;
    hipLaunchKernelGGL(mega, dim3(grid), dim3(NWAVES * 64), LDS_BYTES, stream, a);
#else
    k_rope<<<T * 640 / 256, 256, 0, stream>>>(PROJ, ROPE, QR, KR);
    k_attn_naive<<<BATCH * 8 * SEQ / 4, 256, 0, stream>>>(QR, KR, PROJ, (const float*)d_in[12], ATT);
    a.ph_lo = 3; a.ph_hi = 6; a.li = 1; a.mask = 2;
    hipLaunchKernelGGL(mega, dim3(grid), dim3(NWAVES * 64), LDS_BYTES, stream, a);
#endif
    a.ph_lo = 6; a.ph_hi = 13; a.li = 2; a.mask = 3;
    hipLaunchKernelGGL(mega, dim3(grid), dim3(NWAVES * 64), LDS_BYTES, stream, a);
#endif
}
```
